# Optimizing an MI355X kernel written in HIP

```python
import jax, jax.numpy as jnp
from jax import lax
import numpy as np

D_MODEL = 1024
BATCH = 2
SEQ = 8192
DEPTH = 1

N_HEADS_NSA = 8
HEAD_DIM = 64
N_KV_GROUPS = 2
HPG = N_HEADS_NSA // N_KV_GROUPS
CMP_BLOCK = 32
CMP_STRIDE = 16
CMP_HIDDEN = 128
SEL_BLOCK = 64
N_SELECT = 16
WINDOW = 512
Q_BLOCK = 128
NSA_W = N_HEADS_NSA * HEAD_DIM
GMLP_WIDTH = 512
GMLP_GROUPS = 4
GMLP_CHUNK = 128
GMLP_GROUP_DIM = GMLP_WIDTH // GMLP_GROUPS
MEM_TOKENS = 256
MEM_HEADS = 4
MEM_HEAD_DIM = 128
MEM_W = MEM_HEADS * MEM_HEAD_DIM
D_FF = -(-8 * D_MODEL // (3 * 256)) * 256
KV_W = 2 * N_KV_GROUPS * HEAD_DIM
GATE_W = 3 * N_HEADS_NSA
IN_W = NSA_W + 3 * KV_W + 2 * GMLP_WIDTH + GATE_W
SPLITS = [NSA_W, NSA_W + KV_W, NSA_W + 2 * KV_W, NSA_W + 3 * KV_W, NSA_W + 3 * KV_W + 2 * GMLP_WIDTH]

EPS = 1e-6
NEG = -1e30
FORCE_SCORE = 1e6

kernel_name = "nsa_gmlp_griffin_gated_hybrid"


def rmsnorm(x, g):
    xf = x.astype(jnp.float32)
    y = xf * lax.rsqrt(jnp.mean(xf * xf, axis=-1, keepdims=True) + EPS)
    return (y * g.astype(jnp.float32)).astype(x.dtype)


def layernorm(x, g):
    xf = x.astype(jnp.float32)
    xc = xf - jnp.mean(xf, axis=-1, keepdims=True)
    y = xc * lax.rsqrt(jnp.mean(xc * xc, axis=-1, keepdims=True) + EPS)
    return (y * g.astype(jnp.float32)).astype(x.dtype)


def masked_softmax(s, mask):
    s = jnp.where(mask, s, NEG)
    m = jnp.max(s, axis=-1, keepdims=True)
    p = jnp.where(mask, jnp.exp(s - m), 0.0)
    return p / jnp.maximum(jnp.sum(p, axis=-1, keepdims=True), 1e-30)


def alibi_slopes(n):
    return jnp.asarray([2.0 ** (-8.0 * (h + 1) / n) for h in range(n)], dtype=jnp.float32)


def compress(x, pe, w1, w2):
    B, T, G, Dh = x.shape
    c = x.reshape(B, T // CMP_STRIDE, CMP_STRIDE, G, Dh)
    blk = jnp.concatenate([c[:, :-1], c[:, 1:]], axis=2) + pe[None, None, :, None, :]
    flat = blk.transpose(0, 1, 3, 2, 4).reshape(B, T // CMP_STRIDE - 1, G, CMP_BLOCK * Dh)
    return jax.nn.gelu(flat @ w1) @ w2


def nsa_attention(q, k_cmp, v_cmp, k_slc, v_slc, k_win, v_win, gates):
    B, T = q.shape[0], q.shape[1]
    G, Dh = N_KV_GROUPS, HEAD_DIM
    n_cmp = k_cmp.shape[1]
    n_slc = T // SEL_BLOCK
    n_sel = min(N_SELECT, n_slc)
    n_qb = T // Q_BLOCK
    scale = Dh ** -0.5
    slopes = alibi_slopes(N_HEADS_NSA).reshape(G, HPG)[None, :, :, None, None]
    cmp_start = jnp.arange(n_cmp) * CMP_STRIDE
    cmp_end = cmp_start + CMP_BLOCK - 1
    sel_start = jnp.arange(n_slc) * SEL_BLOCK
    overlap = ((cmp_start[:, None] < sel_start[None, :] + SEL_BLOCK)
               & (cmp_end[:, None] >= sel_start[None, :])).astype(jnp.float32)
    kb = k_slc.reshape(B, n_slc, SEL_BLOCK, G, Dh).transpose(0, 3, 1, 2, 4)
    vb = v_slc.reshape(B, n_slc, SEL_BLOCK, G, Dh).transpose(0, 3, 1, 2, 4)
    kw = jnp.pad(k_win, ((0, 0), (WINDOW, 0), (0, 0), (0, 0)))
    vw = jnp.pad(v_win, ((0, 0), (WINDOW, 0), (0, 0), (0, 0)))
    qb = q.reshape(B, n_qb, Q_BLOCK, G, HPG, Dh).transpose(1, 0, 2, 3, 4, 5)
    gb = gates.reshape(B, n_qb, Q_BLOCK, G, HPG, 3).transpose(1, 0, 2, 3, 4, 5)
    starts = jnp.arange(n_qb, dtype=jnp.int32) * Q_BLOCK
    b_idx = jnp.arange(B)[:, None, None, None]
    g_idx = jnp.arange(G)[None, :, None, None]
    blk_ids = jnp.arange(n_slc)
    key_off = jnp.arange(SEL_BLOCK)
    win_off = jnp.arange(WINDOW + Q_BLOCK)

    def one_block(args):
        qi, gi, start = args
        t = start + jnp.arange(Q_BLOCK)
        s = jnp.einsum('bqghd,bigd->bghqi', qi, k_cmp).astype(jnp.float32) * scale
        s = s - slopes * (t[:, None] - cmp_end[None, :]).astype(jnp.float32)
        p_cmp = masked_softmax(s, cmp_end[None, :] <= t[:, None])
        o_cmp = jnp.einsum('bghqi,bigd->bqghd', p_cmp.astype(v_cmp.dtype), v_cmp)
        imp = jnp.einsum('bghqi,ij->bgqj', p_cmp, overlap)
        cur = t // SEL_BLOCK
        causal_blk = blk_ids[None, :] <= cur[:, None]
        forced = ((blk_ids[None, :] == 0) | (blk_ids[None, :] == cur[:, None])
                  | (blk_ids[None, :] == cur[:, None] - 1))
        rank = jnp.where(causal_blk, jnp.where(forced, FORCE_SCORE, imp), NEG)
        top_val, top_idx = lax.top_k(rank, n_sel)
        k_sel = kb[b_idx, g_idx, top_idx].reshape(B, G, Q_BLOCK, n_sel * SEL_BLOCK, Dh)
        v_sel = vb[b_idx, g_idx, top_idx].reshape(B, G, Q_BLOCK, n_sel * SEL_BLOCK, Dh)
        pos = top_idx[..., None] * SEL_BLOCK + key_off
        ok = (pos <= t[None, None, :, None, None]) & (top_val > NEG / 2)[..., None]
        pos = pos.reshape(B, G, Q_BLOCK, n_sel * SEL_BLOCK)
        ok = ok.reshape(B, G, Q_BLOCK, n_sel * SEL_BLOCK)
        s = jnp.einsum('bqghd,bgqsd->bghqs', qi, k_sel).astype(jnp.float32) * scale
        s = s - slopes * (t[None, None, :, None] - pos)[:, :, None].astype(jnp.float32)
        p = masked_softmax(s, ok[:, :, None])
        o_slc = jnp.einsum('bghqs,bgqsd->bqghd', p.astype(v_sel.dtype), v_sel)
        k_w = lax.dynamic_slice_in_dim(kw, start, WINDOW + Q_BLOCK, axis=1)
        v_w = lax.dynamic_slice_in_dim(vw, start, WINDOW + Q_BLOCK, axis=1)
        pos_w = start - WINDOW + win_off
        dist = t[:, None] - pos_w[None, :]
        s = jnp.einsum('bqghd,bsgd->bghqs', qi, k_w).astype(jnp.float32) * scale
        s = s - slopes * dist.astype(jnp.float32)
        p = masked_softmax(s, (dist >= 0) & (dist < WINDOW) & (pos_w[None, :] >= 0))
        o_win = jnp.einsum('bghqs,bsgd->bqghd', p.astype(v_w.dtype), v_w)
        return gi[..., 0:1] * o_cmp + gi[..., 1:2] * o_slc + gi[..., 2:3] * o_win

    out = lax.map(one_block, (qb, gb, starts))
    return out.transpose(1, 0, 2, 3, 4, 5).reshape(B, T, NSA_W)


def chunked_sgu(u, v, ln_g, w_s, b_s):
    B, T, _ = v.shape
    v = layernorm(v, ln_g)
    vc = v.reshape(B, T // GMLP_CHUNK, GMLP_CHUNK, GMLP_GROUPS, GMLP_GROUP_DIM)
    w = w_s * jnp.tril(jnp.ones((GMLP_CHUNK, GMLP_CHUNK), w_s.dtype))
    s = jnp.einsum('gts,bcsgd->bctgd', w, vc) + b_s.T[None, None, :, :, None]
    return u * s.reshape(B, T, GMLP_WIDTH)


def setup_inputs(seed: int = 0) -> dict:
    key = jax.random.key(seed)
    ks = iter(jax.random.split(key, 40))
    L = DEPTH

    def w(shape, fan_in):
        return jax.random.normal(next(ks), shape, jnp.float32) * fan_in ** -0.5

    def gain(shape):
        return 1.0 + 0.02 * jax.random.normal(next(ks), shape, jnp.float32)

    def small(shape, s):
        return s * jax.random.normal(next(ks), shape, jnp.float32)

    return {
        "x": jax.random.normal(next(ks), (BATCH, SEQ, D_MODEL), jnp.float32),
        "mem": jax.random.normal(next(ks), (BATCH, MEM_TOKENS, D_MODEL), jnp.float32),
        "norm_mix": gain((L, D_MODEL)),
        "w_in": w((L, D_MODEL, IN_W), D_MODEL),
        "w_cmp_k1": w((L, CMP_BLOCK * HEAD_DIM, CMP_HIDDEN), CMP_BLOCK * HEAD_DIM),
        "w_cmp_k2": w((L, CMP_HIDDEN, HEAD_DIM), CMP_HIDDEN),
        "w_cmp_v1": w((L, CMP_BLOCK * HEAD_DIM, CMP_HIDDEN), CMP_BLOCK * HEAD_DIM),
        "w_cmp_v2": w((L, CMP_HIDDEN, HEAD_DIM), CMP_HIDDEN),
        "pe_cmp_k": small((L, CMP_BLOCK, HEAD_DIM), 0.1),
        "pe_cmp_v": small((L, CMP_BLOCK, HEAD_DIM), 0.1),
        "ln_sgu": gain((L, GMLP_WIDTH)),
        "w_spatial": w((L, GMLP_GROUPS, GMLP_CHUNK, GMLP_CHUNK), GMLP_CHUNK),
        "b_spatial": 1.0 + small((L, GMLP_GROUPS, GMLP_CHUNK), 0.1),
        "w_proj_a": w((L, NSA_W, D_MODEL), NSA_W),
        "w_proj_b": w((L, GMLP_WIDTH, D_MODEL), GMLP_WIDTH),
        "w_merge": w((L, D_MODEL, 2 * D_MODEL), D_MODEL),
        "b_merge": small((L, 2 * D_MODEL), 0.1),
        "w_out": w((L, D_MODEL, D_MODEL), D_MODEL),
        "norm_mem_q": gain((L, D_MODEL)),
        "norm_mem_kv": gain((L, D_MODEL)),
        "w_mq": w((L, D_MODEL, MEM_W), D_MODEL),
        "w_mkv": w((L, D_MODEL, 2 * MEM_W), D_MODEL),
        "w_mo": w((L, MEM_W, D_MODEL), MEM_W),
        "norm_ffn": gain((L, D_MODEL)),
        "w_gate_up": w((L, D_MODEL, 2 * D_FF), D_MODEL),
        "w_down": w((L, D_FF, D_MODEL), D_FF),
        "norm_final": gain((D_MODEL,)),
    }


def reference(x, mem, norm_mix, w_in, w_cmp_k1, w_cmp_k2, w_cmp_v1, w_cmp_v2, pe_cmp_k, pe_cmp_v,
              ln_sgu, w_spatial, b_spatial, w_proj_a, w_proj_b, w_merge, b_merge, w_out,
              norm_mem_q, norm_mem_kv, w_mq, w_mkv, w_mo, norm_ffn, w_gate_up, w_down, norm_final):
    B, T, _ = x.shape
    n_mem = mem.shape[1]
    h = x
    for l in range(DEPTH):
        xn = rmsnorm(h, norm_mix[l])
        proj = xn @ w_in[l]
        q, kvc, kvs, kvw, uv, g_raw = jnp.split(proj, SPLITS, axis=-1)
        q = q.reshape(B, T, N_HEADS_NSA, HEAD_DIM)
        kvc = kvc.reshape(B, T, 2, N_KV_GROUPS, HEAD_DIM)
        kvs = kvs.reshape(B, T, 2, N_KV_GROUPS, HEAD_DIM)
        kvw = kvw.reshape(B, T, 2, N_KV_GROUPS, HEAD_DIM)
        k_cmp = compress(kvc[:, :, 0], pe_cmp_k[l], w_cmp_k1[l], w_cmp_k2[l])
        v_cmp = compress(kvc[:, :, 1], pe_cmp_v[l], w_cmp_v1[l], w_cmp_v2[l])
        nsa_gates = jax.nn.sigmoid(g_raw.astype(jnp.float32)).reshape(B, T, N_HEADS_NSA, 3).astype(q.dtype)
        o_nsa = nsa_attention(q, k_cmp, v_cmp, kvs[:, :, 0], kvs[:, :, 1], kvw[:, :, 0], kvw[:, :, 1], nsa_gates)
        u, v = jnp.split(jax.nn.gelu(uv), 2, axis=-1)
        o_sgu = chunked_sgu(u, v, ln_sgu[l], w_spatial[l], b_spatial[l])
        mg = jax.nn.sigmoid((xn @ w_merge[l] + b_merge[l]).astype(jnp.float32)).astype(h.dtype)
        mg = mg.reshape(B, T, 2, D_MODEL)
        mixed = mg[:, :, 0] * (o_nsa @ w_proj_a[l]) + mg[:, :, 1] * (o_sgu @ w_proj_b[l])
        h = h + mixed @ w_out[l]
        hq = (rmsnorm(h, norm_mem_q[l]) @ w_mq[l]).reshape(B, T, MEM_HEADS, MEM_HEAD_DIM)
        mkv = (rmsnorm(mem, norm_mem_kv[l]) @ w_mkv[l]).reshape(B, n_mem, 2, MEM_HEADS, MEM_HEAD_DIM)
        s = jnp.einsum('bthd,bnhd->bhtn', hq, mkv[:, :, 0]).astype(jnp.float32) * MEM_HEAD_DIM ** -0.5
        p = jax.nn.softmax(s, axis=-1).astype(h.dtype)
        o = jnp.einsum('bhtn,bnhd->bthd', p, mkv[:, :, 1]).reshape(B, T, MEM_W)
        h = h + o @ w_mo[l]
        gate, up = jnp.split(rmsnorm(h, norm_ffn[l]) @ w_gate_up[l], 2, axis=-1)
        h = h + (jax.nn.silu(gate) * up) @ w_down[l]
    return rmsnorm(h, norm_final)
```

```cpp
#include <hip/hip_runtime.h>
#include <hip/hip_cooperative_groups.h>
#include <stdint.h>
#include <stdio.h>
namespace cg = cooperative_groups;

#ifndef NSA_G0
#define NSA_G0 1.f
#define NSA_G1 1.f
#define NSA_G2 1.f
#endif
#ifndef ONE_LAUNCH
#define ONE_LAUNCH 1
#endif

typedef unsigned short bf16_t;
using bf16x8 = __attribute__((ext_vector_type(8))) short;
using f32x4 = __attribute__((ext_vector_type(4))) float;
using u32x4 = __attribute__((ext_vector_type(4))) unsigned;
using u32x2 = __attribute__((ext_vector_type(2))) unsigned;

#define T_ 8192
#define M_ 16384
#define NEGF (-1e30f)
#define LOG2E 1.4426950408889634f

constexpr long OFF_W1 = 0;
constexpr long OFF_WMKV = OFF_W1 + 9175040;
constexpr long OFF_WPA = OFF_WMKV + 2097152;
constexpr long OFF_WPB = OFF_WPA + 1048576;
constexpr long OFF_WOUT = OFF_WPB + 1048576;
constexpr long OFF_WMQ = OFF_WOUT + 2097152;
constexpr long OFF_WMO = OFF_WMQ + 1048576;
constexpr long OFF_WGU = OFF_WMO + 1048576;
constexpr long OFF_WDN = OFF_WGU + 11534336;
constexpr long OFF_WCK1 = OFF_WDN + 5767168;
constexpr long OFF_WCV1 = OFF_WCK1 + 524288;
constexpr long OFF_WM = OFF_WCV1 + 524288;
constexpr long OFF_BIAS1 = OFF_WM + 131072;
constexpr long OFF_MEMN = OFF_BIAS1 + 1024;
constexpr long OFF_MK = OFF_MEMN + 1048576;
constexpr long OFF_MVT = OFF_MK + 524288;
constexpr long OFF_KCMP = OFF_MVT + 524288;
constexpr long OFF_VCT = OFF_KCMP + 262144;
constexpr long OFF_A = OFF_VCT + 262144;
constexpr long OFF_B = OFF_A + 33554432;
constexpr long OFF_D = OFF_B + 67108864;
constexpr long OFF_C = OFF_D + 33554432;
constexpr long C_Q = 0, C_U = 16777216, C_GVT = 33554432, C_KC = 50331648, C_VC = 54525952, C_KS = 58720256,
               C_KW = 62914560, C_VST = 67108864, C_VWT = 71303168, C_GATES = 75497472;
constexpr long C_MIXED = 0, C_SCR = 33554432, C_H2 = 0;
constexpr long OFF_BAR = OFF_C + 77070336;
constexpr long WS_NEED = OFF_BAR + 256;

struct Params {
  const float *x, *mem, *norm_mix, *w_in, *w_ck1, *w_ck2, *w_cv1, *w_cv2, *pe_k, *pe_v, *ln_sgu, *w_sp, *b_sp,
      *w_pa, *w_pb, *w_merge, *b_merge, *w_out, *norm_mq, *norm_mkv, *w_mq, *w_mkv, *w_mo, *norm_ffn, *w_gu, *w_dn, *norm_final;
  float* out;
  char* ws;
};

__device__ __forceinline__ int tidx() { int t = threadIdx.x; asm volatile("" : "+v"(t)); return t; }
__device__ __forceinline__ unsigned f2bf(float f) { unsigned u = __float_as_uint(f); u += 0x7fffu + ((u >> 16) & 1u); return u >> 16; }
__device__ __forceinline__ unsigned pack2(float a, float b) { return f2bf(a) | (f2bf(b) << 16); }
__device__ __forceinline__ float bf2f(unsigned h) { return __uint_as_float(h << 16); }
__device__ __forceinline__ float gelu_tanh(float x) { float u = 0.7978845608028654f * (x + 0.044715f * x * x * x); return x / (1.f + __expf(-2.f * u)); }
__device__ __forceinline__ float sigm(float x) { return 1.f / (1.f + __expf(-x)); }
__device__ __forceinline__ float wave_sum(float v) {
#pragma unroll
  for (int o = 32; o > 0; o >>= 1) v += __shfl_xor(v, o, 64);
  return v;
}
__device__ __forceinline__ u32x4 pack8(const float (&v)[8]) {
  u32x4 r; r[0] = pack2(v[0], v[1]); r[1] = pack2(v[2], v[3]); r[2] = pack2(v[4], v[5]); r[3] = pack2(v[6], v[7]); return r;
}

__device__ __forceinline__ int lds_byte(int r, int c) {
  int st = (r >> 4) * 2 + (c >> 5), rr = r & 15, cc = c & 31, ob = rr * 64 + cc * 2;
  return st * 1024 + (ob ^ (((ob >> 9) & 1) << 5));
}
__device__ __forceinline__ void stage_rc(int b, int& R, int& C) {
  int st = b >> 10, sb = b & 1023, swz = sb ^ (((sb >> 9) & 1) << 5);
  R = (st >> 1) * 16 + (swz >> 6); C = (st & 1) * 32 + ((swz & 63) >> 1);
}

#define CS_LD 132
__device__ __forceinline__ void ld8(const float* Cs, int r, int c, float (&v)[8]) {
  f32x4 a = *(const f32x4*)(Cs + r * CS_LD + c); f32x4 b = *(const f32x4*)(Cs + r * CS_LD + c + 4);
  v[0] = a[0]; v[1] = a[1]; v[2] = a[2]; v[3] = a[3]; v[4] = b[0]; v[5] = b[1]; v[6] = b[2]; v[7] = b[3];
}
__device__ __forceinline__ void ld8T(const float* Cs, int r8, int c, float (&v)[8]) {
#pragma unroll
  for (int i = 0; i < 8; ++i) v[i] = Cs[(r8 + i) * CS_LD + c];
}

struct RowLin {
  const bf16_t* base; long ld;
  __device__ __forceinline__ const bf16_t* operator()(int r) const { return base + (long)r * ld; }
};
struct RowCmp {
  const bf16_t* base; int brow;
  __device__ __forceinline__ const bf16_t* operator()(int r) const {
    int R = brow + r; int b = R >> 10, rem = R & 1023, i = rem >> 1, g = rem & 1; if (i > 510) i = 510;
    return base + ((long)(b * T_ + 16 * i) * 128 + g * 64);
  }
};

template <int AUX = 0, class ARow, class BRow, class Epi>
__device__ __forceinline__ void gemm_tile(char* smem, ARow arow, BRow brow, int nkt, int kstepA, int kstepB, Epi epi) {
  const int tid = tidx(), lane = tid & 63, wave = tid >> 6, wr = wave >> 1, wc = wave & 1, fr = lane & 15, fq = lane >> 4;
  const bf16_t* pa[4]; const bf16_t* pb[4];
#pragma unroll
  for (int i = 0; i < 4; ++i) { int b = tid * 16 + i * 4096; int R, C; stage_rc(b, R, C); pa[i] = arow(R) + C; pb[i] = brow(R) + C; }
  f32x4 acc[4][4];
#pragma unroll
  for (int m = 0; m < 4; ++m)
#pragma unroll
    for (int n = 0; n < 4; ++n) acc[m][n] = (f32x4){0.f, 0.f, 0.f, 0.f};
  {
#pragma unroll
    for (int i = 0; i < 4; ++i) {
      __builtin_amdgcn_global_load_lds((const unsigned*)(pa[i]), (unsigned*)(smem + tid * 16 + i * 4096), 16, 0, AUX);
      __builtin_amdgcn_global_load_lds((const unsigned*)(pb[i]), (unsigned*)(smem + 16384 + tid * 16 + i * 4096), 16, 0, AUX);
    }
  }
  for (int kt = 0; kt < nkt; ++kt) {
    asm volatile("s_waitcnt vmcnt(0)" ::: "memory");
    __syncthreads();
    if (kt + 1 < nkt) {
      char* la = smem + ((kt + 1) & 1) * 32768;
#pragma unroll
      for (int i = 0; i < 4; ++i) {
        __builtin_amdgcn_global_load_lds((const unsigned*)(pa[i] + (long)(kt + 1) * kstepA), (unsigned*)(la + tid * 16 + i * 4096), 16, 0, AUX);
        __builtin_amdgcn_global_load_lds((const unsigned*)(pb[i] + (long)(kt + 1) * kstepB), (unsigned*)(la + 16384 + tid * 16 + i * 4096), 16, 0, AUX);
      }
    }
    const char* la = smem + (kt & 1) * 32768; const char* lb = la + 16384;
#pragma unroll
    for (int ks = 0; ks < 2; ++ks) {
      bf16x8 a[4], b[4];
#pragma unroll
      for (int m = 0; m < 4; ++m) a[m] = *(const bf16x8*)(la + lds_byte(wr * 64 + m * 16 + fr, ks * 32 + fq * 8));
#pragma unroll
      for (int n = 0; n < 4; ++n) b[n] = *(const bf16x8*)(lb + lds_byte(wc * 64 + n * 16 + fr, ks * 32 + fq * 8));
#pragma unroll
      for (int m = 0; m < 4; ++m)
#pragma unroll
        for (int n = 0; n < 4; ++n) acc[m][n] = __builtin_amdgcn_mfma_f32_16x16x32_bf16(a[m], b[n], acc[m][n], 0, 0, 0);
    }
  }
  __syncthreads();
  float* Cs = (float*)smem;
#pragma unroll
  for (int m = 0; m < 4; ++m)
#pragma unroll
    for (int n = 0; n < 4; ++n)
#pragma unroll
      for (int r = 0; r < 4; ++r) Cs[(wr * 64 + m * 16 + fq * 4 + r) * CS_LD + wc * 64 + n * 16 + fr] = acc[m][n][r];
  __syncthreads();
  epi(Cs);
  __syncthreads();
}

template <class F>
__device__ __forceinline__ void store_rows_bf16(const float* Cs, bf16_t* dst, long ld, F f) {
#pragma unroll 2
  for (int it = 0; it < 8; ++it) {
    int id = it * 256 + tidx(); int r = id >> 4, c = (id & 15) * 8;
    float v[8]; ld8(Cs, r, c, v);
#pragma unroll
    for (int i = 0; i < 8; ++i) v[i] = f(v[i], c + i);
    *(u32x4*)(dst + (long)r * ld + c) = pack8(v);
  }
}
template <class F>
__device__ __forceinline__ void store_T_bf16(const float* Cs, bf16_t* dst, long cstride, F f) {
#pragma unroll 2
  for (int it = 0; it < 8; ++it) {
    int id = it * 256 + tidx(); int c = id >> 4, r8 = (id & 15) * 8;
    float v[8]; ld8T(Cs, r8, c, v);
#pragma unroll
    for (int i = 0; i < 8; ++i) v[i] = f(v[i]);
    *(u32x4*)(dst + (long)c * cstride + r8) = pack8(v);
  }
}

template <int MODE>
__device__ __forceinline__ void transpose_tile(const float* W, int Nsrc, bf16_t* Wt, int Kd, int k0, int n0, float* lds) {
  const int tid = tidx();
  {
    int tx = tid & 63, ty = tid >> 6; int np = n0 + tx; int sc;
    if (MODE == 0) sc = np < Nsrc ? np : -1;
    else { int x = np & 127, tl = np >> 7; sc = x < 64 ? tl * 64 + x : 2816 + tl * 64 + x - 64; }
#pragma unroll 4
    for (int kk = ty; kk < 64; kk += 4) lds[kk * 65 + tx] = sc >= 0 ? W[(long)(k0 + kk) * Nsrc + sc] : 0.f;
  }
  __syncthreads();
  {
    int nrow = tid >> 2, kseg = (tid & 3) * 16; float v[8];
#pragma unroll
    for (int i = 0; i < 8; ++i) v[i] = lds[(kseg + i) * 65 + nrow];
    *(u32x4*)(Wt + (long)(n0 + nrow) * Kd + k0 + kseg) = pack8(v);
#pragma unroll
    for (int i = 0; i < 8; ++i) v[i] = lds[(kseg + 8 + i) * 65 + nrow];
    *(u32x4*)(Wt + (long)(n0 + nrow) * Kd + k0 + kseg + 8) = pack8(v);
  }
  __syncthreads();
}

template <bool OUTF>
__device__ __forceinline__ void rownorm_row(const float* src, const float* g, void* dst) {
  const int lane = tidx() & 63;
  f32x4 v[4]; float ss = 0.f;
#pragma unroll
  for (int i = 0; i < 4; ++i) { v[i] = *(const f32x4*)(src + i * 256 + lane * 4); ss += v[i][0] * v[i][0] + v[i][1] * v[i][1] + v[i][2] * v[i][2] + v[i][3] * v[i][3]; }
  ss = wave_sum(ss);
  float r = rsqrtf(ss * (1.f / 1024.f) + 1e-6f);
#pragma unroll
  for (int i = 0; i < 4; ++i) {
    f32x4 gg = *(const f32x4*)(g + i * 256 + lane * 4);
    float o0 = v[i][0] * r * gg[0], o1 = v[i][1] * r * gg[1], o2 = v[i][2] * r * gg[2], o3 = v[i][3] * r * gg[3];
    if (OUTF) { *(f32x4*)((float*)dst + i * 256 + lane * 4) = (f32x4){o0, o1, o2, o3}; }
    else { u32x2 p; p[0] = pack2(o0, o1); p[1] = pack2(o2, o3); *(u32x2*)((bf16_t*)dst + i * 256 + lane * 4) = p; }
  }
}

__device__ void phase0(const Params& P, char* smem) {
  float* lds = (float*)smem;
  const int tid = tidx();
  const int NJ = 8 + 4096 + 128 + 32 + 4384;
  for (int job = blockIdx.x; job < NJ; job += gridDim.x) {
    int j = job;
    if (j < 8) {
      int n = j * 32 + (tid & 31), sl = tid >> 5; int kv = n >> 7, nn = n & 127;
      const float* pe = kv ? P.pe_v : P.pe_k; const float* w1 = kv ? P.w_cv1 : P.w_ck1;
      float s = 0.f;
      for (int k = sl * 256; k < sl * 256 + 256; ++k) s += pe[k] * w1[(long)k * 128 + nn];
      lds[sl * 32 + (tid & 31)] = s;
      __syncthreads();
      if (tid < 32) { float t = 0.f; for (int q = 0; q < 8; ++q) t += lds[q * 32 + tid]; ((float*)(P.ws + OFF_BIAS1))[j * 32 + tid] = t; }
      __syncthreads();
      continue;
    }
    j -= 8;
    if (j < 4096) { int row = j * 4 + (tid >> 6); rownorm_row<false>(P.x + (long)row * 1024, P.norm_mix, (bf16_t*)(P.ws + OFF_A) + (long)row * 1024); continue; }
    j -= 4096;
    if (j < 128) { int row = j * 4 + (tid >> 6); rownorm_row<false>(P.mem + (long)row * 1024, P.norm_mkv, (bf16_t*)(P.ws + OFF_MEMN) + (long)row * 1024); continue; }
    j -= 128;
    if (j < 32) {
      int e0 = j * 2048 + tid * 8; float v[8];
#pragma unroll
      for (int i = 0; i < 8; ++i) { int e = e0 + i; int t = (e >> 7) & 127, s = e & 127; v[i] = s <= t ? P.w_sp[e] : 0.f; }
      *(u32x4*)((bf16_t*)(P.ws + OFF_WM) + e0) = pack8(v);
      continue;
    }
    j -= 32;
#define TRJ(KT, NT, W, NSRC, WT, KD, MODE) \
    if (j < (KT) * (NT)) { transpose_tile<MODE>(W, NSRC, (bf16_t*)(P.ws + (WT)), KD, (j % (KT)) * 64, (j / (KT)) * 64, lds); continue; } \
    j -= (KT) * (NT);
    TRJ(16, 88, P.w_gu, 5632, OFF_WGU, 1024, 1)
    TRJ(44, 16, P.w_dn, 1024, OFF_WDN, 2816, 0)
    TRJ(16, 38, P.w_in, 2328, OFF_W1, 1024, 0)
    TRJ(16, 32, P.w_merge, 2048, OFF_W1 + 2432L * 1024 * 2, 1024, 0)
    TRJ(16, 16, P.w_mkv, 1024, OFF_WMKV, 1024, 0)
    TRJ(16, 16, P.w_out, 1024, OFF_WOUT, 1024, 0)
    TRJ(8, 16, P.w_pa, 1024, OFF_WPA, 512, 0)
    TRJ(8, 16, P.w_pb, 1024, OFF_WPB, 512, 0)
    TRJ(16, 8, P.w_mq, 512, OFF_WMQ, 1024, 0)
    TRJ(8, 16, P.w_mo, 1024, OFF_WMO, 512, 0)
    TRJ(32, 2, P.w_ck1, 128, OFF_WCK1, 2048, 0)
    TRJ(32, 2, P.w_cv1, 128, OFF_WCV1, 2048, 0)
#undef TRJ
  }
}

__device__ void phase1(const Params& P, char* smem) {
  char* ws = P.ws;
  const int NG1 = 128 * 35;
  for (int job = blockIdx.x; job < NG1 + 32; job += gridDim.x) {
    if (job < NG1) {
      const int mt = job / 35, nt = job % 35; const int brow = mt * 128;
      RowLin ar{(const bf16_t*)(ws + OFF_A) + (long)brow * 1024, 1024};
      RowLin br{(const bf16_t*)(ws + OFF_W1) + (long)nt * 128 * 1024, 1024};
      gemm_tile(smem, ar, br, 16, 64, 64, [&](const float* Cs) {
        char* C = ws + OFF_C;
        if (nt < 4) {
          store_rows_bf16(Cs, (bf16_t*)(C + C_Q) + (long)brow * 512 + nt * 128, 512, [](float v, int) { return v * (0.125f * LOG2E); });
        } else if (nt == 4 || nt == 5 || nt == 6 || nt == 8) {
          long off = nt == 4 ? C_KC : nt == 5 ? C_VC : nt == 6 ? C_KS : C_KW;
          store_rows_bf16(Cs, (bf16_t*)(C + off) + (long)brow * 128, 128, [](float v, int) { return v; });
        } else if (nt == 7 || nt == 9) {
          long off = nt == 7 ? C_VST : C_VWT; int b = brow >> 13, tl = brow & 8191;
          store_T_bf16(Cs, (bf16_t*)(C + off) + (long)b * 128 * T_ + tl, T_, [](float v) { return v; });
        } else if (nt < 14) {
          store_rows_bf16(Cs, (bf16_t*)(C + C_U) + (long)brow * 512 + (nt - 10) * 128, 512, [](float v, int) { return gelu_tanh(v); });
        } else if (nt < 18) {
          store_T_bf16(Cs, (bf16_t*)(C + C_GVT) + ((long)(brow >> 7) * 512 + (nt - 14) * 128) * 128, 128, [](float v) { return gelu_tanh(v); });
        } else if (nt == 18) {
          float* gates = (float*)(C + C_GATES);
          for (int id = tidx(); id < 128 * 24; id += 256) { int r = id / 24, c = id % 24; gates[(long)(brow + r) * 24 + c] = sigm(Cs[r * CS_LD + c]); }
        } else {
          const float* bm = P.b_merge + (nt - 19) * 128;
          store_rows_bf16(Cs, (bf16_t*)(ws + OFF_B) + (long)brow * 2048 + (nt - 19) * 128, 2048, [bm](float v, int c) { return sigm(v + bm[c]); });
        }
      });
    } else {
      const int j = job - NG1; const int mt = j >> 3, nt = j & 7; const int brow = mt * 128;
      RowLin ar{(const bf16_t*)(ws + OFF_MEMN) + (long)brow * 1024, 1024};
      RowLin br{(const bf16_t*)(ws + OFF_WMKV) + (long)nt * 128 * 1024, 1024};
      gemm_tile(smem, ar, br, 16, 64, 64, [&](const float* Cs) {
        if (nt < 4) store_rows_bf16(Cs, (bf16_t*)(ws + OFF_MK) + (long)brow * 512 + nt * 128, 512, [](float v, int) { return v; });
        else { int b = mt >> 1, n0 = (mt & 1) * 128; store_T_bf16(Cs, (bf16_t*)(ws + OFF_MVT) + ((long)b * 512 + (nt - 4) * 128) * 256 + n0, 256, [](float v) { return v; }); }
      });
    }
  }
}

__device__ void phase2(const Params& P, char* smem) {
  char* ws = P.ws; const int tid = tidx();
  for (int job = blockIdx.x; job < 32 + 128; job += gridDim.x) {
    if (job < 32) {
      const int kv = job >> 4, mt = job & 15, brow = mt * 128;
      RowCmp ar{(const bf16_t*)(ws + OFF_C + (kv ? C_VC : C_KC)), brow};
      RowLin br{(const bf16_t*)(ws + (kv ? OFF_WCV1 : OFF_WCK1)), 2048};
      const float* bias1 = (const float*)(ws + OFF_BIAS1) + kv * 128;
      const float* w2 = kv ? P.w_cv2 : P.w_ck2;
      gemm_tile(smem, ar, br, 32, 128, 64, [&](const float* Csc) {
        float* Cs = (float*)Csc;
        for (int it = 0; it < 64; ++it) { int id = it * 256 + tid; int r = id >> 7, n = id & 127; Cs[r * CS_LD + n] = gelu_tanh(Cs[r * CS_LD + n] + bias1[n]); }
        __syncthreads();
        const int r = tid >> 1, half = tid & 1;
        float acc[32];
#pragma unroll
        for (int i = 0; i < 32; ++i) acc[i] = 0.f;
        for (int n = 0; n < 128; ++n) {
          float h = Cs[r * CS_LD + n]; const float* wr = w2 + n * 64 + half * 32;
#pragma unroll
          for (int q = 0; q < 8; ++q) { f32x4 w = *(const f32x4*)(wr + q * 4); acc[q * 4] += h * w[0]; acc[q * 4 + 1] += h * w[1]; acc[q * 4 + 2] += h * w[2]; acc[q * 4 + 3] += h * w[3]; }
        }
        const int R = brow + r; const int b = R >> 10, rem = R & 1023, i = rem >> 1, g = rem & 1;
        if (i >= 511) {
#pragma unroll
          for (int q = 0; q < 32; ++q) acc[q] = 0.f;
        }
        if (kv == 0) {
          bf16_t* dst = (bf16_t*)(ws + OFF_KCMP) + (long)(b * 512 + i) * 128 + g * 64 + half * 32;
#pragma unroll
          for (int q = 0; q < 4; ++q) { float v[8];
#pragma unroll
            for (int e = 0; e < 8; ++e) v[e] = acc[q * 8 + e];
            *(u32x4*)(dst + q * 8) = pack8(v); }
        } else {
          bf16_t* dst = (bf16_t*)(ws + OFF_VCT) + ((long)(b * 128 + g * 64 + half * 32)) * 512 + i;
#pragma unroll
          for (int q = 0; q < 32; ++q) dst[(long)q * 512] = (bf16_t)f2bf(acc[q]);
        }
      });
    } else {
      const int bc = job - 32; bf16_t* base = (bf16_t*)(ws + OFF_C + C_GVT) + (long)bc * 512 * 128;
      float* ssum = (float*)smem; float* ssq = ssum + 128;
      float* psum = ssum + 256; float* psq = psum + 16 * 128;
      const int cs = tid >> 4, s8 = (tid & 15) * 8;
      float a[8], q[8];
#pragma unroll
      for (int i = 0; i < 8; ++i) { a[i] = 0.f; q[i] = 0.f; }
      for (int it = 0; it < 32; ++it) {
        u32x4 d = *(const u32x4*)(base + (long)(it * 16 + cs) * 128 + s8);
#pragma unroll
        for (int i = 0; i < 4; ++i) { float lo = bf2f(d[i] & 0xffffu), hi = bf2f(d[i] >> 16); a[2 * i] += lo; q[2 * i] += lo * lo; a[2 * i + 1] += hi; q[2 * i + 1] += hi * hi; }
      }
#pragma unroll
      for (int i = 0; i < 8; ++i) { psum[cs * 128 + s8 + i] = a[i]; psq[cs * 128 + s8 + i] = q[i]; }
      __syncthreads();
      if (tid < 128) {
        float su = 0.f, sq = 0.f;
        for (int c = 0; c < 16; ++c) { su += psum[c * 128 + tid]; sq += psq[c * 128 + tid]; }
        float mean_t = su * (1.f / 512.f); float var = sq * (1.f / 512.f) - mean_t * mean_t; if (var < 0.f) var = 0.f;
        ssum[tid] = mean_t; ssq[tid] = rsqrtf(var + 1e-6f);
      }
      __syncthreads();
      float mean[8], rs[8];
#pragma unroll
      for (int i = 0; i < 8; ++i) { mean[i] = ssum[s8 + i]; rs[i] = ssq[s8 + i]; }
      for (int it = 0; it < 32; ++it) {
        int ch = it * 16 + cs; float gg = P.ln_sgu[ch];
        u32x4 d = *(const u32x4*)(base + (long)ch * 128 + s8); float v[8];
#pragma unroll
        for (int i = 0; i < 4; ++i) { v[2 * i] = bf2f(d[i] & 0xffffu); v[2 * i + 1] = bf2f(d[i] >> 16); }
#pragma unroll
        for (int i = 0; i < 8; ++i) v[i] = (v[i] - mean[i]) * rs[i] * gg;
        *(u32x4*)(base + (long)ch * 128 + s8) = pack8(v);
      }
      __syncthreads();
    }
  }
}

template <int MODE>
__device__ __forceinline__ void nsa_block(const bf16x8 (&qf)[4][2], f32x4 (&oacc)[4][4], float (&m)[4], float (&l)[4],
                                          const float (&sl2)[4], const float (&inv)[4], const bf16_t* kp, const bf16_t* vp, long vdt,
                                          int dist0, bool rowok, float (&asum)[2], float (&bsum)[2]) {
  constexpr int DSTEP = (MODE <= 1) ? 16 : 1;
  bf16x8 kf[2][2];
#pragma unroll
  for (int kt = 0; kt < 2; ++kt)
#pragma unroll
    for (int ks = 0; ks < 2; ++ks) kf[kt][ks] = *(const bf16x8*)(kp + kt * 16 * 128 + ks * 32);
  bf16x8 vf[4];
  if (MODE != 0) {
#pragma unroll
    for (int dt = 0; dt < 4; ++dt) {
      u32x2 lo = *(const u32x2*)(vp + dt * vdt); u32x2 hi = *(const u32x2*)(vp + dt * vdt + 16);
      u32x4 c; c[0] = lo[0]; c[1] = lo[1]; c[2] = hi[0]; c[3] = hi[1];
      vf[dt] = __builtin_bit_cast(bf16x8, c);
    }
  }
  const float fd0 = (float)dist0;
#pragma unroll
  for (int h = 0; h < 4; ++h) {
    f32x4 s[2];
#pragma unroll
    for (int kt = 0; kt < 2; ++kt) {
      s[kt] = __builtin_amdgcn_mfma_f32_16x16x32_bf16(kf[kt][0], qf[h][0], (f32x4){0.f, 0.f, 0.f, 0.f}, 0, 0, 0);
      s[kt] = __builtin_amdgcn_mfma_f32_16x16x32_bf16(kf[kt][1], qf[h][1], s[kt], 0, 0, 0);
    }
    float sc[8]; bool ok[8];
#pragma unroll
    for (int kt = 0; kt < 2; ++kt)
#pragma unroll
      for (int r = 0; r < 4; ++r) {
        const int e = kt * 16 + r; const int dist = dist0 - DSTEP * e;
        sc[kt * 4 + r] = s[kt][r] - sl2[h] * (fd0 - (float)(DSTEP * e));
        bool o = dist >= 0;
        if (MODE == 2) o = o && rowok;
        if (MODE == 3) o = o && (dist < 512);
        ok[kt * 4 + r] = o;
      }
    float p[8];
    if (MODE != 1) {
      float ml = NEGF;
#pragma unroll
      for (int i = 0; i < 8; ++i) ml = fmaxf(ml, ok[i] ? sc[i] : NEGF);
      ml = fmaxf(ml, __shfl_xor(ml, 16, 64)); ml = fmaxf(ml, __shfl_xor(ml, 32, 64));
      const float mn = fmaxf(m[h], ml); const float alpha = __builtin_amdgcn_exp2f(m[h] - mn); m[h] = mn;
      float ps = 0.f;
#pragma unroll
      for (int i = 0; i < 8; ++i) { p[i] = ok[i] ? __builtin_amdgcn_exp2f(sc[i] - mn) : 0.f; ps += p[i]; }
      l[h] = l[h] * alpha + ps;
      if (MODE != 0) {
#pragma unroll
        for (int dt = 0; dt < 4; ++dt) oacc[h][dt] *= alpha;
      }
    } else {
#pragma unroll
      for (int i = 0; i < 8; ++i) p[i] = ok[i] ? __builtin_amdgcn_exp2f(sc[i] - m[h]) * l[h] : 0.f;
      asum[0] += (p[0] + p[1]) + (p[2] + p[3]); bsum[0] += p[3];
      asum[1] += (p[4] + p[5]) + (p[6] + p[7]); bsum[1] += p[7];
    }
    if (MODE != 0) {
      u32x4 pk; pk[0] = pack2(p[0], p[1]); pk[1] = pack2(p[2], p[3]); pk[2] = pack2(p[4], p[5]); pk[3] = pack2(p[6], p[7]);
      const bf16x8 pf = __builtin_bit_cast(bf16x8, pk);
#pragma unroll
      for (int dt = 0; dt < 4; ++dt) oacc[h][dt] = __builtin_amdgcn_mfma_f32_16x16x32_bf16(vf[dt], pf, oacc[h][dt], 0, 0, 0);
    }
    __builtin_amdgcn_sched_barrier(0);
  }
}

__device__ void nsa_tile(const Params& P, int wt, char* wl) {
  char* C = P.ws + OFF_C;
  const bf16_t* Q = (const bf16_t*)(C + C_Q);
  const bf16_t* KCMP = (const bf16_t*)(P.ws + OFF_KCMP); const bf16_t* VCT = (const bf16_t*)(P.ws + OFF_VCT);
  const bf16_t* KS = (const bf16_t*)(C + C_KS); const bf16_t* VST = (const bf16_t*)(C + C_VST);
  const bf16_t* KW = (const bf16_t*)(C + C_KW); const bf16_t* VWT = (const bf16_t*)(C + C_VWT);
  const float* GATES = (const float*)(C + C_GATES);
  bf16_t* O = (bf16_t*)(P.ws + OFF_D);
  const int lane = tidx() & 63, qi = lane & 15, quad = lane >> 4;
  wt = __builtin_amdgcn_readfirstlane(wt);
  const int bg = wt & 3, b = bg >> 1, g = bg & 1;
  const int t0 = (511 - (wt >> 2)) * 16;
  const int t = t0 + qi;
  const long row = (long)b * T_ + t;
  bf16x8 qf[4][2];
#pragma unroll
  for (int h = 0; h < 4; ++h)
#pragma unroll
    for (int ks = 0; ks < 2; ++ks) qf[h][ks] = *(const bf16x8*)(Q + row * 512 + (g * 4 + h) * 64 + ks * 32 + quad * 8);
  float sl2[4];
#pragma unroll
  for (int h = 0; h < 4; ++h) sl2[h] = __builtin_amdgcn_exp2f(-(float)(g * 4 + h + 1)) * LOG2E;
  f32x4 oacc[4][4]; float m[4], l[4], inv[4]; float asum[2], bsum[2];
  float* imp = (float*)wl; float* outl = (float*)wl;
  unsigned* sel = (unsigned*)(wl + 16384); unsigned* uni = sel + 64;
#pragma unroll
  for (int h = 0; h < 4; ++h) { m[h] = NEGF; l[h] = 0.f; inv[h] = 0.f; }
  asum[0] = asum[1] = bsum[0] = bsum[1] = 0.f;

  const int nI = t0 >> 4; const int nblk = (nI + 31) >> 5;
  for (int blk = 0; blk < nblk; ++blk) {
    const int key0 = blk * 32;
    const bf16_t* kp = KCMP + (long)(b * 512 + key0 + qi) * 128 + g * 64 + quad * 8;
    nsa_block<0>(qf, oacc, m, l, sl2, inv, kp, nullptr, 0, t - 31 - 16 * (key0 + quad * 4), true, asum, bsum);
  }
#pragma unroll
  for (int h = 0; h < 4; ++h) { float lt = l[h]; lt += __shfl_xor(lt, 16, 64); lt += __shfl_xor(lt, 32, 64); l[h] = 1.f / fmaxf(lt, 1e-30f); }
  for (int i = lane; i < 16 * 132; i += 64) imp[i] = 0.f;
#pragma unroll
  for (int h = 0; h < 4; ++h)
#pragma unroll
    for (int dt = 0; dt < 4; ++dt) oacc[h][dt] = (f32x4){0.f, 0.f, 0.f, 0.f};
  for (int blk = 0; blk < nblk; ++blk) {
    const int key0 = blk * 32;
    const bf16_t* kp = KCMP + (long)(b * 512 + key0 + qi) * 128 + g * 64 + quad * 8;
    const bf16_t* vp = VCT + (long)(b * 128 + g * 64 + qi) * 512 + key0 + quad * 4;
    asum[0] = asum[1] = bsum[0] = bsum[1] = 0.f;
    nsa_block<1>(qf, oacc, m, l, sl2, inv, kp, vp, 16 * 512, t - 31 - 16 * (key0 + quad * 4), true, asum, bsum);
    const int J = (key0 >> 2) + quad;
    atomicAdd(&imp[qi * 132 + J], asum[0]); atomicAdd(&imp[qi * 132 + J + 1], bsum[0]);
    atomicAdd(&imp[qi * 132 + J + 4], asum[1]); atomicAdd(&imp[qi * 132 + J + 5], bsum[1]);
  }
  const int cur = t0 >> 6;
  if (lane < 16) {
    unsigned w0 = 0, w1 = 0, w2 = 0, w3 = 0;
    if (cur < 16) { w0 = (1u << (cur + 1)) - 1u; }
    else {
      w0 = 1u;
      { int j = cur; unsigned bit = 1u << (j & 31); int w = j >> 5; if (w == 0) w0 |= bit; else if (w == 1) w1 |= bit; else if (w == 2) w2 |= bit; else w3 |= bit; }
      { int j = cur - 1; unsigned bit = 1u << (j & 31); int w = j >> 5; if (w == 0) w0 |= bit; else if (w == 1) w1 |= bit; else if (w == 2) w2 |= bit; else w3 |= bit; }
    }
    sel[lane * 4 + 0] = w0; sel[lane * 4 + 1] = w1; sel[lane * 4 + 2] = w2; sel[lane * 4 + 3] = w3;
  }
  if (lane < 4) uni[lane] = 0u;
  if (cur >= 16) {
    for (int rnd = 0; rnd < 4; ++rnd) {
      const int qq = rnd * 4 + quad;
      unsigned key[8];
#pragma unroll
      for (int c = 0; c < 8; ++c) {
        const int j = qi + 16 * c;
        const bool v = (j <= cur) && (j != 0) && (j != cur) && (j != cur - 1);
        const unsigned bits = __float_as_uint(imp[qq * 132 + j]);
        key[c] = v ? ((bits & 0xFFFFFF00u) | (unsigned)(128 - j)) : 0u;
      }
      for (int it = 0; it < 13; ++it) {
        unsigned mx = key[0];
#pragma unroll
        for (int c = 1; c < 8; ++c) mx = key[c] > mx ? key[c] : mx;
#pragma unroll
        for (int o = 1; o < 16; o <<= 1) { unsigned ot = (unsigned)__shfl_xor((int)mx, o, 64); mx = ot > mx ? ot : mx; }
        if (mx != 0u) {
#pragma unroll
          for (int c = 0; c < 8; ++c) {
            if (key[c] == mx) { key[c] = 0u; const int j = qi + 16 * c; atomicOr(&sel[qq * 4 + (j >> 5)], 1u << (j & 31)); }
          }
        }
      }
    }
  }
  unsigned mym[4];
#pragma unroll
  for (int w = 0; w < 4; ++w) mym[w] = sel[qi * 4 + w];
  if (lane < 16) {
#pragma unroll
    for (int w = 0; w < 4; ++w) atomicOr(&uni[w], mym[w]);
  }
  const float* gp = GATES + row * 24 + g * 12;
#pragma unroll
  for (int h = 0; h < 4; ++h) {
    const float gt = gp[h * 3 + 0] * NSA_G0;
#pragma unroll
    for (int dt = 0; dt < 4; ++dt) *(f32x4*)(outl + ((h * 16 + qi) * 64 + (((dt * 4 + quad) ^ qi) << 2))) = oacc[h][dt] * gt;
  }
#pragma unroll
  for (int h = 0; h < 4; ++h) { m[h] = NEGF; l[h] = 0.f;
#pragma unroll
    for (int dt = 0; dt < 4; ++dt) oacc[h][dt] = (f32x4){0.f, 0.f, 0.f, 0.f}; }
#pragma unroll 1
  for (int w = 0; w < 4; ++w) {
    unsigned bits = __builtin_amdgcn_readfirstlane(uni[w]);
    const unsigned myw = sel[qi * 4 + w];
    while (bits) {
      const int jj = __builtin_ctz(bits); bits &= bits - 1u;
      const int j = w * 32 + jj; const bool rowok = (myw >> jj) & 1u;
#pragma unroll 1
      for (int half = 0; half < 2; ++half) {
        const int key0 = j * 64 + half * 32;
        const bf16_t* kp = KS + (long)(b * T_ + key0 + qi) * 128 + g * 64 + quad * 8;
        const bf16_t* vp = VST + (long)(b * 128 + g * 64 + qi) * T_ + key0 + quad * 4;
        nsa_block<2>(qf, oacc, m, l, sl2, inv, kp, vp, 16L * T_, t - (key0 + quad * 4), rowok, asum, bsum);
      }
    }
  }
#pragma unroll
  for (int h = 0; h < 4; ++h) {
    float lt = l[h]; lt += __shfl_xor(lt, 16, 64); lt += __shfl_xor(lt, 32, 64);
    const float sc = NSA_G1 * gp[h * 3 + 1] / fmaxf(lt, 1e-30f);
#pragma unroll
    for (int dt = 0; dt < 4; ++dt) { f32x4* d = (f32x4*)(outl + ((h * 16 + qi) * 64 + (((dt * 4 + quad) ^ qi) << 2))); *d = *d + oacc[h][dt] * sc; }
  }
#pragma unroll
  for (int h = 0; h < 4; ++h) { m[h] = NEGF; l[h] = 0.f;
#pragma unroll
    for (int dt = 0; dt < 4; ++dt) oacc[h][dt] = (f32x4){0.f, 0.f, 0.f, 0.f}; }
  {
    const int kstart = t0 >= 512 ? ((t0 - 511) & ~31) : 0;
    for (int key0 = kstart; key0 <= t0 + 15; key0 += 32) {
      const bf16_t* kp = KW + (long)(b * T_ + key0 + qi) * 128 + g * 64 + quad * 8;
      const bf16_t* vp = VWT + (long)(b * 128 + g * 64 + qi) * T_ + key0 + quad * 4;
      nsa_block<3>(qf, oacc, m, l, sl2, inv, kp, vp, 16L * T_, t - (key0 + quad * 4), true, asum, bsum);
    }
  }
#pragma unroll
  for (int h = 0; h < 4; ++h) {
    float lt = l[h]; lt += __shfl_xor(lt, 16, 64); lt += __shfl_xor(lt, 32, 64);
    const float sc = NSA_G2 * gp[h * 3 + 2] / fmaxf(lt, 1e-30f);
#pragma unroll
    for (int dt = 0; dt < 4; ++dt) { f32x4* d = (f32x4*)(outl + ((h * 16 + qi) * 64 + (((dt * 4 + quad) ^ qi) << 2))); *d = *d + oacc[h][dt] * sc; }
  }
#pragma unroll
  for (int it = 0; it < 8; ++it) {
    const int id = it * 64 + lane; const int h = id >> 7, rem = id & 127, q2 = rem >> 3, c8 = rem & 7;
    f32x4 a = *(const f32x4*)(outl + ((h * 16 + q2) * 64 + (((2 * c8) ^ q2) << 2)));
    f32x4 bb = *(const f32x4*)(outl + ((h * 16 + q2) * 64 + (((2 * c8 + 1) ^ q2) << 2)));
    float v[8] = {a[0], a[1], a[2], a[3], bb[0], bb[1], bb[2], bb[3]};
    *(u32x4*)(O + ((long)b * T_ + t0 + q2) * 512 + (g * 4 + h) * 64 + c8 * 8) = pack8(v);
  }
}

__device__ void xattn_tile(const Params& P, int wt) {
  const bf16_t* HQ = (const bf16_t*)(P.ws + OFF_D);
  const bf16_t* MK = (const bf16_t*)(P.ws + OFF_MK); const bf16_t* MVT = (const bf16_t*)(P.ws + OFF_MVT);
  bf16_t* OX = (bf16_t*)(P.ws + OFF_D) + (long)M_ * 512;
  const int lane = tidx() & 63, qi = lane & 15, quad = lane >> 4;
  wt = __builtin_amdgcn_readfirstlane(wt);
  const int h = wt & 3; const int row0 = (wt >> 2) * 32; const int b = row0 >> 13;
  bf16x8 qf[2][4];
#pragma unroll
  for (int nt = 0; nt < 2; ++nt)
#pragma unroll
    for (int ks = 0; ks < 4; ++ks) qf[nt][ks] = *(const bf16x8*)(HQ + (long)(row0 + nt * 16 + qi) * 512 + h * 128 + ks * 32 + quad * 8);
  f32x4 oacc[2][8]; float m[2], l[2];
#pragma unroll
  for (int nt = 0; nt < 2; ++nt) { m[nt] = NEGF; l[nt] = 0.f;
#pragma unroll
    for (int dt = 0; dt < 8; ++dt) oacc[nt][dt] = (f32x4){0.f, 0.f, 0.f, 0.f}; }
  for (int blk = 0; blk < 8; ++blk) {
    const int key0 = blk * 32;
    f32x4 s[2][2];
#pragma unroll
    for (int nt = 0; nt < 2; ++nt)
#pragma unroll
      for (int kt = 0; kt < 2; ++kt) s[nt][kt] = (f32x4){0.f, 0.f, 0.f, 0.f};
#pragma unroll
    for (int ks = 0; ks < 4; ++ks) {
#pragma unroll
      for (int kt = 0; kt < 2; ++kt) {
        bf16x8 kf = *(const bf16x8*)(MK + (long)(b * 256 + key0 + kt * 16 + qi) * 512 + h * 128 + ks * 32 + quad * 8);
#pragma unroll
        for (int nt = 0; nt < 2; ++nt) s[nt][kt] = __builtin_amdgcn_mfma_f32_16x16x32_bf16(kf, qf[nt][ks], s[nt][kt], 0, 0, 0);
      }
    }
    bf16x8 pf[2];
#pragma unroll
    for (int nt = 0; nt < 2; ++nt) {
      float ml = NEGF;
#pragma unroll
      for (int kt = 0; kt < 2; ++kt)
#pragma unroll
        for (int r = 0; r < 4; ++r) ml = fmaxf(ml, s[nt][kt][r]);
      ml = fmaxf(ml, __shfl_xor(ml, 16, 64)); ml = fmaxf(ml, __shfl_xor(ml, 32, 64));
      const float mn = fmaxf(m[nt], ml); const float alpha = __builtin_amdgcn_exp2f(m[nt] - mn); m[nt] = mn;
      float p[8]; float ps = 0.f;
#pragma unroll
      for (int kt = 0; kt < 2; ++kt)
#pragma unroll
        for (int r = 0; r < 4; ++r) { p[kt * 4 + r] = __builtin_amdgcn_exp2f(s[nt][kt][r] - mn); ps += p[kt * 4 + r]; }
      l[nt] = l[nt] * alpha + ps;
#pragma unroll
      for (int dt = 0; dt < 8; ++dt) oacc[nt][dt] *= alpha;
      u32x4 pk; pk[0] = pack2(p[0], p[1]); pk[1] = pack2(p[2], p[3]); pk[2] = pack2(p[4], p[5]); pk[3] = pack2(p[6], p[7]);
      pf[nt] = __builtin_bit_cast(bf16x8, pk);
    }
#pragma unroll
    for (int dt = 0; dt < 8; ++dt) {
      const bf16_t* vp = MVT + (long)(b * 512 + h * 128 + dt * 16 + qi) * 256 + key0 + quad * 4;
      u32x2 lo = *(const u32x2*)(vp); u32x2 hi = *(const u32x2*)(vp + 16);
      u32x4 c; c[0] = lo[0]; c[1] = lo[1]; c[2] = hi[0]; c[3] = hi[1];
      const bf16x8 vf = __builtin_bit_cast(bf16x8, c);
#pragma unroll
      for (int nt = 0; nt < 2; ++nt) oacc[nt][dt] = __builtin_amdgcn_mfma_f32_16x16x32_bf16(vf, pf[nt], oacc[nt][dt], 0, 0, 0);
    }
  }
#pragma unroll
  for (int nt = 0; nt < 2; ++nt) {
    float lt = l[nt]; lt += __shfl_xor(lt, 16, 64); lt += __shfl_xor(lt, 32, 64);
    const float iv = 1.f / lt;
#pragma unroll
    for (int dt = 0; dt < 8; ++dt) {
      f32x4 v = oacc[nt][dt] * iv; u32x2 pk; pk[0] = pack2(v[0], v[1]); pk[1] = pack2(v[2], v[3]);
      *(u32x2*)(OX + (long)(row0 + nt * 16 + qi) * 512 + h * 128 + dt * 16 + quad * 4) = pk;
    }
  }
}

__device__ void run_phase(const Params& P, int ph, char* smem) {
  char* ws = P.ws; const int tid = tidx();
  switch (ph) {
    case 0: phase0(P, smem); break;
    case 1: phase1(P, smem); break;
    case 2: phase2(P, smem); break;
    case 3: {
      for (int job = blockIdx.x; job < 512; job += gridDim.x) { const int wv = tidx() >> 6; nsa_tile(P, job * 4 + wv, smem + wv * 16896); }
      __syncthreads();
      for (int job = blockIdx.x; job < 512; job += gridDim.x) {
        {
          const int tid = tidx();
          const int s = job; const int bc = s >> 2, g = s & 3;
          RowLin ar{(const bf16_t*)(ws + OFF_WM) + g * 16384, 128};
          RowLin br{(const bf16_t*)(ws + OFF_C + C_GVT) + ((long)bc * 512 + g * 128) * 128, 128};
          const float* bs = P.b_sp + g * 128;
          const bf16_t* U = (const bf16_t*)(ws + OFF_C + C_U) + (long)bc * 128 * 512 + g * 128;
          bf16_t* OS = (bf16_t*)(ws + OFF_D) + (long)M_ * 512 + (long)bc * 128 * 512 + g * 128;
          gemm_tile(smem, ar, br, 2, 64, 64, [&](const float* Cs) {
#pragma unroll 2
            for (int it = 0; it < 8; ++it) {
              int id = it * 256 + tid; int r = id >> 4, c = (id & 15) * 8; float v[8]; ld8(Cs, r, c, v);
              u32x4 d = *(const u32x4*)(U + (long)r * 512 + c); const float bb = bs[r];
#pragma unroll
              for (int i = 0; i < 4; ++i) { v[2 * i] = (v[2 * i] + bb) * bf2f(d[i] & 0xffffu); v[2 * i + 1] = (v[2 * i + 1] + bb) * bf2f(d[i] >> 16); }
              *(u32x4*)(OS + (long)r * 512 + c) = pack8(v);
            }
          });
        }
      }
    } break;
    case 4: {
      float* scr = (float*)(ws + OFF_C + C_SCR) + (long)blockIdx.x * 16384;
      for (int job = blockIdx.x; job < 1024; job += gridDim.x) {
        const int mt = job >> 3, nt = job & 7, brow = mt * 128, bcol = nt * 128;
        const bf16_t* MG = (const bf16_t*)(ws + OFF_B) + (long)brow * 2048 + bcol;
        RowLin a1{(const bf16_t*)(ws + OFF_D) + (long)brow * 512, 512};
        RowLin b1{(const bf16_t*)(ws + OFF_WPA) + (long)bcol * 512, 512};
        gemm_tile(smem, a1, b1, 8, 64, 64, [&](const float* Cs) {
#pragma unroll 2
          for (int it = 0; it < 8; ++it) {
            int id = it * 256 + tid; int r = id >> 4, c = (id & 15) * 8; float v[8]; ld8(Cs, r, c, v);
            u32x4 d = *(const u32x4*)(MG + (long)r * 2048 + c);
#pragma unroll
            for (int i = 0; i < 4; ++i) { v[2 * i] *= bf2f(d[i] & 0xffffu); v[2 * i + 1] *= bf2f(d[i] >> 16); }
            *(f32x4*)(scr + id * 8) = (f32x4){v[0], v[1], v[2], v[3]}; *(f32x4*)(scr + id * 8 + 4) = (f32x4){v[4], v[5], v[6], v[7]};
          }
        });
        RowLin a2{(const bf16_t*)(ws + OFF_D) + (long)M_ * 512 + (long)brow * 512, 512};
        RowLin b2{(const bf16_t*)(ws + OFF_WPB) + (long)bcol * 512, 512};
        bf16_t* MX = (bf16_t*)(ws + OFF_C + C_MIXED) + (long)brow * 1024 + bcol;
        gemm_tile(smem, a2, b2, 8, 64, 64, [&](const float* Cs) {
#pragma unroll 2
          for (int it = 0; it < 8; ++it) {
            int id = it * 256 + tid; int r = id >> 4, c = (id & 15) * 8; float v[8]; ld8(Cs, r, c, v);
            u32x4 d = *(const u32x4*)(MG + (long)r * 2048 + 1024 + c);
            f32x4 p0 = *(const f32x4*)(scr + id * 8), p1 = *(const f32x4*)(scr + id * 8 + 4);
            float pv[8] = {p0[0], p0[1], p0[2], p0[3], p1[0], p1[1], p1[2], p1[3]};
#pragma unroll
            for (int i = 0; i < 4; ++i) { v[2 * i] = pv[2 * i] + v[2 * i] * bf2f(d[i] & 0xffffu); v[2 * i + 1] = pv[2 * i + 1] + v[2 * i + 1] * bf2f(d[i] >> 16); }
            *(u32x4*)(MX + (long)r * 1024 + c) = pack8(v);
          }
        });
      }
    } break;
    case 5: case 9: case 12: {
      const bf16_t* A; const bf16_t* W; const float* RES; float* DST; int K;
      if (ph == 5) { A = (const bf16_t*)(ws + OFF_C + C_MIXED); W = (const bf16_t*)(ws + OFF_WOUT); RES = P.x; DST = (float*)(ws + OFF_B); K = 1024; }
      else if (ph == 9) { A = (const bf16_t*)(ws + OFF_D) + (long)M_ * 512; W = (const bf16_t*)(ws + OFF_WMO); RES = (const float*)(ws + OFF_B); DST = (float*)(ws + OFF_C + C_H2); K = 512; }
      else { A = (const bf16_t*)(ws + OFF_B); W = (const bf16_t*)(ws + OFF_WDN); RES = (const float*)(ws + OFF_C + C_H2); DST = P.out; K = 2816; }
      for (int job = blockIdx.x; job < 1024; job += gridDim.x) {
        const int mt = job >> 3, nt = job & 7, brow = mt * 128, bcol = nt * 128;
        RowLin ar{A + (long)brow * K, K}; RowLin br{W + (long)bcol * K, K};
        const float* rs = RES + (long)brow * 1024 + bcol; float* ds = DST + (long)brow * 1024 + bcol;
        gemm_tile(smem, ar, br, K / 64, 64, 64, [&](const float* Cs) {
#pragma unroll 2
          for (int it = 0; it < 8; ++it) {
            int id = it * 256 + tid; int r = id >> 4, c = (id & 15) * 8;
            f32x4 a = *(const f32x4*)(Cs + r * CS_LD + c), bq = *(const f32x4*)(Cs + r * CS_LD + c + 4);
            f32x4 r0 = *(const f32x4*)(rs + (long)r * 1024 + c), r1 = *(const f32x4*)(rs + (long)r * 1024 + c + 4);
            *(f32x4*)(ds + (long)r * 1024 + c) = a + r0; *(f32x4*)(ds + (long)r * 1024 + c + 4) = bq + r1;
          }
        });
      }
    } break;
    case 6: case 10: {
      const float* src = ph == 6 ? (const float*)(ws + OFF_B) : (const float*)(ws + OFF_C + C_H2);
      const float* g = ph == 6 ? P.norm_mq : P.norm_ffn;
      for (int job = blockIdx.x; job < 4096; job += gridDim.x) { int row = job * 4 + (tid >> 6); rownorm_row<false>(src + (long)row * 1024, g, (bf16_t*)(ws + OFF_A) + (long)row * 1024); }
    } break;
    case 7: {
      for (int job = blockIdx.x; job < 512; job += gridDim.x) {
        const int mt = job >> 2, nt = job & 3, brow = mt * 128;
        RowLin ar{(const bf16_t*)(ws + OFF_A) + (long)brow * 1024, 1024}; RowLin br{(const bf16_t*)(ws + OFF_WMQ) + (long)nt * 128 * 1024, 1024};
        gemm_tile(smem, ar, br, 16, 64, 64, [&](const float* Cs) {
          store_rows_bf16(Cs, (bf16_t*)(ws + OFF_D) + (long)brow * 512 + nt * 128, 512, [](float v, int) { return v * (0.08838834764831845f * LOG2E); });
        });
      }
    } break;
    case 8: {
      for (int job = blockIdx.x; job < 512; job += gridDim.x) xattn_tile(P, job * 4 + (tid >> 6));
    } break;
    case 11: {
      for (int job = blockIdx.x; job < 128 * 44; job += gridDim.x) {
        const int mt = job / 44, nt = job % 44, brow = mt * 128;
        RowLin ar{(const bf16_t*)(ws + OFF_A) + (long)brow * 1024, 1024}; RowLin br{(const bf16_t*)(ws + OFF_WGU) + (long)nt * 128 * 1024, 1024};
        bf16_t* ACT = (bf16_t*)(ws + OFF_B) + (long)brow * 2816 + nt * 64;
        gemm_tile(smem, ar, br, 16, 64, 64, [&](const float* Cs) {
#pragma unroll 2
          for (int it = 0; it < 4; ++it) {
            int id = it * 256 + tid; int r = id >> 3, c = (id & 7) * 8; float gt[8], up[8]; ld8(Cs, r, c, gt); ld8(Cs, r, c + 64, up);
#pragma unroll
            for (int i = 0; i < 8; ++i) gt[i] = gt[i] * sigm(gt[i]) * up[i];
            *(u32x4*)(ACT + (long)r * 2816 + c) = pack8(gt);
          }
        });
      }
    } break;
    case 13: {
      for (int job = blockIdx.x; job < 4096; job += gridDim.x) { int row = job * 4 + (tid >> 6); rownorm_row<true>(P.out + (long)row * 1024, P.norm_final, P.out + (long)row * 1024); }
    } break;
#ifdef PROBE_K
    case 14: {
      const bf16_t* s0 = (const bf16_t*)(ws + PROBE_SRC0); const bf16_t* s1 = (const bf16_t*)(ws + PROBE_SRC1);
      for (long i = (long)blockIdx.x * 256 + tid; i < (long)M_ * 512; i += (long)gridDim.x * 256) {
        long row = i >> 9; int c = (int)(i & 511);
        P.out[row * 1024 + c] = bf2f(s0[i]); P.out[row * 1024 + 512 + c] = bf2f(s1[i]);
      }
    } break;
    case 15: {
      const float* s0 = (const float*)(ws + PROBE_SRC0);
      for (long i = (long)blockIdx.x * 256 + tid; i < (long)M_ * 1024; i += (long)gridDim.x * 256) P.out[i] = s0[i];
    } break;
#endif
  }
}

__global__ void __launch_bounds__(256, 2) fwd_kernel(Params P, int ph_lo, int ph_hi) {
  __shared__ __attribute__((aligned(16))) char smem[67584];
  for (int ph = ph_lo; ph <= ph_hi; ++ph) {
#ifdef PROBE_K
    if (ph > PROBE_K && ph < PROBE_DUMP) continue;
#endif
    const uint64_t __attribute__((address_space(4)))* ka = (const uint64_t __attribute__((address_space(4)))*)__builtin_amdgcn_kernarg_segment_ptr();
    asm volatile("" : "+s"(ka));
    Params Pl; uint64_t* pd = (uint64_t*)&Pl;
#pragma unroll
    for (int i = 0; i < (int)(sizeof(Params) / 8); ++i) pd[i] = ka[i];
    run_phase(Pl, ph, smem);
    if (ph < ph_hi) {
      __threadfence();
      cg::this_grid().sync();
      unsigned* bar = (unsigned*)(Pl.ws + OFF_BAR);
      __syncthreads();
      if (threadIdx.x == 0) {
        const unsigned target = (unsigned)(ph - ph_lo + 1) * gridDim.x;
        __hip_atomic_fetch_add(bar, 1u, __ATOMIC_RELEASE, __HIP_MEMORY_SCOPE_AGENT);
        while (__hip_atomic_load(bar, __ATOMIC_RELAXED, __HIP_MEMORY_SCOPE_AGENT) < target) __builtin_amdgcn_s_sleep(2);
      }
      __syncthreads();
      __threadfence();
    }
  }
}

extern "C" void kernel_launch(void* const* d_in, const int* in_sizes, int n_in, void* d_out, int out_size, void* d_ws, size_t ws_size,
                              hipStream_t stream) {
  static int grid_blocks = 0;
  if (!grid_blocks) {
    int dev = 0, cus = 0, per_cu = 0;
    hipGetDevice(&dev);
    hipDeviceGetAttribute(&cus, hipDeviceAttributeMultiprocessorCount, dev);
    hipOccupancyMaxActiveBlocksPerMultiprocessor(&per_cu, fwd_kernel, 256, 0);
    if (per_cu > 2) per_cu = 2;
    if (per_cu < 1) per_cu = 1;
    grid_blocks = cus * per_cu;
  }
  if (ws_size < (size_t)WS_NEED) fprintf(stderr, "workspace too small: %zu < %ld\n", ws_size, (long)WS_NEED);
  Params P{};
  const float** pp = (const float**)&P;
  for (int i = 0; i < 27; ++i) pp[i] = (const float*)d_in[i];
  P.out = (float*)d_out; P.ws = (char*)d_ws;
  hipMemsetAsync((char*)d_ws + OFF_BAR, 0, 256, stream);
#if ONE_LAUNCH
#ifdef PROBE_K
  int lo = 0, hi = PROBE_DUMP;
#else
  int lo = 0, hi = 13;
#endif
  void* args[] = {&P, &lo, &hi};
  hipError_t e = hipLaunchCooperativeKernel((void*)fwd_kernel, dim3(grid_blocks), dim3(256), args, 0, stream);
  if (e != hipSuccess) fprintf(stderr, "cooperative launch failed: %s (grid %d)\n", hipGetErrorString(e), grid_blocks);
#else
  for (int ph = 0; ph <= 13; ++ph) fwd_kernel<<<grid_blocks, 256, 0, stream>>>(P, ph, ph);
#endif
}
```

```cpp
#include <hip/hip_runtime.h>
#include <hip/hip_cooperative_groups.h>
#include <stdint.h>
#include <stdio.h>
namespace cg = cooperative_groups;

#ifndef NSA_G0
#define NSA_G0 1.f
#define NSA_G1 1.f
#define NSA_G2 1.f
#endif
#ifndef ONE_LAUNCH
#define ONE_LAUNCH 1
#endif

typedef unsigned short bf16_t;
using bf16x8 = __attribute__((ext_vector_type(8))) short;
using f32x4 = __attribute__((ext_vector_type(4))) float;
using u32x4 = __attribute__((ext_vector_type(4))) unsigned;
using u32x2 = __attribute__((ext_vector_type(2))) unsigned;

#define T_ 8192
#define M_ 16384
#define NEGF (-1e30f)
#define LOG2E 1.4426950408889634f

constexpr long OFF_W1 = 0;
constexpr long OFF_WMKV = OFF_W1 + 9175040;
constexpr long OFF_WPA = OFF_WMKV + 2097152;
constexpr long OFF_WPB = OFF_WPA + 1048576;
constexpr long OFF_WOUT = OFF_WPB + 1048576;
constexpr long OFF_WMQ = OFF_WOUT + 2097152;
constexpr long OFF_WMO = OFF_WMQ + 1048576;
constexpr long OFF_WGU = OFF_WMO + 1048576;
constexpr long OFF_WDN = OFF_WGU + 11534336;
constexpr long OFF_WCK1 = OFF_WDN + 5767168;
constexpr long OFF_WCV1 = OFF_WCK1 + 524288;
constexpr long OFF_WM = OFF_WCV1 + 524288;
constexpr long OFF_BIAS1 = OFF_WM + 131072;
constexpr long OFF_MEMN = OFF_BIAS1 + 1024;
constexpr long OFF_MK = OFF_MEMN + 1048576;
constexpr long OFF_MVT = OFF_MK + 524288;
constexpr long OFF_KCMP = OFF_MVT + 524288;
constexpr long OFF_VCT = OFF_KCMP + 262144;
constexpr long OFF_A = OFF_VCT + 262144;
constexpr long OFF_B = OFF_A + 33554432;
constexpr long OFF_D = OFF_B + 67108864;
constexpr long OFF_C = OFF_D + 33554432;
constexpr long C_Q = 0, C_U = 16777216, C_GVT = 33554432, C_KC = 50331648, C_VC = 54525952, C_KS = 58720256,
               C_KW = 62914560, C_VST = 67108864, C_VWT = 71303168, C_GATES = 75497472;
constexpr long C_MIXED = 0, C_SCR = 33554432, C_H2 = 0;
constexpr long OFF_BAR = OFF_C + 77070336;
constexpr long WS_NEED = OFF_BAR + 256;

struct Params {
  const float *x, *mem, *norm_mix, *w_in, *w_ck1, *w_ck2, *w_cv1, *w_cv2, *pe_k, *pe_v, *ln_sgu, *w_sp, *b_sp,
      *w_pa, *w_pb, *w_merge, *b_merge, *w_out, *norm_mq, *norm_mkv, *w_mq, *w_mkv, *w_mo, *norm_ffn, *w_gu, *w_dn, *norm_final;
  float* out;
  char* ws;
};

__device__ __forceinline__ int tidx() { int t = threadIdx.x; asm volatile("" : "+v"(t)); return t; }
__device__ __forceinline__ unsigned f2bf(float f) { unsigned u = __float_as_uint(f); u += 0x7fffu + ((u >> 16) & 1u); return u >> 16; }
__device__ __forceinline__ unsigned pack2(float a, float b) { return f2bf(a) | (f2bf(b) << 16); }
__device__ __forceinline__ float bf2f(unsigned h) { return __uint_as_float(h << 16); }
__device__ __forceinline__ float gelu_tanh(float x) { float u = 0.7978845608028654f * (x + 0.044715f * x * x * x); return x / (1.f + __expf(-2.f * u)); }
__device__ __forceinline__ float sigm(float x) { return 1.f / (1.f + __expf(-x)); }
__device__ __forceinline__ float wave_sum(float v) {
#pragma unroll
  for (int o = 32; o > 0; o >>= 1) v += __shfl_xor(v, o, 64);
  return v;
}
__device__ __forceinline__ u32x4 pack8(const float (&v)[8]) {
  u32x4 r; r[0] = pack2(v[0], v[1]); r[1] = pack2(v[2], v[3]); r[2] = pack2(v[4], v[5]); r[3] = pack2(v[6], v[7]); return r;
}

__device__ __forceinline__ int lds_byte(int r, int c) {
  int st = (r >> 4) * 2 + (c >> 5), rr = r & 15, cc = c & 31, ob = rr * 64 + cc * 2;
  return st * 1024 + (ob ^ (((ob >> 9) & 1) << 5));
}
__device__ __forceinline__ void stage_rc(int b, int& R, int& C) {
  int st = b >> 10, sb = b & 1023, swz = sb ^ (((sb >> 9) & 1) << 5);
  R = (st >> 1) * 16 + (swz >> 6); C = (st & 1) * 32 + ((swz & 63) >> 1);
}

#define CS_LD 132
__device__ __forceinline__ void ld8(const float* Cs, int r, int c, float (&v)[8]) {
  f32x4 a = *(const f32x4*)(Cs + r * CS_LD + c); f32x4 b = *(const f32x4*)(Cs + r * CS_LD + c + 4);
  v[0] = a[0]; v[1] = a[1]; v[2] = a[2]; v[3] = a[3]; v[4] = b[0]; v[5] = b[1]; v[6] = b[2]; v[7] = b[3];
}
__device__ __forceinline__ void ld8T(const float* Cs, int r8, int c, float (&v)[8]) {
#pragma unroll
  for (int i = 0; i < 8; ++i) v[i] = Cs[(r8 + i) * CS_LD + c];
}

struct RowLin {
  const bf16_t* base; long ld;
  __device__ __forceinline__ const bf16_t* operator()(int r) const { return base + (long)r * ld; }
};
struct RowCmp {
  const bf16_t* base; int brow;
  __device__ __forceinline__ const bf16_t* operator()(int r) const {
    int R = brow + r; int b = R >> 10, rem = R & 1023, i = rem >> 1, g = rem & 1; if (i > 510) i = 510;
    return base + ((long)(b * T_ + 16 * i) * 128 + g * 64);
  }
};

template <int AUX = 0, class ARow, class BRow, class Epi>
__device__ __forceinline__ void gemm_tile(char* smem, ARow arow, BRow brow, int nkt, int kstepA, int kstepB, Epi epi) {
  const int tid = tidx(), lane = tid & 63, wave = tid >> 6, wr = wave >> 1, wc = wave & 1, fr = lane & 15, fq = lane >> 4;
  const bf16_t* pa[4]; const bf16_t* pb[4];
#pragma unroll
  for (int i = 0; i < 4; ++i) { int b = tid * 16 + i * 4096; int R, C; stage_rc(b, R, C); pa[i] = arow(R) + C; pb[i] = brow(R) + C; }
  f32x4 acc[4][4];
#pragma unroll
  for (int m = 0; m < 4; ++m)
#pragma unroll
    for (int n = 0; n < 4; ++n) acc[m][n] = (f32x4){0.f, 0.f, 0.f, 0.f};
  {
#pragma unroll
    for (int i = 0; i < 4; ++i) {
      __builtin_amdgcn_global_load_lds((const unsigned*)(pa[i]), (unsigned*)(smem + tid * 16 + i * 4096), 16, 0, AUX);
      __builtin_amdgcn_global_load_lds((const unsigned*)(pb[i]), (unsigned*)(smem + 16384 + tid * 16 + i * 4096), 16, 0, AUX);
    }
  }
  for (int kt = 0; kt < nkt; ++kt) {
    asm volatile("s_waitcnt vmcnt(0)" ::: "memory");
    __syncthreads();
    if (kt + 1 < nkt) {
      char* la = smem + ((kt + 1) & 1) * 32768;
#pragma unroll
      for (int i = 0; i < 4; ++i) {
        __builtin_amdgcn_global_load_lds((const unsigned*)(pa[i] + (long)(kt + 1) * kstepA), (unsigned*)(la + tid * 16 + i * 4096), 16, 0, AUX);
        __builtin_amdgcn_global_load_lds((const unsigned*)(pb[i] + (long)(kt + 1) * kstepB), (unsigned*)(la + 16384 + tid * 16 + i * 4096), 16, 0, AUX);
      }
    }
    const char* la = smem + (kt & 1) * 32768; const char* lb = la + 16384;
#pragma unroll
    for (int ks = 0; ks < 2; ++ks) {
      bf16x8 a[4], b[4];
#pragma unroll
      for (int m = 0; m < 4; ++m) a[m] = *(const bf16x8*)(la + lds_byte(wr * 64 + m * 16 + fr, ks * 32 + fq * 8));
#pragma unroll
      for (int n = 0; n < 4; ++n) b[n] = *(const bf16x8*)(lb + lds_byte(wc * 64 + n * 16 + fr, ks * 32 + fq * 8));
#pragma unroll
      for (int m = 0; m < 4; ++m)
#pragma unroll
        for (int n = 0; n < 4; ++n) acc[m][n] = __builtin_amdgcn_mfma_f32_16x16x32_bf16(a[m], b[n], acc[m][n], 0, 0, 0);
    }
  }
  __syncthreads();
  float* Cs = (float*)smem;
#pragma unroll
  for (int m = 0; m < 4; ++m)
#pragma unroll
    for (int n = 0; n < 4; ++n)
#pragma unroll
      for (int r = 0; r < 4; ++r) Cs[(wr * 64 + m * 16 + fq * 4 + r) * CS_LD + wc * 64 + n * 16 + fr] = acc[m][n][r];
  __syncthreads();
  epi(Cs);
  __syncthreads();
}

template <class F>
__device__ __forceinline__ void store_rows_bf16(const float* Cs, bf16_t* dst, long ld, F f) {
#pragma unroll 2
  for (int it = 0; it < 8; ++it) {
    int id = it * 256 + tidx(); int r = id >> 4, c = (id & 15) * 8;
    float v[8]; ld8(Cs, r, c, v);
#pragma unroll
    for (int i = 0; i < 8; ++i) v[i] = f(v[i], c + i);
    *(u32x4*)(dst + (long)r * ld + c) = pack8(v);
  }
}
template <class F>
__device__ __forceinline__ void store_T_bf16(const float* Cs, bf16_t* dst, long cstride, F f) {
#pragma unroll 2
  for (int it = 0; it < 8; ++it) {
    int id = it * 256 + tidx(); int c = id >> 4, r8 = (id & 15) * 8;
    float v[8]; ld8T(Cs, r8, c, v);
#pragma unroll
    for (int i = 0; i < 8; ++i) v[i] = f(v[i]);
    *(u32x4*)(dst + (long)c * cstride + r8) = pack8(v);
  }
}

template <int MODE>
__device__ __forceinline__ void transpose_tile(const float* W, int Nsrc, bf16_t* Wt, int Kd, int k0, int n0, float* lds) {
  const int tid = tidx();
  {
    int tx = tid & 63, ty = tid >> 6; int np = n0 + tx; int sc;
    if (MODE == 0) sc = np < Nsrc ? np : -1;
    else { int x = np & 127, tl = np >> 7; sc = x < 64 ? tl * 64 + x : 2816 + tl * 64 + x - 64; }
#pragma unroll 4
    for (int kk = ty; kk < 64; kk += 4) lds[kk * 65 + tx] = sc >= 0 ? W[(long)(k0 + kk) * Nsrc + sc] : 0.f;
  }
  __syncthreads();
  {
    int nrow = tid >> 2, kseg = (tid & 3) * 16; float v[8];
#pragma unroll
    for (int i = 0; i < 8; ++i) v[i] = lds[(kseg + i) * 65 + nrow];
    *(u32x4*)(Wt + (long)(n0 + nrow) * Kd + k0 + kseg) = pack8(v);
#pragma unroll
    for (int i = 0; i < 8; ++i) v[i] = lds[(kseg + 8 + i) * 65 + nrow];
    *(u32x4*)(Wt + (long)(n0 + nrow) * Kd + k0 + kseg + 8) = pack8(v);
  }
  __syncthreads();
}

template <bool OUTF>
__device__ __forceinline__ void rownorm_row(const float* src, const float* g, void* dst) {
  const int lane = tidx() & 63;
  f32x4 v[4]; float ss = 0.f;
#pragma unroll
  for (int i = 0; i < 4; ++i) { v[i] = *(const f32x4*)(src + i * 256 + lane * 4); ss += v[i][0] * v[i][0] + v[i][1] * v[i][1] + v[i][2] * v[i][2] + v[i][3] * v[i][3]; }
  ss = wave_sum(ss);
  float r = rsqrtf(ss * (1.f / 1024.f) + 1e-6f);
#pragma unroll
  for (int i = 0; i < 4; ++i) {
    f32x4 gg = *(const f32x4*)(g + i * 256 + lane * 4);
    float o0 = v[i][0] * r * gg[0], o1 = v[i][1] * r * gg[1], o2 = v[i][2] * r * gg[2], o3 = v[i][3] * r * gg[3];
    if (OUTF) { *(f32x4*)((float*)dst + i * 256 + lane * 4) = (f32x4){o0, o1, o2, o3}; }
    else { u32x2 p; p[0] = pack2(o0, o1); p[1] = pack2(o2, o3); *(u32x2*)((bf16_t*)dst + i * 256 + lane * 4) = p; }
  }
}

__device__ void phase0(const Params& P, char* smem) {
  float* lds = (float*)smem;
  const int tid = tidx();
  const int NJ = 8 + 4096 + 128 + 32 + 4384;
  for (int job = blockIdx.x; job < NJ; job += gridDim.x) {
    int j = job;
    if (j < 8) {
      int n = j * 32 + (tid & 31), sl = tid >> 5; int kv = n >> 7, nn = n & 127;
      const float* pe = kv ? P.pe_v : P.pe_k; const float* w1 = kv ? P.w_cv1 : P.w_ck1;
      float s = 0.f;
      for (int k = sl * 256; k < sl * 256 + 256; ++k) s += pe[k] * w1[(long)k * 128 + nn];
      lds[sl * 32 + (tid & 31)] = s;
      __syncthreads();
      if (tid < 32) { float t = 0.f; for (int q = 0; q < 8; ++q) t += lds[q * 32 + tid]; ((float*)(P.ws + OFF_BIAS1))[j * 32 + tid] = t; }
      __syncthreads();
      continue;
    }
    j -= 8;
    if (j < 4096) { int row = j * 4 + (tid >> 6); rownorm_row<false>(P.x + (long)row * 1024, P.norm_mix, (bf16_t*)(P.ws + OFF_A) + (long)row * 1024); continue; }
    j -= 4096;
    if (j < 128) { int row = j * 4 + (tid >> 6); rownorm_row<false>(P.mem + (long)row * 1024, P.norm_mkv, (bf16_t*)(P.ws + OFF_MEMN) + (long)row * 1024); continue; }
    j -= 128;
    if (j < 32) {
      int e0 = j * 2048 + tid * 8; float v[8];
#pragma unroll
      for (int i = 0; i < 8; ++i) { int e = e0 + i; int t = (e >> 7) & 127, s = e & 127; v[i] = s <= t ? P.w_sp[e] : 0.f; }
      *(u32x4*)((bf16_t*)(P.ws + OFF_WM) + e0) = pack8(v);
      continue;
    }
    j -= 32;
#define TRJ(KT, NT, W, NSRC, WT, KD, MODE) \
    if (j < (KT) * (NT)) { transpose_tile<MODE>(W, NSRC, (bf16_t*)(P.ws + (WT)), KD, (j % (KT)) * 64, (j / (KT)) * 64, lds); continue; } \
    j -= (KT) * (NT);
    TRJ(16, 88, P.w_gu, 5632, OFF_WGU, 1024, 1)
    TRJ(44, 16, P.w_dn, 1024, OFF_WDN, 2816, 0)
    TRJ(16, 38, P.w_in, 2328, OFF_W1, 1024, 0)
    TRJ(16, 32, P.w_merge, 2048, OFF_W1 + 2432L * 1024 * 2, 1024, 0)
    TRJ(16, 16, P.w_mkv, 1024, OFF_WMKV, 1024, 0)
    TRJ(16, 16, P.w_out, 1024, OFF_WOUT, 1024, 0)
    TRJ(8, 16, P.w_pa, 1024, OFF_WPA, 512, 0)
    TRJ(8, 16, P.w_pb, 1024, OFF_WPB, 512, 0)
    TRJ(16, 8, P.w_mq, 512, OFF_WMQ, 1024, 0)
    TRJ(8, 16, P.w_mo, 1024, OFF_WMO, 512, 0)
    TRJ(32, 2, P.w_ck1, 128, OFF_WCK1, 2048, 0)
    TRJ(32, 2, P.w_cv1, 128, OFF_WCV1, 2048, 0)
#undef TRJ
  }
}

__device__ void phase1(const Params& P, char* smem) {
  char* ws = P.ws;
  const int NG1 = 128 * 35;
  for (int job = blockIdx.x; job < NG1 + 32; job += gridDim.x) {
    if (job < NG1) {
      const int mt = job / 35, nt = job % 35; const int brow = mt * 128;
      RowLin ar{(const bf16_t*)(ws + OFF_A) + (long)brow * 1024, 1024};
      RowLin br{(const bf16_t*)(ws + OFF_W1) + (long)nt * 128 * 1024, 1024};
      gemm_tile(smem, ar, br, 16, 64, 64, [&](const float* Cs) {
        char* C = ws + OFF_C;
        if (nt < 4) {
          store_rows_bf16(Cs, (bf16_t*)(C + C_Q) + (long)brow * 512 + nt * 128, 512, [](float v, int) { return v * (0.125f * LOG2E); });
        } else if (nt == 4 || nt == 5 || nt == 6 || nt == 8) {
          long off = nt == 4 ? C_KC : nt == 5 ? C_VC : nt == 6 ? C_KS : C_KW;
          store_rows_bf16(Cs, (bf16_t*)(C + off) + (long)brow * 128, 128, [](float v, int) { return v; });
        } else if (nt == 7 || nt == 9) {
          long off = nt == 7 ? C_VST : C_VWT; int b = brow >> 13, tl = brow & 8191;
          store_T_bf16(Cs, (bf16_t*)(C + off) + (long)b * 128 * T_ + tl, T_, [](float v) { return v; });
        } else if (nt < 14) {
          store_rows_bf16(Cs, (bf16_t*)(C + C_U) + (long)brow * 512 + (nt - 10) * 128, 512, [](float v, int) { return gelu_tanh(v); });
        } else if (nt < 18) {
          store_T_bf16(Cs, (bf16_t*)(C + C_GVT) + ((long)(brow >> 7) * 512 + (nt - 14) * 128) * 128, 128, [](float v) { return gelu_tanh(v); });
        } else if (nt == 18) {
          float* gates = (float*)(C + C_GATES);
          for (int id = tidx(); id < 128 * 24; id += 256) { int r = id / 24, c = id % 24; gates[(long)(brow + r) * 24 + c] = sigm(Cs[r * CS_LD + c]); }
        } else {
          const float* bm = P.b_merge + (nt - 19) * 128;
          store_rows_bf16(Cs, (bf16_t*)(ws + OFF_B) + (long)brow * 2048 + (nt - 19) * 128, 2048, [bm](float v, int c) { return sigm(v + bm[c]); });
        }
      });
    } else {
      const int j = job - NG1; const int mt = j >> 3, nt = j & 7; const int brow = mt * 128;
      RowLin ar{(const bf16_t*)(ws + OFF_MEMN) + (long)brow * 1024, 1024};
      RowLin br{(const bf16_t*)(ws + OFF_WMKV) + (long)nt * 128 * 1024, 1024};
      gemm_tile(smem, ar, br, 16, 64, 64, [&](const float* Cs) {
        if (nt < 4) store_rows_bf16(Cs, (bf16_t*)(ws + OFF_MK) + (long)brow * 512 + nt * 128, 512, [](float v, int) { return v; });
        else { int b = mt >> 1, n0 = (mt & 1) * 128; store_T_bf16(Cs, (bf16_t*)(ws + OFF_MVT) + ((long)b * 512 + (nt - 4) * 128) * 256 + n0, 256, [](float v) { return v; }); }
      });
    }
  }
}

__device__ void phase2(const Params& P, char* smem) {
  char* ws = P.ws; const int tid = tidx();
  for (int job = blockIdx.x; job < 32 + 128; job += gridDim.x) {
    if (job < 32) {
      const int kv = job >> 4, mt = job & 15, brow = mt * 128;
      RowCmp ar{(const bf16_t*)(ws + OFF_C + (kv ? C_VC : C_KC)), brow};
      RowLin br{(const bf16_t*)(ws + (kv ? OFF_WCV1 : OFF_WCK1)), 2048};
      const float* bias1 = (const float*)(ws + OFF_BIAS1) + kv * 128;
      const float* w2 = kv ? P.w_cv2 : P.w_ck2;
      gemm_tile(smem, ar, br, 32, 128, 64, [&](const float* Csc) {
        float* Cs = (float*)Csc;
        for (int it = 0; it < 64; ++it) { int id = it * 256 + tid; int r = id >> 7, n = id & 127; Cs[r * CS_LD + n] = gelu_tanh(Cs[r * CS_LD + n] + bias1[n]); }
        __syncthreads();
        const int r = tid >> 1, half = tid & 1;
        float acc[32];
#pragma unroll
        for (int i = 0; i < 32; ++i) acc[i] = 0.f;
        for (int n = 0; n < 128; ++n) {
          float h = Cs[r * CS_LD + n]; const float* wr = w2 + n * 64 + half * 32;
#pragma unroll
          for (int q = 0; q < 8; ++q) { f32x4 w = *(const f32x4*)(wr + q * 4); acc[q * 4] += h * w[0]; acc[q * 4 + 1] += h * w[1]; acc[q * 4 + 2] += h * w[2]; acc[q * 4 + 3] += h * w[3]; }
        }
        const int R = brow + r; const int b = R >> 10, rem = R & 1023, i = rem >> 1, g = rem & 1;
        if (i >= 511) {
#pragma unroll
          for (int q = 0; q < 32; ++q) acc[q] = 0.f;
        }
        if (kv == 0) {
          bf16_t* dst = (bf16_t*)(ws + OFF_KCMP) + (long)(b * 512 + i) * 128 + g * 64 + half * 32;
#pragma unroll
          for (int q = 0; q < 4; ++q) { float v[8];
#pragma unroll
            for (int e = 0; e < 8; ++e) v[e] = acc[q * 8 + e];
            *(u32x4*)(dst + q * 8) = pack8(v); }
        } else {
          bf16_t* dst = (bf16_t*)(ws + OFF_VCT) + ((long)(b * 128 + g * 64 + half * 32)) * 512 + i;
#pragma unroll
          for (int q = 0; q < 32; ++q) dst[(long)q * 512] = (bf16_t)f2bf(acc[q]);
        }
      });
    } else {
      const int bc = job - 32; bf16_t* base = (bf16_t*)(ws + OFF_C + C_GVT) + (long)bc * 512 * 128;
      float* ssum = (float*)smem; float* ssq = ssum + 128;
      float* psum = ssum + 256; float* psq = psum + 16 * 128;
      const int cs = tid >> 4, s8 = (tid & 15) * 8;
      float a[8], q[8];
#pragma unroll
      for (int i = 0; i < 8; ++i) { a[i] = 0.f; q[i] = 0.f; }
      for (int it = 0; it < 32; ++it) {
        u32x4 d = *(const u32x4*)(base + (long)(it * 16 + cs) * 128 + s8);
#pragma unroll
        for (int i = 0; i < 4; ++i) { float lo = bf2f(d[i] & 0xffffu), hi = bf2f(d[i] >> 16); a[2 * i] += lo; q[2 * i] += lo * lo; a[2 * i + 1] += hi; q[2 * i + 1] += hi * hi; }
      }
#pragma unroll
      for (int i = 0; i < 8; ++i) { psum[cs * 128 + s8 + i] = a[i]; psq[cs * 128 + s8 + i] = q[i]; }
      __syncthreads();
      if (tid < 128) {
        float su = 0.f, sq = 0.f;
        for (int c = 0; c < 16; ++c) { su += psum[c * 128 + tid]; sq += psq[c * 128 + tid]; }
        float mean_t = su * (1.f / 512.f); float var = sq * (1.f / 512.f) - mean_t * mean_t; if (var < 0.f) var = 0.f;
        ssum[tid] = mean_t; ssq[tid] = rsqrtf(var + 1e-6f);
      }
      __syncthreads();
      float mean[8], rs[8];
#pragma unroll
      for (int i = 0; i < 8; ++i) { mean[i] = ssum[s8 + i]; rs[i] = ssq[s8 + i]; }
      for (int it = 0; it < 32; ++it) {
        int ch = it * 16 + cs; float gg = P.ln_sgu[ch];
        u32x4 d = *(const u32x4*)(base + (long)ch * 128 + s8); float v[8];
#pragma unroll
        for (int i = 0; i < 4; ++i) { v[2 * i] = bf2f(d[i] & 0xffffu); v[2 * i + 1] = bf2f(d[i] >> 16); }
#pragma unroll
        for (int i = 0; i < 8; ++i) v[i] = (v[i] - mean[i]) * rs[i] * gg;
        *(u32x4*)(base + (long)ch * 128 + s8) = pack8(v);
      }
      __syncthreads();
    }
  }
}

template <int MODE>
__device__ __forceinline__ void nsa_block(const bf16x8 (&qf)[4][2], f32x4 (&oacc)[4][4], float (&m)[4], float (&l)[4],
                                          const float (&sl2)[4], const float (&inv)[4], const bf16_t* kp, const bf16_t* vp, long vdt,
                                          int dist0, bool rowok, float (&asum)[2], float (&bsum)[2]) {
  constexpr int DSTEP = (MODE <= 1) ? 16 : 1;
  bf16x8 kf[2][2];
#pragma unroll
  for (int kt = 0; kt < 2; ++kt)
#pragma unroll
    for (int ks = 0; ks < 2; ++ks) kf[kt][ks] = *(const bf16x8*)(kp + kt * 16 * 128 + ks * 32);
  bf16x8 vf[4];
  if (MODE != 0) {
#pragma unroll
    for (int dt = 0; dt < 4; ++dt) {
      u32x2 lo = *(const u32x2*)(vp + dt * vdt); u32x2 hi = *(const u32x2*)(vp + dt * vdt + 16);
      u32x4 c; c[0] = lo[0]; c[1] = lo[1]; c[2] = hi[0]; c[3] = hi[1];
      vf[dt] = __builtin_bit_cast(bf16x8, c);
    }
  }
  const float fd0 = (float)dist0;
#pragma unroll
  for (int h = 0; h < 4; ++h) {
    f32x4 s[2];
#pragma unroll
    for (int kt = 0; kt < 2; ++kt) {
      s[kt] = __builtin_amdgcn_mfma_f32_16x16x32_bf16(kf[kt][0], qf[h][0], (f32x4){0.f, 0.f, 0.f, 0.f}, 0, 0, 0);
      s[kt] = __builtin_amdgcn_mfma_f32_16x16x32_bf16(kf[kt][1], qf[h][1], s[kt], 0, 0, 0);
    }
    float sc[8]; bool ok[8];
#pragma unroll
    for (int kt = 0; kt < 2; ++kt)
#pragma unroll
      for (int r = 0; r < 4; ++r) {
        const int e = kt * 16 + r; const int dist = dist0 - DSTEP * e;
        sc[kt * 4 + r] = s[kt][r] - sl2[h] * (fd0 - (float)(DSTEP * e));
        bool o = dist >= 0;
        if (MODE == 2) o = o && rowok;
        if (MODE == 3) o = o && (dist < 512);
        ok[kt * 4 + r] = o;
      }
    float p[8];
    if (MODE != 1) {
      float ml = NEGF;
#pragma unroll
      for (int i = 0; i < 8; ++i) ml = fmaxf(ml, ok[i] ? sc[i] : NEGF);
      ml = fmaxf(ml, __shfl_xor(ml, 16, 64)); ml = fmaxf(ml, __shfl_xor(ml, 32, 64));
      const float mn = fmaxf(m[h], ml); const float alpha = __builtin_amdgcn_exp2f(m[h] - mn); m[h] = mn;
      float ps = 0.f;
#pragma unroll
      for (int i = 0; i < 8; ++i) { p[i] = ok[i] ? __builtin_amdgcn_exp2f(sc[i] - mn) : 0.f; ps += p[i]; }
      l[h] = l[h] * alpha + ps;
      if (MODE != 0) {
#pragma unroll
        for (int dt = 0; dt < 4; ++dt) oacc[h][dt] *= alpha;
      }
    } else {
#pragma unroll
      for (int i = 0; i < 8; ++i) p[i] = ok[i] ? __builtin_amdgcn_exp2f(sc[i] - m[h]) * l[h] : 0.f;
      asum[0] += (p[0] + p[1]) + (p[2] + p[3]); bsum[0] += p[3];
      asum[1] += (p[4] + p[5]) + (p[6] + p[7]); bsum[1] += p[7];
    }
    if (MODE != 0) {
      u32x4 pk; pk[0] = pack2(p[0], p[1]); pk[1] = pack2(p[2], p[3]); pk[2] = pack2(p[4], p[5]); pk[3] = pack2(p[6], p[7]);
      const bf16x8 pf = __builtin_bit_cast(bf16x8, pk);
#pragma unroll
      for (int dt = 0; dt < 4; ++dt) oacc[h][dt] = __builtin_amdgcn_mfma_f32_16x16x32_bf16(vf[dt], pf, oacc[h][dt], 0, 0, 0);
    }
    __builtin_amdgcn_sched_barrier(0);
  }
}

__device__ void nsa_tile(const Params& P, int wt, char* wl) {
  char* C = P.ws + OFF_C;
  const bf16_t* Q = (const bf16_t*)(C + C_Q);
  const bf16_t* KCMP = (const bf16_t*)(P.ws + OFF_KCMP); const bf16_t* VCT = (const bf16_t*)(P.ws + OFF_VCT);
  const bf16_t* KS = (const bf16_t*)(C + C_KS); const bf16_t* VST = (const bf16_t*)(C + C_VST);
  const bf16_t* KW = (const bf16_t*)(C + C_KW); const bf16_t* VWT = (const bf16_t*)(C + C_VWT);
  const float* GATES = (const float*)(C + C_GATES);
  bf16_t* O = (bf16_t*)(P.ws + OFF_D);
  const int lane = tidx() & 63, qi = lane & 15, quad = lane >> 4;
  wt = __builtin_amdgcn_readfirstlane(wt);
  const int bg = wt & 3, b = bg >> 1, g = bg & 1;
  const int t0 = (511 - (wt >> 2)) * 16;
  const int t = t0 + qi;
  const long row = (long)b * T_ + t;
  bf16x8 qf[4][2];
#pragma unroll
  for (int h = 0; h < 4; ++h)
#pragma unroll
    for (int ks = 0; ks < 2; ++ks) qf[h][ks] = *(const bf16x8*)(Q + row * 512 + (g * 4 + h) * 64 + ks * 32 + quad * 8);
  float sl2[4];
#pragma unroll
  for (int h = 0; h < 4; ++h) sl2[h] = __builtin_amdgcn_exp2f(-(float)(g * 4 + h + 1)) * LOG2E;
  f32x4 oacc[4][4]; float m[4], l[4], inv[4]; float asum[2], bsum[2];
  float* imp = (float*)wl; float* outl = (float*)wl;
  unsigned* sel = (unsigned*)(wl + 16384); unsigned* uni = sel + 64;
#pragma unroll
  for (int h = 0; h < 4; ++h) { m[h] = NEGF; l[h] = 0.f; inv[h] = 0.f; }
  asum[0] = asum[1] = bsum[0] = bsum[1] = 0.f;

  const int nI = t0 >> 4; const int nblk = (nI + 31) >> 5;
  for (int blk = 0; blk < nblk; ++blk) {
    const int key0 = blk * 32;
    const bf16_t* kp = KCMP + (long)(b * 512 + key0 + qi) * 128 + g * 64 + quad * 8;
    nsa_block<0>(qf, oacc, m, l, sl2, inv, kp, nullptr, 0, t - 31 - 16 * (key0 + quad * 4), true, asum, bsum);
  }
#pragma unroll
  for (int h = 0; h < 4; ++h) { float lt = l[h]; lt += __shfl_xor(lt, 16, 64); lt += __shfl_xor(lt, 32, 64); l[h] = 1.f / fmaxf(lt, 1e-30f); }
  for (int i = lane; i < 16 * 132; i += 64) imp[i] = 0.f;
#pragma unroll
  for (int h = 0; h < 4; ++h)
#pragma unroll
    for (int dt = 0; dt < 4; ++dt) oacc[h][dt] = (f32x4){0.f, 0.f, 0.f, 0.f};
  for (int blk = 0; blk < nblk; ++blk) {
    const int key0 = blk * 32;
    const bf16_t* kp = KCMP + (long)(b * 512 + key0 + qi) * 128 + g * 64 + quad * 8;
    const bf16_t* vp = VCT + (long)(b * 128 + g * 64 + qi) * 512 + key0 + quad * 4;
    asum[0] = asum[1] = bsum[0] = bsum[1] = 0.f;
    nsa_block<1>(qf, oacc, m, l, sl2, inv, kp, vp, 16 * 512, t - 31 - 16 * (key0 + quad * 4), true, asum, bsum);
    const int J = (key0 >> 2) + quad;
    atomicAdd(&imp[qi * 132 + J], asum[0]); atomicAdd(&imp[qi * 132 + J + 1], bsum[0]);
    atomicAdd(&imp[qi * 132 + J + 4], asum[1]); atomicAdd(&imp[qi * 132 + J + 5], bsum[1]);
  }
  const int cur = t0 >> 6;
  if (lane < 16) {
    unsigned w0 = 0, w1 = 0, w2 = 0, w3 = 0;
    if (cur < 16) { w0 = (1u << (cur + 1)) - 1u; }
    else {
      w0 = 1u;
      { int j = cur; unsigned bit = 1u << (j & 31); int w = j >> 5; if (w == 0) w0 |= bit; else if (w == 1) w1 |= bit; else if (w == 2) w2 |= bit; else w3 |= bit; }
      { int j = cur - 1; unsigned bit = 1u << (j & 31); int w = j >> 5; if (w == 0) w0 |= bit; else if (w == 1) w1 |= bit; else if (w == 2) w2 |= bit; else w3 |= bit; }
    }
    sel[lane * 4 + 0] = w0; sel[lane * 4 + 1] = w1; sel[lane * 4 + 2] = w2; sel[lane * 4 + 3] = w3;
  }
  if (lane < 4) uni[lane] = 0u;
  if (cur >= 16) {
    for (int rnd = 0; rnd < 4; ++rnd) {
      const int qq = rnd * 4 + quad;
      unsigned key[8];
#pragma unroll
      for (int c = 0; c < 8; ++c) {
        const int j = qi + 16 * c;
        const bool v = (j <= cur) && (j != 0) && (j != cur) && (j != cur - 1);
        const unsigned bits = __float_as_uint(imp[qq * 132 + j]);
        key[c] = v ? ((bits & 0xFFFFFF00u) | (unsigned)(128 - j)) : 0u;
      }
      for (int it = 0; it < 13; ++it) {
        unsigned mx = key[0];
#pragma unroll
        for (int c = 1; c < 8; ++c) mx = key[c] > mx ? key[c] : mx;
#pragma unroll
        for (int o = 1; o < 16; o <<= 1) { unsigned ot = (unsigned)__shfl_xor((int)mx, o, 64); mx = ot > mx ? ot : mx; }
        if (mx != 0u) {
#pragma unroll
          for (int c = 0; c < 8; ++c) {
            if (key[c] == mx) { key[c] = 0u; const int j = qi + 16 * c; atomicOr(&sel[qq * 4 + (j >> 5)], 1u << (j & 31)); }
          }
        }
      }
    }
  }
  unsigned mym[4];
#pragma unroll
  for (int w = 0; w < 4; ++w) mym[w] = sel[qi * 4 + w];
  if (lane < 16) {
#pragma unroll
    for (int w = 0; w < 4; ++w) atomicOr(&uni[w], mym[w]);
  }
  const float* gp = GATES + row * 24 + g * 12;
#pragma unroll
  for (int h = 0; h < 4; ++h) {
    const float gt = gp[h * 3 + 0] * NSA_G0;
#pragma unroll
    for (int dt = 0; dt < 4; ++dt) *(f32x4*)(outl + ((h * 16 + qi) * 64 + (((dt * 4 + quad) ^ qi) << 2))) = oacc[h][dt] * gt;
  }
#pragma unroll
  for (int h = 0; h < 4; ++h) { m[h] = NEGF; l[h] = 0.f;
#pragma unroll
    for (int dt = 0; dt < 4; ++dt) oacc[h][dt] = (f32x4){0.f, 0.f, 0.f, 0.f}; }
#pragma unroll 1
  for (int w = 0; w < 4; ++w) {
    unsigned bits = __builtin_amdgcn_readfirstlane(uni[w]);
    const unsigned myw = sel[qi * 4 + w];
    while (bits) {
      const int jj = __builtin_ctz(bits); bits &= bits - 1u;
      const int j = w * 32 + jj; const bool rowok = (myw >> jj) & 1u;
#pragma unroll 1
      for (int half = 0; half < 2; ++half) {
        const int key0 = j * 64 + half * 32;
        const bf16_t* kp = KS + (long)(b * T_ + key0 + qi) * 128 + g * 64 + quad * 8;
        const bf16_t* vp = VST + (long)(b * 128 + g * 64 + qi) * T_ + key0 + quad * 4;
        nsa_block<2>(qf, oacc, m, l, sl2, inv, kp, vp, 16L * T_, t - (key0 + quad * 4), rowok, asum, bsum);
      }
    }
  }
#pragma unroll
  for (int h = 0; h < 4; ++h) {
    float lt = l[h]; lt += __shfl_xor(lt, 16, 64); lt += __shfl_xor(lt, 32, 64);
    const float sc = NSA_G1 * gp[h * 3 + 1] / fmaxf(lt, 1e-30f);
#pragma unroll
    for (int dt = 0; dt < 4; ++dt) { f32x4* d = (f32x4*)(outl + ((h * 16 + qi) * 64 + (((dt * 4 + quad) ^ qi) << 2))); *d = *d + oacc[h][dt] * sc; }
  }
#pragma unroll
  for (int h = 0; h < 4; ++h) { m[h] = NEGF; l[h] = 0.f;
#pragma unroll
    for (int dt = 0; dt < 4; ++dt) oacc[h][dt] = (f32x4){0.f, 0.f, 0.f, 0.f}; }
  {
    const int kstart = t0 >= 512 ? ((t0 - 511) & ~31) : 0;
    for (int key0 = kstart; key0 <= t0 + 15; key0 += 32) {
      const bf16_t* kp = KW + (long)(b * T_ + key0 + qi) * 128 + g * 64 + quad * 8;
      const bf16_t* vp = VWT + (long)(b * 128 + g * 64 + qi) * T_ + key0 + quad * 4;
      nsa_block<3>(qf, oacc, m, l, sl2, inv, kp, vp, 16L * T_, t - (key0 + quad * 4), true, asum, bsum);
    }
  }
#pragma unroll
  for (int h = 0; h < 4; ++h) {
    float lt = l[h]; lt += __shfl_xor(lt, 16, 64); lt += __shfl_xor(lt, 32, 64);
    const float sc = NSA_G2 * gp[h * 3 + 2] / fmaxf(lt, 1e-30f);
#pragma unroll
    for (int dt = 0; dt < 4; ++dt) { f32x4* d = (f32x4*)(outl + ((h * 16 + qi) * 64 + (((dt * 4 + quad) ^ qi) << 2))); *d = *d + oacc[h][dt] * sc; }
  }
#pragma unroll
  for (int it = 0; it < 8; ++it) {
    const int id = it * 64 + lane; const int h = id >> 7, rem = id & 127, q2 = rem >> 3, c8 = rem & 7;
    f32x4 a = *(const f32x4*)(outl + ((h * 16 + q2) * 64 + (((2 * c8) ^ q2) << 2)));
    f32x4 bb = *(const f32x4*)(outl + ((h * 16 + q2) * 64 + (((2 * c8 + 1) ^ q2) << 2)));
    float v[8] = {a[0], a[1], a[2], a[3], bb[0], bb[1], bb[2], bb[3]};
    *(u32x4*)(O + ((long)b * T_ + t0 + q2) * 512 + (g * 4 + h) * 64 + c8 * 8) = pack8(v);
  }
}

__device__ void xattn_tile(const Params& P, int wt) {
  const bf16_t* HQ = (const bf16_t*)(P.ws + OFF_D);
  const bf16_t* MK = (const bf16_t*)(P.ws + OFF_MK); const bf16_t* MVT = (const bf16_t*)(P.ws + OFF_MVT);
  bf16_t* OX = (bf16_t*)(P.ws + OFF_D) + (long)M_ * 512;
  const int lane = tidx() & 63, qi = lane & 15, quad = lane >> 4;
  wt = __builtin_amdgcn_readfirstlane(wt);
  const int h = wt & 3; const int row0 = (wt >> 2) * 32; const int b = row0 >> 13;
  bf16x8 qf[2][4];
#pragma unroll
  for (int nt = 0; nt < 2; ++nt)
#pragma unroll
    for (int ks = 0; ks < 4; ++ks) qf[nt][ks] = *(const bf16x8*)(HQ + (long)(row0 + nt * 16 + qi) * 512 + h * 128 + ks * 32 + quad * 8);
  f32x4 oacc[2][8]; float m[2], l[2];
#pragma unroll
  for (int nt = 0; nt < 2; ++nt) { m[nt] = NEGF; l[nt] = 0.f;
#pragma unroll
    for (int dt = 0; dt < 8; ++dt) oacc[nt][dt] = (f32x4){0.f, 0.f, 0.f, 0.f}; }
  for (int blk = 0; blk < 8; ++blk) {
    const int key0 = blk * 32;
    f32x4 s[2][2];
#pragma unroll
    for (int nt = 0; nt < 2; ++nt)
#pragma unroll
      for (int kt = 0; kt < 2; ++kt) s[nt][kt] = (f32x4){0.f, 0.f, 0.f, 0.f};
#pragma unroll
    for (int ks = 0; ks < 4; ++ks) {
#pragma unroll
      for (int kt = 0; kt < 2; ++kt) {
        bf16x8 kf = *(const bf16x8*)(MK + (long)(b * 256 + key0 + kt * 16 + qi) * 512 + h * 128 + ks * 32 + quad * 8);
#pragma unroll
        for (int nt = 0; nt < 2; ++nt) s[nt][kt] = __builtin_amdgcn_mfma_f32_16x16x32_bf16(kf, qf[nt][ks], s[nt][kt], 0, 0, 0);
      }
    }
    bf16x8 pf[2];
#pragma unroll
    for (int nt = 0; nt < 2; ++nt) {
      float ml = NEGF;
#pragma unroll
      for (int kt = 0; kt < 2; ++kt)
#pragma unroll
        for (int r = 0; r < 4; ++r) ml = fmaxf(ml, s[nt][kt][r]);
      ml = fmaxf(ml, __shfl_xor(ml, 16, 64)); ml = fmaxf(ml, __shfl_xor(ml, 32, 64));
      const float mn = fmaxf(m[nt], ml); const float alpha = __builtin_amdgcn_exp2f(m[nt] - mn); m[nt] = mn;
      float p[8]; float ps = 0.f;
#pragma unroll
      for (int kt = 0; kt < 2; ++kt)
#pragma unroll
        for (int r = 0; r < 4; ++r) { p[kt * 4 + r] = __builtin_amdgcn_exp2f(s[nt][kt][r] - mn); ps += p[kt * 4 + r]; }
      l[nt] = l[nt] * alpha + ps;
#pragma unroll
      for (int dt = 0; dt < 8; ++dt) oacc[nt][dt] *= alpha;
      u32x4 pk; pk[0] = pack2(p[0], p[1]); pk[1] = pack2(p[2], p[3]); pk[2] = pack2(p[4], p[5]); pk[3] = pack2(p[6], p[7]);
      pf[nt] = __builtin_bit_cast(bf16x8, pk);
    }
#pragma unroll
    for (int dt = 0; dt < 8; ++dt) {
      const bf16_t* vp = MVT + (long)(b * 512 + h * 128 + dt * 16 + qi) * 256 + key0 + quad * 4;
      u32x2 lo = *(const u32x2*)(vp); u32x2 hi = *(const u32x2*)(vp + 16);
      u32x4 c; c[0] = lo[0]; c[1] = lo[1]; c[2] = hi[0]; c[3] = hi[1];
      const bf16x8 vf = __builtin_bit_cast(bf16x8, c);
#pragma unroll
      for (int nt = 0; nt < 2; ++nt) oacc[nt][dt] = __builtin_amdgcn_mfma_f32_16x16x32_bf16(vf, pf[nt], oacc[nt][dt], 0, 0, 0);
    }
  }
#pragma unroll
  for (int nt = 0; nt < 2; ++nt) {
    float lt = l[nt]; lt += __shfl_xor(lt, 16, 64); lt += __shfl_xor(lt, 32, 64);
    const float iv = 1.f / lt;
#pragma unroll
    for (int dt = 0; dt < 8; ++dt) {
      f32x4 v = oacc[nt][dt] * iv; u32x2 pk; pk[0] = pack2(v[0], v[1]); pk[1] = pack2(v[2], v[3]);
      *(u32x2*)(OX + (long)(row0 + nt * 16 + qi) * 512 + h * 128 + dt * 16 + quad * 4) = pk;
    }
  }
}

__device__ void run_phase(const Params& P, int ph, char* smem) {
  char* ws = P.ws; const int tid = tidx();
  switch (ph) {
    case 0: phase0(P, smem); break;
    case 1: phase1(P, smem); break;
    case 2: phase2(P, smem); break;
    case 3: {
      for (int job = blockIdx.x; job < 512; job += gridDim.x) { const int wv = tidx() >> 6; nsa_tile(P, job * 4 + wv, smem + wv * 16896); }
      __syncthreads();
      for (int job = blockIdx.x; job < 512; job += gridDim.x) {
        {
          const int tid = tidx();
          const int s = job; const int bc = s >> 2, g = s & 3;
          RowLin ar{(const bf16_t*)(ws + OFF_WM) + g * 16384, 128};
          RowLin br{(const bf16_t*)(ws + OFF_C + C_GVT) + ((long)bc * 512 + g * 128) * 128, 128};
          const float* bs = P.b_sp + g * 128;
          const bf16_t* U = (const bf16_t*)(ws + OFF_C + C_U) + (long)bc * 128 * 512 + g * 128;
          bf16_t* OS = (bf16_t*)(ws + OFF_D) + (long)M_ * 512 + (long)bc * 128 * 512 + g * 128;
          gemm_tile(smem, ar, br, 2, 64, 64, [&](const float* Cs) {
#pragma unroll 2
            for (int it = 0; it < 8; ++it) {
              int id = it * 256 + tid; int r = id >> 4, c = (id & 15) * 8; float v[8]; ld8(Cs, r, c, v);
              u32x4 d = *(const u32x4*)(U + (long)r * 512 + c); const float bb = bs[r];
#pragma unroll
              for (int i = 0; i < 4; ++i) { v[2 * i] = (v[2 * i] + bb) * bf2f(d[i] & 0xffffu); v[2 * i + 1] = (v[2 * i + 1] + bb) * bf2f(d[i] >> 16); }
              *(u32x4*)(OS + (long)r * 512 + c) = pack8(v);
            }
          });
        }
      }
    } break;
    case 4: {
      float* scr = (float*)(ws + OFF_C + C_SCR) + (long)blockIdx.x * 16384;
      for (int job = blockIdx.x; job < 1024; job += gridDim.x) {
        const int mt = job >> 3, nt = job & 7, brow = mt * 128, bcol = nt * 128;
        const bf16_t* MG = (const bf16_t*)(ws + OFF_B) + (long)brow * 2048 + bcol;
        RowLin a1{(const bf16_t*)(ws + OFF_D) + (long)brow * 512, 512};
        RowLin b1{(const bf16_t*)(ws + OFF_WPA) + (long)bcol * 512, 512};
        gemm_tile(smem, a1, b1, 8, 64, 64, [&](const float* Cs) {
#pragma unroll 2
          for (int it = 0; it < 8; ++it) {
            int id = it * 256 + tid; int r = id >> 4, c = (id & 15) * 8; float v[8]; ld8(Cs, r, c, v);
            u32x4 d = *(const u32x4*)(MG + (long)r * 2048 + c);
#pragma unroll
            for (int i = 0; i < 4; ++i) { v[2 * i] *= bf2f(d[i] & 0xffffu); v[2 * i + 1] *= bf2f(d[i] >> 16); }
            *(f32x4*)(scr + id * 8) = (f32x4){v[0], v[1], v[2], v[3]}; *(f32x4*)(scr + id * 8 + 4) = (f32x4){v[4], v[5], v[6], v[7]};
          }
        });
        RowLin a2{(const bf16_t*)(ws + OFF_D) + (long)M_ * 512 + (long)brow * 512, 512};
        RowLin b2{(const bf16_t*)(ws + OFF_WPB) + (long)bcol * 512, 512};
        bf16_t* MX = (bf16_t*)(ws + OFF_C + C_MIXED) + (long)brow * 1024 + bcol;
        gemm_tile(smem, a2, b2, 8, 64, 64, [&](const float* Cs) {
#pragma unroll 2
          for (int it = 0; it < 8; ++it) {
            int id = it * 256 + tid; int r = id >> 4, c = (id & 15) * 8; float v[8]; ld8(Cs, r, c, v);
            u32x4 d = *(const u32x4*)(MG + (long)r * 2048 + 1024 + c);
            f32x4 p0 = *(const f32x4*)(scr + id * 8), p1 = *(const f32x4*)(scr + id * 8 + 4);
            float pv[8] = {p0[0], p0[1], p0[2], p0[3], p1[0], p1[1], p1[2], p1[3]};
#pragma unroll
            for (int i = 0; i < 4; ++i) { v[2 * i] = pv[2 * i] + v[2 * i] * bf2f(d[i] & 0xffffu); v[2 * i + 1] = pv[2 * i + 1] + v[2 * i + 1] * bf2f(d[i] >> 16); }
            *(u32x4*)(MX + (long)r * 1024 + c) = pack8(v);
          }
        });
      }
    } break;
    case 5: case 9: case 12: {
      const bf16_t* A; const bf16_t* W; const float* RES; float* DST; int K;
      if (ph == 5) { A = (const bf16_t*)(ws + OFF_C + C_MIXED); W = (const bf16_t*)(ws + OFF_WOUT); RES = P.x; DST = (float*)(ws + OFF_B); K = 1024; }
      else if (ph == 9) { A = (const bf16_t*)(ws + OFF_D) + (long)M_ * 512; W = (const bf16_t*)(ws + OFF_WMO); RES = (const float*)(ws + OFF_B); DST = (float*)(ws + OFF_C + C_H2); K = 512; }
      else { A = (const bf16_t*)(ws + OFF_B); W = (const bf16_t*)(ws + OFF_WDN); RES = (const float*)(ws + OFF_C + C_H2); DST = P.out; K = 2816; }
      for (int job = blockIdx.x; job < 1024; job += gridDim.x) {
        const int mt = job >> 3, nt = job & 7, brow = mt * 128, bcol = nt * 128;
        RowLin ar{A + (long)brow * K, K}; RowLin br{W + (long)bcol * K, K};
        const float* rs = RES + (long)brow * 1024 + bcol; float* ds = DST + (long)brow * 1024 + bcol;
        gemm_tile(smem, ar, br, K / 64, 64, 64, [&](const float* Cs) {
#pragma unroll 2
          for (int it = 0; it < 8; ++it) {
            int id = it * 256 + tid; int r = id >> 4, c = (id & 15) * 8;
            f32x4 a = *(const f32x4*)(Cs + r * CS_LD + c), bq = *(const f32x4*)(Cs + r * CS_LD + c + 4);
            f32x4 r0 = *(const f32x4*)(rs + (long)r * 1024 + c), r1 = *(const f32x4*)(rs + (long)r * 1024 + c + 4);
            *(f32x4*)(ds + (long)r * 1024 + c) = a + r0; *(f32x4*)(ds + (long)r * 1024 + c + 4) = bq + r1;
          }
        });
      }
    } break;
    case 6: case 10: {
      const float* src = ph == 6 ? (const float*)(ws + OFF_B) : (const float*)(ws + OFF_C + C_H2);
      const float* g = ph == 6 ? P.norm_mq : P.norm_ffn;
      for (int job = blockIdx.x; job < 4096; job += gridDim.x) { int row = job * 4 + (tid >> 6); rownorm_row<false>(src + (long)row * 1024, g, (bf16_t*)(ws + OFF_A) + (long)row * 1024); }
    } break;
    case 7: {
      for (int job = blockIdx.x; job < 512; job += gridDim.x) {
        const int mt = job >> 2, nt = job & 3, brow = mt * 128;
        RowLin ar{(const bf16_t*)(ws + OFF_A) + (long)brow * 1024, 1024}; RowLin br{(const bf16_t*)(ws + OFF_WMQ) + (long)nt * 128 * 1024, 1024};
        gemm_tile(smem, ar, br, 16, 64, 64, [&](const float* Cs) {
          store_rows_bf16(Cs, (bf16_t*)(ws + OFF_D) + (long)brow * 512 + nt * 128, 512, [](float v, int) { return v * (0.08838834764831845f * LOG2E); });
        });
      }
    } break;
    case 8: {
      for (int job = blockIdx.x; job < 512; job += gridDim.x) xattn_tile(P, job * 4 + (tid >> 6));
    } break;
    case 11: {
      for (int job = blockIdx.x; job < 128 * 44; job += gridDim.x) {
        const int mt = job / 44, nt = job % 44, brow = mt * 128;
        RowLin ar{(const bf16_t*)(ws + OFF_A) + (long)brow * 1024, 1024}; RowLin br{(const bf16_t*)(ws + OFF_WGU) + (long)nt * 128 * 1024, 1024};
        bf16_t* ACT = (bf16_t*)(ws + OFF_B) + (long)brow * 2816 + nt * 64;
        gemm_tile(smem, ar, br, 16, 64, 64, [&](const float* Cs) {
#pragma unroll 2
          for (int it = 0; it < 4; ++it) {
            int id = it * 256 + tid; int r = id >> 3, c = (id & 7) * 8; float gt[8], up[8]; ld8(Cs, r, c, gt); ld8(Cs, r, c + 64, up);
#pragma unroll
            for (int i = 0; i < 8; ++i) gt[i] = gt[i] * sigm(gt[i]) * up[i];
            *(u32x4*)(ACT + (long)r * 2816 + c) = pack8(gt);
          }
        });
      }
    } break;
    case 13: {
      for (int job = blockIdx.x; job < 4096; job += gridDim.x) { int row = job * 4 + (tid >> 6); rownorm_row<true>(P.out + (long)row * 1024, P.norm_final, P.out + (long)row * 1024); }
    } break;
#ifdef PROBE_K
    case 14: {
      const bf16_t* s0 = (const bf16_t*)(ws + PROBE_SRC0); const bf16_t* s1 = (const bf16_t*)(ws + PROBE_SRC1);
      for (long i = (long)blockIdx.x * 256 + tid; i < (long)M_ * 512; i += (long)gridDim.x * 256) {
        long row = i >> 9; int c = (int)(i & 511);
        P.out[row * 1024 + c] = bf2f(s0[i]); P.out[row * 1024 + 512 + c] = bf2f(s1[i]);
      }
    } break;
    case 15: {
      const float* s0 = (const float*)(ws + PROBE_SRC0);
      for (long i = (long)blockIdx.x * 256 + tid; i < (long)M_ * 1024; i += (long)gridDim.x * 256) P.out[i] = s0[i];
    } break;
#endif
  }
}

__global__ void __launch_bounds__(256, 2) fwd_kernel(Params P, int ph_lo, int ph_hi) {
  __shared__ __attribute__((aligned(16))) char smem[67584];
  for (int ph = ph_lo; ph <= ph_hi; ++ph) {
#ifdef PROBE_K
    if (ph > PROBE_K && ph < PROBE_DUMP) continue;
#endif
    const uint64_t __attribute__((address_space(4)))* ka = (const uint64_t __attribute__((address_space(4)))*)__builtin_amdgcn_kernarg_segment_ptr();
    asm volatile("" : "+s"(ka));
    Params Pl; uint64_t* pd = (uint64_t*)&Pl;
#pragma unroll
    for (int i = 0; i < (int)(sizeof(Params) / 8); ++i) pd[i] = ka[i];
    run_phase(Pl, ph, smem);
    if (ph < ph_hi) {
      asm volatile("s_waitcnt vmcnt(0) lgkmcnt(0)" ::: "memory");
      cg::this_grid().sync();
    }
  }
}

extern "C" void kernel_launch(void* const* d_in, const int* in_sizes, int n_in, void* d_out, int out_size, void* d_ws, size_t ws_size,
                              hipStream_t stream) {
  static int grid_blocks = 0;
  if (!grid_blocks) {
    int dev = 0, cus = 0, per_cu = 0;
    hipGetDevice(&dev);
    hipDeviceGetAttribute(&cus, hipDeviceAttributeMultiprocessorCount, dev);
    hipOccupancyMaxActiveBlocksPerMultiprocessor(&per_cu, fwd_kernel, 256, 0);
    if (per_cu > 2) per_cu = 2;
    if (per_cu < 1) per_cu = 1;
    grid_blocks = cus * per_cu;
  }
  if (ws_size < (size_t)WS_NEED) fprintf(stderr, "workspace too small: %zu < %ld\n", ws_size, (long)WS_NEED);
  Params P{};
  const float** pp = (const float**)&P;
  for (int i = 0; i < 27; ++i) pp[i] = (const float*)d_in[i];
  P.out = (float*)d_out; P.ws = (char*)d_ws;
#if ONE_LAUNCH
#ifdef PROBE_K
  int lo = 0, hi = PROBE_DUMP;
#else
  int lo = 0, hi = 13;
#endif
  void* args[] = {&P, &lo, &hi};
  hipError_t e = hipLaunchCooperativeKernel((void*)fwd_kernel, dim3(grid_blocks), dim3(256), args, 0, stream);
  if (e != hipSuccess) fprintf(stderr, "cooperative launch failed: %s (grid %d)\n", hipGetErrorString(e), grid_blocks);
#else
  for (int ph = 0; ph <= 13; ++ph) fwd_kernel<<<grid_blocks, 256, 0, stream>>>(P, ph, ph);
#endif
}
```

```cpp
#include <hip/hip_runtime.h>
#include <hip/hip_cooperative_groups.h>
#include <stdint.h>
#include <stdio.h>
namespace cg = cooperative_groups;

#ifndef NSA_G0
#define NSA_G0 1.f
#define NSA_G1 1.f
#define NSA_G2 1.f
#endif
#ifndef ONE_LAUNCH
#define ONE_LAUNCH 1
#endif

typedef unsigned short bf16_t;
using bf16x8 = __attribute__((ext_vector_type(8))) short;
using f32x4 = __attribute__((ext_vector_type(4))) float;
using u32x4 = __attribute__((ext_vector_type(4))) unsigned;
using u32x2 = __attribute__((ext_vector_type(2))) unsigned;

#define T_ 8192
#define M_ 16384
#define NEGF (-1e30f)
#define LOG2E 1.4426950408889634f

constexpr long OFF_W1 = 0;
constexpr long OFF_WMKV = OFF_W1 + 9175040;
constexpr long OFF_WPA = OFF_WMKV + 2097152;
constexpr long OFF_WPB = OFF_WPA + 1048576;
constexpr long OFF_WOUT = OFF_WPB + 1048576;
constexpr long OFF_WMQ = OFF_WOUT + 2097152;
constexpr long OFF_WMO = OFF_WMQ + 1048576;
constexpr long OFF_WGU = OFF_WMO + 1048576;
constexpr long OFF_WDN = OFF_WGU + 11534336;
constexpr long OFF_WCK1 = OFF_WDN + 5767168;
constexpr long OFF_WCV1 = OFF_WCK1 + 524288;
constexpr long OFF_WM = OFF_WCV1 + 524288;
constexpr long OFF_BIAS1 = OFF_WM + 131072;
constexpr long OFF_MEMN = OFF_BIAS1 + 1024;
constexpr long OFF_MK = OFF_MEMN + 1048576;
constexpr long OFF_MVT = OFF_MK + 524288;
constexpr long OFF_KCMP = OFF_MVT + 524288;
constexpr long OFF_VCT = OFF_KCMP + 262144;
constexpr long OFF_A = OFF_VCT + 262144;
constexpr long OFF_B = OFF_A + 33554432;
constexpr long OFF_D = OFF_B + 67108864;
constexpr long OFF_C = OFF_D + 33554432;
constexpr long C_Q = 0, C_U = 16777216, C_GVT = 33554432, C_KC = 50331648, C_VC = 54525952, C_KS = 58720256,
               C_KW = 62914560, C_VST = 67108864, C_VWT = 71303168, C_GATES = 75497472;
constexpr long C_MIXED = 0, C_SCR = 33554432, C_H2 = 0;
constexpr long OFF_BAR = OFF_C + 77070336;
constexpr long WS_NEED = OFF_BAR + 16384;

struct Params {
  const float *x, *mem, *norm_mix, *w_in, *w_ck1, *w_ck2, *w_cv1, *w_cv2, *pe_k, *pe_v, *ln_sgu, *w_sp, *b_sp,
      *w_pa, *w_pb, *w_merge, *b_merge, *w_out, *norm_mq, *norm_mkv, *w_mq, *w_mkv, *w_mo, *norm_ffn, *w_gu, *w_dn, *norm_final;
  float* out;
  char* ws;
};

__device__ __forceinline__ int tidx() { int t = threadIdx.x; asm volatile("" : "+v"(t)); return t; }
__device__ __forceinline__ unsigned f2bf(float f) { unsigned u = __float_as_uint(f); u += 0x7fffu + ((u >> 16) & 1u); return u >> 16; }
__device__ __forceinline__ unsigned pack2(float a, float b) { return f2bf(a) | (f2bf(b) << 16); }
__device__ __forceinline__ float bf2f(unsigned h) { return __uint_as_float(h << 16); }
__device__ __forceinline__ float gelu_tanh(float x) { float u = 0.7978845608028654f * (x + 0.044715f * x * x * x); return x / (1.f + __expf(-2.f * u)); }
__device__ __forceinline__ float sigm(float x) { return 1.f / (1.f + __expf(-x)); }
__device__ __forceinline__ float wave_sum(float v) {
#pragma unroll
  for (int o = 32; o > 0; o >>= 1) v += __shfl_xor(v, o, 64);
  return v;
}
__device__ __forceinline__ u32x4 pack8(const float (&v)[8]) {
  u32x4 r; r[0] = pack2(v[0], v[1]); r[1] = pack2(v[2], v[3]); r[2] = pack2(v[4], v[5]); r[3] = pack2(v[6], v[7]); return r;
}

__device__ __forceinline__ int lds_byte(int r, int c) {
  int st = (r >> 4) * 2 + (c >> 5), rr = r & 15, cc = c & 31, ob = rr * 64 + cc * 2;
  return st * 1024 + (ob ^ (((ob >> 9) & 1) << 5));
}
__device__ __forceinline__ void stage_rc(int b, int& R, int& C) {
  int st = b >> 10, sb = b & 1023, swz = sb ^ (((sb >> 9) & 1) << 5);
  R = (st >> 1) * 16 + (swz >> 6); C = (st & 1) * 32 + ((swz & 63) >> 1);
}

#define CS_LD 132
__device__ __forceinline__ void ld8(const float* Cs, int r, int c, float (&v)[8]) {
  f32x4 a = *(const f32x4*)(Cs + r * CS_LD + c); f32x4 b = *(const f32x4*)(Cs + r * CS_LD + c + 4);
  v[0] = a[0]; v[1] = a[1]; v[2] = a[2]; v[3] = a[3]; v[4] = b[0]; v[5] = b[1]; v[6] = b[2]; v[7] = b[3];
}
__device__ __forceinline__ void ld8T(const float* Cs, int r8, int c, float (&v)[8]) {
#pragma unroll
  for (int i = 0; i < 8; ++i) v[i] = Cs[(r8 + i) * CS_LD + c];
}

struct RowLin {
  const bf16_t* base; long ld;
  __device__ __forceinline__ const bf16_t* operator()(int r) const { return base + (long)r * ld; }
};
struct RowCmp {
  const bf16_t* base; int brow;
  __device__ __forceinline__ const bf16_t* operator()(int r) const {
    int R = brow + r; int b = R >> 10, rem = R & 1023, i = rem >> 1, g = rem & 1; if (i > 510) i = 510;
    return base + ((long)(b * T_ + 16 * i) * 128 + g * 64);
  }
};

template <int AUX = 0, class ARow, class BRow, class Epi>
__device__ __forceinline__ void gemm_tile(char* smem, ARow arow, BRow brow, int nkt, int kstepA, int kstepB, Epi epi) {
  const int tid = tidx(), lane = tid & 63, wave = tid >> 6, wr = wave >> 1, wc = wave & 1, fr = lane & 15, fq = lane >> 4;
  const bf16_t* pa[4]; const bf16_t* pb[4];
#pragma unroll
  for (int i = 0; i < 4; ++i) { int b = tid * 16 + i * 4096; int R, C; stage_rc(b, R, C); pa[i] = arow(R) + C; pb[i] = brow(R) + C; }
  f32x4 acc[4][4];
#pragma unroll
  for (int m = 0; m < 4; ++m)
#pragma unroll
    for (int n = 0; n < 4; ++n) acc[m][n] = (f32x4){0.f, 0.f, 0.f, 0.f};
  {
#pragma unroll
    for (int i = 0; i < 4; ++i) {
      __builtin_amdgcn_global_load_lds((const unsigned*)(pa[i]), (unsigned*)(smem + tid * 16 + i * 4096), 16, 0, AUX);
      __builtin_amdgcn_global_load_lds((const unsigned*)(pb[i]), (unsigned*)(smem + 16384 + tid * 16 + i * 4096), 16, 0, AUX);
    }
  }
  for (int kt = 0; kt < nkt; ++kt) {
    asm volatile("s_waitcnt vmcnt(0)" ::: "memory");
    __syncthreads();
    if (kt + 1 < nkt) {
      char* la = smem + ((kt + 1) & 1) * 32768;
#pragma unroll
      for (int i = 0; i < 4; ++i) {
        __builtin_amdgcn_global_load_lds((const unsigned*)(pa[i] + (long)(kt + 1) * kstepA), (unsigned*)(la + tid * 16 + i * 4096), 16, 0, AUX);
        __builtin_amdgcn_global_load_lds((const unsigned*)(pb[i] + (long)(kt + 1) * kstepB), (unsigned*)(la + 16384 + tid * 16 + i * 4096), 16, 0, AUX);
      }
    }
    const char* la = smem + (kt & 1) * 32768; const char* lb = la + 16384;
#pragma unroll
    for (int ks = 0; ks < 2; ++ks) {
      bf16x8 a[4], b[4];
#pragma unroll
      for (int m = 0; m < 4; ++m) a[m] = *(const bf16x8*)(la + lds_byte(wr * 64 + m * 16 + fr, ks * 32 + fq * 8));
#pragma unroll
      for (int n = 0; n < 4; ++n) b[n] = *(const bf16x8*)(lb + lds_byte(wc * 64 + n * 16 + fr, ks * 32 + fq * 8));
#pragma unroll
      for (int m = 0; m < 4; ++m)
#pragma unroll
        for (int n = 0; n < 4; ++n) acc[m][n] = __builtin_amdgcn_mfma_f32_16x16x32_bf16(a[m], b[n], acc[m][n], 0, 0, 0);
    }
  }
  __syncthreads();
  float* Cs = (float*)smem;
#pragma unroll
  for (int m = 0; m < 4; ++m)
#pragma unroll
    for (int n = 0; n < 4; ++n)
#pragma unroll
      for (int r = 0; r < 4; ++r) Cs[(wr * 64 + m * 16 + fq * 4 + r) * CS_LD + wc * 64 + n * 16 + fr] = acc[m][n][r];
  __syncthreads();
  epi(Cs);
  __syncthreads();
}

template <class F>
__device__ __forceinline__ void store_rows_bf16(const float* Cs, bf16_t* dst, long ld, F f) {
#pragma unroll 2
  for (int it = 0; it < 8; ++it) {
    int id = it * 256 + tidx(); int r = id >> 4, c = (id & 15) * 8;
    float v[8]; ld8(Cs, r, c, v);
#pragma unroll
    for (int i = 0; i < 8; ++i) v[i] = f(v[i], c + i);
    *(u32x4*)(dst + (long)r * ld + c) = pack8(v);
  }
}
template <class F>
__device__ __forceinline__ void store_T_bf16(const float* Cs, bf16_t* dst, long cstride, F f) {
#pragma unroll 2
  for (int it = 0; it < 8; ++it) {
    int id = it * 256 + tidx(); int c = id >> 4, r8 = (id & 15) * 8;
    float v[8]; ld8T(Cs, r8, c, v);
#pragma unroll
    for (int i = 0; i < 8; ++i) v[i] = f(v[i]);
    *(u32x4*)(dst + (long)c * cstride + r8) = pack8(v);
  }
}

template <int MODE>
__device__ __forceinline__ void transpose_tile(const float* W, int Nsrc, bf16_t* Wt, int Kd, int k0, int n0, float* lds) {
  const int tid = tidx();
  {
    int tx = tid & 63, ty = tid >> 6; int np = n0 + tx; int sc;
    if (MODE == 0) sc = np < Nsrc ? np : -1;
    else { int x = np & 127, tl = np >> 7; sc = x < 64 ? tl * 64 + x : 2816 + tl * 64 + x - 64; }
#pragma unroll 4
    for (int kk = ty; kk < 64; kk += 4) lds[kk * 65 + tx] = sc >= 0 ? W[(long)(k0 + kk) * Nsrc + sc] : 0.f;
  }
  __syncthreads();
  {
    int nrow = tid >> 2, kseg = (tid & 3) * 16; float v[8];
#pragma unroll
    for (int i = 0; i < 8; ++i) v[i] = lds[(kseg + i) * 65 + nrow];
    *(u32x4*)(Wt + (long)(n0 + nrow) * Kd + k0 + kseg) = pack8(v);
#pragma unroll
    for (int i = 0; i < 8; ++i) v[i] = lds[(kseg + 8 + i) * 65 + nrow];
    *(u32x4*)(Wt + (long)(n0 + nrow) * Kd + k0 + kseg + 8) = pack8(v);
  }
  __syncthreads();
}

template <bool OUTF>
__device__ __forceinline__ void rownorm_row(const float* src, const float* g, void* dst) {
  const int lane = tidx() & 63;
  f32x4 v[4]; float ss = 0.f;
#pragma unroll
  for (int i = 0; i < 4; ++i) { v[i] = *(const f32x4*)(src + i * 256 + lane * 4); ss += v[i][0] * v[i][0] + v[i][1] * v[i][1] + v[i][2] * v[i][2] + v[i][3] * v[i][3]; }
  ss = wave_sum(ss);
  float r = rsqrtf(ss * (1.f / 1024.f) + 1e-6f);
#pragma unroll
  for (int i = 0; i < 4; ++i) {
    f32x4 gg = *(const f32x4*)(g + i * 256 + lane * 4);
    float o0 = v[i][0] * r * gg[0], o1 = v[i][1] * r * gg[1], o2 = v[i][2] * r * gg[2], o3 = v[i][3] * r * gg[3];
    if (OUTF) { *(f32x4*)((float*)dst + i * 256 + lane * 4) = (f32x4){o0, o1, o2, o3}; }
    else { u32x2 p; p[0] = pack2(o0, o1); p[1] = pack2(o2, o3); *(u32x2*)((bf16_t*)dst + i * 256 + lane * 4) = p; }
  }
}

__device__ void phase0(const Params& P, char* smem) {
  float* lds = (float*)smem;
  const int tid = tidx();
  const int NJ = 8 + 4096 + 128 + 32 + 4384;
  for (int job = blockIdx.x; job < NJ; job += gridDim.x) {
    int j = job;
    if (j < 8) {
      int n = j * 32 + (tid & 31), sl = tid >> 5; int kv = n >> 7, nn = n & 127;
      const float* pe = kv ? P.pe_v : P.pe_k; const float* w1 = kv ? P.w_cv1 : P.w_ck1;
      float s = 0.f;
      for (int k = sl * 256; k < sl * 256 + 256; ++k) s += pe[k] * w1[(long)k * 128 + nn];
      lds[sl * 32 + (tid & 31)] = s;
      __syncthreads();
      if (tid < 32) { float t = 0.f; for (int q = 0; q < 8; ++q) t += lds[q * 32 + tid]; ((float*)(P.ws + OFF_BIAS1))[j * 32 + tid] = t; }
      __syncthreads();
      continue;
    }
    j -= 8;
    if (j < 4096) { int row = j * 4 + (tid >> 6); rownorm_row<false>(P.x + (long)row * 1024, P.norm_mix, (bf16_t*)(P.ws + OFF_A) + (long)row * 1024); continue; }
    j -= 4096;
    if (j < 128) { int row = j * 4 + (tid >> 6); rownorm_row<false>(P.mem + (long)row * 1024, P.norm_mkv, (bf16_t*)(P.ws + OFF_MEMN) + (long)row * 1024); continue; }
    j -= 128;
    if (j < 32) {
      int e0 = j * 2048 + tid * 8; float v[8];
#pragma unroll
      for (int i = 0; i < 8; ++i) { int e = e0 + i; int t = (e >> 7) & 127, s = e & 127; v[i] = s <= t ? P.w_sp[e] : 0.f; }
      *(u32x4*)((bf16_t*)(P.ws + OFF_WM) + e0) = pack8(v);
      continue;
    }
    j -= 32;
#define TRJ(KT, NT, W, NSRC, WT, KD, MODE) \
    if (j < (KT) * (NT)) { transpose_tile<MODE>(W, NSRC, (bf16_t*)(P.ws + (WT)), KD, (j % (KT)) * 64, (j / (KT)) * 64, lds); continue; } \
    j -= (KT) * (NT);
    TRJ(16, 88, P.w_gu, 5632, OFF_WGU, 1024, 1)
    TRJ(44, 16, P.w_dn, 1024, OFF_WDN, 2816, 0)
    TRJ(16, 38, P.w_in, 2328, OFF_W1, 1024, 0)
    TRJ(16, 32, P.w_merge, 2048, OFF_W1 + 2432L * 1024 * 2, 1024, 0)
    TRJ(16, 16, P.w_mkv, 1024, OFF_WMKV, 1024, 0)
    TRJ(16, 16, P.w_out, 1024, OFF_WOUT, 1024, 0)
    TRJ(8, 16, P.w_pa, 1024, OFF_WPA, 512, 0)
    TRJ(8, 16, P.w_pb, 1024, OFF_WPB, 512, 0)
    TRJ(16, 8, P.w_mq, 512, OFF_WMQ, 1024, 0)
    TRJ(8, 16, P.w_mo, 1024, OFF_WMO, 512, 0)
    TRJ(32, 2, P.w_ck1, 128, OFF_WCK1, 2048, 0)
    TRJ(32, 2, P.w_cv1, 128, OFF_WCV1, 2048, 0)
#undef TRJ
  }
}

__device__ void phase1(const Params& P, char* smem) {
  char* ws = P.ws;
  const int NG1 = 128 * 35;
  for (int job = blockIdx.x; job < NG1 + 32; job += gridDim.x) {
    if (job < NG1) {
      const int mt = job / 35, nt = job % 35; const int brow = mt * 128;
      RowLin ar{(const bf16_t*)(ws + OFF_A) + (long)brow * 1024, 1024};
      RowLin br{(const bf16_t*)(ws + OFF_W1) + (long)nt * 128 * 1024, 1024};
      gemm_tile(smem, ar, br, 16, 64, 64, [&](const float* Cs) {
        char* C = ws + OFF_C;
        if (nt < 4) {
          store_rows_bf16(Cs, (bf16_t*)(C + C_Q) + (long)brow * 512 + nt * 128, 512, [](float v, int) { return v * (0.125f * LOG2E); });
        } else if (nt == 4 || nt == 5 || nt == 6 || nt == 8) {
          long off = nt == 4 ? C_KC : nt == 5 ? C_VC : nt == 6 ? C_KS : C_KW;
          store_rows_bf16(Cs, (bf16_t*)(C + off) + (long)brow * 128, 128, [](float v, int) { return v; });
        } else if (nt == 7 || nt == 9) {
          long off = nt == 7 ? C_VST : C_VWT; int b = brow >> 13, tl = brow & 8191;
          store_T_bf16(Cs, (bf16_t*)(C + off) + (long)b * 128 * T_ + tl, T_, [](float v) { return v; });
        } else if (nt < 14) {
          store_rows_bf16(Cs, (bf16_t*)(C + C_U) + (long)brow * 512 + (nt - 10) * 128, 512, [](float v, int) { return gelu_tanh(v); });
        } else if (nt < 18) {
          store_T_bf16(Cs, (bf16_t*)(C + C_GVT) + ((long)(brow >> 7) * 512 + (nt - 14) * 128) * 128, 128, [](float v) { return gelu_tanh(v); });
        } else if (nt == 18) {
          float* gates = (float*)(C + C_GATES);
          for (int id = tidx(); id < 128 * 24; id += 256) { int r = id / 24, c = id % 24; gates[(long)(brow + r) * 24 + c] = sigm(Cs[r * CS_LD + c]); }
        } else {
          const float* bm = P.b_merge + (nt - 19) * 128;
          store_rows_bf16(Cs, (bf16_t*)(ws + OFF_B) + (long)brow * 2048 + (nt - 19) * 128, 2048, [bm](float v, int c) { return sigm(v + bm[c]); });
        }
      });
    } else {
      const int j = job - NG1; const int mt = j >> 3, nt = j & 7; const int brow = mt * 128;
      RowLin ar{(const bf16_t*)(ws + OFF_MEMN) + (long)brow * 1024, 1024};
      RowLin br{(const bf16_t*)(ws + OFF_WMKV) + (long)nt * 128 * 1024, 1024};
      gemm_tile(smem, ar, br, 16, 64, 64, [&](const float* Cs) {
        if (nt < 4) store_rows_bf16(Cs, (bf16_t*)(ws + OFF_MK) + (long)brow * 512 + nt * 128, 512, [](float v, int) { return v; });
        else { int b = mt >> 1, n0 = (mt & 1) * 128; store_T_bf16(Cs, (bf16_t*)(ws + OFF_MVT) + ((long)b * 512 + (nt - 4) * 128) * 256 + n0, 256, [](float v) { return v; }); }
      });
    }
  }
}

__device__ void phase2(const Params& P, char* smem) {
  char* ws = P.ws; const int tid = tidx();
  for (int job = blockIdx.x; job < 32 + 128; job += gridDim.x) {
    if (job < 32) {
      const int kv = job >> 4, mt = job & 15, brow = mt * 128;
      RowCmp ar{(const bf16_t*)(ws + OFF_C + (kv ? C_VC : C_KC)), brow};
      RowLin br{(const bf16_t*)(ws + (kv ? OFF_WCV1 : OFF_WCK1)), 2048};
      const float* bias1 = (const float*)(ws + OFF_BIAS1) + kv * 128;
      const float* w2 = kv ? P.w_cv2 : P.w_ck2;
      gemm_tile(smem, ar, br, 32, 128, 64, [&](const float* Csc) {
        float* Cs = (float*)Csc;
        for (int it = 0; it < 64; ++it) { int id = it * 256 + tid; int r = id >> 7, n = id & 127; Cs[r * CS_LD + n] = gelu_tanh(Cs[r * CS_LD + n] + bias1[n]); }
        __syncthreads();
        const int r = tid >> 1, half = tid & 1;
        float acc[32];
#pragma unroll
        for (int i = 0; i < 32; ++i) acc[i] = 0.f;
        for (int n = 0; n < 128; ++n) {
          float h = Cs[r * CS_LD + n]; const float* wr = w2 + n * 64 + half * 32;
#pragma unroll
          for (int q = 0; q < 8; ++q) { f32x4 w = *(const f32x4*)(wr + q * 4); acc[q * 4] += h * w[0]; acc[q * 4 + 1] += h * w[1]; acc[q * 4 + 2] += h * w[2]; acc[q * 4 + 3] += h * w[3]; }
        }
        const int R = brow + r; const int b = R >> 10, rem = R & 1023, i = rem >> 1, g = rem & 1;
        if (i >= 511) {
#pragma unroll
          for (int q = 0; q < 32; ++q) acc[q] = 0.f;
        }
        if (kv == 0) {
          bf16_t* dst = (bf16_t*)(ws + OFF_KCMP) + (long)(b * 512 + i) * 128 + g * 64 + half * 32;
#pragma unroll
          for (int q = 0; q < 4; ++q) { float v[8];
#pragma unroll
            for (int e = 0; e < 8; ++e) v[e] = acc[q * 8 + e];
            *(u32x4*)(dst + q * 8) = pack8(v); }
        } else {
          bf16_t* dst = (bf16_t*)(ws + OFF_VCT) + ((long)(b * 128 + g * 64 + half * 32)) * 512 + i;
#pragma unroll
          for (int q = 0; q < 32; ++q) dst[(long)q * 512] = (bf16_t)f2bf(acc[q]);
        }
      });
    } else {
      const int bc = job - 32; bf16_t* base = (bf16_t*)(ws + OFF_C + C_GVT) + (long)bc * 512 * 128;
      float* ssum = (float*)smem; float* ssq = ssum + 128;
      float* psum = ssum + 256; float* psq = psum + 16 * 128;
      const int cs = tid >> 4, s8 = (tid & 15) * 8;
      float a[8], q[8];
#pragma unroll
      for (int i = 0; i < 8; ++i) { a[i] = 0.f; q[i] = 0.f; }
      for (int it = 0; it < 32; ++it) {
        u32x4 d = *(const u32x4*)(base + (long)(it * 16 + cs) * 128 + s8);
#pragma unroll
        for (int i = 0; i < 4; ++i) { float lo = bf2f(d[i] & 0xffffu), hi = bf2f(d[i] >> 16); a[2 * i] += lo; q[2 * i] += lo * lo; a[2 * i + 1] += hi; q[2 * i + 1] += hi * hi; }
      }
#pragma unroll
      for (int i = 0; i < 8; ++i) { psum[cs * 128 + s8 + i] = a[i]; psq[cs * 128 + s8 + i] = q[i]; }
      __syncthreads();
      if (tid < 128) {
        float su = 0.f, sq = 0.f;
        for (int c = 0; c < 16; ++c) { su += psum[c * 128 + tid]; sq += psq[c * 128 + tid]; }
        float mean_t = su * (1.f / 512.f); float var = sq * (1.f / 512.f) - mean_t * mean_t; if (var < 0.f) var = 0.f;
        ssum[tid] = mean_t; ssq[tid] = rsqrtf(var + 1e-6f);
      }
      __syncthreads();
      float mean[8], rs[8];
#pragma unroll
      for (int i = 0; i < 8; ++i) { mean[i] = ssum[s8 + i]; rs[i] = ssq[s8 + i]; }
      for (int it = 0; it < 32; ++it) {
        int ch = it * 16 + cs; float gg = P.ln_sgu[ch];
        u32x4 d = *(const u32x4*)(base + (long)ch * 128 + s8); float v[8];
#pragma unroll
        for (int i = 0; i < 4; ++i) { v[2 * i] = bf2f(d[i] & 0xffffu); v[2 * i + 1] = bf2f(d[i] >> 16); }
#pragma unroll
        for (int i = 0; i < 8; ++i) v[i] = (v[i] - mean[i]) * rs[i] * gg;
        *(u32x4*)(base + (long)ch * 128 + s8) = pack8(v);
      }
      __syncthreads();
    }
  }
}

template <int MODE>
__device__ __forceinline__ void nsa_block(const bf16x8 (&qf)[4][2], f32x4 (&oacc)[4][4], float (&m)[4], float (&l)[4],
                                          const float (&sl2)[4], const float (&inv)[4], const bf16_t* kp, const bf16_t* vp, long vdt,
                                          int dist0, bool rowok, float (&asum)[2], float (&bsum)[2]) {
  constexpr int DSTEP = (MODE <= 1) ? 16 : 1;
  bf16x8 kf[2][2];
#pragma unroll
  for (int kt = 0; kt < 2; ++kt)
#pragma unroll
    for (int ks = 0; ks < 2; ++ks) kf[kt][ks] = *(const bf16x8*)(kp + kt * 16 * 128 + ks * 32);
  bf16x8 vf[4];
  if (MODE != 0) {
#pragma unroll
    for (int dt = 0; dt < 4; ++dt) {
      u32x2 lo = *(const u32x2*)(vp + dt * vdt); u32x2 hi = *(const u32x2*)(vp + dt * vdt + 16);
      u32x4 c; c[0] = lo[0]; c[1] = lo[1]; c[2] = hi[0]; c[3] = hi[1];
      vf[dt] = __builtin_bit_cast(bf16x8, c);
    }
  }
  const float fd0 = (float)dist0;
#pragma unroll
  for (int h = 0; h < 4; ++h) {
    f32x4 s[2];
#pragma unroll
    for (int kt = 0; kt < 2; ++kt) {
      s[kt] = __builtin_amdgcn_mfma_f32_16x16x32_bf16(kf[kt][0], qf[h][0], (f32x4){0.f, 0.f, 0.f, 0.f}, 0, 0, 0);
      s[kt] = __builtin_amdgcn_mfma_f32_16x16x32_bf16(kf[kt][1], qf[h][1], s[kt], 0, 0, 0);
    }
    float sc[8]; bool ok[8];
#pragma unroll
    for (int kt = 0; kt < 2; ++kt)
#pragma unroll
      for (int r = 0; r < 4; ++r) {
        const int e = kt * 16 + r; const int dist = dist0 - DSTEP * e;
        sc[kt * 4 + r] = s[kt][r] - sl2[h] * (fd0 - (float)(DSTEP * e));
        bool o = dist >= 0;
        if (MODE == 2) o = o && rowok;
        if (MODE == 3) o = o && (dist < 512);
        ok[kt * 4 + r] = o;
      }
    float p[8];
    if (MODE != 1) {
      float ml = NEGF;
#pragma unroll
      for (int i = 0; i < 8; ++i) ml = fmaxf(ml, ok[i] ? sc[i] : NEGF);
      ml = fmaxf(ml, __shfl_xor(ml, 16, 64)); ml = fmaxf(ml, __shfl_xor(ml, 32, 64));
      const float mn = fmaxf(m[h], ml); const float alpha = __builtin_amdgcn_exp2f(m[h] - mn); m[h] = mn;
      float ps = 0.f;
#pragma unroll
      for (int i = 0; i < 8; ++i) { p[i] = ok[i] ? __builtin_amdgcn_exp2f(sc[i] - mn) : 0.f; ps += p[i]; }
      l[h] = l[h] * alpha + ps;
      if (MODE != 0) {
#pragma unroll
        for (int dt = 0; dt < 4; ++dt) oacc[h][dt] *= alpha;
      }
    } else {
#pragma unroll
      for (int i = 0; i < 8; ++i) p[i] = ok[i] ? __builtin_amdgcn_exp2f(sc[i] - m[h]) * l[h] : 0.f;
      asum[0] += (p[0] + p[1]) + (p[2] + p[3]); bsum[0] += p[3];
      asum[1] += (p[4] + p[5]) + (p[6] + p[7]); bsum[1] += p[7];
    }
    if (MODE != 0) {
      u32x4 pk; pk[0] = pack2(p[0], p[1]); pk[1] = pack2(p[2], p[3]); pk[2] = pack2(p[4], p[5]); pk[3] = pack2(p[6], p[7]);
      const bf16x8 pf = __builtin_bit_cast(bf16x8, pk);
#pragma unroll
      for (int dt = 0; dt < 4; ++dt) oacc[h][dt] = __builtin_amdgcn_mfma_f32_16x16x32_bf16(vf[dt], pf, oacc[h][dt], 0, 0, 0);
    }
    __builtin_amdgcn_sched_barrier(0);
  }
}

__device__ void nsa_tile(const Params& P, int wt, char* wl) {
  char* C = P.ws + OFF_C;
  const bf16_t* Q = (const bf16_t*)(C + C_Q);
  const bf16_t* KCMP = (const bf16_t*)(P.ws + OFF_KCMP); const bf16_t* VCT = (const bf16_t*)(P.ws + OFF_VCT);
  const bf16_t* KS = (const bf16_t*)(C + C_KS); const bf16_t* VST = (const bf16_t*)(C + C_VST);
  const bf16_t* KW = (const bf16_t*)(C + C_KW); const bf16_t* VWT = (const bf16_t*)(C + C_VWT);
  const float* GATES = (const float*)(C + C_GATES);
  bf16_t* O = (bf16_t*)(P.ws + OFF_D);
  const int lane = tidx() & 63, qi = lane & 15, quad = lane >> 4;
  wt = __builtin_amdgcn_readfirstlane(wt);
  const int bg = wt & 3, b = bg >> 1, g = bg & 1;
  const int t0 = (511 - (wt >> 2)) * 16;
  const int t = t0 + qi;
  const long row = (long)b * T_ + t;
  bf16x8 qf[4][2];
#pragma unroll
  for (int h = 0; h < 4; ++h)
#pragma unroll
    for (int ks = 0; ks < 2; ++ks) qf[h][ks] = *(const bf16x8*)(Q + row * 512 + (g * 4 + h) * 64 + ks * 32 + quad * 8);
  float sl2[4];
#pragma unroll
  for (int h = 0; h < 4; ++h) sl2[h] = __builtin_amdgcn_exp2f(-(float)(g * 4 + h + 1)) * LOG2E;
  f32x4 oacc[4][4]; float m[4], l[4], inv[4]; float asum[2], bsum[2];
  float* imp = (float*)wl; float* outl = (float*)wl;
  unsigned* sel = (unsigned*)(wl + 16384); unsigned* uni = sel + 64;
#pragma unroll
  for (int h = 0; h < 4; ++h) { m[h] = NEGF; l[h] = 0.f; inv[h] = 0.f; }
  asum[0] = asum[1] = bsum[0] = bsum[1] = 0.f;

  const int nI = t0 >> 4; const int nblk = (nI + 31) >> 5;
  for (int blk = 0; blk < nblk; ++blk) {
    const int key0 = blk * 32;
    const bf16_t* kp = KCMP + (long)(b * 512 + key0 + qi) * 128 + g * 64 + quad * 8;
    nsa_block<0>(qf, oacc, m, l, sl2, inv, kp, nullptr, 0, t - 31 - 16 * (key0 + quad * 4), true, asum, bsum);
  }
#pragma unroll
  for (int h = 0; h < 4; ++h) { float lt = l[h]; lt += __shfl_xor(lt, 16, 64); lt += __shfl_xor(lt, 32, 64); l[h] = 1.f / fmaxf(lt, 1e-30f); }
  for (int i = lane; i < 16 * 132; i += 64) imp[i] = 0.f;
#pragma unroll
  for (int h = 0; h < 4; ++h)
#pragma unroll
    for (int dt = 0; dt < 4; ++dt) oacc[h][dt] = (f32x4){0.f, 0.f, 0.f, 0.f};
  for (int blk = 0; blk < nblk; ++blk) {
    const int key0 = blk * 32;
    const bf16_t* kp = KCMP + (long)(b * 512 + key0 + qi) * 128 + g * 64 + quad * 8;
    const bf16_t* vp = VCT + (long)(b * 128 + g * 64 + qi) * 512 + key0 + quad * 4;
    asum[0] = asum[1] = bsum[0] = bsum[1] = 0.f;
    nsa_block<1>(qf, oacc, m, l, sl2, inv, kp, vp, 16 * 512, t - 31 - 16 * (key0 + quad * 4), true, asum, bsum);
    const int J = (key0 >> 2) + quad;
    atomicAdd(&imp[qi * 132 + J], asum[0]); atomicAdd(&imp[qi * 132 + J + 1], bsum[0]);
    atomicAdd(&imp[qi * 132 + J + 4], asum[1]); atomicAdd(&imp[qi * 132 + J + 5], bsum[1]);
  }
  const int cur = t0 >> 6;
  if (lane < 16) {
    unsigned w0 = 0, w1 = 0, w2 = 0, w3 = 0;
    if (cur < 16) { w0 = (1u << (cur + 1)) - 1u; }
    else {
      w0 = 1u;
      { int j = cur; unsigned bit = 1u << (j & 31); int w = j >> 5; if (w == 0) w0 |= bit; else if (w == 1) w1 |= bit; else if (w == 2) w2 |= bit; else w3 |= bit; }
      { int j = cur - 1; unsigned bit = 1u << (j & 31); int w = j >> 5; if (w == 0) w0 |= bit; else if (w == 1) w1 |= bit; else if (w == 2) w2 |= bit; else w3 |= bit; }
    }
    sel[lane * 4 + 0] = w0; sel[lane * 4 + 1] = w1; sel[lane * 4 + 2] = w2; sel[lane * 4 + 3] = w3;
  }
  if (lane < 4) uni[lane] = 0u;
  if (cur >= 16) {
    for (int rnd = 0; rnd < 4; ++rnd) {
      const int qq = rnd * 4 + quad;
      unsigned key[8];
#pragma unroll
      for (int c = 0; c < 8; ++c) {
        const int j = qi + 16 * c;
        const bool v = (j <= cur) && (j != 0) && (j != cur) && (j != cur - 1);
        const unsigned bits = __float_as_uint(imp[qq * 132 + j]);
        key[c] = v ? ((bits & 0xFFFFFF00u) | (unsigned)(128 - j)) : 0u;
      }
      for (int it = 0; it < 13; ++it) {
        unsigned mx = key[0];
#pragma unroll
        for (int c = 1; c < 8; ++c) mx = key[c] > mx ? key[c] : mx;
#pragma unroll
        for (int o = 1; o < 16; o <<= 1) { unsigned ot = (unsigned)__shfl_xor((int)mx, o, 64); mx = ot > mx ? ot : mx; }
        if (mx != 0u) {
#pragma unroll
          for (int c = 0; c < 8; ++c) {
            if (key[c] == mx) { key[c] = 0u; const int j = qi + 16 * c; atomicOr(&sel[qq * 4 + (j >> 5)], 1u << (j & 31)); }
          }
        }
      }
    }
  }
  unsigned mym[4];
#pragma unroll
  for (int w = 0; w < 4; ++w) mym[w] = sel[qi * 4 + w];
  if (lane < 16) {
#pragma unroll
    for (int w = 0; w < 4; ++w) atomicOr(&uni[w], mym[w]);
  }
  const float* gp = GATES + row * 24 + g * 12;
#pragma unroll
  for (int h = 0; h < 4; ++h) {
    const float gt = gp[h * 3 + 0] * NSA_G0;
#pragma unroll
    for (int dt = 0; dt < 4; ++dt) *(f32x4*)(outl + ((h * 16 + qi) * 64 + (((dt * 4 + quad) ^ qi) << 2))) = oacc[h][dt] * gt;
  }
#pragma unroll
  for (int h = 0; h < 4; ++h) { m[h] = NEGF; l[h] = 0.f;
#pragma unroll
    for (int dt = 0; dt < 4; ++dt) oacc[h][dt] = (f32x4){0.f, 0.f, 0.f, 0.f}; }
#pragma unroll 1
  for (int w = 0; w < 4; ++w) {
    unsigned bits = __builtin_amdgcn_readfirstlane(uni[w]);
    const unsigned myw = sel[qi * 4 + w];
    while (bits) {
      const int jj = __builtin_ctz(bits); bits &= bits - 1u;
      const int j = w * 32 + jj; const bool rowok = (myw >> jj) & 1u;
#pragma unroll 1
      for (int half = 0; half < 2; ++half) {
        const int key0 = j * 64 + half * 32;
        const bf16_t* kp = KS + (long)(b * T_ + key0 + qi) * 128 + g * 64 + quad * 8;
        const bf16_t* vp = VST + (long)(b * 128 + g * 64 + qi) * T_ + key0 + quad * 4;
        nsa_block<2>(qf, oacc, m, l, sl2, inv, kp, vp, 16L * T_, t - (key0 + quad * 4), rowok, asum, bsum);
      }
    }
  }
#pragma unroll
  for (int h = 0; h < 4; ++h) {
    float lt = l[h]; lt += __shfl_xor(lt, 16, 64); lt += __shfl_xor(lt, 32, 64);
    const float sc = NSA_G1 * gp[h * 3 + 1] / fmaxf(lt, 1e-30f);
#pragma unroll
    for (int dt = 0; dt < 4; ++dt) { f32x4* d = (f32x4*)(outl + ((h * 16 + qi) * 64 + (((dt * 4 + quad) ^ qi) << 2))); *d = *d + oacc[h][dt] * sc; }
  }
#pragma unroll
  for (int h = 0; h < 4; ++h) { m[h] = NEGF; l[h] = 0.f;
#pragma unroll
    for (int dt = 0; dt < 4; ++dt) oacc[h][dt] = (f32x4){0.f, 0.f, 0.f, 0.f}; }
  {
    const int kstart = t0 >= 512 ? ((t0 - 511) & ~31) : 0;
    for (int key0 = kstart; key0 <= t0 + 15; key0 += 32) {
      const bf16_t* kp = KW + (long)(b * T_ + key0 + qi) * 128 + g * 64 + quad * 8;
      const bf16_t* vp = VWT + (long)(b * 128 + g * 64 + qi) * T_ + key0 + quad * 4;
      nsa_block<3>(qf, oacc, m, l, sl2, inv, kp, vp, 16L * T_, t - (key0 + quad * 4), true, asum, bsum);
    }
  }
#pragma unroll
  for (int h = 0; h < 4; ++h) {
    float lt = l[h]; lt += __shfl_xor(lt, 16, 64); lt += __shfl_xor(lt, 32, 64);
    const float sc = NSA_G2 * gp[h * 3 + 2] / fmaxf(lt, 1e-30f);
#pragma unroll
    for (int dt = 0; dt < 4; ++dt) { f32x4* d = (f32x4*)(outl + ((h * 16 + qi) * 64 + (((dt * 4 + quad) ^ qi) << 2))); *d = *d + oacc[h][dt] * sc; }
  }
#pragma unroll
  for (int it = 0; it < 8; ++it) {
    const int id = it * 64 + lane; const int h = id >> 7, rem = id & 127, q2 = rem >> 3, c8 = rem & 7;
    f32x4 a = *(const f32x4*)(outl + ((h * 16 + q2) * 64 + (((2 * c8) ^ q2) << 2)));
    f32x4 bb = *(const f32x4*)(outl + ((h * 16 + q2) * 64 + (((2 * c8 + 1) ^ q2) << 2)));
    float v[8] = {a[0], a[1], a[2], a[3], bb[0], bb[1], bb[2], bb[3]};
    *(u32x4*)(O + ((long)b * T_ + t0 + q2) * 512 + (g * 4 + h) * 64 + c8 * 8) = pack8(v);
  }
}

__device__ void xattn_tile(const Params& P, int wt) {
  const bf16_t* HQ = (const bf16_t*)(P.ws + OFF_D);
  const bf16_t* MK = (const bf16_t*)(P.ws + OFF_MK); const bf16_t* MVT = (const bf16_t*)(P.ws + OFF_MVT);
  bf16_t* OX = (bf16_t*)(P.ws + OFF_D) + (long)M_ * 512;
  const int lane = tidx() & 63, qi = lane & 15, quad = lane >> 4;
  wt = __builtin_amdgcn_readfirstlane(wt);
  const int h = wt & 3; const int row0 = (wt >> 2) * 32; const int b = row0 >> 13;
  bf16x8 qf[2][4];
#pragma unroll
  for (int nt = 0; nt < 2; ++nt)
#pragma unroll
    for (int ks = 0; ks < 4; ++ks) qf[nt][ks] = *(const bf16x8*)(HQ + (long)(row0 + nt * 16 + qi) * 512 + h * 128 + ks * 32 + quad * 8);
  f32x4 oacc[2][8]; float m[2], l[2];
#pragma unroll
  for (int nt = 0; nt < 2; ++nt) { m[nt] = NEGF; l[nt] = 0.f;
#pragma unroll
    for (int dt = 0; dt < 8; ++dt) oacc[nt][dt] = (f32x4){0.f, 0.f, 0.f, 0.f}; }
  for (int blk = 0; blk < 8; ++blk) {
    const int key0 = blk * 32;
    f32x4 s[2][2];
#pragma unroll
    for (int nt = 0; nt < 2; ++nt)
#pragma unroll
      for (int kt = 0; kt < 2; ++kt) s[nt][kt] = (f32x4){0.f, 0.f, 0.f, 0.f};
#pragma unroll
    for (int ks = 0; ks < 4; ++ks) {
#pragma unroll
      for (int kt = 0; kt < 2; ++kt) {
        bf16x8 kf = *(const bf16x8*)(MK + (long)(b * 256 + key0 + kt * 16 + qi) * 512 + h * 128 + ks * 32 + quad * 8);
#pragma unroll
        for (int nt = 0; nt < 2; ++nt) s[nt][kt] = __builtin_amdgcn_mfma_f32_16x16x32_bf16(kf, qf[nt][ks], s[nt][kt], 0, 0, 0);
      }
    }
    bf16x8 pf[2];
#pragma unroll
    for (int nt = 0; nt < 2; ++nt) {
      float ml = NEGF;
#pragma unroll
      for (int kt = 0; kt < 2; ++kt)
#pragma unroll
        for (int r = 0; r < 4; ++r) ml = fmaxf(ml, s[nt][kt][r]);
      ml = fmaxf(ml, __shfl_xor(ml, 16, 64)); ml = fmaxf(ml, __shfl_xor(ml, 32, 64));
      const float mn = fmaxf(m[nt], ml); const float alpha = __builtin_amdgcn_exp2f(m[nt] - mn); m[nt] = mn;
      float p[8]; float ps = 0.f;
#pragma unroll
      for (int kt = 0; kt < 2; ++kt)
#pragma unroll
        for (int r = 0; r < 4; ++r) { p[kt * 4 + r] = __builtin_amdgcn_exp2f(s[nt][kt][r] - mn); ps += p[kt * 4 + r]; }
      l[nt] = l[nt] * alpha + ps;
#pragma unroll
      for (int dt = 0; dt < 8; ++dt) oacc[nt][dt] *= alpha;
      u32x4 pk; pk[0] = pack2(p[0], p[1]); pk[1] = pack2(p[2], p[3]); pk[2] = pack2(p[4], p[5]); pk[3] = pack2(p[6], p[7]);
      pf[nt] = __builtin_bit_cast(bf16x8, pk);
    }
#pragma unroll
    for (int dt = 0; dt < 8; ++dt) {
      const bf16_t* vp = MVT + (long)(b * 512 + h * 128 + dt * 16 + qi) * 256 + key0 + quad * 4;
      u32x2 lo = *(const u32x2*)(vp); u32x2 hi = *(const u32x2*)(vp + 16);
      u32x4 c; c[0] = lo[0]; c[1] = lo[1]; c[2] = hi[0]; c[3] = hi[1];
      const bf16x8 vf = __builtin_bit_cast(bf16x8, c);
#pragma unroll
      for (int nt = 0; nt < 2; ++nt) oacc[nt][dt] = __builtin_amdgcn_mfma_f32_16x16x32_bf16(vf, pf[nt], oacc[nt][dt], 0, 0, 0);
    }
  }
#pragma unroll
  for (int nt = 0; nt < 2; ++nt) {
    float lt = l[nt]; lt += __shfl_xor(lt, 16, 64); lt += __shfl_xor(lt, 32, 64);
    const float iv = 1.f / lt;
#pragma unroll
    for (int dt = 0; dt < 8; ++dt) {
      f32x4 v = oacc[nt][dt] * iv; u32x2 pk; pk[0] = pack2(v[0], v[1]); pk[1] = pack2(v[2], v[3]);
      *(u32x2*)(OX + (long)(row0 + nt * 16 + qi) * 512 + h * 128 + dt * 16 + quad * 4) = pk;
    }
  }
}


#define XB_TMO      128
#define XB_XCNT(j)  (256  + 64 * (j))
#define XB_XSUB(j)  (1280 + 64 * (j))
#define XB_XGEN(j)  (2304 + 64 * (j))
#define XB_TOP      3328
#define XB_TOPGEN   3392
#define XCD_BAR_WORDS 3456
#define XB_SPIN_CAP (1u << 18)
#define LAS __attribute__((address_space(3)))
__device__ __forceinline__ unsigned xb_ld(unsigned* p) { return __hip_atomic_load(p, __ATOMIC_RELAXED, __HIP_MEMORY_SCOPE_AGENT); }
__device__ __forceinline__ unsigned xb_add(unsigned* p, unsigned v) { return __hip_atomic_fetch_add(p, v, __ATOMIC_RELAXED, __HIP_MEMORY_SCOPE_AGENT); }
__device__ __forceinline__ unsigned xb_xcc_id() { return (unsigned)__builtin_amdgcn_s_getreg((3 << 11) | 20) & 0xFu; }
#define XB_SPIN(cond, bar) do { unsigned _sp = 0; while (cond) { __builtin_amdgcn_s_sleep(1); \
    if ((++_sp & 255u) == 0u) { if (xb_ld(&(bar)[XB_TMO])) break; if (_sp > XB_SPIN_CAP) { atomicAdd(&(bar)[XB_TMO], 1u); break; } } } } while (0)
__device__ __forceinline__ void xcd_barrier_complete(unsigned* bar, unsigned x, unsigned& nloc, unsigned& nx) {
  const unsigned G = gridDim.x * gridDim.y * gridDim.z;
  unsigned sum, cnt, mine, sp = 0u;
  for (;;) {
    sum = 0u; cnt = 0u; mine = 0u;
#pragma unroll
    for (unsigned j = 0; j < 16; ++j) { const unsigned c = xb_ld(&bar[XB_XCNT(j)]); sum += c; cnt += (c > 0u) ? 1u : 0u; mine = (j == x) ? c : mine; }
    if (sum == G) break;
    __builtin_amdgcn_s_sleep(1);
    if ((++sp & 255u) == 0u) { if (xb_ld(&bar[XB_TMO])) break; if (sp > XB_SPIN_CAP) { atomicAdd(&bar[XB_TMO], 1u); break; } }
  }
  nloc = mine > 0u ? mine : 1u; nx = cnt > 0u ? cnt : 1u;
}
__device__ __forceinline__ void xcd_barrier(unsigned* bar, unsigned x, volatile LAS unsigned* st) {
  asm volatile("s_waitcnt vmcnt(0)" ::: "memory");
  __syncthreads();
  if (threadIdx.x == 0) {
    __builtin_amdgcn_s_waitcnt(0);
    unsigned nloc = st[0], nx = st[1];
    if (nloc == 0u) { xcd_barrier_complete(bar, x, nloc, nx); st[0] = nloc; st[1] = nx; }
    const unsigned old = xb_add(&bar[XB_XSUB(x)], 1u);
    const unsigned gen = old / nloc;
    if (old + 1u == (gen + 1u) * nloc) {
      __builtin_amdgcn_fence(__ATOMIC_RELEASE, "agent");
      asm volatile("s_waitcnt vmcnt(0)" ::: "memory");
      const unsigned og = xb_add(&bar[XB_TOP], 1u);
      const unsigned tg = og / nx;
      if (og + 1u == (tg + 1u) * nx) xb_add(&bar[XB_TOPGEN], 1u);
      else XB_SPIN(xb_ld(&bar[XB_TOPGEN]) == tg, bar);
      __builtin_amdgcn_fence(__ATOMIC_ACQUIRE, "agent");
      xb_add(&bar[XB_XGEN(x)], 1u);
      asm volatile("s_waitcnt vmcnt(0)" ::: "memory");
    } else {
      XB_SPIN(xb_ld(&bar[XB_XGEN(x)]) == gen, bar);
      __builtin_amdgcn_fence(__ATOMIC_ACQUIRE, "agent");
      asm volatile("s_waitcnt vmcnt(0)" ::: "memory");
    }
  }
  __syncthreads();
}

__device__ void run_phase(const Params& P, int ph, char* smem) {
  char* ws = P.ws; const int tid = tidx();
  switch (ph) {
    case 0: phase0(P, smem); break;
    case 1: phase1(P, smem); break;
    case 2: phase2(P, smem); break;
    case 3: {
      for (int job = blockIdx.x; job < 512; job += gridDim.x) { const int wv = tidx() >> 6; nsa_tile(P, job * 4 + wv, smem + wv * 16896); }
      __syncthreads();
      for (int job = blockIdx.x; job < 512; job += gridDim.x) {
        {
          const int tid = tidx();
          const int s = job; const int bc = s >> 2, g = s & 3;
          RowLin ar{(const bf16_t*)(ws + OFF_WM) + g * 16384, 128};
          RowLin br{(const bf16_t*)(ws + OFF_C + C_GVT) + ((long)bc * 512 + g * 128) * 128, 128};
          const float* bs = P.b_sp + g * 128;
          const bf16_t* U = (const bf16_t*)(ws + OFF_C + C_U) + (long)bc * 128 * 512 + g * 128;
          bf16_t* OS = (bf16_t*)(ws + OFF_D) + (long)M_ * 512 + (long)bc * 128 * 512 + g * 128;
          gemm_tile(smem, ar, br, 2, 64, 64, [&](const float* Cs) {
#pragma unroll 2
            for (int it = 0; it < 8; ++it) {
              int id = it * 256 + tid; int r = id >> 4, c = (id & 15) * 8; float v[8]; ld8(Cs, r, c, v);
              u32x4 d = *(const u32x4*)(U + (long)r * 512 + c); const float bb = bs[r];
#pragma unroll
              for (int i = 0; i < 4; ++i) { v[2 * i] = (v[2 * i] + bb) * bf2f(d[i] & 0xffffu); v[2 * i + 1] = (v[2 * i + 1] + bb) * bf2f(d[i] >> 16); }
              *(u32x4*)(OS + (long)r * 512 + c) = pack8(v);
            }
          });
        }
      }
    } break;
    case 4: {
      float* scr = (float*)(ws + OFF_C + C_SCR) + (long)blockIdx.x * 16384;
      for (int job = blockIdx.x; job < 1024; job += gridDim.x) {
        const int mt = job >> 3, nt = job & 7, brow = mt * 128, bcol = nt * 128;
        const bf16_t* MG = (const bf16_t*)(ws + OFF_B) + (long)brow * 2048 + bcol;
        RowLin a1{(const bf16_t*)(ws + OFF_D) + (long)brow * 512, 512};
        RowLin b1{(const bf16_t*)(ws + OFF_WPA) + (long)bcol * 512, 512};
        gemm_tile(smem, a1, b1, 8, 64, 64, [&](const float* Cs) {
#pragma unroll 2
          for (int it = 0; it < 8; ++it) {
            int id = it * 256 + tid; int r = id >> 4, c = (id & 15) * 8; float v[8]; ld8(Cs, r, c, v);
            u32x4 d = *(const u32x4*)(MG + (long)r * 2048 + c);
#pragma unroll
            for (int i = 0; i < 4; ++i) { v[2 * i] *= bf2f(d[i] & 0xffffu); v[2 * i + 1] *= bf2f(d[i] >> 16); }
            *(f32x4*)(scr + id * 8) = (f32x4){v[0], v[1], v[2], v[3]}; *(f32x4*)(scr + id * 8 + 4) = (f32x4){v[4], v[5], v[6], v[7]};
          }
        });
        RowLin a2{(const bf16_t*)(ws + OFF_D) + (long)M_ * 512 + (long)brow * 512, 512};
        RowLin b2{(const bf16_t*)(ws + OFF_WPB) + (long)bcol * 512, 512};
        bf16_t* MX = (bf16_t*)(ws + OFF_C + C_MIXED) + (long)brow * 1024 + bcol;
        gemm_tile(smem, a2, b2, 8, 64, 64, [&](const float* Cs) {
#pragma unroll 2
          for (int it = 0; it < 8; ++it) {
            int id = it * 256 + tid; int r = id >> 4, c = (id & 15) * 8; float v[8]; ld8(Cs, r, c, v);
            u32x4 d = *(const u32x4*)(MG + (long)r * 2048 + 1024 + c);
            f32x4 p0 = *(const f32x4*)(scr + id * 8), p1 = *(const f32x4*)(scr + id * 8 + 4);
            float pv[8] = {p0[0], p0[1], p0[2], p0[3], p1[0], p1[1], p1[2], p1[3]};
#pragma unroll
            for (int i = 0; i < 4; ++i) { v[2 * i] = pv[2 * i] + v[2 * i] * bf2f(d[i] & 0xffffu); v[2 * i + 1] = pv[2 * i + 1] + v[2 * i + 1] * bf2f(d[i] >> 16); }
            *(u32x4*)(MX + (long)r * 1024 + c) = pack8(v);
          }
        });
      }
    } break;
    case 5: case 9: case 12: {
      const bf16_t* A; const bf16_t* W; const float* RES; float* DST; int K;
      if (ph == 5) { A = (const bf16_t*)(ws + OFF_C + C_MIXED); W = (const bf16_t*)(ws + OFF_WOUT); RES = P.x; DST = (float*)(ws + OFF_B); K = 1024; }
      else if (ph == 9) { A = (const bf16_t*)(ws + OFF_D) + (long)M_ * 512; W = (const bf16_t*)(ws + OFF_WMO); RES = (const float*)(ws + OFF_B); DST = (float*)(ws + OFF_C + C_H2); K = 512; }
      else { A = (const bf16_t*)(ws + OFF_B); W = (const bf16_t*)(ws + OFF_WDN); RES = (const float*)(ws + OFF_C + C_H2); DST = P.out; K = 2816; }
      for (int job = blockIdx.x; job < 1024; job += gridDim.x) {
        const int mt = job >> 3, nt = job & 7, brow = mt * 128, bcol = nt * 128;
        RowLin ar{A + (long)brow * K, K}; RowLin br{W + (long)bcol * K, K};
        const float* rs = RES + (long)brow * 1024 + bcol; float* ds = DST + (long)brow * 1024 + bcol;
        gemm_tile(smem, ar, br, K / 64, 64, 64, [&](const float* Cs) {
#pragma unroll 2
          for (int it = 0; it < 8; ++it) {
            int id = it * 256 + tid; int r = id >> 4, c = (id & 15) * 8;
            f32x4 a = *(const f32x4*)(Cs + r * CS_LD + c), bq = *(const f32x4*)(Cs + r * CS_LD + c + 4);
            f32x4 r0 = *(const f32x4*)(rs + (long)r * 1024 + c), r1 = *(const f32x4*)(rs + (long)r * 1024 + c + 4);
            *(f32x4*)(ds + (long)r * 1024 + c) = a + r0; *(f32x4*)(ds + (long)r * 1024 + c + 4) = bq + r1;
          }
        });
      }
    } break;
    case 6: case 10: {
      const float* src = ph == 6 ? (const float*)(ws + OFF_B) : (const float*)(ws + OFF_C + C_H2);
      const float* g = ph == 6 ? P.norm_mq : P.norm_ffn;
      for (int job = blockIdx.x; job < 4096; job += gridDim.x) { int row = job * 4 + (tid >> 6); rownorm_row<false>(src + (long)row * 1024, g, (bf16_t*)(ws + OFF_A) + (long)row * 1024); }
    } break;
    case 7: {
      for (int job = blockIdx.x; job < 512; job += gridDim.x) {
        const int mt = job >> 2, nt = job & 3, brow = mt * 128;
        RowLin ar{(const bf16_t*)(ws + OFF_A) + (long)brow * 1024, 1024}; RowLin br{(const bf16_t*)(ws + OFF_WMQ) + (long)nt * 128 * 1024, 1024};
        gemm_tile(smem, ar, br, 16, 64, 64, [&](const float* Cs) {
          store_rows_bf16(Cs, (bf16_t*)(ws + OFF_D) + (long)brow * 512 + nt * 128, 512, [](float v, int) { return v * (0.08838834764831845f * LOG2E); });
        });
      }
    } break;
    case 8: {
      for (int job = blockIdx.x; job < 512; job += gridDim.x) xattn_tile(P, job * 4 + (tid >> 6));
    } break;
    case 11: {
      for (int job = blockIdx.x; job < 128 * 44; job += gridDim.x) {
        const int mt = job / 44, nt = job % 44, brow = mt * 128;
        RowLin ar{(const bf16_t*)(ws + OFF_A) + (long)brow * 1024, 1024}; RowLin br{(const bf16_t*)(ws + OFF_WGU) + (long)nt * 128 * 1024, 1024};
        bf16_t* ACT = (bf16_t*)(ws + OFF_B) + (long)brow * 2816 + nt * 64;
        gemm_tile(smem, ar, br, 16, 64, 64, [&](const float* Cs) {
#pragma unroll 2
          for (int it = 0; it < 4; ++it) {
            int id = it * 256 + tid; int r = id >> 3, c = (id & 7) * 8; float gt[8], up[8]; ld8(Cs, r, c, gt); ld8(Cs, r, c + 64, up);
#pragma unroll
            for (int i = 0; i < 8; ++i) gt[i] = gt[i] * sigm(gt[i]) * up[i];
            *(u32x4*)(ACT + (long)r * 2816 + c) = pack8(gt);
          }
        });
      }
    } break;
    case 13: {
      for (int job = blockIdx.x; job < 4096; job += gridDim.x) { int row = job * 4 + (tid >> 6); rownorm_row<true>(P.out + (long)row * 1024, P.norm_final, P.out + (long)row * 1024); }
    } break;
#ifdef PROBE_K
    case 14: {
      const bf16_t* s0 = (const bf16_t*)(ws + PROBE_SRC0); const bf16_t* s1 = (const bf16_t*)(ws + PROBE_SRC1);
      for (long i = (long)blockIdx.x * 256 + tid; i < (long)M_ * 512; i += (long)gridDim.x * 256) {
        long row = i >> 9; int c = (int)(i & 511);
        P.out[row * 1024 + c] = bf2f(s0[i]); P.out[row * 1024 + 512 + c] = bf2f(s1[i]);
      }
    } break;
    case 15: {
      const float* s0 = (const float*)(ws + PROBE_SRC0);
      for (long i = (long)blockIdx.x * 256 + tid; i < (long)M_ * 1024; i += (long)gridDim.x * 256) P.out[i] = s0[i];
    } break;
#endif
  }
}

__global__ void __launch_bounds__(256, 2) fwd_kernel(Params P, int ph_lo, int ph_hi) {
  __shared__ __attribute__((aligned(16))) char smem[67584 + 16];
  volatile LAS unsigned* st = (volatile LAS unsigned*)(smem + 67584);
  const unsigned xcc = xb_xcc_id();
  if (ph_lo < ph_hi) {
    if (threadIdx.x == 0) { st[0] = 0u; st[1] = 0u; }
    __syncthreads();
    if (threadIdx.x == 0) (void)xb_add(&((unsigned*)(P.ws + OFF_BAR))[XB_XCNT(xcc)], 1u);
  }
  if (ph_hi < 0) cg::this_grid().sync();
  for (int ph = ph_lo; ph <= ph_hi; ++ph) {
    const uint64_t __attribute__((address_space(4)))* ka = (const uint64_t __attribute__((address_space(4)))*)__builtin_amdgcn_kernarg_segment_ptr();
    asm volatile("" : "+s"(ka));
    Params Pl; uint64_t* pd = (uint64_t*)&Pl;
#pragma unroll
    for (int i = 0; i < (int)(sizeof(Params) / 8); ++i) pd[i] = ka[i];
    run_phase(Pl, ph, smem);
    if (ph < ph_hi) xcd_barrier((unsigned*)(Pl.ws + OFF_BAR), xcc, st);
  }
}

extern "C" void kernel_launch(void* const* d_in, const int* in_sizes, int n_in, void* d_out, int out_size, void* d_ws, size_t ws_size,
                              hipStream_t stream) {
  static int grid_blocks = 0;
  if (!grid_blocks) {
    int dev = 0, cus = 0, per_cu = 0;
    hipGetDevice(&dev);
    hipDeviceGetAttribute(&cus, hipDeviceAttributeMultiprocessorCount, dev);
    hipOccupancyMaxActiveBlocksPerMultiprocessor(&per_cu, fwd_kernel, 256, 0);
    if (per_cu > 2) per_cu = 2;
    if (per_cu < 1) per_cu = 1;
    grid_blocks = cus * per_cu;
  }
  if (ws_size < (size_t)WS_NEED) fprintf(stderr, "workspace too small: %zu < %ld\n", ws_size, (long)WS_NEED);
  Params P{};
  const float** pp = (const float**)&P;
  for (int i = 0; i < 27; ++i) pp[i] = (const float*)d_in[i];
  P.out = (float*)d_out; P.ws = (char*)d_ws;
#if ONE_LAUNCH
  hipMemsetAsync((char*)d_ws + OFF_BAR, 0, XCD_BAR_WORDS * 4, stream);
#ifdef PROBE_K
  int lo = 0, hi = PROBE_DUMP;
#else
  int lo = 0, hi = 13;
#endif
  void* args[] = {&P, &lo, &hi};
  hipError_t e = hipLaunchCooperativeKernel((void*)fwd_kernel, dim3(grid_blocks), dim3(256), args, 0, stream);
  if (e != hipSuccess) fprintf(stderr, "cooperative launch failed: %s (grid %d)\n", hipGetErrorString(e), grid_blocks);
#else
  for (int ph = 0; ph <= 13; ++ph) fwd_kernel<<<grid_blocks, 256, 0, stream>>>(P, ph, ph);
#endif
}
```

```cpp
#include <hip/hip_runtime.h>
#include <hip/hip_cooperative_groups.h>
#include <stdint.h>
#include <stdio.h>
namespace cg = cooperative_groups;

#ifndef NSA_G0
#define NSA_G0 1.f
#define NSA_G1 1.f
#define NSA_G2 1.f
#endif
#ifndef ONE_LAUNCH
#define ONE_LAUNCH 1
#endif

typedef unsigned short bf16_t;
using bf16x8 = __attribute__((ext_vector_type(8))) short;
using f32x4 = __attribute__((ext_vector_type(4))) float;
using u32x4 = __attribute__((ext_vector_type(4))) unsigned;
using u32x2 = __attribute__((ext_vector_type(2))) unsigned;

#define T_ 8192
#define M_ 16384
#define NEGF (-1e30f)
#define LOG2E 1.4426950408889634f

constexpr long OFF_W1 = 0;
constexpr long OFF_WMKV = OFF_W1 + 9175040;
constexpr long OFF_WPA = OFF_WMKV + 2097152;
constexpr long OFF_WPB = OFF_WPA + 1048576;
constexpr long OFF_WOUT = OFF_WPB + 1048576;
constexpr long OFF_WMQ = OFF_WOUT + 2097152;
constexpr long OFF_WMO = OFF_WMQ + 1048576;
constexpr long OFF_WGU = OFF_WMO + 1048576;
constexpr long OFF_WDN = OFF_WGU + 11534336;
constexpr long OFF_WCK1 = OFF_WDN + 5767168;
constexpr long OFF_WCV1 = OFF_WCK1 + 524288;
constexpr long OFF_WM = OFF_WCV1 + 524288;
constexpr long OFF_BIAS1 = OFF_WM + 131072;
constexpr long OFF_MEMN = OFF_BIAS1 + 1024;
constexpr long OFF_MK = OFF_MEMN + 1048576;
constexpr long OFF_MVT = OFF_MK + 524288;
constexpr long OFF_KCMP = OFF_MVT + 524288;
constexpr long OFF_VCT = OFF_KCMP + 262144;
constexpr long OFF_A = OFF_VCT + 262144;
constexpr long OFF_B = OFF_A + 33554432;
constexpr long OFF_D = OFF_B + 67108864;
constexpr long OFF_C = OFF_D + 33554432;
constexpr long C_Q = 0, C_U = 16777216, C_GVT = 33554432, C_KC = 50331648, C_VC = 54525952, C_KS = 58720256,
               C_KW = 62914560, C_VST = 67108864, C_VWT = 71303168, C_GATES = 75497472;
constexpr long C_MIXED = 0, C_SCR = 33554432, C_H2 = 0;
constexpr long OFF_BAR = OFF_C + 77070336;
constexpr long WS_NEED = OFF_BAR + 16384;

struct Params {
  const float *x, *mem, *norm_mix, *w_in, *w_ck1, *w_ck2, *w_cv1, *w_cv2, *pe_k, *pe_v, *ln_sgu, *w_sp, *b_sp,
      *w_pa, *w_pb, *w_merge, *b_merge, *w_out, *norm_mq, *norm_mkv, *w_mq, *w_mkv, *w_mo, *norm_ffn, *w_gu, *w_dn, *norm_final;
  float* out;
  char* ws;
};

__device__ __forceinline__ int tidx() { int t = threadIdx.x; asm volatile("" : "+v"(t)); return t; }
__device__ __forceinline__ unsigned f2bf(float f) { unsigned u = __float_as_uint(f); u += 0x7fffu + ((u >> 16) & 1u); return u >> 16; }
__device__ __forceinline__ unsigned pack2(float a, float b) { return f2bf(a) | (f2bf(b) << 16); }
__device__ __forceinline__ float bf2f(unsigned h) { return __uint_as_float(h << 16); }
__device__ __forceinline__ float gelu_tanh(float x) { float u = 0.7978845608028654f * (x + 0.044715f * x * x * x); return x / (1.f + __expf(-2.f * u)); }
__device__ __forceinline__ float sigm(float x) { return 1.f / (1.f + __expf(-x)); }
__device__ __forceinline__ float wave_sum(float v) {
#pragma unroll
  for (int o = 32; o > 0; o >>= 1) v += __shfl_xor(v, o, 64);
  return v;
}
__device__ __forceinline__ u32x4 pack8(const float (&v)[8]) {
  u32x4 r; r[0] = pack2(v[0], v[1]); r[1] = pack2(v[2], v[3]); r[2] = pack2(v[4], v[5]); r[3] = pack2(v[6], v[7]); return r;
}

__device__ __forceinline__ int lds_byte(int r, int c) {
  int st = (r >> 4) * 2 + (c >> 5), rr = r & 15, cc = c & 31, ob = rr * 64 + cc * 2;
  return st * 1024 + (ob ^ (((ob >> 9) & 1) << 5));
}
__device__ __forceinline__ void stage_rc(int b, int& R, int& C) {
  int st = b >> 10, sb = b & 1023, swz = sb ^ (((sb >> 9) & 1) << 5);
  R = (st >> 1) * 16 + (swz >> 6); C = (st & 1) * 32 + ((swz & 63) >> 1);
}

#define CS_LD 132
__device__ __forceinline__ void ld8(const float* Cs, int r, int c, float (&v)[8]) {
  f32x4 a = *(const f32x4*)(Cs + r * CS_LD + c); f32x4 b = *(const f32x4*)(Cs + r * CS_LD + c + 4);
  v[0] = a[0]; v[1] = a[1]; v[2] = a[2]; v[3] = a[3]; v[4] = b[0]; v[5] = b[1]; v[6] = b[2]; v[7] = b[3];
}
__device__ __forceinline__ void ld8T(const float* Cs, int r8, int c, float (&v)[8]) {
#pragma unroll
  for (int i = 0; i < 8; ++i) v[i] = Cs[(r8 + i) * CS_LD + c];
}

struct RowLin {
  const bf16_t* base; long ld;
  __device__ __forceinline__ const bf16_t* operator()(int r) const { return base + (long)r * ld; }
};
struct RowCmp {
  const bf16_t* base; int brow;
  __device__ __forceinline__ const bf16_t* operator()(int r) const {
    int R = brow + r; int b = R >> 10, rem = R & 1023, i = rem >> 1, g = rem & 1; if (i > 510) i = 510;
    return base + ((long)(b * T_ + 16 * i) * 128 + g * 64);
  }
};

template <int AUX = 0, class ARow, class BRow, class Epi>
__device__ __forceinline__ void gemm_tile(char* smem, ARow arow, BRow brow, int nkt, int kstepA, int kstepB, Epi epi) {
  const int tid = tidx(), lane = tid & 63, wave = tid >> 6, wr = wave >> 1, wc = wave & 1, fr = lane & 15, fq = lane >> 4;
  const bf16_t* pa[4]; const bf16_t* pb[4];
#pragma unroll
  for (int i = 0; i < 4; ++i) { int b = tid * 16 + i * 4096; int R, C; stage_rc(b, R, C); pa[i] = arow(R) + C; pb[i] = brow(R) + C; }
  f32x4 acc[4][4];
#pragma unroll
  for (int m = 0; m < 4; ++m)
#pragma unroll
    for (int n = 0; n < 4; ++n) acc[m][n] = (f32x4){0.f, 0.f, 0.f, 0.f};
  {
#pragma unroll
    for (int i = 0; i < 4; ++i) {
      __builtin_amdgcn_global_load_lds((const unsigned*)(pa[i]), (unsigned*)(smem + tid * 16 + i * 4096), 16, 0, AUX);
      __builtin_amdgcn_global_load_lds((const unsigned*)(pb[i]), (unsigned*)(smem + 16384 + tid * 16 + i * 4096), 16, 0, AUX);
    }
  }
  for (int kt = 0; kt < nkt; ++kt) {
    asm volatile("s_waitcnt vmcnt(0)" ::: "memory");
    __syncthreads();
    if (kt + 1 < nkt) {
      char* la = smem + ((kt + 1) & 1) * 32768;
#pragma unroll
      for (int i = 0; i < 4; ++i) {
        __builtin_amdgcn_global_load_lds((const unsigned*)(pa[i] + (long)(kt + 1) * kstepA), (unsigned*)(la + tid * 16 + i * 4096), 16, 0, AUX);
        __builtin_amdgcn_global_load_lds((const unsigned*)(pb[i] + (long)(kt + 1) * kstepB), (unsigned*)(la + 16384 + tid * 16 + i * 4096), 16, 0, AUX);
      }
    }
    const char* la = smem + (kt & 1) * 32768; const char* lb = la + 16384;
#pragma unroll
    for (int ks = 0; ks < 2; ++ks) {
      bf16x8 a[4], b[4];
#pragma unroll
      for (int m = 0; m < 4; ++m) a[m] = *(const bf16x8*)(la + lds_byte(wr * 64 + m * 16 + fr, ks * 32 + fq * 8));
#pragma unroll
      for (int n = 0; n < 4; ++n) b[n] = *(const bf16x8*)(lb + lds_byte(wc * 64 + n * 16 + fr, ks * 32 + fq * 8));
#pragma unroll
      for (int m = 0; m < 4; ++m)
#pragma unroll
        for (int n = 0; n < 4; ++n) acc[m][n] = __builtin_amdgcn_mfma_f32_16x16x32_bf16(a[m], b[n], acc[m][n], 0, 0, 0);
    }
  }
  __syncthreads();
  float* Cs = (float*)smem;
#pragma unroll
  for (int m = 0; m < 4; ++m)
#pragma unroll
    for (int n = 0; n < 4; ++n)
#pragma unroll
      for (int r = 0; r < 4; ++r) Cs[(wr * 64 + m * 16 + fq * 4 + r) * CS_LD + wc * 64 + n * 16 + fr] = acc[m][n][r];
  __syncthreads();
  epi(Cs);
  __syncthreads();
}

template <class F>
__device__ __forceinline__ void store_rows_bf16(const float* Cs, bf16_t* dst, long ld, F f) {
#pragma unroll 2
  for (int it = 0; it < 8; ++it) {
    int id = it * 256 + tidx(); int r = id >> 4, c = (id & 15) * 8;
    float v[8]; ld8(Cs, r, c, v);
#pragma unroll
    for (int i = 0; i < 8; ++i) v[i] = f(v[i], c + i);
    *(u32x4*)(dst + (long)r * ld + c) = pack8(v);
  }
}
template <class F>
__device__ __forceinline__ void store_T_bf16(const float* Cs, bf16_t* dst, long cstride, F f) {
#pragma unroll 2
  for (int it = 0; it < 8; ++it) {
    int id = it * 256 + tidx(); int c = id >> 4, r8 = (id & 15) * 8;
    float v[8]; ld8T(Cs, r8, c, v);
#pragma unroll
    for (int i = 0; i < 8; ++i) v[i] = f(v[i]);
    *(u32x4*)(dst + (long)c * cstride + r8) = pack8(v);
  }
}


__device__ __forceinline__ int lds_byte32(int r, int c) { int rr = r & 15; return (r >> 4) * 1024 + rr * 64 + ((((c >> 3) ^ ((-(rr >> 2)) & 3)) & 3) << 4); }
__device__ __forceinline__ void stage_rc32(int b, int& R, int& C) { int st = b >> 10, sb = b & 1023, rr = sb >> 6, cp = (sb >> 4) & 3; R = st * 16 + rr; C = ((cp ^ ((-(rr >> 2)) & 3)) & 3) * 8; }
struct RowClamp {
  const bf16_t* base; long ld; int maxr;
  __device__ __forceinline__ const bf16_t* operator()(int r) const { return base + (long)(r < maxr ? r : maxr) * ld; }
};
#define G2_STAGE 24576
template <class ARow, class BRow, class Epi>
__device__ __forceinline__ void gemm_tile2(char* smem, ARow arow, BRow brow, int nkt, Epi epi) {
  const int tid = tidx(), lane = tid & 63, wave = tid >> 6, wr = wave >> 1, wc = wave & 1, fr = lane & 15, fq = lane >> 4;
  const bf16_t* pa[2]; const bf16_t* pb[4];
#pragma unroll
  for (int i = 0; i < 2; ++i) { int R, C; stage_rc32(tid * 16 + i * 4096, R, C); pa[i] = arow(R) + C; }
#pragma unroll
  for (int i = 0; i < 4; ++i) { int R, C; stage_rc32(tid * 16 + i * 4096, R, C); pb[i] = brow(R) + C; }
  f32x4 acc[4][8];
#pragma unroll
  for (int m = 0; m < 4; ++m)
#pragma unroll
    for (int n = 0; n < 8; ++n) acc[m][n] = (f32x4){0.f, 0.f, 0.f, 0.f};
#define G2_ISSUE(BUF, KT) do { char* _la = smem + (BUF) * G2_STAGE; \
    _Pragma("unroll") for (int _i = 0; _i < 2; ++_i) __builtin_amdgcn_global_load_lds((const unsigned*)(pa[_i] + (long)(KT) * 32), (unsigned*)(_la + tid * 16 + _i * 4096), 16, 0, 0); \
    _Pragma("unroll") for (int _i = 0; _i < 4; ++_i) __builtin_amdgcn_global_load_lds((const unsigned*)(pb[_i] + (long)(KT) * 32), (unsigned*)(_la + 8192 + tid * 16 + _i * 4096), 16, 0, 0); } while (0)
  G2_ISSUE(0, 0);
  if (nkt > 1) G2_ISSUE(1, 1);
  int cur = 0;
  for (int kt = 0; kt < nkt; ++kt) {
    if (kt + 1 < nkt) asm volatile("s_waitcnt vmcnt(6)" ::: "memory"); else asm volatile("s_waitcnt vmcnt(0)" ::: "memory");
    asm volatile("s_waitcnt lgkmcnt(0)" ::: "memory");
    __builtin_amdgcn_s_barrier();
    asm volatile("" ::: "memory");
    if (kt + 2 < nkt) { const int nb = cur == 0 ? 2 : cur - 1; G2_ISSUE(nb, kt + 2); }
    const char* la = smem + cur * G2_STAGE; const char* lb = la + 8192;
    bf16x8 a[4], b[8];
#pragma unroll
    for (int m = 0; m < 4; ++m) a[m] = *(const bf16x8*)(la + lds_byte32(wr * 64 + m * 16 + fr, fq * 8));
#pragma unroll
    for (int n = 0; n < 8; ++n) b[n] = *(const bf16x8*)(lb + lds_byte32(wc * 128 + n * 16 + fr, fq * 8));
#pragma unroll
    for (int m = 0; m < 4; ++m)
#pragma unroll
      for (int n = 0; n < 8; ++n) acc[m][n] = __builtin_amdgcn_mfma_f32_16x16x32_bf16(a[m], b[n], acc[m][n], 0, 0, 0);
    cur = cur == 2 ? 0 : cur + 1;
  }
#undef G2_ISSUE
  float* Cs = (float*)smem;
#pragma unroll
  for (int p = 0; p < 2; ++p) {
    __syncthreads();
    if (wc == p) {
#pragma unroll
      for (int m = 0; m < 4; ++m)
#pragma unroll
        for (int n = 0; n < 8; ++n)
#pragma unroll
          for (int r = 0; r < 4; ++r) Cs[(wr * 64 + m * 16 + fq * 4 + r) * CS_LD + n * 16 + fr] = acc[m][n][r];
    }
    __syncthreads();
    epi(Cs, p);
  }
  __syncthreads();
}

template <int MODE>
__device__ __forceinline__ void transpose_tile(const float* W, int Nsrc, bf16_t* Wt, int Kd, int k0, int n0, float* lds) {
  const int tid = tidx();
  {
    int tx = tid & 63, ty = tid >> 6; int np = n0 + tx; int sc;
    if (MODE == 0) sc = np < Nsrc ? np : -1;
    else { int x = np & 127, tl = np >> 7; sc = x < 64 ? tl * 64 + x : 2816 + tl * 64 + x - 64; }
#pragma unroll
    for (int kk = ty; kk < 64; kk += 4) lds[kk * 65 + tx] = sc >= 0 ? W[(long)(k0 + kk) * Nsrc + sc] : 0.f;
  }
  __syncthreads();
  {
    int nrow = tid >> 2, kseg = (tid & 3) * 16; float v[8];
#pragma unroll
    for (int i = 0; i < 8; ++i) v[i] = lds[(kseg + i) * 65 + nrow];
    *(u32x4*)(Wt + (long)(n0 + nrow) * Kd + k0 + kseg) = pack8(v);
#pragma unroll
    for (int i = 0; i < 8; ++i) v[i] = lds[(kseg + 8 + i) * 65 + nrow];
    *(u32x4*)(Wt + (long)(n0 + nrow) * Kd + k0 + kseg + 8) = pack8(v);
  }
  __syncthreads();
}

template <bool OUTF, int NR>
__device__ __forceinline__ void rownorm_rows(const float* src, const float* g, void* dst) {
  const int lane = tidx() & 63;
  f32x4 v[NR][4];
#pragma unroll
  for (int r = 0; r < NR; ++r)
#pragma unroll
    for (int i = 0; i < 4; ++i) v[r][i] = *(const f32x4*)(src + (long)r * 1024 + i * 256 + lane * 4);
  f32x4 gg[4];
#pragma unroll
  for (int i = 0; i < 4; ++i) gg[i] = *(const f32x4*)(g + i * 256 + lane * 4);
#pragma unroll
  for (int r = 0; r < NR; ++r) {
    float ss = 0.f;
#pragma unroll
    for (int i = 0; i < 4; ++i) ss += v[r][i][0] * v[r][i][0] + v[r][i][1] * v[r][i][1] + v[r][i][2] * v[r][i][2] + v[r][i][3] * v[r][i][3];
    ss = wave_sum(ss);
    const float rr = rsqrtf(ss * (1.f / 1024.f) + 1e-6f);
#pragma unroll
    for (int i = 0; i < 4; ++i) {
      float o0 = v[r][i][0] * rr * gg[i][0], o1 = v[r][i][1] * rr * gg[i][1], o2 = v[r][i][2] * rr * gg[i][2], o3 = v[r][i][3] * rr * gg[i][3];
      if (OUTF) { *(f32x4*)((float*)dst + (long)r * 1024 + i * 256 + lane * 4) = (f32x4){o0, o1, o2, o3}; }
      else { u32x2 p; p[0] = pack2(o0, o1); p[1] = pack2(o2, o3); *(u32x2*)((bf16_t*)dst + (long)r * 1024 + i * 256 + lane * 4) = p; }
    }
  }
}

__device__ void phase0(const Params& P, char* smem) {
  float* lds = (float*)smem;
  const int tid = tidx();
  const int NJ = 8 + 1024 + 32 + 32 + 4384;
  for (int job = blockIdx.x; job < NJ; job += gridDim.x) {
    int j = job;
    if (j < 8) {
      int n = j * 32 + (tid & 31), sl = tid >> 5; int kv = n >> 7, nn = n & 127;
      const float* pe = kv ? P.pe_v : P.pe_k; const float* w1 = kv ? P.w_cv1 : P.w_ck1;
      float s = 0.f;
      for (int k = sl * 256; k < sl * 256 + 256; ++k) s += pe[k] * w1[(long)k * 128 + nn];
      lds[sl * 32 + (tid & 31)] = s;
      __syncthreads();
      if (tid < 32) { float t = 0.f; for (int q = 0; q < 8; ++q) t += lds[q * 32 + tid]; ((float*)(P.ws + OFF_BIAS1))[j * 32 + tid] = t; }
      __syncthreads();
      continue;
    }
    j -= 8;
    if (j < 1024) { int row = j * 16 + (tid >> 6) * 4; rownorm_rows<false, 4>(P.x + (long)row * 1024, P.norm_mix, (bf16_t*)(P.ws + OFF_A) + (long)row * 1024); continue; }
    j -= 1024;
    if (j < 32) { int row = j * 16 + (tid >> 6) * 4; rownorm_rows<false, 4>(P.mem + (long)row * 1024, P.norm_mkv, (bf16_t*)(P.ws + OFF_MEMN) + (long)row * 1024); continue; }
    j -= 32;
    if (j < 32) {
      int e0 = j * 2048 + tid * 8; float v[8];
#pragma unroll
      for (int i = 0; i < 8; ++i) { int e = e0 + i; int t = (e >> 7) & 127, s = e & 127; v[i] = s <= t ? P.w_sp[e] : 0.f; }
      *(u32x4*)((bf16_t*)(P.ws + OFF_WM) + e0) = pack8(v);
      continue;
    }
    j -= 32;
#define TRJ(KT, NT, W, NSRC, WT, KD, MODE) \
    if (j < (KT) * (NT)) { transpose_tile<MODE>(W, NSRC, (bf16_t*)(P.ws + (WT)), KD, (j % (KT)) * 64, (j / (KT)) * 64, lds); continue; } \
    j -= (KT) * (NT);
    TRJ(16, 88, P.w_gu, 5632, OFF_WGU, 1024, 1)
    TRJ(44, 16, P.w_dn, 1024, OFF_WDN, 2816, 0)
    TRJ(16, 38, P.w_in, 2328, OFF_W1, 1024, 0)
    TRJ(16, 32, P.w_merge, 2048, OFF_W1 + 2432L * 1024 * 2, 1024, 0)
    TRJ(16, 16, P.w_mkv, 1024, OFF_WMKV, 1024, 0)
    TRJ(16, 16, P.w_out, 1024, OFF_WOUT, 1024, 0)
    TRJ(8, 16, P.w_pa, 1024, OFF_WPA, 512, 0)
    TRJ(8, 16, P.w_pb, 1024, OFF_WPB, 512, 0)
    TRJ(16, 8, P.w_mq, 512, OFF_WMQ, 1024, 0)
    TRJ(8, 16, P.w_mo, 1024, OFF_WMO, 512, 0)
    TRJ(32, 2, P.w_ck1, 128, OFF_WCK1, 2048, 0)
    TRJ(32, 2, P.w_cv1, 128, OFF_WCV1, 2048, 0)
#undef TRJ
  }
}

__device__ void phase1(const Params& P, char* smem) {
  char* ws = P.ws;
  const int NG1 = 128 * 18;
  const int xq = blockIdx.x & 7, lq = blockIdx.x >> 3, sq = gridDim.x >> 3;
  for (int t = lq; t < 16 * 18 + 4; t += sq) {
    const int job = t < 16 * 18 ? 0 : NG1 + xq * 4 + (t - 16 * 18);
    if (t < 16 * 18) {
      const int mt = xq * 16 + (t & 15), nt2 = t >> 4; const int brow = mt * 128;
      RowLin ar{(const bf16_t*)(ws + OFF_A) + (long)brow * 1024, 1024};
      RowClamp br{(const bf16_t*)(ws + OFF_W1) + (long)nt2 * 256 * 1024, 1024, 4479 - nt2 * 256};
      gemm_tile2(smem, ar, br, 32, [&](const float* Cs, int p) {
        const int nt = nt2 * 2 + p; if (nt >= 35) return;
        char* C = ws + OFF_C;
        if (nt < 4) {
          store_rows_bf16(Cs, (bf16_t*)(C + C_Q) + (long)brow * 512 + nt * 128, 512, [](float v, int) { return v * (0.125f * LOG2E); });
        } else if (nt == 4 || nt == 5 || nt == 6 || nt == 8) {
          long off = nt == 4 ? C_KC : nt == 5 ? C_VC : nt == 6 ? C_KS : C_KW;
          store_rows_bf16(Cs, (bf16_t*)(C + off) + (long)brow * 128, 128, [](float v, int) { return v; });
        } else if (nt == 7 || nt == 9) {
          long off = nt == 7 ? C_VST : C_VWT; int b = brow >> 13, tl = brow & 8191;
          store_T_bf16(Cs, (bf16_t*)(C + off) + (long)b * 128 * T_ + tl, T_, [](float v) { return v; });
        } else if (nt < 14) {
          store_rows_bf16(Cs, (bf16_t*)(C + C_U) + (long)brow * 512 + (nt - 10) * 128, 512, [](float v, int) { return gelu_tanh(v); });
        } else if (nt < 18) {
          store_T_bf16(Cs, (bf16_t*)(C + C_GVT) + ((long)(brow >> 7) * 512 + (nt - 14) * 128) * 128, 128, [](float v) { return gelu_tanh(v); });
        } else if (nt == 18) {
          float* gates = (float*)(C + C_GATES);
          for (int id = tidx(); id < 128 * 24; id += 256) { int r = id / 24, c = id % 24; gates[(long)(brow + r) * 24 + c] = sigm(Cs[r * CS_LD + c]); }
        } else {
          const float* bm = P.b_merge + (nt - 19) * 128;
          store_rows_bf16(Cs, (bf16_t*)(ws + OFF_B) + (long)brow * 2048 + (nt - 19) * 128, 2048, [bm](float v, int c) { return sigm(v + bm[c]); });
        }
      });
    } else {
      const int j = job - NG1; const int mt = j >> 3, nt = j & 7; const int brow = mt * 128;
      RowLin ar{(const bf16_t*)(ws + OFF_MEMN) + (long)brow * 1024, 1024};
      RowLin br{(const bf16_t*)(ws + OFF_WMKV) + (long)nt * 128 * 1024, 1024};
      gemm_tile(smem, ar, br, 16, 64, 64, [&](const float* Cs) {
        if (nt < 4) store_rows_bf16(Cs, (bf16_t*)(ws + OFF_MK) + (long)brow * 512 + nt * 128, 512, [](float v, int) { return v; });
        else { int b = mt >> 1, n0 = (mt & 1) * 128; store_T_bf16(Cs, (bf16_t*)(ws + OFF_MVT) + ((long)b * 512 + (nt - 4) * 128) * 256 + n0, 256, [](float v) { return v; }); }
      });
    }
  }
}

__device__ void phase2(const Params& P, char* smem) {
  char* ws = P.ws; const int tid = tidx();
  for (int job = blockIdx.x; job < 32 + 128; job += gridDim.x) {
    if (job < 32) {
      const int kv = job >> 4, mt = job & 15, brow = mt * 128;
      RowCmp ar{(const bf16_t*)(ws + OFF_C + (kv ? C_VC : C_KC)), brow};
      RowLin br{(const bf16_t*)(ws + (kv ? OFF_WCV1 : OFF_WCK1)), 2048};
      const float* bias1 = (const float*)(ws + OFF_BIAS1) + kv * 128;
      const float* w2 = kv ? P.w_cv2 : P.w_ck2;
      gemm_tile(smem, ar, br, 32, 128, 64, [&](const float* Csc) {
        float* Cs = (float*)Csc;
        for (int it = 0; it < 64; ++it) { int id = it * 256 + tid; int r = id >> 7, n = id & 127; Cs[r * CS_LD + n] = gelu_tanh(Cs[r * CS_LD + n] + bias1[n]); }
        __syncthreads();
        const int r = tid >> 1, half = tid & 1;
        float acc[32];
#pragma unroll
        for (int i = 0; i < 32; ++i) acc[i] = 0.f;
        for (int n = 0; n < 128; ++n) {
          float h = Cs[r * CS_LD + n]; const float* wr = w2 + n * 64 + half * 32;
#pragma unroll
          for (int q = 0; q < 8; ++q) { f32x4 w = *(const f32x4*)(wr + q * 4); acc[q * 4] += h * w[0]; acc[q * 4 + 1] += h * w[1]; acc[q * 4 + 2] += h * w[2]; acc[q * 4 + 3] += h * w[3]; }
        }
        const int R = brow + r; const int b = R >> 10, rem = R & 1023, i = rem >> 1, g = rem & 1;
        if (i >= 511) {
#pragma unroll
          for (int q = 0; q < 32; ++q) acc[q] = 0.f;
        }
        if (kv == 0) {
          bf16_t* dst = (bf16_t*)(ws + OFF_KCMP) + (long)(b * 512 + i) * 128 + g * 64 + half * 32;
#pragma unroll
          for (int q = 0; q < 4; ++q) { float v[8];
#pragma unroll
            for (int e = 0; e < 8; ++e) v[e] = acc[q * 8 + e];
            *(u32x4*)(dst + q * 8) = pack8(v); }
        } else {
          bf16_t* dst = (bf16_t*)(ws + OFF_VCT) + ((long)(b * 128 + g * 64 + half * 32)) * 512 + i;
#pragma unroll
          for (int q = 0; q < 32; ++q) dst[(long)q * 512] = (bf16_t)f2bf(acc[q]);
        }
      });
    } else {
      const int bc = job - 32; bf16_t* base = (bf16_t*)(ws + OFF_C + C_GVT) + (long)bc * 512 * 128;
      float* ssum = (float*)smem; float* ssq = ssum + 128;
      float* psum = ssum + 256; float* psq = psum + 16 * 128;
      const int cs = tid >> 4, s8 = (tid & 15) * 8;
      float a[8], q[8];
#pragma unroll
      for (int i = 0; i < 8; ++i) { a[i] = 0.f; q[i] = 0.f; }
      for (int it = 0; it < 32; ++it) {
        u32x4 d = *(const u32x4*)(base + (long)(it * 16 + cs) * 128 + s8);
#pragma unroll
        for (int i = 0; i < 4; ++i) { float lo = bf2f(d[i] & 0xffffu), hi = bf2f(d[i] >> 16); a[2 * i] += lo; q[2 * i] += lo * lo; a[2 * i + 1] += hi; q[2 * i + 1] += hi * hi; }
      }
#pragma unroll
      for (int i = 0; i < 8; ++i) { psum[cs * 128 + s8 + i] = a[i]; psq[cs * 128 + s8 + i] = q[i]; }
      __syncthreads();
      if (tid < 128) {
        float su = 0.f, sq = 0.f;
        for (int c = 0; c < 16; ++c) { su += psum[c * 128 + tid]; sq += psq[c * 128 + tid]; }
        float mean_t = su * (1.f / 512.f); float var = sq * (1.f / 512.f) - mean_t * mean_t; if (var < 0.f) var = 0.f;
        ssum[tid] = mean_t; ssq[tid] = rsqrtf(var + 1e-6f);
      }
      __syncthreads();
      float mean[8], rs[8];
#pragma unroll
      for (int i = 0; i < 8; ++i) { mean[i] = ssum[s8 + i]; rs[i] = ssq[s8 + i]; }
      for (int it = 0; it < 32; ++it) {
        int ch = it * 16 + cs; float gg = P.ln_sgu[ch];
        u32x4 d = *(const u32x4*)(base + (long)ch * 128 + s8); float v[8];
#pragma unroll
        for (int i = 0; i < 4; ++i) { v[2 * i] = bf2f(d[i] & 0xffffu); v[2 * i + 1] = bf2f(d[i] >> 16); }
#pragma unroll
        for (int i = 0; i < 8; ++i) v[i] = (v[i] - mean[i]) * rs[i] * gg;
        *(u32x4*)(base + (long)ch * 128 + s8) = pack8(v);
      }
      __syncthreads();
    }
  }
}

template <int MODE>
__device__ __forceinline__ void nsa_block(const bf16x8 (&qf)[4][2], f32x4 (&oacc)[4][4], float (&m)[4], float (&l)[4],
                                          const float (&sl2)[4], const float (&inv)[4], const bf16_t* kp, const bf16_t* vp, long vdt,
                                          int dist0, bool rowok, float (&asum)[2], float (&bsum)[2]) {
  constexpr int DSTEP = (MODE <= 1) ? 16 : 1;
  bf16x8 kf[2][2];
#pragma unroll
  for (int kt = 0; kt < 2; ++kt)
#pragma unroll
    for (int ks = 0; ks < 2; ++ks) kf[kt][ks] = *(const bf16x8*)(kp + kt * 16 * 128 + ks * 32);
  bf16x8 vf[4];
  if (MODE != 0) {
#pragma unroll
    for (int dt = 0; dt < 4; ++dt) {
      u32x2 lo = *(const u32x2*)(vp + dt * vdt); u32x2 hi = *(const u32x2*)(vp + dt * vdt + 16);
      u32x4 c; c[0] = lo[0]; c[1] = lo[1]; c[2] = hi[0]; c[3] = hi[1];
      vf[dt] = __builtin_bit_cast(bf16x8, c);
    }
  }
  const float fd0 = (float)dist0;
#pragma unroll
  for (int h = 0; h < 4; ++h) {
    f32x4 s[2];
#pragma unroll
    for (int kt = 0; kt < 2; ++kt) {
      s[kt] = __builtin_amdgcn_mfma_f32_16x16x32_bf16(kf[kt][0], qf[h][0], (f32x4){0.f, 0.f, 0.f, 0.f}, 0, 0, 0);
      s[kt] = __builtin_amdgcn_mfma_f32_16x16x32_bf16(kf[kt][1], qf[h][1], s[kt], 0, 0, 0);
    }
    float sc[8]; bool ok[8];
#pragma unroll
    for (int kt = 0; kt < 2; ++kt)
#pragma unroll
      for (int r = 0; r < 4; ++r) {
        const int e = kt * 16 + r; const int dist = dist0 - DSTEP * e;
        sc[kt * 4 + r] = s[kt][r] - sl2[h] * (fd0 - (float)(DSTEP * e));
        bool o = dist >= 0;
        if (MODE == 2) o = o && rowok;
        if (MODE == 3) o = o && (dist < 512);
        ok[kt * 4 + r] = o;
      }
    float p[8];
    if (MODE != 1) {
      float ml = NEGF;
#pragma unroll
      for (int i = 0; i < 8; ++i) ml = fmaxf(ml, ok[i] ? sc[i] : NEGF);
      ml = fmaxf(ml, __shfl_xor(ml, 16, 64)); ml = fmaxf(ml, __shfl_xor(ml, 32, 64));
      const float mn = fmaxf(m[h], ml); const float alpha = __builtin_amdgcn_exp2f(m[h] - mn); m[h] = mn;
      float ps = 0.f;
#pragma unroll
      for (int i = 0; i < 8; ++i) { p[i] = ok[i] ? __builtin_amdgcn_exp2f(sc[i] - mn) : 0.f; ps += p[i]; }
      l[h] = l[h] * alpha + ps;
      if (MODE != 0) {
#pragma unroll
        for (int dt = 0; dt < 4; ++dt) oacc[h][dt] *= alpha;
      }
    } else {
#pragma unroll
      for (int i = 0; i < 8; ++i) p[i] = ok[i] ? __builtin_amdgcn_exp2f(sc[i] - m[h]) * l[h] : 0.f;
      asum[0] += (p[0] + p[1]) + (p[2] + p[3]); bsum[0] += p[3];
      asum[1] += (p[4] + p[5]) + (p[6] + p[7]); bsum[1] += p[7];
    }
    if (MODE != 0) {
      u32x4 pk; pk[0] = pack2(p[0], p[1]); pk[1] = pack2(p[2], p[3]); pk[2] = pack2(p[4], p[5]); pk[3] = pack2(p[6], p[7]);
      const bf16x8 pf = __builtin_bit_cast(bf16x8, pk);
#pragma unroll
      for (int dt = 0; dt < 4; ++dt) oacc[h][dt] = __builtin_amdgcn_mfma_f32_16x16x32_bf16(vf[dt], pf, oacc[h][dt], 0, 0, 0);
    }
    __builtin_amdgcn_sched_barrier(0);
  }
}

__device__ void nsa_tile(const Params& P, int wt, char* wl) {
  char* C = P.ws + OFF_C;
  const bf16_t* Q = (const bf16_t*)(C + C_Q);
  const bf16_t* KCMP = (const bf16_t*)(P.ws + OFF_KCMP); const bf16_t* VCT = (const bf16_t*)(P.ws + OFF_VCT);
  const bf16_t* KS = (const bf16_t*)(C + C_KS); const bf16_t* VST = (const bf16_t*)(C + C_VST);
  const bf16_t* KW = (const bf16_t*)(C + C_KW); const bf16_t* VWT = (const bf16_t*)(C + C_VWT);
  const float* GATES = (const float*)(C + C_GATES);
  bf16_t* O = (bf16_t*)(P.ws + OFF_D);
  const int lane = tidx() & 63, qi = lane & 15, quad = lane >> 4;
  wt = __builtin_amdgcn_readfirstlane(wt);
  const int bg = wt & 3, b = bg >> 1, g = bg & 1;
  const int tq = (wt >> 2) < 256 ? 511 - (wt >> 2) : (wt >> 2) - 256;
  const int t0 = tq * 16;
  const int t = t0 + qi;
  const long row = (long)b * T_ + t;
  bf16x8 qf[4][2];
#pragma unroll
  for (int h = 0; h < 4; ++h)
#pragma unroll
    for (int ks = 0; ks < 2; ++ks) qf[h][ks] = *(const bf16x8*)(Q + row * 512 + (g * 4 + h) * 64 + ks * 32 + quad * 8);
  float sl2[4];
#pragma unroll
  for (int h = 0; h < 4; ++h) sl2[h] = __builtin_amdgcn_exp2f(-(float)(g * 4 + h + 1)) * LOG2E;
  f32x4 oacc[4][4]; float m[4], l[4], inv[4]; float asum[2], bsum[2];
  float* imp = (float*)wl; float* outl = (float*)wl;
  unsigned* sel = (unsigned*)(wl + 16384); unsigned* uni = sel + 64;
#pragma unroll
  for (int h = 0; h < 4; ++h) { m[h] = NEGF; l[h] = 0.f; inv[h] = 0.f; }
  asum[0] = asum[1] = bsum[0] = bsum[1] = 0.f;

  const int nI = t0 >> 4; const int nblk = (nI + 31) >> 5;
  for (int blk = 0; blk < nblk; ++blk) {
    const int key0 = blk * 32;
    const bf16_t* kp = KCMP + (long)(b * 512 + key0 + qi) * 128 + g * 64 + quad * 8;
    nsa_block<0>(qf, oacc, m, l, sl2, inv, kp, nullptr, 0, t - 31 - 16 * (key0 + quad * 4), true, asum, bsum);
  }
#pragma unroll
  for (int h = 0; h < 4; ++h) { float lt = l[h]; lt += __shfl_xor(lt, 16, 64); lt += __shfl_xor(lt, 32, 64); l[h] = 1.f / fmaxf(lt, 1e-30f); }
  for (int i = lane; i < 16 * 132; i += 64) imp[i] = 0.f;
#pragma unroll
  for (int h = 0; h < 4; ++h)
#pragma unroll
    for (int dt = 0; dt < 4; ++dt) oacc[h][dt] = (f32x4){0.f, 0.f, 0.f, 0.f};
  for (int blk = 0; blk < nblk; ++blk) {
    const int key0 = blk * 32;
    const bf16_t* kp = KCMP + (long)(b * 512 + key0 + qi) * 128 + g * 64 + quad * 8;
    const bf16_t* vp = VCT + (long)(b * 128 + g * 64 + qi) * 512 + key0 + quad * 4;
    asum[0] = asum[1] = bsum[0] = bsum[1] = 0.f;
    nsa_block<1>(qf, oacc, m, l, sl2, inv, kp, vp, 16 * 512, t - 31 - 16 * (key0 + quad * 4), true, asum, bsum);
    const int J = (key0 >> 2) + quad;
    atomicAdd(&imp[qi * 132 + J], asum[0]); atomicAdd(&imp[qi * 132 + J + 1], bsum[0]);
    atomicAdd(&imp[qi * 132 + J + 4], asum[1]); atomicAdd(&imp[qi * 132 + J + 5], bsum[1]);
  }
  const int cur = t0 >> 6;
  if (lane < 16) {
    unsigned w0 = 0, w1 = 0, w2 = 0, w3 = 0;
    if (cur < 16) { w0 = (1u << (cur + 1)) - 1u; }
    else {
      w0 = 1u;
      { int j = cur; unsigned bit = 1u << (j & 31); int w = j >> 5; if (w == 0) w0 |= bit; else if (w == 1) w1 |= bit; else if (w == 2) w2 |= bit; else w3 |= bit; }
      { int j = cur - 1; unsigned bit = 1u << (j & 31); int w = j >> 5; if (w == 0) w0 |= bit; else if (w == 1) w1 |= bit; else if (w == 2) w2 |= bit; else w3 |= bit; }
    }
    sel[lane * 4 + 0] = w0; sel[lane * 4 + 1] = w1; sel[lane * 4 + 2] = w2; sel[lane * 4 + 3] = w3;
  }
  if (lane < 4) uni[lane] = 0u;
  if (cur >= 16) {
    for (int rnd = 0; rnd < 4; ++rnd) {
      const int qq = rnd * 4 + quad;
      unsigned key[8];
#pragma unroll
      for (int c = 0; c < 8; ++c) {
        const int j = qi + 16 * c;
        const bool v = (j <= cur) && (j != 0) && (j != cur) && (j != cur - 1);
        const unsigned bits = __float_as_uint(imp[qq * 132 + j]);
        key[c] = v ? ((bits & 0xFFFFFF00u) | (unsigned)(128 - j)) : 0u;
      }
      for (int it = 0; it < 13; ++it) {
        unsigned mx = key[0];
#pragma unroll
        for (int c = 1; c < 8; ++c) mx = key[c] > mx ? key[c] : mx;
#pragma unroll
        for (int o = 1; o < 16; o <<= 1) { unsigned ot = (unsigned)__shfl_xor((int)mx, o, 64); mx = ot > mx ? ot : mx; }
        if (mx != 0u) {
#pragma unroll
          for (int c = 0; c < 8; ++c) {
            if (key[c] == mx) { key[c] = 0u; const int j = qi + 16 * c; atomicOr(&sel[qq * 4 + (j >> 5)], 1u << (j & 31)); }
          }
        }
      }
    }
  }
  unsigned mym[4];
#pragma unroll
  for (int w = 0; w < 4; ++w) mym[w] = sel[qi * 4 + w];
  if (lane < 16) {
#pragma unroll
    for (int w = 0; w < 4; ++w) atomicOr(&uni[w], mym[w]);
  }
  const float* gp = GATES + row * 24 + g * 12;
#pragma unroll
  for (int h = 0; h < 4; ++h) {
    const float gt = gp[h * 3 + 0] * NSA_G0;
#pragma unroll
    for (int dt = 0; dt < 4; ++dt) *(f32x4*)(outl + ((h * 16 + qi) * 64 + (((dt * 4 + quad) ^ qi) << 2))) = oacc[h][dt] * gt;
  }
#pragma unroll
  for (int h = 0; h < 4; ++h) { m[h] = NEGF; l[h] = 0.f;
#pragma unroll
    for (int dt = 0; dt < 4; ++dt) oacc[h][dt] = (f32x4){0.f, 0.f, 0.f, 0.f}; }
#pragma unroll 1
  for (int w = 0; w < 4; ++w) {
    unsigned bits = __builtin_amdgcn_readfirstlane(uni[w]);
    const unsigned myw = sel[qi * 4 + w];
    while (bits) {
      const int jj = __builtin_ctz(bits); bits &= bits - 1u;
      const int j = w * 32 + jj; const bool rowok = (myw >> jj) & 1u;
#pragma unroll 1
      for (int half = 0; half < 2; ++half) {
        const int key0 = j * 64 + half * 32;
        const bf16_t* kp = KS + (long)(b * T_ + key0 + qi) * 128 + g * 64 + quad * 8;
        const bf16_t* vp = VST + (long)(b * 128 + g * 64 + qi) * T_ + key0 + quad * 4;
        nsa_block<2>(qf, oacc, m, l, sl2, inv, kp, vp, 16L * T_, t - (key0 + quad * 4), rowok, asum, bsum);
      }
    }
  }
#pragma unroll
  for (int h = 0; h < 4; ++h) {
    float lt = l[h]; lt += __shfl_xor(lt, 16, 64); lt += __shfl_xor(lt, 32, 64);
    const float sc = NSA_G1 * gp[h * 3 + 1] / fmaxf(lt, 1e-30f);
#pragma unroll
    for (int dt = 0; dt < 4; ++dt) { f32x4* d = (f32x4*)(outl + ((h * 16 + qi) * 64 + (((dt * 4 + quad) ^ qi) << 2))); *d = *d + oacc[h][dt] * sc; }
  }
#pragma unroll
  for (int h = 0; h < 4; ++h) { m[h] = NEGF; l[h] = 0.f;
#pragma unroll
    for (int dt = 0; dt < 4; ++dt) oacc[h][dt] = (f32x4){0.f, 0.f, 0.f, 0.f}; }
  {
    const int kstart = t0 >= 512 ? ((t0 - 511) & ~31) : 0;
    for (int key0 = kstart; key0 <= t0 + 15; key0 += 32) {
      const bf16_t* kp = KW + (long)(b * T_ + key0 + qi) * 128 + g * 64 + quad * 8;
      const bf16_t* vp = VWT + (long)(b * 128 + g * 64 + qi) * T_ + key0 + quad * 4;
      nsa_block<3>(qf, oacc, m, l, sl2, inv, kp, vp, 16L * T_, t - (key0 + quad * 4), true, asum, bsum);
    }
  }
#pragma unroll
  for (int h = 0; h < 4; ++h) {
    float lt = l[h]; lt += __shfl_xor(lt, 16, 64); lt += __shfl_xor(lt, 32, 64);
    const float sc = NSA_G2 * gp[h * 3 + 2] / fmaxf(lt, 1e-30f);
#pragma unroll
    for (int dt = 0; dt < 4; ++dt) { f32x4* d = (f32x4*)(outl + ((h * 16 + qi) * 64 + (((dt * 4 + quad) ^ qi) << 2))); *d = *d + oacc[h][dt] * sc; }
  }
#pragma unroll
  for (int it = 0; it < 8; ++it) {
    const int id = it * 64 + lane; const int h = id >> 7, rem = id & 127, q2 = rem >> 3, c8 = rem & 7;
    f32x4 a = *(const f32x4*)(outl + ((h * 16 + q2) * 64 + (((2 * c8) ^ q2) << 2)));
    f32x4 bb = *(const f32x4*)(outl + ((h * 16 + q2) * 64 + (((2 * c8 + 1) ^ q2) << 2)));
    float v[8] = {a[0], a[1], a[2], a[3], bb[0], bb[1], bb[2], bb[3]};
    *(u32x4*)(O + ((long)b * T_ + t0 + q2) * 512 + (g * 4 + h) * 64 + c8 * 8) = pack8(v);
  }
}

__device__ void xattn_tile(const Params& P, int wt) {
  const bf16_t* HQ = (const bf16_t*)(P.ws + OFF_D);
  const bf16_t* MK = (const bf16_t*)(P.ws + OFF_MK); const bf16_t* MVT = (const bf16_t*)(P.ws + OFF_MVT);
  bf16_t* OX = (bf16_t*)(P.ws + OFF_D) + (long)M_ * 512;
  const int lane = tidx() & 63, qi = lane & 15, quad = lane >> 4;
  wt = __builtin_amdgcn_readfirstlane(wt);
  const int h = wt & 3; const int row0 = (wt >> 2) * 32; const int b = row0 >> 13;
  bf16x8 qf[2][4];
#pragma unroll
  for (int nt = 0; nt < 2; ++nt)
#pragma unroll
    for (int ks = 0; ks < 4; ++ks) qf[nt][ks] = *(const bf16x8*)(HQ + (long)(row0 + nt * 16 + qi) * 512 + h * 128 + ks * 32 + quad * 8);
  f32x4 oacc[2][8]; float m[2], l[2];
#pragma unroll
  for (int nt = 0; nt < 2; ++nt) { m[nt] = NEGF; l[nt] = 0.f;
#pragma unroll
    for (int dt = 0; dt < 8; ++dt) oacc[nt][dt] = (f32x4){0.f, 0.f, 0.f, 0.f}; }
  for (int blk = 0; blk < 8; ++blk) {
    const int key0 = blk * 32;
    f32x4 s[2][2];
#pragma unroll
    for (int nt = 0; nt < 2; ++nt)
#pragma unroll
      for (int kt = 0; kt < 2; ++kt) s[nt][kt] = (f32x4){0.f, 0.f, 0.f, 0.f};
#pragma unroll
    for (int ks = 0; ks < 4; ++ks) {
#pragma unroll
      for (int kt = 0; kt < 2; ++kt) {
        bf16x8 kf = *(const bf16x8*)(MK + (long)(b * 256 + key0 + kt * 16 + qi) * 512 + h * 128 + ks * 32 + quad * 8);
#pragma unroll
        for (int nt = 0; nt < 2; ++nt) s[nt][kt] = __builtin_amdgcn_mfma_f32_16x16x32_bf16(kf, qf[nt][ks], s[nt][kt], 0, 0, 0);
      }
    }
    bf16x8 pf[2];
#pragma unroll
    for (int nt = 0; nt < 2; ++nt) {
      float ml = NEGF;
#pragma unroll
      for (int kt = 0; kt < 2; ++kt)
#pragma unroll
        for (int r = 0; r < 4; ++r) ml = fmaxf(ml, s[nt][kt][r]);
      ml = fmaxf(ml, __shfl_xor(ml, 16, 64)); ml = fmaxf(ml, __shfl_xor(ml, 32, 64));
      const float mn = fmaxf(m[nt], ml); const float alpha = __builtin_amdgcn_exp2f(m[nt] - mn); m[nt] = mn;
      float p[8]; float ps = 0.f;
#pragma unroll
      for (int kt = 0; kt < 2; ++kt)
#pragma unroll
        for (int r = 0; r < 4; ++r) { p[kt * 4 + r] = __builtin_amdgcn_exp2f(s[nt][kt][r] - mn); ps += p[kt * 4 + r]; }
      l[nt] = l[nt] * alpha + ps;
#pragma unroll
      for (int dt = 0; dt < 8; ++dt) oacc[nt][dt] *= alpha;
      u32x4 pk; pk[0] = pack2(p[0], p[1]); pk[1] = pack2(p[2], p[3]); pk[2] = pack2(p[4], p[5]); pk[3] = pack2(p[6], p[7]);
      pf[nt] = __builtin_bit_cast(bf16x8, pk);
    }
#pragma unroll
    for (int dt = 0; dt < 8; ++dt) {
      const bf16_t* vp = MVT + (long)(b * 512 + h * 128 + dt * 16 + qi) * 256 + key0 + quad * 4;
      u32x2 lo = *(const u32x2*)(vp); u32x2 hi = *(const u32x2*)(vp + 16);
      u32x4 c; c[0] = lo[0]; c[1] = lo[1]; c[2] = hi[0]; c[3] = hi[1];
      const bf16x8 vf = __builtin_bit_cast(bf16x8, c);
#pragma unroll
      for (int nt = 0; nt < 2; ++nt) oacc[nt][dt] = __builtin_amdgcn_mfma_f32_16x16x32_bf16(vf, pf[nt], oacc[nt][dt], 0, 0, 0);
    }
  }
#pragma unroll
  for (int nt = 0; nt < 2; ++nt) {
    float lt = l[nt]; lt += __shfl_xor(lt, 16, 64); lt += __shfl_xor(lt, 32, 64);
    const float iv = 1.f / lt;
#pragma unroll
    for (int dt = 0; dt < 8; ++dt) {
      f32x4 v = oacc[nt][dt] * iv; u32x2 pk; pk[0] = pack2(v[0], v[1]); pk[1] = pack2(v[2], v[3]);
      *(u32x2*)(OX + (long)(row0 + nt * 16 + qi) * 512 + h * 128 + dt * 16 + quad * 4) = pk;
    }
  }
}


#define XB_TMO      128
#define XB_XCNT(j)  (256  + 64 * (j))
#define XB_XSUB(j)  (1280 + 64 * (j))
#define XB_XGEN(j)  (2304 + 64 * (j))
#define XB_TOP      3328
#define XB_TOPGEN   3392
#define XCD_BAR_WORDS 3456
#define XB_SPIN_CAP (1u << 18)
#define LAS __attribute__((address_space(3)))
__device__ __forceinline__ unsigned xb_ld(unsigned* p) { return __hip_atomic_load(p, __ATOMIC_RELAXED, __HIP_MEMORY_SCOPE_AGENT); }
__device__ __forceinline__ unsigned xb_add(unsigned* p, unsigned v) { return __hip_atomic_fetch_add(p, v, __ATOMIC_RELAXED, __HIP_MEMORY_SCOPE_AGENT); }
__device__ __forceinline__ unsigned xb_xcc_id() { return (unsigned)__builtin_amdgcn_s_getreg((3 << 11) | 20) & 0xFu; }
#define XB_SPIN(cond, bar) do { unsigned _sp = 0; while (cond) { __builtin_amdgcn_s_sleep(1); \
    if ((++_sp & 255u) == 0u) { if (xb_ld(&(bar)[XB_TMO])) break; if (_sp > XB_SPIN_CAP) { atomicAdd(&(bar)[XB_TMO], 1u); break; } } } } while (0)
__device__ __forceinline__ void xcd_barrier_complete(unsigned* bar, unsigned x, unsigned& nloc, unsigned& nx) {
  const unsigned G = gridDim.x * gridDim.y * gridDim.z;
  unsigned sum, cnt, mine, sp = 0u;
  for (;;) {
    sum = 0u; cnt = 0u; mine = 0u;
#pragma unroll
    for (unsigned j = 0; j < 16; ++j) { const unsigned c = xb_ld(&bar[XB_XCNT(j)]); sum += c; cnt += (c > 0u) ? 1u : 0u; mine = (j == x) ? c : mine; }
    if (sum == G) break;
    __builtin_amdgcn_s_sleep(1);
    if ((++sp & 255u) == 0u) { if (xb_ld(&bar[XB_TMO])) break; if (sp > XB_SPIN_CAP) { atomicAdd(&bar[XB_TMO], 1u); break; } }
  }
  nloc = mine > 0u ? mine : 1u; nx = cnt > 0u ? cnt : 1u;
}
__device__ __forceinline__ void xcd_barrier(unsigned* bar, unsigned x, volatile LAS unsigned* st) {
  asm volatile("s_waitcnt vmcnt(0)" ::: "memory");
  __syncthreads();
  if (threadIdx.x == 0) {
    __builtin_amdgcn_s_waitcnt(0);
    unsigned nloc = st[0], nx = st[1];
    if (nloc == 0u) { xcd_barrier_complete(bar, x, nloc, nx); st[0] = nloc; st[1] = nx; }
    const unsigned old = xb_add(&bar[XB_XSUB(x)], 1u);
    const unsigned gen = old / nloc;
    if (old + 1u == (gen + 1u) * nloc) {
      __builtin_amdgcn_fence(__ATOMIC_RELEASE, "agent");
      asm volatile("s_waitcnt vmcnt(0)" ::: "memory");
      const unsigned og = xb_add(&bar[XB_TOP], 1u);
      const unsigned tg = og / nx;
      if (og + 1u == (tg + 1u) * nx) xb_add(&bar[XB_TOPGEN], 1u);
      else XB_SPIN(xb_ld(&bar[XB_TOPGEN]) == tg, bar);
      __builtin_amdgcn_fence(__ATOMIC_ACQUIRE, "agent");
      xb_add(&bar[XB_XGEN(x)], 1u);
      asm volatile("s_waitcnt vmcnt(0)" ::: "memory");
    } else {
      XB_SPIN(xb_ld(&bar[XB_XGEN(x)]) == gen, bar);
      __builtin_amdgcn_fence(__ATOMIC_ACQUIRE, "agent");
      asm volatile("s_waitcnt vmcnt(0)" ::: "memory");
    }
  }
  __syncthreads();
}

__device__ void run_phase(const Params& P, int ph, char* smem) {
  char* ws = P.ws; const int tid = tidx();
  switch (ph) {
    case 0: phase0(P, smem); break;
    case 1: phase1(P, smem); break;
    case 2: phase2(P, smem); break;
    case 3: {
      for (int job = blockIdx.x; job < 512; job += gridDim.x) { const int wv = tidx() >> 6; nsa_tile(P, job * 4 + wv, smem + wv * 16896); }
      __syncthreads();
      for (int job = blockIdx.x; job < 512; job += gridDim.x) {
        {
          const int tid = tidx();
          const int s = job; const int bc = s >> 2, g = s & 3;
          RowLin ar{(const bf16_t*)(ws + OFF_WM) + g * 16384, 128};
          RowLin br{(const bf16_t*)(ws + OFF_C + C_GVT) + ((long)bc * 512 + g * 128) * 128, 128};
          const float* bs = P.b_sp + g * 128;
          const bf16_t* U = (const bf16_t*)(ws + OFF_C + C_U) + (long)bc * 128 * 512 + g * 128;
          bf16_t* OS = (bf16_t*)(ws + OFF_D) + (long)M_ * 512 + (long)bc * 128 * 512 + g * 128;
          gemm_tile(smem, ar, br, 2, 64, 64, [&](const float* Cs) {
#pragma unroll 2
            for (int it = 0; it < 8; ++it) {
              int id = it * 256 + tid; int r = id >> 4, c = (id & 15) * 8; float v[8]; ld8(Cs, r, c, v);
              u32x4 d = *(const u32x4*)(U + (long)r * 512 + c); const float bb = bs[r];
#pragma unroll
              for (int i = 0; i < 4; ++i) { v[2 * i] = (v[2 * i] + bb) * bf2f(d[i] & 0xffffu); v[2 * i + 1] = (v[2 * i + 1] + bb) * bf2f(d[i] >> 16); }
              *(u32x4*)(OS + (long)r * 512 + c) = pack8(v);
            }
          });
        }
      }
    } break;
    case 4: {
      float* scr = (float*)(ws + OFF_C + C_SCR) + (long)blockIdx.x * 16384;
      const int xq = blockIdx.x & 7, lq = blockIdx.x >> 3, sq = gridDim.x >> 3;
      for (int t = lq; t < 16 * 8; t += sq) {
        const int mt = xq * 16 + (t & 15), nt = t >> 4, brow = mt * 128, bcol = nt * 128;
        const bf16_t* MG = (const bf16_t*)(ws + OFF_B) + (long)brow * 2048 + bcol;
        RowLin a1{(const bf16_t*)(ws + OFF_D) + (long)brow * 512, 512};
        RowLin b1{(const bf16_t*)(ws + OFF_WPA) + (long)bcol * 512, 512};
        gemm_tile(smem, a1, b1, 8, 64, 64, [&](const float* Cs) {
#pragma unroll 2
          for (int it = 0; it < 8; ++it) {
            int id = it * 256 + tid; int r = id >> 4, c = (id & 15) * 8; float v[8]; ld8(Cs, r, c, v);
            u32x4 d = *(const u32x4*)(MG + (long)r * 2048 + c);
#pragma unroll
            for (int i = 0; i < 4; ++i) { v[2 * i] *= bf2f(d[i] & 0xffffu); v[2 * i + 1] *= bf2f(d[i] >> 16); }
            *(f32x4*)(scr + id * 8) = (f32x4){v[0], v[1], v[2], v[3]}; *(f32x4*)(scr + id * 8 + 4) = (f32x4){v[4], v[5], v[6], v[7]};
          }
        });
        RowLin a2{(const bf16_t*)(ws + OFF_D) + (long)M_ * 512 + (long)brow * 512, 512};
        RowLin b2{(const bf16_t*)(ws + OFF_WPB) + (long)bcol * 512, 512};
        bf16_t* MX = (bf16_t*)(ws + OFF_C + C_MIXED) + (long)brow * 1024 + bcol;
        gemm_tile(smem, a2, b2, 8, 64, 64, [&](const float* Cs) {
#pragma unroll 2
          for (int it = 0; it < 8; ++it) {
            int id = it * 256 + tid; int r = id >> 4, c = (id & 15) * 8; float v[8]; ld8(Cs, r, c, v);
            u32x4 d = *(const u32x4*)(MG + (long)r * 2048 + 1024 + c);
            f32x4 p0 = *(const f32x4*)(scr + id * 8), p1 = *(const f32x4*)(scr + id * 8 + 4);
            float pv[8] = {p0[0], p0[1], p0[2], p0[3], p1[0], p1[1], p1[2], p1[3]};
#pragma unroll
            for (int i = 0; i < 4; ++i) { v[2 * i] = pv[2 * i] + v[2 * i] * bf2f(d[i] & 0xffffu); v[2 * i + 1] = pv[2 * i + 1] + v[2 * i + 1] * bf2f(d[i] >> 16); }
            *(u32x4*)(MX + (long)r * 1024 + c) = pack8(v);
          }
        });
      }
    } break;
    case 5: case 9: case 12: {
      const bf16_t* A; const bf16_t* W; const float* RES; float* DST; int K;
      if (ph == 5) { A = (const bf16_t*)(ws + OFF_C + C_MIXED); W = (const bf16_t*)(ws + OFF_WOUT); RES = P.x; DST = (float*)(ws + OFF_B); K = 1024; }
      else if (ph == 9) { A = (const bf16_t*)(ws + OFF_D) + (long)M_ * 512; W = (const bf16_t*)(ws + OFF_WMO); RES = (const float*)(ws + OFF_B); DST = (float*)(ws + OFF_C + C_H2); K = 512; }
      else { A = (const bf16_t*)(ws + OFF_B); W = (const bf16_t*)(ws + OFF_WDN); RES = (const float*)(ws + OFF_C + C_H2); DST = P.out; K = 2816; }
      const int xq = blockIdx.x & 7, lq = blockIdx.x >> 3, sq = gridDim.x >> 3;
      for (int t = lq; t < 16 * 4; t += sq) {
        const int mt = xq * 16 + (t & 15), nt2 = t >> 4, brow = mt * 128;
        RowLin ar{A + (long)brow * K, K}; RowLin br{W + (long)nt2 * 256 * K, K};
        gemm_tile2(smem, ar, br, K / 32, [&](const float* Cs, int p) {
          const int bcol = nt2 * 256 + p * 128;
          const float* rs = RES + (long)brow * 1024 + bcol; float* ds = DST + (long)brow * 1024 + bcol;
#pragma unroll 2
          for (int it = 0; it < 8; ++it) {
            int id = it * 256 + tid; int r = id >> 4, c = (id & 15) * 8;
            f32x4 a = *(const f32x4*)(Cs + r * CS_LD + c), bq = *(const f32x4*)(Cs + r * CS_LD + c + 4);
            f32x4 r0 = *(const f32x4*)(rs + (long)r * 1024 + c), r1 = *(const f32x4*)(rs + (long)r * 1024 + c + 4);
            *(f32x4*)(ds + (long)r * 1024 + c) = a + r0; *(f32x4*)(ds + (long)r * 1024 + c + 4) = bq + r1;
          }
        });
      }
    } break;
    case 6: case 10: {
      const float* src = ph == 6 ? (const float*)(ws + OFF_B) : (const float*)(ws + OFF_C + C_H2);
      const float* g = ph == 6 ? P.norm_mq : P.norm_ffn;
      for (int job = blockIdx.x; job < 1024; job += gridDim.x) { int row = job * 16 + (tid >> 6) * 4; rownorm_rows<false, 4>(src + (long)row * 1024, g, (bf16_t*)(ws + OFF_A) + (long)row * 1024); }
    } break;
    case 7: {
      const int xq = blockIdx.x & 7, lq = blockIdx.x >> 3, sq = gridDim.x >> 3;
      for (int t = lq; t < 16 * 2; t += sq) {
        const int mt = xq * 16 + (t & 15), nt2 = t >> 4, brow = mt * 128;
        RowLin ar{(const bf16_t*)(ws + OFF_A) + (long)brow * 1024, 1024}; RowLin br{(const bf16_t*)(ws + OFF_WMQ) + (long)nt2 * 256 * 1024, 1024};
        gemm_tile2(smem, ar, br, 32, [&](const float* Cs, int p) {
          const int nt = nt2 * 2 + p;
          store_rows_bf16(Cs, (bf16_t*)(ws + OFF_D) + (long)brow * 512 + nt * 128, 512, [](float v, int) { return v * (0.08838834764831845f * LOG2E); });
        });
      }
    } break;
    case 8: {
      for (int job = blockIdx.x; job < 512; job += gridDim.x) xattn_tile(P, job * 4 + (tid >> 6));
    } break;
    case 11: {
      const int xq = blockIdx.x & 7, lq = blockIdx.x >> 3, sq = gridDim.x >> 3;
      for (int t = lq; t < 16 * 22; t += sq) {
        const int mt = xq * 16 + (t & 15), nt2 = t >> 4, brow = mt * 128;
        RowLin ar{(const bf16_t*)(ws + OFF_A) + (long)brow * 1024, 1024}; RowLin br{(const bf16_t*)(ws + OFF_WGU) + (long)nt2 * 256 * 1024, 1024};
        gemm_tile2(smem, ar, br, 32, [&](const float* Cs, int p) {
          bf16_t* ACT = (bf16_t*)(ws + OFF_B) + (long)brow * 2816 + (nt2 * 2 + p) * 64;
#pragma unroll 2
          for (int it = 0; it < 4; ++it) {
            int id = it * 256 + tid; int r = id >> 3, c = (id & 7) * 8; float gt[8], up[8]; ld8(Cs, r, c, gt); ld8(Cs, r, c + 64, up);
#pragma unroll
            for (int i = 0; i < 8; ++i) gt[i] = gt[i] * sigm(gt[i]) * up[i];
            *(u32x4*)(ACT + (long)r * 2816 + c) = pack8(gt);
          }
        });
      }
    } break;
    case 13: {
      for (int job = blockIdx.x; job < 1024; job += gridDim.x) { int row = job * 16 + (tid >> 6) * 4; rownorm_rows<true, 4>(P.out + (long)row * 1024, P.norm_final, P.out + (long)row * 1024); }
    } break;
#ifdef PROBE_K
    case 14: {
      const bf16_t* s0 = (const bf16_t*)(ws + PROBE_SRC0); const bf16_t* s1 = (const bf16_t*)(ws + PROBE_SRC1);
      for (long i = (long)blockIdx.x * 256 + tid; i < (long)M_ * 512; i += (long)gridDim.x * 256) {
        long row = i >> 9; int c = (int)(i & 511);
        P.out[row * 1024 + c] = bf2f(s0[i]); P.out[row * 1024 + 512 + c] = bf2f(s1[i]);
      }
    } break;
    case 15: {
      const float* s0 = (const float*)(ws + PROBE_SRC0);
      for (long i = (long)blockIdx.x * 256 + tid; i < (long)M_ * 1024; i += (long)gridDim.x * 256) P.out[i] = s0[i];
    } break;
#endif
  }
}

__global__ void __launch_bounds__(256, 2) fwd_kernel(Params P, int ph_lo, int ph_hi) {
  __shared__ __attribute__((aligned(16))) char smem[73728 + 16];
  volatile LAS unsigned* st = (volatile LAS unsigned*)(smem + 73728);
  const unsigned xcc = xb_xcc_id();
  if (ph_lo < ph_hi) {
    if (threadIdx.x == 0) { st[0] = 0u; st[1] = 0u; }
    __syncthreads();
    if (threadIdx.x == 0) (void)xb_add(&((unsigned*)(P.ws + OFF_BAR))[XB_XCNT(xcc)], 1u);
  }
  if (ph_hi < 0) cg::this_grid().sync();
  for (int ph = ph_lo; ph <= ph_hi; ++ph) {
    const uint64_t __attribute__((address_space(4)))* ka = (const uint64_t __attribute__((address_space(4)))*)__builtin_amdgcn_kernarg_segment_ptr();
    asm volatile("" : "+s"(ka));
    Params Pl; uint64_t* pd = (uint64_t*)&Pl;
#pragma unroll
    for (int i = 0; i < (int)(sizeof(Params) / 8); ++i) pd[i] = ka[i];
    run_phase(Pl, ph, smem);
    if (ph < ph_hi) xcd_barrier((unsigned*)(Pl.ws + OFF_BAR), xcc, st);
  }
}

extern "C" void kernel_launch(void* const* d_in, const int* in_sizes, int n_in, void* d_out, int out_size, void* d_ws, size_t ws_size,
                              hipStream_t stream) {
  static int grid_blocks = 0;
  if (!grid_blocks) {
    int dev = 0, cus = 0, per_cu = 0;
    hipGetDevice(&dev);
    hipDeviceGetAttribute(&cus, hipDeviceAttributeMultiprocessorCount, dev);
    hipOccupancyMaxActiveBlocksPerMultiprocessor(&per_cu, fwd_kernel, 256, 0);
    if (per_cu > 2) per_cu = 2;
    if (per_cu < 1) per_cu = 1;
    grid_blocks = cus * per_cu;
  }
  if (ws_size < (size_t)WS_NEED) fprintf(stderr, "workspace too small: %zu < %ld\n", ws_size, (long)WS_NEED);
  Params P{};
  const float** pp = (const float**)&P;
  for (int i = 0; i < 27; ++i) pp[i] = (const float*)d_in[i];
  P.out = (float*)d_out; P.ws = (char*)d_ws;
#if ONE_LAUNCH
  hipMemsetAsync((char*)d_ws + OFF_BAR, 0, XCD_BAR_WORDS * 4, stream);
#ifdef PROBE_K
  int lo = 0, hi = PROBE_DUMP;
#else
  int lo = 0, hi = 13;
#endif
  void* args[] = {&P, &lo, &hi};
  hipError_t e = hipLaunchCooperativeKernel((void*)fwd_kernel, dim3(grid_blocks), dim3(256), args, 0, stream);
  if (e != hipSuccess) fprintf(stderr, "cooperative launch failed: %s (grid %d)\n", hipGetErrorString(e), grid_blocks);
#else
  for (int ph = 0; ph <= 13; ++ph) fwd_kernel<<<grid_blocks, 256, 0, stream>>>(P, ph, ph);
#endif
}
```

```cpp
#include <hip/hip_runtime.h>
#include <hip/hip_cooperative_groups.h>
#include <stdint.h>
#include <stdio.h>
namespace cg = cooperative_groups;

#ifndef NSA_G0
#define NSA_G0 1.f
#define NSA_G1 1.f
#define NSA_G2 1.f
#endif
#ifndef ONE_LAUNCH
#define ONE_LAUNCH 1
#endif

typedef unsigned short bf16_t;
using bf16x8 = __attribute__((ext_vector_type(8))) short;
using f32x4 = __attribute__((ext_vector_type(4))) float;
using u32x4 = __attribute__((ext_vector_type(4))) unsigned;
using u32x2 = __attribute__((ext_vector_type(2))) unsigned;

#define T_ 8192
#define M_ 16384
#define NEGF (-1e30f)
#define LOG2E 1.4426950408889634f

constexpr long OFF_W1 = 0;
constexpr long OFF_WMKV = OFF_W1 + 9175040;
constexpr long OFF_WPA = OFF_WMKV + 2097152;
constexpr long OFF_WPB = OFF_WPA + 1048576;
constexpr long OFF_WOUT = OFF_WPB + 1048576;
constexpr long OFF_WMQ = OFF_WOUT + 2097152;
constexpr long OFF_WMO = OFF_WMQ + 1048576;
constexpr long OFF_WGU = OFF_WMO + 1048576;
constexpr long OFF_WDN = OFF_WGU + 11534336;
constexpr long OFF_WCK1 = OFF_WDN + 5767168;
constexpr long OFF_WCV1 = OFF_WCK1 + 524288;
constexpr long OFF_WM = OFF_WCV1 + 524288;
constexpr long OFF_BIAS1 = OFF_WM + 131072;
constexpr long OFF_MEMN = OFF_BIAS1 + 1024;
constexpr long OFF_MK = OFF_MEMN + 1048576;
constexpr long OFF_MVT = OFF_MK + 524288;
constexpr long OFF_KCMP = OFF_MVT + 524288;
constexpr long OFF_VCT = OFF_KCMP + 262144;
constexpr long OFF_A = OFF_VCT + 262144;
constexpr long OFF_B = OFF_A + 33554432;
constexpr long OFF_D = OFF_B + 67108864;
constexpr long OFF_C = OFF_D + 33554432;
constexpr long C_Q = 0, C_U = 16777216, C_GVT = 33554432, C_KC = 50331648, C_VC = 54525952, C_KS = 58720256,
               C_KW = 62914560, C_VST = 67108864, C_VWT = 71303168, C_GATES = 75497472;
constexpr long C_MIXED = 0, C_SCR = 33554432, C_H2 = 0;
constexpr long OFF_BAR = OFF_C + 77070336;
constexpr long OFF_SSQ1 = OFF_BAR + 16384;
constexpr long OFF_SSQ2 = OFF_SSQ1 + 524288;
constexpr long WS_NEED = OFF_SSQ2 + 524288;

struct Params {
  const float *x, *mem, *norm_mix, *w_in, *w_ck1, *w_ck2, *w_cv1, *w_cv2, *pe_k, *pe_v, *ln_sgu, *w_sp, *b_sp,
      *w_pa, *w_pb, *w_merge, *b_merge, *w_out, *norm_mq, *norm_mkv, *w_mq, *w_mkv, *w_mo, *norm_ffn, *w_gu, *w_dn, *norm_final;
  float* out;
  char* ws;
};

__device__ __forceinline__ int tidx() { int t = threadIdx.x; asm volatile("" : "+v"(t)); return t; }
__device__ __forceinline__ unsigned f2bf(float f) { unsigned u = __float_as_uint(f); u += 0x7fffu + ((u >> 16) & 1u); return u >> 16; }
__device__ __forceinline__ unsigned pack2(float a, float b) { return f2bf(a) | (f2bf(b) << 16); }
__device__ __forceinline__ float bf2f(unsigned h) { return __uint_as_float(h << 16); }
__device__ __forceinline__ float gelu_tanh(float x) { float u = 0.7978845608028654f * (x + 0.044715f * x * x * x); return x / (1.f + __expf(-2.f * u)); }
__device__ __forceinline__ float sigm(float x) { return 1.f / (1.f + __expf(-x)); }
__device__ __forceinline__ float wave_sum(float v) {
#pragma unroll
  for (int o = 32; o > 0; o >>= 1) v += __shfl_xor(v, o, 64);
  return v;
}
__device__ __forceinline__ u32x4 pack8(const float (&v)[8]) {
  u32x4 r; r[0] = pack2(v[0], v[1]); r[1] = pack2(v[2], v[3]); r[2] = pack2(v[4], v[5]); r[3] = pack2(v[6], v[7]); return r;
}

__device__ __forceinline__ int lds_byte(int r, int c) {
  int st = (r >> 4) * 2 + (c >> 5), rr = r & 15, cc = c & 31, ob = rr * 64 + cc * 2;
  return st * 1024 + (ob ^ (((ob >> 9) & 1) << 5));
}
__device__ __forceinline__ void stage_rc(int b, int& R, int& C) {
  int st = b >> 10, sb = b & 1023, swz = sb ^ (((sb >> 9) & 1) << 5);
  R = (st >> 1) * 16 + (swz >> 6); C = (st & 1) * 32 + ((swz & 63) >> 1);
}

#define CS_LD 132
__device__ __forceinline__ void ld8(const float* Cs, int r, int c, float (&v)[8]) {
  f32x4 a = *(const f32x4*)(Cs + r * CS_LD + c); f32x4 b = *(const f32x4*)(Cs + r * CS_LD + c + 4);
  v[0] = a[0]; v[1] = a[1]; v[2] = a[2]; v[3] = a[3]; v[4] = b[0]; v[5] = b[1]; v[6] = b[2]; v[7] = b[3];
}
__device__ __forceinline__ void ld8T(const float* Cs, int r8, int c, float (&v)[8]) {
#pragma unroll
  for (int i = 0; i < 8; ++i) v[i] = Cs[(r8 + i) * CS_LD + c];
}

struct RowLin {
  const bf16_t* base; long ld;
  __device__ __forceinline__ const bf16_t* operator()(int r) const { return base + (long)r * ld; }
};
struct RowCmp {
  const bf16_t* base; int brow;
  __device__ __forceinline__ const bf16_t* operator()(int r) const {
    int R = brow + r; int b = R >> 10, rem = R & 1023, i = rem >> 1, g = rem & 1; if (i > 510) i = 510;
    return base + ((long)(b * T_ + 16 * i) * 128 + g * 64);
  }
};

template <int AUX = 0, class ARow, class BRow, class Epi>
__device__ __forceinline__ void gemm_tile(char* smem, ARow arow, BRow brow, int nkt, int kstepA, int kstepB, Epi epi) {
  const int tid = tidx(), lane = tid & 63, wave = tid >> 6, wr = wave >> 1, wc = wave & 1, fr = lane & 15, fq = lane >> 4;
  const bf16_t* pa[4]; const bf16_t* pb[4];
#pragma unroll
  for (int i = 0; i < 4; ++i) { int b = tid * 16 + i * 4096; int R, C; stage_rc(b, R, C); pa[i] = arow(R) + C; pb[i] = brow(R) + C; }
  f32x4 acc[4][4];
#pragma unroll
  for (int m = 0; m < 4; ++m)
#pragma unroll
    for (int n = 0; n < 4; ++n) acc[m][n] = (f32x4){0.f, 0.f, 0.f, 0.f};
  {
#pragma unroll
    for (int i = 0; i < 4; ++i) {
      __builtin_amdgcn_global_load_lds((const unsigned*)(pa[i]), (unsigned*)(smem + tid * 16 + i * 4096), 16, 0, AUX);
      __builtin_amdgcn_global_load_lds((const unsigned*)(pb[i]), (unsigned*)(smem + 16384 + tid * 16 + i * 4096), 16, 0, AUX);
    }
  }
  for (int kt = 0; kt < nkt; ++kt) {
    asm volatile("s_waitcnt vmcnt(0)" ::: "memory");
    __syncthreads();
    if (kt + 1 < nkt) {
      char* la = smem + ((kt + 1) & 1) * 32768;
#pragma unroll
      for (int i = 0; i < 4; ++i) {
        __builtin_amdgcn_global_load_lds((const unsigned*)(pa[i] + (long)(kt + 1) * kstepA), (unsigned*)(la + tid * 16 + i * 4096), 16, 0, AUX);
        __builtin_amdgcn_global_load_lds((const unsigned*)(pb[i] + (long)(kt + 1) * kstepB), (unsigned*)(la + 16384 + tid * 16 + i * 4096), 16, 0, AUX);
      }
    }
    const char* la = smem + (kt & 1) * 32768; const char* lb = la + 16384;
#pragma unroll
    for (int ks = 0; ks < 2; ++ks) {
      bf16x8 a[4], b[4];
#pragma unroll
      for (int m = 0; m < 4; ++m) a[m] = *(const bf16x8*)(la + lds_byte(wr * 64 + m * 16 + fr, ks * 32 + fq * 8));
#pragma unroll
      for (int n = 0; n < 4; ++n) b[n] = *(const bf16x8*)(lb + lds_byte(wc * 64 + n * 16 + fr, ks * 32 + fq * 8));
#pragma unroll
      for (int m = 0; m < 4; ++m)
#pragma unroll
        for (int n = 0; n < 4; ++n) acc[m][n] = __builtin_amdgcn_mfma_f32_16x16x32_bf16(a[m], b[n], acc[m][n], 0, 0, 0);
    }
  }
  __syncthreads();
  float* Cs = (float*)smem;
#pragma unroll
  for (int m = 0; m < 4; ++m)
#pragma unroll
    for (int n = 0; n < 4; ++n)
#pragma unroll
      for (int r = 0; r < 4; ++r) Cs[(wr * 64 + m * 16 + fq * 4 + r) * CS_LD + wc * 64 + n * 16 + fr] = acc[m][n][r];
  __syncthreads();
  epi(Cs);
  __syncthreads();
}

template <class F>
__device__ __forceinline__ void store_rows_bf16(const float* Cs, bf16_t* dst, long ld, F f) {
#pragma unroll 2
  for (int it = 0; it < 8; ++it) {
    int id = it * 256 + tidx(); int r = id >> 4, c = (id & 15) * 8;
    float v[8]; ld8(Cs, r, c, v);
#pragma unroll
    for (int i = 0; i < 8; ++i) v[i] = f(v[i], c + i);
    *(u32x4*)(dst + (long)r * ld + c) = pack8(v);
  }
}
template <class F>
__device__ __forceinline__ void store_T_bf16(const float* Cs, bf16_t* dst, long cstride, F f) {
#pragma unroll 2
  for (int it = 0; it < 8; ++it) {
    int id = it * 256 + tidx(); int c = id >> 4, r8 = (id & 15) * 8;
    float v[8]; ld8T(Cs, r8, c, v);
#pragma unroll
    for (int i = 0; i < 8; ++i) v[i] = f(v[i]);
    *(u32x4*)(dst + (long)c * cstride + r8) = pack8(v);
  }
}


__device__ __forceinline__ int lds_byte32(int r, int c) { int rr = r & 15; return (r >> 4) * 1024 + rr * 64 + ((((c >> 3) ^ ((-(rr >> 2)) & 3)) & 3) << 4); }
__device__ __forceinline__ void stage_rc32(int b, int& R, int& C) { int st = b >> 10, sb = b & 1023, rr = sb >> 6, cp = (sb >> 4) & 3; R = st * 16 + rr; C = ((cp ^ ((-(rr >> 2)) & 3)) & 3) * 8; }
struct RowClamp {
  const bf16_t* base; long ld; int maxr;
  __device__ __forceinline__ const bf16_t* operator()(int r) const { return base + (long)(r < maxr ? r : maxr) * ld; }
};
__device__ __forceinline__ int lds_byte64(int r, int c) { int rr = r & 15; return (r >> 4) * 2048 + rr * 128 + ((((c >> 3) ^ (rr >> 1)) & 7) << 4); }
__device__ __forceinline__ void stage_rc64(int b, int& R, int& C) { int st = b >> 11, sb = b & 2047, rr = sb >> 7, cp = (sb >> 4) & 7; R = st * 16 + rr; C = ((cp ^ (rr >> 1)) & 7) * 8; }
template <class ARow, class BRow, class Epi>
__device__ __forceinline__ void gemm_tile2(char* smem, ARow arow, BRow brow, int nkt, Epi epi) {
  const int tid = tidx(), lane = tid & 63, wave = tid >> 6, wr = wave >> 1, wc = wave & 1, fr = lane & 15, fq = lane >> 4;
  const bf16_t* pa[4]; const bf16_t* pb[8];
#pragma unroll
  for (int i = 0; i < 4; ++i) { int R, C; stage_rc64(tid * 16 + i * 4096, R, C); pa[i] = arow(R) + C; }
#pragma unroll
  for (int i = 0; i < 8; ++i) { int R, C; stage_rc64(tid * 16 + i * 4096, R, C); pb[i] = brow(R) + C; }
  f32x4 acc[4][8];
#pragma unroll
  for (int m = 0; m < 4; ++m)
#pragma unroll
    for (int n = 0; n < 8; ++n) acc[m][n] = (f32x4){0.f, 0.f, 0.f, 0.f};
  for (int kt = 0; kt < nkt; ++kt) {
    __syncthreads();
#pragma unroll
    for (int i = 0; i < 4; ++i) __builtin_amdgcn_global_load_lds((const unsigned*)(pa[i] + (long)kt * 64), (unsigned*)(smem + tid * 16 + i * 4096), 16, 0, 0);
#pragma unroll
    for (int i = 0; i < 8; ++i) __builtin_amdgcn_global_load_lds((const unsigned*)(pb[i] + (long)kt * 64), (unsigned*)(smem + 16384 + tid * 16 + i * 4096), 16, 0, 0);
    asm volatile("s_waitcnt vmcnt(0)" ::: "memory");
    __syncthreads();
    {
      const char* pA = smem + lds_byte64(wr * 64 + fr, fq * 8);
      const char* pB = smem + 16384 + lds_byte64(wc * 128 + fr, fq * 8);
      const int k1 = lds_byte64(fr, 32 + fq * 8) - lds_byte64(fr, fq * 8);
      bf16x8 a[4], bl[4], bh[4];
#define SB __builtin_amdgcn_sched_barrier(0)
#define LDA(K) _Pragma("unroll") for (int m = 0; m < 4; ++m) a[m] = *(const bf16x8*)(pA + m * 2048 + (K))
#define LDBL(K) _Pragma("unroll") for (int n = 0; n < 4; ++n) bl[n] = *(const bf16x8*)(pB + n * 2048 + (K))
#define LDBH(K) _Pragma("unroll") for (int n = 0; n < 4; ++n) bh[n] = *(const bf16x8*)(pB + (n + 4) * 2048 + (K))
#define MML _Pragma("unroll") for (int m = 0; m < 4; ++m) _Pragma("unroll") for (int n = 0; n < 4; ++n) acc[m][n] = __builtin_amdgcn_mfma_f32_16x16x32_bf16(a[m], bl[n], acc[m][n], 0, 0, 0)
#define MMH _Pragma("unroll") for (int m = 0; m < 4; ++m) _Pragma("unroll") for (int n = 0; n < 4; ++n) acc[m][n + 4] = __builtin_amdgcn_mfma_f32_16x16x32_bf16(a[m], bh[n], acc[m][n + 4], 0, 0, 0)
      LDA(0); LDBL(0); SB;
      LDBH(0); SB;
      MML; SB;
      LDBL(k1); SB;
      MMH; SB;
      LDA(k1); SB;
      LDBH(k1); SB;
      MML; SB;
      MMH; SB;
#undef SB
#undef LDA
#undef LDBL
#undef LDBH
#undef MML
#undef MMH
    }
  }
  float* Cs = (float*)smem;
#pragma unroll
  for (int p = 0; p < 2; ++p) {
    __syncthreads();
    if (wc == p) {
#pragma unroll
      for (int m = 0; m < 4; ++m)
#pragma unroll
        for (int n = 0; n < 8; ++n)
#pragma unroll
          for (int r = 0; r < 4; ++r) Cs[(wr * 64 + m * 16 + fq * 4 + r) * CS_LD + n * 16 + fr] = acc[m][n][r];
    }
    __syncthreads();
    epi(Cs, p);
  }
  __syncthreads();
}

template <int MODE>
__device__ __forceinline__ void transpose_tile(const float* W, int Nsrc, bf16_t* Wt, int Kd, int k0, int n0, float* lds) {
  const int tid = tidx();
  {
    int tx = tid & 63, ty = tid >> 6; int np = n0 + tx; int sc;
    if (MODE == 0) sc = np < Nsrc ? np : -1;
    else { int x = np & 127, tl = np >> 7; sc = x < 64 ? tl * 64 + x : 2816 + tl * 64 + x - 64; }
#pragma unroll
    for (int kk = ty; kk < 64; kk += 4) lds[kk * 65 + tx] = sc >= 0 ? W[(long)(k0 + kk) * Nsrc + sc] : 0.f;
  }
  __syncthreads();
  {
    int nrow = tid >> 2, kseg = (tid & 3) * 16; float v[8];
#pragma unroll
    for (int i = 0; i < 8; ++i) v[i] = lds[(kseg + i) * 65 + nrow];
    *(u32x4*)(Wt + (long)(n0 + nrow) * Kd + k0 + kseg) = pack8(v);
#pragma unroll
    for (int i = 0; i < 8; ++i) v[i] = lds[(kseg + 8 + i) * 65 + nrow];
    *(u32x4*)(Wt + (long)(n0 + nrow) * Kd + k0 + kseg + 8) = pack8(v);
  }
  __syncthreads();
}

template <bool OUTF, int NR>
__device__ __forceinline__ void rownorm_rows(const float* src, const float* g, void* dst) {
  const int lane = tidx() & 63;
  f32x4 v[NR][4];
#pragma unroll
  for (int r = 0; r < NR; ++r)
#pragma unroll
    for (int i = 0; i < 4; ++i) v[r][i] = *(const f32x4*)(src + (long)r * 1024 + i * 256 + lane * 4);
  f32x4 gg[4];
#pragma unroll
  for (int i = 0; i < 4; ++i) gg[i] = *(const f32x4*)(g + i * 256 + lane * 4);
#pragma unroll
  for (int r = 0; r < NR; ++r) {
    float ss = 0.f;
#pragma unroll
    for (int i = 0; i < 4; ++i) ss += v[r][i][0] * v[r][i][0] + v[r][i][1] * v[r][i][1] + v[r][i][2] * v[r][i][2] + v[r][i][3] * v[r][i][3];
    ss = wave_sum(ss);
    const float rr = rsqrtf(ss * (1.f / 1024.f) + 1e-6f);
#pragma unroll
    for (int i = 0; i < 4; ++i) {
      float o0 = v[r][i][0] * rr * gg[i][0], o1 = v[r][i][1] * rr * gg[i][1], o2 = v[r][i][2] * rr * gg[i][2], o3 = v[r][i][3] * rr * gg[i][3];
      if (OUTF) { *(f32x4*)((float*)dst + (long)r * 1024 + i * 256 + lane * 4) = (f32x4){o0, o1, o2, o3}; }
      else { u32x2 p; p[0] = pack2(o0, o1); p[1] = pack2(o2, o3); *(u32x2*)((bf16_t*)dst + (long)r * 1024 + i * 256 + lane * 4) = p; }
    }
  }
}

__device__ void phase0(const Params& P, char* smem) {
  float* lds = (float*)smem;
  const int tid = tidx();
  const int NJ = 8 + 1024 + 32 + 32 + 4384;
  for (int job = blockIdx.x; job < NJ; job += gridDim.x) {
    int j = job;
    if (j < 8) {
      int n = j * 32 + (tid & 31), sl = tid >> 5; int kv = n >> 7, nn = n & 127;
      const float* pe = kv ? P.pe_v : P.pe_k; const float* w1 = kv ? P.w_cv1 : P.w_ck1;
      float s = 0.f;
      for (int k = sl * 256; k < sl * 256 + 256; ++k) s += pe[k] * w1[(long)k * 128 + nn];
      lds[sl * 32 + (tid & 31)] = s;
      __syncthreads();
      if (tid < 32) { float t = 0.f; for (int q = 0; q < 8; ++q) t += lds[q * 32 + tid]; ((float*)(P.ws + OFF_BIAS1))[j * 32 + tid] = t; }
      __syncthreads();
      continue;
    }
    j -= 8;
    if (j < 1024) { int row = j * 16 + (tid >> 6) * 4; rownorm_rows<false, 4>(P.x + (long)row * 1024, P.norm_mix, (bf16_t*)(P.ws + OFF_A) + (long)row * 1024); continue; }
    j -= 1024;
    if (j < 32) { int row = j * 16 + (tid >> 6) * 4; rownorm_rows<false, 4>(P.mem + (long)row * 1024, P.norm_mkv, (bf16_t*)(P.ws + OFF_MEMN) + (long)row * 1024); continue; }
    j -= 32;
    if (j < 32) {
      int e0 = j * 2048 + tid * 8; float v[8];
#pragma unroll
      for (int i = 0; i < 8; ++i) { int e = e0 + i; int t = (e >> 7) & 127, s = e & 127; v[i] = s <= t ? P.w_sp[e] : 0.f; }
      *(u32x4*)((bf16_t*)(P.ws + OFF_WM) + e0) = pack8(v);
      continue;
    }
    j -= 32;
#define TRJ(KT, NT, W, NSRC, WT, KD, MODE) \
    if (j < (KT) * (NT)) { transpose_tile<MODE>(W, NSRC, (bf16_t*)(P.ws + (WT)), KD, (j % (KT)) * 64, (j / (KT)) * 64, lds); continue; } \
    j -= (KT) * (NT);
    TRJ(16, 88, P.w_gu, 5632, OFF_WGU, 1024, 1)
    TRJ(44, 16, P.w_dn, 1024, OFF_WDN, 2816, 0)
    TRJ(16, 38, P.w_in, 2328, OFF_W1, 1024, 0)
    TRJ(16, 32, P.w_merge, 2048, OFF_W1 + 2432L * 1024 * 2, 1024, 0)
    TRJ(16, 16, P.w_mkv, 1024, OFF_WMKV, 1024, 0)
    TRJ(16, 16, P.w_out, 1024, OFF_WOUT, 1024, 0)
    TRJ(8, 16, P.w_pa, 1024, OFF_WPA, 512, 0)
    TRJ(8, 16, P.w_pb, 1024, OFF_WPB, 512, 0)
    TRJ(16, 8, P.w_mq, 512, OFF_WMQ, 1024, 0)
    TRJ(8, 16, P.w_mo, 1024, OFF_WMO, 512, 0)
    TRJ(32, 2, P.w_ck1, 128, OFF_WCK1, 2048, 0)
    TRJ(32, 2, P.w_cv1, 128, OFF_WCV1, 2048, 0)
#undef TRJ
  }
}

__device__ void phase1(const Params& P, char* smem) {
  char* ws = P.ws;
  const int NG1 = 128 * 18;
  const int xq = blockIdx.x & 7, lq = blockIdx.x >> 3, sq = gridDim.x >> 3;
  for (int t = lq; t < 16 * 18 + 4; t += sq) {
    const int job = t < 16 * 18 ? 0 : NG1 + xq * 4 + (t - 16 * 18);
    if (t < 16 * 18) {
      const int mt = xq * 16 + (t & 15), nt2 = t >> 4; const int brow = mt * 128;
      RowLin ar{(const bf16_t*)(ws + OFF_A) + (long)brow * 1024, 1024};
      RowClamp br{(const bf16_t*)(ws + OFF_W1) + (long)nt2 * 256 * 1024, 1024, 4479 - nt2 * 256};
      gemm_tile2(smem, ar, br, 16, [&](const float* Cs, int p) {
        const int nt = nt2 * 2 + p; if (nt >= 35) return;
        char* C = ws + OFF_C;
        if (nt < 4) {
          store_rows_bf16(Cs, (bf16_t*)(C + C_Q) + (long)brow * 512 + nt * 128, 512, [](float v, int) { return v * (0.125f * LOG2E); });
        } else if (nt == 4 || nt == 5 || nt == 6 || nt == 8) {
          long off = nt == 4 ? C_KC : nt == 5 ? C_VC : nt == 6 ? C_KS : C_KW;
          store_rows_bf16(Cs, (bf16_t*)(C + off) + (long)brow * 128, 128, [](float v, int) { return v; });
        } else if (nt == 7 || nt == 9) {
          long off = nt == 7 ? C_VST : C_VWT; int b = brow >> 13, tl = brow & 8191;
          store_T_bf16(Cs, (bf16_t*)(C + off) + (long)b * 128 * T_ + tl, T_, [](float v) { return v; });
        } else if (nt < 14) {
          store_rows_bf16(Cs, (bf16_t*)(C + C_U) + (long)brow * 512 + (nt - 10) * 128, 512, [](float v, int) { return gelu_tanh(v); });
        } else if (nt < 18) {
          store_T_bf16(Cs, (bf16_t*)(C + C_GVT) + ((long)(brow >> 7) * 512 + (nt - 14) * 128) * 128, 128, [](float v) { return gelu_tanh(v); });
        } else if (nt == 18) {
          float* gates = (float*)(C + C_GATES);
          for (int id = tidx(); id < 128 * 24; id += 256) { int r = id / 24, c = id % 24; gates[(long)(brow + r) * 24 + c] = sigm(Cs[r * CS_LD + c]); }
        } else {
          const float* bm = P.b_merge + (nt - 19) * 128;
          store_rows_bf16(Cs, (bf16_t*)(ws + OFF_B) + (long)brow * 2048 + (nt - 19) * 128, 2048, [bm](float v, int c) { return sigm(v + bm[c]); });
        }
      });
    } else {
      const int j = job - NG1; const int mt = j >> 3, nt = j & 7; const int brow = mt * 128;
      RowLin ar{(const bf16_t*)(ws + OFF_MEMN) + (long)brow * 1024, 1024};
      RowLin br{(const bf16_t*)(ws + OFF_WMKV) + (long)nt * 128 * 1024, 1024};
      gemm_tile(smem, ar, br, 16, 64, 64, [&](const float* Cs) {
        if (nt < 4) store_rows_bf16(Cs, (bf16_t*)(ws + OFF_MK) + (long)brow * 512 + nt * 128, 512, [](float v, int) { return v; });
        else { int b = mt >> 1, n0 = (mt & 1) * 128; store_T_bf16(Cs, (bf16_t*)(ws + OFF_MVT) + ((long)b * 512 + (nt - 4) * 128) * 256 + n0, 256, [](float v) { return v; }); }
      });
    }
  }
}

__device__ void phase2(const Params& P, char* smem) {
  char* ws = P.ws; const int tid = tidx();
  for (int job = blockIdx.x; job < 32 + 128; job += gridDim.x) {
    if (job < 32) {
      const int kv = job >> 4, mt = job & 15, brow = mt * 128;
      RowCmp ar{(const bf16_t*)(ws + OFF_C + (kv ? C_VC : C_KC)), brow};
      RowLin br{(const bf16_t*)(ws + (kv ? OFF_WCV1 : OFF_WCK1)), 2048};
      const float* bias1 = (const float*)(ws + OFF_BIAS1) + kv * 128;
      const float* w2 = kv ? P.w_cv2 : P.w_ck2;
      gemm_tile(smem, ar, br, 32, 128, 64, [&](const float* Csc) {
        float* Cs = (float*)Csc;
        for (int it = 0; it < 64; ++it) { int id = it * 256 + tid; int r = id >> 7, n = id & 127; Cs[r * CS_LD + n] = gelu_tanh(Cs[r * CS_LD + n] + bias1[n]); }
        __syncthreads();
        const int r = tid >> 1, half = tid & 1;
        float acc[32];
#pragma unroll
        for (int i = 0; i < 32; ++i) acc[i] = 0.f;
        for (int n = 0; n < 128; ++n) {
          float h = Cs[r * CS_LD + n]; const float* wr = w2 + n * 64 + half * 32;
#pragma unroll
          for (int q = 0; q < 8; ++q) { f32x4 w = *(const f32x4*)(wr + q * 4); acc[q * 4] += h * w[0]; acc[q * 4 + 1] += h * w[1]; acc[q * 4 + 2] += h * w[2]; acc[q * 4 + 3] += h * w[3]; }
        }
        const int R = brow + r; const int b = R >> 10, rem = R & 1023, i = rem >> 1, g = rem & 1;
        if (i >= 511) {
#pragma unroll
          for (int q = 0; q < 32; ++q) acc[q] = 0.f;
        }
        if (kv == 0) {
          bf16_t* dst = (bf16_t*)(ws + OFF_KCMP) + (long)(b * 512 + i) * 128 + g * 64 + half * 32;
#pragma unroll
          for (int q = 0; q < 4; ++q) { float v[8];
#pragma unroll
            for (int e = 0; e < 8; ++e) v[e] = acc[q * 8 + e];
            *(u32x4*)(dst + q * 8) = pack8(v); }
        } else {
          bf16_t* dst = (bf16_t*)(ws + OFF_VCT) + ((long)(b * 128 + g * 64 + half * 32)) * 512 + i;
#pragma unroll
          for (int q = 0; q < 32; ++q) dst[(long)q * 512] = (bf16_t)f2bf(acc[q]);
        }
      });
    } else {
      const int bc = job - 32; bf16_t* base = (bf16_t*)(ws + OFF_C + C_GVT) + (long)bc * 512 * 128;
      float* ssum = (float*)smem; float* ssq = ssum + 128;
      float* psum = ssum + 256; float* psq = psum + 16 * 128;
      const int cs = tid >> 4, s8 = (tid & 15) * 8;
      float a[8], q[8];
#pragma unroll
      for (int i = 0; i < 8; ++i) { a[i] = 0.f; q[i] = 0.f; }
      for (int it = 0; it < 32; ++it) {
        u32x4 d = *(const u32x4*)(base + (long)(it * 16 + cs) * 128 + s8);
#pragma unroll
        for (int i = 0; i < 4; ++i) { float lo = bf2f(d[i] & 0xffffu), hi = bf2f(d[i] >> 16); a[2 * i] += lo; q[2 * i] += lo * lo; a[2 * i + 1] += hi; q[2 * i + 1] += hi * hi; }
      }
#pragma unroll
      for (int i = 0; i < 8; ++i) { psum[cs * 128 + s8 + i] = a[i]; psq[cs * 128 + s8 + i] = q[i]; }
      __syncthreads();
      if (tid < 128) {
        float su = 0.f, sq = 0.f;
        for (int c = 0; c < 16; ++c) { su += psum[c * 128 + tid]; sq += psq[c * 128 + tid]; }
        float mean_t = su * (1.f / 512.f); float var = sq * (1.f / 512.f) - mean_t * mean_t; if (var < 0.f) var = 0.f;
        ssum[tid] = mean_t; ssq[tid] = rsqrtf(var + 1e-6f);
      }
      __syncthreads();
      float mean[8], rs[8];
#pragma unroll
      for (int i = 0; i < 8; ++i) { mean[i] = ssum[s8 + i]; rs[i] = ssq[s8 + i]; }
      for (int it = 0; it < 32; ++it) {
        int ch = it * 16 + cs; float gg = P.ln_sgu[ch];
        u32x4 d = *(const u32x4*)(base + (long)ch * 128 + s8); float v[8];
#pragma unroll
        for (int i = 0; i < 4; ++i) { v[2 * i] = bf2f(d[i] & 0xffffu); v[2 * i + 1] = bf2f(d[i] >> 16); }
#pragma unroll
        for (int i = 0; i < 8; ++i) v[i] = (v[i] - mean[i]) * rs[i] * gg;
        *(u32x4*)(base + (long)ch * 128 + s8) = pack8(v);
      }
      __syncthreads();
    }
  }
}

template <int MODE>
__device__ __forceinline__ void nsa_block(const bf16x8 (&qf)[4][2], f32x4 (&oacc)[4][4], float (&m)[4], float (&l)[4],
                                          const float (&sl2)[4], const float (&inv)[4], const bf16_t* kp, const bf16_t* vp, long vdt,
                                          int dist0, bool rowok, float (&asum)[2], float (&bsum)[2]) {
  constexpr int DSTEP = (MODE <= 1) ? 16 : 1;
  bf16x8 kf[2][2];
#pragma unroll
  for (int kt = 0; kt < 2; ++kt)
#pragma unroll
    for (int ks = 0; ks < 2; ++ks) kf[kt][ks] = *(const bf16x8*)(kp + kt * 16 * 128 + ks * 32);
  bf16x8 vf[4];
  if (MODE != 0) {
#pragma unroll
    for (int dt = 0; dt < 4; ++dt) {
      u32x2 lo = *(const u32x2*)(vp + dt * vdt); u32x2 hi = *(const u32x2*)(vp + dt * vdt + 16);
      u32x4 c; c[0] = lo[0]; c[1] = lo[1]; c[2] = hi[0]; c[3] = hi[1];
      vf[dt] = __builtin_bit_cast(bf16x8, c);
    }
  }
  const float fd0 = (float)dist0;
#pragma unroll
  for (int h = 0; h < 4; ++h) {
    f32x4 s[2];
#pragma unroll
    for (int kt = 0; kt < 2; ++kt) {
      s[kt] = __builtin_amdgcn_mfma_f32_16x16x32_bf16(kf[kt][0], qf[h][0], (f32x4){0.f, 0.f, 0.f, 0.f}, 0, 0, 0);
      s[kt] = __builtin_amdgcn_mfma_f32_16x16x32_bf16(kf[kt][1], qf[h][1], s[kt], 0, 0, 0);
    }
    float sc[8]; bool ok[8];
#pragma unroll
    for (int kt = 0; kt < 2; ++kt)
#pragma unroll
      for (int r = 0; r < 4; ++r) {
        const int e = kt * 16 + r; const int dist = dist0 - DSTEP * e;
        sc[kt * 4 + r] = s[kt][r] - sl2[h] * (fd0 - (float)(DSTEP * e));
        bool o = dist >= 0;
        if (MODE == 2) o = o && rowok;
        if (MODE == 3) o = o && (dist < 512);
        ok[kt * 4 + r] = o;
      }
    float p[8];
    if (MODE != 1) {
      float ml = NEGF;
#pragma unroll
      for (int i = 0; i < 8; ++i) ml = fmaxf(ml, ok[i] ? sc[i] : NEGF);
      ml = fmaxf(ml, __shfl_xor(ml, 16, 64)); ml = fmaxf(ml, __shfl_xor(ml, 32, 64));
      const float mn = fmaxf(m[h], ml); const float alpha = __builtin_amdgcn_exp2f(m[h] - mn); m[h] = mn;
      float ps = 0.f;
#pragma unroll
      for (int i = 0; i < 8; ++i) { p[i] = ok[i] ? __builtin_amdgcn_exp2f(sc[i] - mn) : 0.f; ps += p[i]; }
      l[h] = l[h] * alpha + ps;
      if (MODE != 0) {
#pragma unroll
        for (int dt = 0; dt < 4; ++dt) oacc[h][dt] *= alpha;
      }
    } else {
#pragma unroll
      for (int i = 0; i < 8; ++i) p[i] = ok[i] ? __builtin_amdgcn_exp2f(sc[i] - m[h]) * l[h] : 0.f;
      asum[0] += (p[0] + p[1]) + (p[2] + p[3]); bsum[0] += p[3];
      asum[1] += (p[4] + p[5]) + (p[6] + p[7]); bsum[1] += p[7];
    }
    if (MODE != 0) {
      u32x4 pk; pk[0] = pack2(p[0], p[1]); pk[1] = pack2(p[2], p[3]); pk[2] = pack2(p[4], p[5]); pk[3] = pack2(p[6], p[7]);
      const bf16x8 pf = __builtin_bit_cast(bf16x8, pk);
#pragma unroll
      for (int dt = 0; dt < 4; ++dt) oacc[h][dt] = __builtin_amdgcn_mfma_f32_16x16x32_bf16(vf[dt], pf, oacc[h][dt], 0, 0, 0);
    }
    __builtin_amdgcn_sched_barrier(0);
  }
}

__device__ void nsa_tile(const Params& P, int wt, char* wl) {
  char* C = P.ws + OFF_C;
  const bf16_t* Q = (const bf16_t*)(C + C_Q);
  const bf16_t* KCMP = (const bf16_t*)(P.ws + OFF_KCMP); const bf16_t* VCT = (const bf16_t*)(P.ws + OFF_VCT);
  const bf16_t* KS = (const bf16_t*)(C + C_KS); const bf16_t* VST = (const bf16_t*)(C + C_VST);
  const bf16_t* KW = (const bf16_t*)(C + C_KW); const bf16_t* VWT = (const bf16_t*)(C + C_VWT);
  const float* GATES = (const float*)(C + C_GATES);
  bf16_t* O = (bf16_t*)(P.ws + OFF_D);
  const int lane = tidx() & 63, qi = lane & 15, quad = lane >> 4;
  wt = __builtin_amdgcn_readfirstlane(wt);
  const int jb = wt >> 2, wv4 = wt & 3;
  const int bg = jb & 3, b = bg >> 1, g = bg & 1;
  const int gq = jb >> 2;
  const int tq = (gq < 64 ? 127 - gq : gq - 64) * 4 + wv4;
  const int t0 = tq * 16;
  const int t = t0 + qi;
  const long row = (long)b * T_ + t;
  bf16x8 qf[4][2];
#pragma unroll
  for (int h = 0; h < 4; ++h)
#pragma unroll
    for (int ks = 0; ks < 2; ++ks) qf[h][ks] = *(const bf16x8*)(Q + row * 512 + (g * 4 + h) * 64 + ks * 32 + quad * 8);
  float sl2[4];
#pragma unroll
  for (int h = 0; h < 4; ++h) sl2[h] = __builtin_amdgcn_exp2f(-(float)(g * 4 + h + 1)) * LOG2E;
  f32x4 oacc[4][4]; float m[4], l[4], inv[4]; float asum[2], bsum[2];
  float* imp = (float*)wl; float* outl = (float*)wl;
  unsigned* sel = (unsigned*)(wl + 16384); unsigned* uni = sel + 64;
#pragma unroll
  for (int h = 0; h < 4; ++h) { m[h] = NEGF; l[h] = 0.f; inv[h] = 0.f; }
  asum[0] = asum[1] = bsum[0] = bsum[1] = 0.f;

  const int nI = t0 >> 4; const int nblk = (nI + 31) >> 5;
  for (int blk = 0; blk < nblk; ++blk) {
    const int key0 = blk * 32;
    const bf16_t* kp = KCMP + (long)(b * 512 + key0 + qi) * 128 + g * 64 + quad * 8;
    nsa_block<0>(qf, oacc, m, l, sl2, inv, kp, nullptr, 0, t - 31 - 16 * (key0 + quad * 4), true, asum, bsum);
  }
#pragma unroll
  for (int h = 0; h < 4; ++h) { float lt = l[h]; lt += __shfl_xor(lt, 16, 64); lt += __shfl_xor(lt, 32, 64); l[h] = 1.f / fmaxf(lt, 1e-30f); }
  for (int i = lane; i < 16 * 132; i += 64) imp[i] = 0.f;
#pragma unroll
  for (int h = 0; h < 4; ++h)
#pragma unroll
    for (int dt = 0; dt < 4; ++dt) oacc[h][dt] = (f32x4){0.f, 0.f, 0.f, 0.f};
  for (int blk = 0; blk < nblk; ++blk) {
    const int key0 = blk * 32;
    const bf16_t* kp = KCMP + (long)(b * 512 + key0 + qi) * 128 + g * 64 + quad * 8;
    const bf16_t* vp = VCT + (long)(b * 128 + g * 64 + qi) * 512 + key0 + quad * 4;
    asum[0] = asum[1] = bsum[0] = bsum[1] = 0.f;
    nsa_block<1>(qf, oacc, m, l, sl2, inv, kp, vp, 16 * 512, t - 31 - 16 * (key0 + quad * 4), true, asum, bsum);
    const int J = (key0 >> 2) + quad;
    atomicAdd(&imp[qi * 132 + J], asum[0]); atomicAdd(&imp[qi * 132 + J + 1], bsum[0]);
    atomicAdd(&imp[qi * 132 + J + 4], asum[1]); atomicAdd(&imp[qi * 132 + J + 5], bsum[1]);
  }
  const int cur = t0 >> 6;
  if (lane < 16) {
    unsigned w0 = 0, w1 = 0, w2 = 0, w3 = 0;
    if (cur < 16) { w0 = (1u << (cur + 1)) - 1u; }
    else {
      w0 = 1u;
      { int j = cur; unsigned bit = 1u << (j & 31); int w = j >> 5; if (w == 0) w0 |= bit; else if (w == 1) w1 |= bit; else if (w == 2) w2 |= bit; else w3 |= bit; }
      { int j = cur - 1; unsigned bit = 1u << (j & 31); int w = j >> 5; if (w == 0) w0 |= bit; else if (w == 1) w1 |= bit; else if (w == 2) w2 |= bit; else w3 |= bit; }
    }
    sel[lane * 4 + 0] = w0; sel[lane * 4 + 1] = w1; sel[lane * 4 + 2] = w2; sel[lane * 4 + 3] = w3;
  }
  if (lane < 4) uni[lane] = 0u;
  if (cur >= 16) {
    for (int rnd = 0; rnd < 4; ++rnd) {
      const int qq = rnd * 4 + quad;
      unsigned key[8];
#pragma unroll
      for (int c = 0; c < 8; ++c) {
        const int j = qi + 16 * c;
        const bool v = (j <= cur) && (j != 0) && (j != cur) && (j != cur - 1);
        const unsigned bits = __float_as_uint(imp[qq * 132 + j]);
        key[c] = v ? ((bits & 0xFFFFFF00u) | (unsigned)(128 - j)) : 0u;
      }
      for (int it = 0; it < 13; ++it) {
        unsigned mx = key[0];
#pragma unroll
        for (int c = 1; c < 8; ++c) mx = key[c] > mx ? key[c] : mx;
#pragma unroll
        for (int o = 1; o < 16; o <<= 1) { unsigned ot = (unsigned)__shfl_xor((int)mx, o, 64); mx = ot > mx ? ot : mx; }
        if (mx != 0u) {
#pragma unroll
          for (int c = 0; c < 8; ++c) {
            if (key[c] == mx) { key[c] = 0u; const int j = qi + 16 * c; atomicOr(&sel[qq * 4 + (j >> 5)], 1u << (j & 31)); }
          }
        }
      }
    }
  }
  unsigned mym[4];
#pragma unroll
  for (int w = 0; w < 4; ++w) mym[w] = sel[qi * 4 + w];
  if (lane < 16) {
#pragma unroll
    for (int w = 0; w < 4; ++w) atomicOr(&uni[w], mym[w]);
  }
  const float* gp = GATES + row * 24 + g * 12;
#pragma unroll
  for (int h = 0; h < 4; ++h) {
    const float gt = gp[h * 3 + 0] * NSA_G0;
#pragma unroll
    for (int dt = 0; dt < 4; ++dt) *(f32x4*)(outl + ((h * 16 + qi) * 64 + (((dt * 4 + quad) ^ qi) << 2))) = oacc[h][dt] * gt;
  }
#pragma unroll
  for (int h = 0; h < 4; ++h) { m[h] = NEGF; l[h] = 0.f;
#pragma unroll
    for (int dt = 0; dt < 4; ++dt) oacc[h][dt] = (f32x4){0.f, 0.f, 0.f, 0.f}; }
#pragma unroll 1
  for (int w = 0; w < 4; ++w) {
    unsigned bits = __builtin_amdgcn_readfirstlane(uni[w]);
    const unsigned myw = sel[qi * 4 + w];
    while (bits) {
      const int jj = __builtin_ctz(bits); bits &= bits - 1u;
      const int j = w * 32 + jj; const bool rowok = (myw >> jj) & 1u;
#pragma unroll 1
      for (int half = 0; half < 2; ++half) {
        const int key0 = j * 64 + half * 32;
        const bf16_t* kp = KS + (long)(b * T_ + key0 + qi) * 128 + g * 64 + quad * 8;
        const bf16_t* vp = VST + (long)(b * 128 + g * 64 + qi) * T_ + key0 + quad * 4;
        nsa_block<2>(qf, oacc, m, l, sl2, inv, kp, vp, 16L * T_, t - (key0 + quad * 4), rowok, asum, bsum);
      }
    }
  }
#pragma unroll
  for (int h = 0; h < 4; ++h) {
    float lt = l[h]; lt += __shfl_xor(lt, 16, 64); lt += __shfl_xor(lt, 32, 64);
    const float sc = NSA_G1 * gp[h * 3 + 1] / fmaxf(lt, 1e-30f);
#pragma unroll
    for (int dt = 0; dt < 4; ++dt) { f32x4* d = (f32x4*)(outl + ((h * 16 + qi) * 64 + (((dt * 4 + quad) ^ qi) << 2))); *d = *d + oacc[h][dt] * sc; }
  }
#pragma unroll
  for (int h = 0; h < 4; ++h) { m[h] = NEGF; l[h] = 0.f;
#pragma unroll
    for (int dt = 0; dt < 4; ++dt) oacc[h][dt] = (f32x4){0.f, 0.f, 0.f, 0.f}; }
  {
    const int kstart = t0 >= 512 ? ((t0 - 511) & ~31) : 0;
    for (int key0 = kstart; key0 <= t0 + 15; key0 += 32) {
      const bf16_t* kp = KW + (long)(b * T_ + key0 + qi) * 128 + g * 64 + quad * 8;
      const bf16_t* vp = VWT + (long)(b * 128 + g * 64 + qi) * T_ + key0 + quad * 4;
      nsa_block<3>(qf, oacc, m, l, sl2, inv, kp, vp, 16L * T_, t - (key0 + quad * 4), true, asum, bsum);
    }
  }
#pragma unroll
  for (int h = 0; h < 4; ++h) {
    float lt = l[h]; lt += __shfl_xor(lt, 16, 64); lt += __shfl_xor(lt, 32, 64);
    const float sc = NSA_G2 * gp[h * 3 + 2] / fmaxf(lt, 1e-30f);
#pragma unroll
    for (int dt = 0; dt < 4; ++dt) { f32x4* d = (f32x4*)(outl + ((h * 16 + qi) * 64 + (((dt * 4 + quad) ^ qi) << 2))); *d = *d + oacc[h][dt] * sc; }
  }
#pragma unroll
  for (int it = 0; it < 8; ++it) {
    const int id = it * 64 + lane; const int h = id >> 7, rem = id & 127, q2 = rem >> 3, c8 = rem & 7;
    f32x4 a = *(const f32x4*)(outl + ((h * 16 + q2) * 64 + (((2 * c8) ^ q2) << 2)));
    f32x4 bb = *(const f32x4*)(outl + ((h * 16 + q2) * 64 + (((2 * c8 + 1) ^ q2) << 2)));
    float v[8] = {a[0], a[1], a[2], a[3], bb[0], bb[1], bb[2], bb[3]};
    *(u32x4*)(O + ((long)b * T_ + t0 + q2) * 512 + (g * 4 + h) * 64 + c8 * 8) = pack8(v);
  }
}

__device__ void xattn_tile(const Params& P, int wt) {
  const bf16_t* HQ = (const bf16_t*)(P.ws + OFF_D);
  const bf16_t* MK = (const bf16_t*)(P.ws + OFF_MK); const bf16_t* MVT = (const bf16_t*)(P.ws + OFF_MVT);
  bf16_t* OX = (bf16_t*)(P.ws + OFF_D) + (long)M_ * 512;
  const int lane = tidx() & 63, qi = lane & 15, quad = lane >> 4;
  wt = __builtin_amdgcn_readfirstlane(wt);
  const int h = wt & 3; const int row0 = (wt >> 2) * 32; const int b = row0 >> 13;
  bf16x8 qf[2][4];
#pragma unroll
  for (int nt = 0; nt < 2; ++nt)
#pragma unroll
    for (int ks = 0; ks < 4; ++ks) qf[nt][ks] = *(const bf16x8*)(HQ + (long)(row0 + nt * 16 + qi) * 512 + h * 128 + ks * 32 + quad * 8);
  f32x4 oacc[2][8]; float m[2], l[2];
#pragma unroll
  for (int nt = 0; nt < 2; ++nt) { m[nt] = NEGF; l[nt] = 0.f;
#pragma unroll
    for (int dt = 0; dt < 8; ++dt) oacc[nt][dt] = (f32x4){0.f, 0.f, 0.f, 0.f}; }
  for (int blk = 0; blk < 8; ++blk) {
    const int key0 = blk * 32;
    f32x4 s[2][2];
#pragma unroll
    for (int nt = 0; nt < 2; ++nt)
#pragma unroll
      for (int kt = 0; kt < 2; ++kt) s[nt][kt] = (f32x4){0.f, 0.f, 0.f, 0.f};
#pragma unroll
    for (int ks = 0; ks < 4; ++ks) {
#pragma unroll
      for (int kt = 0; kt < 2; ++kt) {
        bf16x8 kf = *(const bf16x8*)(MK + (long)(b * 256 + key0 + kt * 16 + qi) * 512 + h * 128 + ks * 32 + quad * 8);
#pragma unroll
        for (int nt = 0; nt < 2; ++nt) s[nt][kt] = __builtin_amdgcn_mfma_f32_16x16x32_bf16(kf, qf[nt][ks], s[nt][kt], 0, 0, 0);
      }
    }
    bf16x8 pf[2];
#pragma unroll
    for (int nt = 0; nt < 2; ++nt) {
      float ml = NEGF;
#pragma unroll
      for (int kt = 0; kt < 2; ++kt)
#pragma unroll
        for (int r = 0; r < 4; ++r) ml = fmaxf(ml, s[nt][kt][r]);
      ml = fmaxf(ml, __shfl_xor(ml, 16, 64)); ml = fmaxf(ml, __shfl_xor(ml, 32, 64));
      const float mn = fmaxf(m[nt], ml); const float alpha = __builtin_amdgcn_exp2f(m[nt] - mn); m[nt] = mn;
      float p[8]; float ps = 0.f;
#pragma unroll
      for (int kt = 0; kt < 2; ++kt)
#pragma unroll
        for (int r = 0; r < 4; ++r) { p[kt * 4 + r] = __builtin_amdgcn_exp2f(s[nt][kt][r] - mn); ps += p[kt * 4 + r]; }
      l[nt] = l[nt] * alpha + ps;
#pragma unroll
      for (int dt = 0; dt < 8; ++dt) oacc[nt][dt] *= alpha;
      u32x4 pk; pk[0] = pack2(p[0], p[1]); pk[1] = pack2(p[2], p[3]); pk[2] = pack2(p[4], p[5]); pk[3] = pack2(p[6], p[7]);
      pf[nt] = __builtin_bit_cast(bf16x8, pk);
    }
#pragma unroll
    for (int dt = 0; dt < 8; ++dt) {
      const bf16_t* vp = MVT + (long)(b * 512 + h * 128 + dt * 16 + qi) * 256 + key0 + quad * 4;
      u32x2 lo = *(const u32x2*)(vp); u32x2 hi = *(const u32x2*)(vp + 16);
      u32x4 c; c[0] = lo[0]; c[1] = lo[1]; c[2] = hi[0]; c[3] = hi[1];
      const bf16x8 vf = __builtin_bit_cast(bf16x8, c);
#pragma unroll
      for (int nt = 0; nt < 2; ++nt) oacc[nt][dt] = __builtin_amdgcn_mfma_f32_16x16x32_bf16(vf, pf[nt], oacc[nt][dt], 0, 0, 0);
    }
  }
#pragma unroll
  for (int nt = 0; nt < 2; ++nt) {
    float lt = l[nt]; lt += __shfl_xor(lt, 16, 64); lt += __shfl_xor(lt, 32, 64);
    const float iv = 1.f / lt;
#pragma unroll
    for (int dt = 0; dt < 8; ++dt) {
      f32x4 v = oacc[nt][dt] * iv; u32x2 pk; pk[0] = pack2(v[0], v[1]); pk[1] = pack2(v[2], v[3]);
      *(u32x2*)(OX + (long)(row0 + nt * 16 + qi) * 512 + h * 128 + dt * 16 + quad * 4) = pk;
    }
  }
}


#define XB_TMO      128
#define XB_XCNT(j)  (256  + 64 * (j))
#define XB_XSUB(j)  (1280 + 64 * (j))
#define XB_XGEN(j)  (2304 + 64 * (j))
#define XB_TOP      3328
#define XB_TOPGEN   3392
#define XCD_BAR_WORDS 3456
#define XB_SPIN_CAP (1u << 18)
#define LAS __attribute__((address_space(3)))
__device__ __forceinline__ unsigned xb_ld(unsigned* p) { return __hip_atomic_load(p, __ATOMIC_RELAXED, __HIP_MEMORY_SCOPE_AGENT); }
__device__ __forceinline__ unsigned xb_add(unsigned* p, unsigned v) { return __hip_atomic_fetch_add(p, v, __ATOMIC_RELAXED, __HIP_MEMORY_SCOPE_AGENT); }
__device__ __forceinline__ unsigned xb_xcc_id() { return (unsigned)__builtin_amdgcn_s_getreg((3 << 11) | 20) & 0xFu; }
#define XB_SPIN(cond, bar) do { unsigned _sp = 0; while (cond) { __builtin_amdgcn_s_sleep(1); \
    if ((++_sp & 255u) == 0u) { if (xb_ld(&(bar)[XB_TMO])) break; if (_sp > XB_SPIN_CAP) { atomicAdd(&(bar)[XB_TMO], 1u); break; } } } } while (0)
__device__ __forceinline__ void xcd_barrier_complete(unsigned* bar, unsigned x, unsigned& nloc, unsigned& nx) {
  const unsigned G = gridDim.x * gridDim.y * gridDim.z;
  unsigned sum, cnt, mine, sp = 0u;
  for (;;) {
    sum = 0u; cnt = 0u; mine = 0u;
#pragma unroll
    for (unsigned j = 0; j < 16; ++j) { const unsigned c = xb_ld(&bar[XB_XCNT(j)]); sum += c; cnt += (c > 0u) ? 1u : 0u; mine = (j == x) ? c : mine; }
    if (sum == G) break;
    __builtin_amdgcn_s_sleep(1);
    if ((++sp & 255u) == 0u) { if (xb_ld(&bar[XB_TMO])) break; if (sp > XB_SPIN_CAP) { atomicAdd(&bar[XB_TMO], 1u); break; } }
  }
  nloc = mine > 0u ? mine : 1u; nx = cnt > 0u ? cnt : 1u;
}
__device__ __forceinline__ void xcd_barrier(unsigned* bar, unsigned x, volatile LAS unsigned* st) {
  asm volatile("s_waitcnt vmcnt(0)" ::: "memory");
  __syncthreads();
  if (threadIdx.x == 0) {
    __builtin_amdgcn_s_waitcnt(0);
    unsigned nloc = st[0], nx = st[1];
    if (nloc == 0u) { xcd_barrier_complete(bar, x, nloc, nx); st[0] = nloc; st[1] = nx; }
    const unsigned old = xb_add(&bar[XB_XSUB(x)], 1u);
    const unsigned gen = old / nloc;
    if (old + 1u == (gen + 1u) * nloc) {
      __builtin_amdgcn_fence(__ATOMIC_RELEASE, "agent");
      asm volatile("s_waitcnt vmcnt(0)" ::: "memory");
      const unsigned og = xb_add(&bar[XB_TOP], 1u);
      const unsigned tg = og / nx;
      if (og + 1u == (tg + 1u) * nx) xb_add(&bar[XB_TOPGEN], 1u);
      else XB_SPIN(xb_ld(&bar[XB_TOPGEN]) == tg, bar);
      __builtin_amdgcn_fence(__ATOMIC_ACQUIRE, "agent");
      xb_add(&bar[XB_XGEN(x)], 1u);
      asm volatile("s_waitcnt vmcnt(0)" ::: "memory");
    } else {
      XB_SPIN(xb_ld(&bar[XB_XGEN(x)]) == gen, bar);
      __builtin_amdgcn_fence(__ATOMIC_ACQUIRE, "agent");
      asm volatile("s_waitcnt vmcnt(0)" ::: "memory");
    }
  }
  __syncthreads();
}

__device__ void run_phase(const Params& P, int ph, char* smem) {
  char* ws = P.ws; const int tid = tidx();
  switch (ph) {
    case 0: phase0(P, smem); break;
    case 1: phase1(P, smem); break;
    case 2: phase2(P, smem); break;
    case 3: {
      for (int job = blockIdx.x; job < 512; job += gridDim.x) { const int wv = tidx() >> 6; nsa_tile(P, job * 4 + wv, smem + wv * 16896); }
      __syncthreads();
      for (int job = blockIdx.x; job < 512; job += gridDim.x) {
        {
          const int tid = tidx();
          const int s = job; const int bc = s >> 2, g = s & 3;
          RowLin ar{(const bf16_t*)(ws + OFF_WM) + g * 16384, 128};
          RowLin br{(const bf16_t*)(ws + OFF_C + C_GVT) + ((long)bc * 512 + g * 128) * 128, 128};
          const float* bs = P.b_sp + g * 128;
          const bf16_t* U = (const bf16_t*)(ws + OFF_C + C_U) + (long)bc * 128 * 512 + g * 128;
          bf16_t* OS = (bf16_t*)(ws + OFF_D) + (long)M_ * 512 + (long)bc * 128 * 512 + g * 128;
          gemm_tile(smem, ar, br, 2, 64, 64, [&](const float* Cs) {
#pragma unroll 2
            for (int it = 0; it < 8; ++it) {
              int id = it * 256 + tid; int r = id >> 4, c = (id & 15) * 8; float v[8]; ld8(Cs, r, c, v);
              u32x4 d = *(const u32x4*)(U + (long)r * 512 + c); const float bb = bs[r];
#pragma unroll
              for (int i = 0; i < 4; ++i) { v[2 * i] = (v[2 * i] + bb) * bf2f(d[i] & 0xffffu); v[2 * i + 1] = (v[2 * i + 1] + bb) * bf2f(d[i] >> 16); }
              *(u32x4*)(OS + (long)r * 512 + c) = pack8(v);
            }
          });
        }
      }
    } break;
    case 4: {
      float* scr = (float*)(ws + OFF_C + C_SCR) + (long)blockIdx.x * 16384;
      const int xq = blockIdx.x & 7, lq = blockIdx.x >> 3, sq = gridDim.x >> 3;
      for (int t = lq; t < 16 * 8; t += sq) {
        const int mt = xq * 16 + (t & 15), nt = t >> 4, brow = mt * 128, bcol = nt * 128;
        const bf16_t* MG = (const bf16_t*)(ws + OFF_B) + (long)brow * 2048 + bcol;
        RowLin a1{(const bf16_t*)(ws + OFF_D) + (long)brow * 512, 512};
        RowLin b1{(const bf16_t*)(ws + OFF_WPA) + (long)bcol * 512, 512};
        gemm_tile(smem, a1, b1, 8, 64, 64, [&](const float* Cs) {
#pragma unroll 2
          for (int it = 0; it < 8; ++it) {
            int id = it * 256 + tid; int r = id >> 4, c = (id & 15) * 8; float v[8]; ld8(Cs, r, c, v);
            u32x4 d = *(const u32x4*)(MG + (long)r * 2048 + c);
#pragma unroll
            for (int i = 0; i < 4; ++i) { v[2 * i] *= bf2f(d[i] & 0xffffu); v[2 * i + 1] *= bf2f(d[i] >> 16); }
            *(f32x4*)(scr + id * 8) = (f32x4){v[0], v[1], v[2], v[3]}; *(f32x4*)(scr + id * 8 + 4) = (f32x4){v[4], v[5], v[6], v[7]};
          }
        });
        RowLin a2{(const bf16_t*)(ws + OFF_D) + (long)M_ * 512 + (long)brow * 512, 512};
        RowLin b2{(const bf16_t*)(ws + OFF_WPB) + (long)bcol * 512, 512};
        bf16_t* MX = (bf16_t*)(ws + OFF_C + C_MIXED) + (long)brow * 1024 + bcol;
        gemm_tile(smem, a2, b2, 8, 64, 64, [&](const float* Cs) {
#pragma unroll 2
          for (int it = 0; it < 8; ++it) {
            int id = it * 256 + tid; int r = id >> 4, c = (id & 15) * 8; float v[8]; ld8(Cs, r, c, v);
            u32x4 d = *(const u32x4*)(MG + (long)r * 2048 + 1024 + c);
            f32x4 p0 = *(const f32x4*)(scr + id * 8), p1 = *(const f32x4*)(scr + id * 8 + 4);
            float pv[8] = {p0[0], p0[1], p0[2], p0[3], p1[0], p1[1], p1[2], p1[3]};
#pragma unroll
            for (int i = 0; i < 4; ++i) { v[2 * i] = pv[2 * i] + v[2 * i] * bf2f(d[i] & 0xffffu); v[2 * i + 1] = pv[2 * i + 1] + v[2 * i + 1] * bf2f(d[i] >> 16); }
            *(u32x4*)(MX + (long)r * 1024 + c) = pack8(v);
          }
        });
      }
    } break;
    case 5: case 9: case 12: {
      const bf16_t* A; const bf16_t* W; const float* RES; float* DST; int K;
      if (ph == 5) { A = (const bf16_t*)(ws + OFF_C + C_MIXED); W = (const bf16_t*)(ws + OFF_WOUT); RES = P.x; DST = (float*)(ws + OFF_B); K = 1024; }
      else if (ph == 9) { A = (const bf16_t*)(ws + OFF_D) + (long)M_ * 512; W = (const bf16_t*)(ws + OFF_WMO); RES = (const float*)(ws + OFF_B); DST = (float*)(ws + OFF_C + C_H2); K = 512; }
      else { A = (const bf16_t*)(ws + OFF_B); W = (const bf16_t*)(ws + OFF_WDN); RES = (const float*)(ws + OFF_C + C_H2); DST = P.out; K = 2816; }
      const int xq = blockIdx.x & 7, lq = blockIdx.x >> 3, sq = gridDim.x >> 3;
      for (int t = lq; t < 16 * 4; t += sq) {
        const int mt = xq * 16 + (t & 15), nt2 = t >> 4, brow = mt * 128;
        RowLin ar{A + (long)brow * K, K}; RowLin br{W + (long)nt2 * 256 * K, K};
        gemm_tile2(smem, ar, br, K / 64, [&](const float* Cs, int p) {
          const int bcol = nt2 * 256 + p * 128;
          const float* rs = RES + (long)brow * 1024 + bcol; float* ds = DST + (long)brow * 1024 + bcol;
#pragma unroll 4
          for (int it = 0; it < 8; ++it) {
            int id = it * 256 + tid; int r = id >> 4, c = (id & 15) * 8;
            f32x4 a = *(const f32x4*)(Cs + r * CS_LD + c), bq = *(const f32x4*)(Cs + r * CS_LD + c + 4);
            f32x4 r0 = *(const f32x4*)(rs + (long)r * 1024 + c), r1 = *(const f32x4*)(rs + (long)r * 1024 + c + 4);
            const f32x4 h0 = a + r0, h1v = bq + r1;
            *(f32x4*)(ds + (long)r * 1024 + c) = h0; *(f32x4*)(ds + (long)r * 1024 + c + 4) = h1v;
            if (ph != 12) {
              const float* gn = (ph == 5 ? P.norm_mq : P.norm_ffn) + bcol + c;
              const f32x4 g0 = *(const f32x4*)gn, g1 = *(const f32x4*)(gn + 4);
              float v[8] = {h0[0] * g0[0], h0[1] * g0[1], h0[2] * g0[2], h0[3] * g0[3], h1v[0] * g1[0], h1v[1] * g1[1], h1v[2] * g1[2], h1v[3] * g1[3]};
              *(u32x4*)((bf16_t*)(ws + OFF_A) + (long)(brow + r) * 1024 + bcol + c) = pack8(v);
              float ss = (h0[0] * h0[0] + h0[1] * h0[1]) + (h0[2] * h0[2] + h0[3] * h0[3]) + (h1v[0] * h1v[0] + h1v[1] * h1v[1]) + (h1v[2] * h1v[2] + h1v[3] * h1v[3]);
              ss += __shfl_xor(ss, 1, 64); ss += __shfl_xor(ss, 2, 64); ss += __shfl_xor(ss, 4, 64); ss += __shfl_xor(ss, 8, 64);
              if ((tid & 15) == 0) ((float*)(ws + (ph == 5 ? OFF_SSQ1 : OFF_SSQ2)))[(long)(brow + r) * 8 + nt2 * 2 + p] = ss;
            }
          }
        });
      }
    } break;
    case 6: case 10: {
      const float* src = ph == 6 ? (const float*)(ws + OFF_B) : (const float*)(ws + OFF_C + C_H2);
      const float* g = ph == 6 ? P.norm_mq : P.norm_ffn;
      (void)src; (void)g;
    } break;
    case 7: {
      const int xq = blockIdx.x & 7, lq = blockIdx.x >> 3, sq = gridDim.x >> 3;
      for (int t = lq; t < 16 * 2; t += sq) {
        const int mt = xq * 16 + (t & 15), nt2 = t >> 4, brow = mt * 128;
        RowLin ar{(const bf16_t*)(ws + OFF_A) + (long)brow * 1024, 1024}; RowLin br{(const bf16_t*)(ws + OFF_WMQ) + (long)nt2 * 256 * 1024, 1024};
        gemm_tile2(smem, ar, br, 16, [&](const float* Cs, int p) {
          const int nt = nt2 * 2 + p;
          bf16_t* dq = (bf16_t*)(ws + OFF_D) + (long)brow * 512 + nt * 128; const float* sq1 = (const float*)(ws + OFF_SSQ1) + (long)brow * 8;
#pragma unroll 2
          for (int it = 0; it < 8; ++it) {
            int id = it * 256 + tid; int r = id >> 4, c = (id & 15) * 8; float v[8]; ld8(Cs, r, c, v);
            const f32x4 s0 = *(const f32x4*)(sq1 + r * 8), s1 = *(const f32x4*)(sq1 + r * 8 + 4);
            const float ssum = ((s0[0] + s0[1]) + (s0[2] + s0[3])) + ((s1[0] + s1[1]) + (s1[2] + s1[3]));
            const float rr = rsqrtf(ssum * (1.f / 1024.f) + 1e-6f) * (0.08838834764831845f * LOG2E);
#pragma unroll
            for (int i = 0; i < 8; ++i) v[i] *= rr;
            *(u32x4*)(dq + (long)r * 512 + c) = pack8(v);
          }
        });
      }
    } break;
    case 8: {
      for (int job = blockIdx.x; job < 512; job += gridDim.x) xattn_tile(P, job * 4 + (tid >> 6));
    } break;
    case 11: {
      const int xq = blockIdx.x & 7, lq = blockIdx.x >> 3, sq = gridDim.x >> 3;
      for (int t = lq; t < 16 * 22; t += sq) {
        const int mt = xq * 16 + (t & 15), nt2 = t >> 4, brow = mt * 128;
        RowLin ar{(const bf16_t*)(ws + OFF_A) + (long)brow * 1024, 1024}; RowLin br{(const bf16_t*)(ws + OFF_WGU) + (long)nt2 * 256 * 1024, 1024};
        gemm_tile2(smem, ar, br, 16, [&](const float* Cs, int p) {
          bf16_t* ACT = (bf16_t*)(ws + OFF_B) + (long)brow * 2816 + (nt2 * 2 + p) * 64;
#pragma unroll 2
          for (int it = 0; it < 4; ++it) {
            int id = it * 256 + tid; int r = id >> 3, c = (id & 7) * 8; float gt[8], up[8]; ld8(Cs, r, c, gt); ld8(Cs, r, c + 64, up);
            const float* sq2 = (const float*)(ws + OFF_SSQ2) + (long)(brow + r) * 8;
            const f32x4 s0 = *(const f32x4*)(sq2), s1 = *(const f32x4*)(sq2 + 4);
            const float ssum = ((s0[0] + s0[1]) + (s0[2] + s0[3])) + ((s1[0] + s1[1]) + (s1[2] + s1[3]));
            const float rr = rsqrtf(ssum * (1.f / 1024.f) + 1e-6f);
#pragma unroll
            for (int i = 0; i < 8; ++i) { const float gg = gt[i] * rr; gt[i] = gg * sigm(gg) * (up[i] * rr); }
            *(u32x4*)(ACT + (long)r * 2816 + c) = pack8(gt);
          }
        });
      }
    } break;
    case 13: {
      for (int job = blockIdx.x; job < 1024; job += gridDim.x) { int row = job * 16 + (tid >> 6) * 4; rownorm_rows<true, 4>(P.out + (long)row * 1024, P.norm_final, P.out + (long)row * 1024); }
    } break;
#ifdef PROBE_K
    case 14: {
      const bf16_t* s0 = (const bf16_t*)(ws + PROBE_SRC0); const bf16_t* s1 = (const bf16_t*)(ws + PROBE_SRC1);
      for (long i = (long)blockIdx.x * 256 + tid; i < (long)M_ * 512; i += (long)gridDim.x * 256) {
        long row = i >> 9; int c = (int)(i & 511);
        P.out[row * 1024 + c] = bf2f(s0[i]); P.out[row * 1024 + 512 + c] = bf2f(s1[i]);
      }
    } break;
    case 15: {
      const float* s0 = (const float*)(ws + PROBE_SRC0);
      for (long i = (long)blockIdx.x * 256 + tid; i < (long)M_ * 1024; i += (long)gridDim.x * 256) P.out[i] = s0[i];
    } break;
#endif
  }
}

__global__ void __launch_bounds__(256, 2) fwd_kernel(Params P, int ph_lo, int ph_hi) {
  __shared__ __attribute__((aligned(16))) char smem[73728 + 16];
  volatile LAS unsigned* st = (volatile LAS unsigned*)(smem + 73728);
  const unsigned xcc = xb_xcc_id();
  if (ph_lo < ph_hi) {
    if (threadIdx.x == 0) { st[0] = 0u; st[1] = 0u; }
    __syncthreads();
    if (threadIdx.x == 0) (void)xb_add(&((unsigned*)(P.ws + OFF_BAR))[XB_XCNT(xcc)], 1u);
  }
  if (ph_hi < 0) cg::this_grid().sync();
  for (int ph = ph_lo; ph <= ph_hi; ++ph) {
    const uint64_t __attribute__((address_space(4)))* ka = (const uint64_t __attribute__((address_space(4)))*)__builtin_amdgcn_kernarg_segment_ptr();
    asm volatile("" : "+s"(ka));
    Params Pl; uint64_t* pd = (uint64_t*)&Pl;
#pragma unroll
    for (int i = 0; i < (int)(sizeof(Params) / 8); ++i) pd[i] = ka[i];
    if (ph_lo < ph_hi && (ph == 6 || ph == 10)) continue;
    run_phase(Pl, ph, smem);
    if (ph < ph_hi) xcd_barrier((unsigned*)(Pl.ws + OFF_BAR), xcc, st);
  }
}

extern "C" void kernel_launch(void* const* d_in, const int* in_sizes, int n_in, void* d_out, int out_size, void* d_ws, size_t ws_size,
                              hipStream_t stream) {
  static int grid_blocks = 0;
  if (!grid_blocks) {
    int dev = 0, cus = 0, per_cu = 0;
    hipGetDevice(&dev);
    hipDeviceGetAttribute(&cus, hipDeviceAttributeMultiprocessorCount, dev);
    hipOccupancyMaxActiveBlocksPerMultiprocessor(&per_cu, fwd_kernel, 256, 0);
    if (per_cu > 2) per_cu = 2;
    if (per_cu < 1) per_cu = 1;
    grid_blocks = cus * per_cu;
  }
  if (ws_size < (size_t)WS_NEED) fprintf(stderr, "workspace too small: %zu < %ld\n", ws_size, (long)WS_NEED);
  Params P{};
  const float** pp = (const float**)&P;
  for (int i = 0; i < 27; ++i) pp[i] = (const float*)d_in[i];
  P.out = (float*)d_out; P.ws = (char*)d_ws;
#if ONE_LAUNCH
  hipMemsetAsync((char*)d_ws + OFF_BAR, 0, XCD_BAR_WORDS * 4, stream);
#ifdef PROBE_K
  int lo = 0, hi = PROBE_DUMP;
#else
  int lo = 0, hi = 13;
#endif
  void* args[] = {&P, &lo, &hi};
  hipError_t e = hipLaunchCooperativeKernel((void*)fwd_kernel, dim3(grid_blocks), dim3(256), args, 0, stream);
  if (e != hipSuccess) fprintf(stderr, "cooperative launch failed: %s (grid %d)\n", hipGetErrorString(e), grid_blocks);
#else
  for (int ph = 0; ph <= 13; ++ph) fwd_kernel<<<grid_blocks, 256, 0, stream>>>(P, ph, ph);
#endif
}
```

```cpp
#include <hip/hip_runtime.h>
#include <hip/hip_cooperative_groups.h>
#include <stdint.h>
#include <stdio.h>
namespace cg = cooperative_groups;

#ifndef NSA_G0
#define NSA_G0 1.f
#define NSA_G1 1.f
#define NSA_G2 1.f
#endif
#ifndef ONE_LAUNCH
#define ONE_LAUNCH 1
#endif

typedef unsigned short bf16_t;
using bf16x8 = __attribute__((ext_vector_type(8))) short;
using f32x4 = __attribute__((ext_vector_type(4))) float;
using u32x4 = __attribute__((ext_vector_type(4))) unsigned;
using u32x2 = __attribute__((ext_vector_type(2))) unsigned;

#define T_ 8192
#define M_ 16384
#define NEGF (-1e30f)
#define LOG2E 1.4426950408889634f

constexpr long OFF_W1 = 0;
constexpr long OFF_WMKV = OFF_W1 + 9175040;
constexpr long OFF_WPA = OFF_WMKV + 2097152;
constexpr long OFF_WPB = OFF_WPA + 1048576;
constexpr long OFF_WOUT = OFF_WPB + 1048576;
constexpr long OFF_WMQ = OFF_WOUT + 2097152;
constexpr long OFF_WMO = OFF_WMQ + 1048576;
constexpr long OFF_WGU = OFF_WMO + 1048576;
constexpr long OFF_WDN = OFF_WGU + 11534336;
constexpr long OFF_WCK1 = OFF_WDN + 5767168;
constexpr long OFF_WCV1 = OFF_WCK1 + 524288;
constexpr long OFF_WM = OFF_WCV1 + 524288;
constexpr long OFF_BIAS1 = OFF_WM + 131072;
constexpr long OFF_MEMN = OFF_BIAS1 + 1024;
constexpr long OFF_MK = OFF_MEMN + 1048576;
constexpr long OFF_MVT = OFF_MK + 524288;
constexpr long OFF_KCMP = OFF_MVT + 524288;
constexpr long OFF_VCT = OFF_KCMP + 262144;
constexpr long OFF_A = OFF_VCT + 262144;
constexpr long OFF_B = OFF_A + 33554432;
constexpr long OFF_D = OFF_B + 67108864;
constexpr long OFF_C = OFF_D + 33554432;
constexpr long C_Q = 0, C_U = 16777216, C_GVT = 33554432, C_KC = 50331648, C_VC = 54525952, C_KS = 58720256,
               C_KW = 62914560, C_VST = 67108864, C_VWT = 71303168, C_GATES = 75497472;
constexpr long C_MIXED = 0, C_SCR = 33554432, C_H2 = 0;
constexpr long OFF_BAR = OFF_C + 77070336;
constexpr long OFF_SSQ1 = OFF_BAR + 16384;
constexpr long OFF_SSQ2 = OFF_SSQ1 + 524288;
constexpr long WS_NEED = OFF_SSQ2 + 524288;

struct Params {
  const float *x, *mem, *norm_mix, *w_in, *w_ck1, *w_ck2, *w_cv1, *w_cv2, *pe_k, *pe_v, *ln_sgu, *w_sp, *b_sp,
      *w_pa, *w_pb, *w_merge, *b_merge, *w_out, *norm_mq, *norm_mkv, *w_mq, *w_mkv, *w_mo, *norm_ffn, *w_gu, *w_dn, *norm_final;
  float* out;
  char* ws;
};

__device__ __forceinline__ int tidx() { int t = threadIdx.x; asm volatile("" : "+v"(t)); return t; }
__device__ __forceinline__ unsigned f2bf(float f) { unsigned u = __float_as_uint(f); u += 0x7fffu + ((u >> 16) & 1u); return u >> 16; }
__device__ __forceinline__ unsigned pack2(float a, float b) { unsigned r; asm("v_cvt_pk_bf16_f32 %0, %1, %2" : "=v"(r) : "v"(a), "v"(b)); return r; }
__device__ __forceinline__ float bf2f(unsigned h) { return __uint_as_float(h << 16); }
__device__ __forceinline__ float gelu_tanh(float x) { float u = 0.7978845608028654f * (x + 0.044715f * x * x * x); return x / (1.f + __expf(-2.f * u)); }
__device__ __forceinline__ float sigm(float x) { return 1.f / (1.f + __expf(-x)); }
__device__ __forceinline__ float wave_sum(float v) {
#pragma unroll
  for (int o = 32; o > 0; o >>= 1) v += __shfl_xor(v, o, 64);
  return v;
}
__device__ __forceinline__ u32x4 pack8(const float (&v)[8]) {
  u32x4 r; r[0] = pack2(v[0], v[1]); r[1] = pack2(v[2], v[3]); r[2] = pack2(v[4], v[5]); r[3] = pack2(v[6], v[7]); return r;
}

__device__ __forceinline__ int lds_byte(int r, int c) {
  int st = (r >> 4) * 2 + (c >> 5), rr = r & 15, cc = c & 31, ob = rr * 64 + cc * 2;
  return st * 1024 + (ob ^ (((ob >> 9) & 1) << 5));
}
__device__ __forceinline__ void stage_rc(int b, int& R, int& C) {
  int st = b >> 10, sb = b & 1023, swz = sb ^ (((sb >> 9) & 1) << 5);
  R = (st >> 1) * 16 + (swz >> 6); C = (st & 1) * 32 + ((swz & 63) >> 1);
}

#define CS_LD 132
__device__ __forceinline__ void ld8(const float* Cs, int r, int c, float (&v)[8]) {
  f32x4 a = *(const f32x4*)(Cs + r * CS_LD + c); f32x4 b = *(const f32x4*)(Cs + r * CS_LD + c + 4);
  v[0] = a[0]; v[1] = a[1]; v[2] = a[2]; v[3] = a[3]; v[4] = b[0]; v[5] = b[1]; v[6] = b[2]; v[7] = b[3];
}
__device__ __forceinline__ void ld8T(const float* Cs, int r8, int c, float (&v)[8]) {
#pragma unroll
  for (int i = 0; i < 8; ++i) v[i] = Cs[(r8 + i) * CS_LD + c];
}

struct RowLin {
  const bf16_t* base; long ld;
  __device__ __forceinline__ const bf16_t* operator()(int r) const { return base + (long)r * ld; }
};
struct RowCmp {
  const bf16_t* base; int brow;
  __device__ __forceinline__ const bf16_t* operator()(int r) const {
    int R = brow + r; int b = R >> 10, rem = R & 1023, i = rem >> 1, g = rem & 1; if (i > 510) i = 510;
    return base + ((long)(b * T_ + 16 * i) * 128 + g * 64);
  }
};

template <int AUX = 0, class ARow, class BRow, class Epi>
__device__ __forceinline__ void gemm_tile(char* smem, ARow arow, BRow brow, int nkt, int kstepA, int kstepB, Epi epi) {
  const int tid = tidx(), lane = tid & 63, wave = tid >> 6, wr = wave >> 1, wc = wave & 1, fr = lane & 15, fq = lane >> 4;
  const bf16_t* pa[4]; const bf16_t* pb[4];
#pragma unroll
  for (int i = 0; i < 4; ++i) { int b = tid * 16 + i * 4096; int R, C; stage_rc(b, R, C); pa[i] = arow(R) + C; pb[i] = brow(R) + C; }
  f32x4 acc[4][4];
#pragma unroll
  for (int m = 0; m < 4; ++m)
#pragma unroll
    for (int n = 0; n < 4; ++n) acc[m][n] = (f32x4){0.f, 0.f, 0.f, 0.f};
  {
#pragma unroll
    for (int i = 0; i < 4; ++i) {
      __builtin_amdgcn_global_load_lds((const unsigned*)(pa[i]), (unsigned*)(smem + tid * 16 + i * 4096), 16, 0, AUX);
      __builtin_amdgcn_global_load_lds((const unsigned*)(pb[i]), (unsigned*)(smem + 16384 + tid * 16 + i * 4096), 16, 0, AUX);
    }
  }
  for (int kt = 0; kt < nkt; ++kt) {
    asm volatile("s_waitcnt vmcnt(0)" ::: "memory");
    __syncthreads();
    if (kt + 1 < nkt) {
      char* la = smem + ((kt + 1) & 1) * 32768;
#pragma unroll
      for (int i = 0; i < 4; ++i) {
        __builtin_amdgcn_global_load_lds((const unsigned*)(pa[i] + (long)(kt + 1) * kstepA), (unsigned*)(la + tid * 16 + i * 4096), 16, 0, AUX);
        __builtin_amdgcn_global_load_lds((const unsigned*)(pb[i] + (long)(kt + 1) * kstepB), (unsigned*)(la + 16384 + tid * 16 + i * 4096), 16, 0, AUX);
      }
    }
    const char* la = smem + (kt & 1) * 32768; const char* lb = la + 16384;
#pragma unroll
    for (int ks = 0; ks < 2; ++ks) {
      bf16x8 a[4], b[4];
#pragma unroll
      for (int m = 0; m < 4; ++m) a[m] = *(const bf16x8*)(la + lds_byte(wr * 64 + m * 16 + fr, ks * 32 + fq * 8));
#pragma unroll
      for (int n = 0; n < 4; ++n) b[n] = *(const bf16x8*)(lb + lds_byte(wc * 64 + n * 16 + fr, ks * 32 + fq * 8));
#pragma unroll
      for (int m = 0; m < 4; ++m)
#pragma unroll
        for (int n = 0; n < 4; ++n) acc[m][n] = __builtin_amdgcn_mfma_f32_16x16x32_bf16(a[m], b[n], acc[m][n], 0, 0, 0);
    }
  }
  __syncthreads();
  float* Cs = (float*)smem;
#pragma unroll
  for (int m = 0; m < 4; ++m)
#pragma unroll
    for (int n = 0; n < 4; ++n)
#pragma unroll
      for (int r = 0; r < 4; ++r) Cs[(wr * 64 + m * 16 + fq * 4 + r) * CS_LD + wc * 64 + n * 16 + fr] = acc[m][n][r];
  __syncthreads();
  epi(Cs);
  __syncthreads();
}

template <class F>
__device__ __forceinline__ void store_rows_bf16(const float* Cs, bf16_t* dst, long ld, F f) {
#pragma unroll 2
  for (int it = 0; it < 8; ++it) {
    int id = it * 256 + tidx(); int r = id >> 4, c = (id & 15) * 8;
    float v[8]; ld8(Cs, r, c, v);
#pragma unroll
    for (int i = 0; i < 8; ++i) v[i] = f(v[i], c + i);
    *(u32x4*)(dst + (long)r * ld + c) = pack8(v);
  }
}
template <class F>
__device__ __forceinline__ void store_T_bf16(const float* Cs, bf16_t* dst, long cstride, F f) {
#pragma unroll 2
  for (int it = 0; it < 8; ++it) {
    int id = it * 256 + tidx(); int c = id >> 4, r8 = (id & 15) * 8;
    float v[8]; ld8T(Cs, r8, c, v);
#pragma unroll
    for (int i = 0; i < 8; ++i) v[i] = f(v[i]);
    *(u32x4*)(dst + (long)c * cstride + r8) = pack8(v);
  }
}


__device__ __forceinline__ int lds_byte32(int r, int c) { int rr = r & 15; return (r >> 4) * 1024 + rr * 64 + ((((c >> 3) ^ ((-(rr >> 2)) & 3)) & 3) << 4); }
__device__ __forceinline__ void stage_rc32(int b, int& R, int& C) { int st = b >> 10, sb = b & 1023, rr = sb >> 6, cp = (sb >> 4) & 3; R = st * 16 + rr; C = ((cp ^ ((-(rr >> 2)) & 3)) & 3) * 8; }
struct RowClamp {
  const bf16_t* base; long ld; int maxr;
  __device__ __forceinline__ const bf16_t* operator()(int r) const { return base + (long)(r < maxr ? r : maxr) * ld; }
};
__device__ __forceinline__ int lds_byte64(int r, int c) { int rr = r & 15; return (r >> 4) * 2048 + rr * 128 + ((((c >> 3) ^ (rr >> 1)) & 7) << 4); }
__device__ __forceinline__ void stage_rc64(int b, int& R, int& C) { int st = b >> 11, sb = b & 2047, rr = sb >> 7, cp = (sb >> 4) & 7; R = st * 16 + rr; C = ((cp ^ (rr >> 1)) & 7) * 8; }
template <class ARow, class BRow, class Epi>
__device__ __forceinline__ void gemm_tile2(char* smem, ARow arow, BRow brow, int nkt, Epi epi) {
  const int tid = tidx(), lane = tid & 63, wave = tid >> 6, wr = wave >> 1, wc = wave & 1, fr = lane & 15, fq = lane >> 4;
  const bf16_t* pa[4]; const bf16_t* pb[8];
#pragma unroll
  for (int i = 0; i < 4; ++i) { int R, C; stage_rc64(tid * 16 + i * 4096, R, C); pa[i] = arow(R) + C; }
#pragma unroll
  for (int i = 0; i < 8; ++i) { int R, C; stage_rc64(tid * 16 + i * 4096, R, C); pb[i] = brow(R) + C; }
  f32x4 acc[4][8];
#pragma unroll
  for (int m = 0; m < 4; ++m)
#pragma unroll
    for (int n = 0; n < 8; ++n) acc[m][n] = (f32x4){0.f, 0.f, 0.f, 0.f};
  for (int kt = 0; kt < nkt; ++kt) {
    __syncthreads();
#pragma unroll
    for (int i = 0; i < 4; ++i) __builtin_amdgcn_global_load_lds((const unsigned*)(pa[i] + (long)kt * 64), (unsigned*)(smem + tid * 16 + i * 4096), 16, 0, 0);
#pragma unroll
    for (int i = 0; i < 8; ++i) __builtin_amdgcn_global_load_lds((const unsigned*)(pb[i] + (long)kt * 64), (unsigned*)(smem + 16384 + tid * 16 + i * 4096), 16, 0, 0);
    asm volatile("s_waitcnt vmcnt(0)" ::: "memory");
    __syncthreads();
    {
      const char* pA = smem + lds_byte64(wr * 64 + fr, fq * 8);
      const char* pB = smem + 16384 + lds_byte64(wc * 128 + fr, fq * 8);
      const int k1 = lds_byte64(fr, 32 + fq * 8) - lds_byte64(fr, fq * 8);
      bf16x8 a[4], bl[4], bh[4];
#define SB __builtin_amdgcn_sched_barrier(0)
#define LDA(K) _Pragma("unroll") for (int m = 0; m < 4; ++m) a[m] = *(const bf16x8*)(pA + m * 2048 + (K))
#define LDBL(K) _Pragma("unroll") for (int n = 0; n < 4; ++n) bl[n] = *(const bf16x8*)(pB + n * 2048 + (K))
#define LDBH(K) _Pragma("unroll") for (int n = 0; n < 4; ++n) bh[n] = *(const bf16x8*)(pB + (n + 4) * 2048 + (K))
#define MML _Pragma("unroll") for (int m = 0; m < 4; ++m) _Pragma("unroll") for (int n = 0; n < 4; ++n) acc[m][n] = __builtin_amdgcn_mfma_f32_16x16x32_bf16(a[m], bl[n], acc[m][n], 0, 0, 0)
#define MMH _Pragma("unroll") for (int m = 0; m < 4; ++m) _Pragma("unroll") for (int n = 0; n < 4; ++n) acc[m][n + 4] = __builtin_amdgcn_mfma_f32_16x16x32_bf16(a[m], bh[n], acc[m][n + 4], 0, 0, 0)
      LDA(0); LDBL(0); SB;
      LDBH(0); SB;
      MML; SB;
      LDBL(k1); SB;
      MMH; SB;
      LDA(k1); SB;
      LDBH(k1); SB;
      MML; SB;
      MMH; SB;
#undef SB
#undef LDA
#undef LDBL
#undef LDBH
#undef MML
#undef MMH
    }
  }
  float* Cs = (float*)smem;
#pragma unroll
  for (int p = 0; p < 2; ++p) {
    __syncthreads();
    if (wc == p) {
#pragma unroll
      for (int m = 0; m < 4; ++m)
#pragma unroll
        for (int n = 0; n < 8; ++n)
#pragma unroll
          for (int r = 0; r < 4; ++r) Cs[(wr * 64 + m * 16 + fq * 4 + r) * CS_LD + n * 16 + fr] = acc[m][n][r];
    }
    __syncthreads();
    epi(Cs, p);
  }
  __syncthreads();
}

template <int MODE>
__device__ __forceinline__ void transpose_tile(const float* W, int Nsrc, bf16_t* Wt, int Kd, int k0, int n0, float* lds) {
  const int tid = tidx();
  {
    int tx = tid & 63, ty = tid >> 6; int np = n0 + tx; int sc;
    if (MODE == 0) sc = np < Nsrc ? np : -1;
    else { int x = np & 127, tl = np >> 7; sc = x < 64 ? tl * 64 + x : 2816 + tl * 64 + x - 64; }
#pragma unroll
    for (int kk = ty; kk < 64; kk += 4) lds[kk * 65 + tx] = sc >= 0 ? W[(long)(k0 + kk) * Nsrc + sc] : 0.f;
  }
  __syncthreads();
  {
    int nrow = tid >> 2, kseg = (tid & 3) * 16; float v[8];
#pragma unroll
    for (int i = 0; i < 8; ++i) v[i] = lds[(kseg + i) * 65 + nrow];
    *(u32x4*)(Wt + (long)(n0 + nrow) * Kd + k0 + kseg) = pack8(v);
#pragma unroll
    for (int i = 0; i < 8; ++i) v[i] = lds[(kseg + 8 + i) * 65 + nrow];
    *(u32x4*)(Wt + (long)(n0 + nrow) * Kd + k0 + kseg + 8) = pack8(v);
  }
  __syncthreads();
}

template <bool OUTF, int NR>
__device__ __forceinline__ void rownorm_rows(const float* src, const float* g, void* dst) {
  const int lane = tidx() & 63;
  f32x4 v[NR][4];
#pragma unroll
  for (int r = 0; r < NR; ++r)
#pragma unroll
    for (int i = 0; i < 4; ++i) v[r][i] = *(const f32x4*)(src + (long)r * 1024 + i * 256 + lane * 4);
  f32x4 gg[4];
#pragma unroll
  for (int i = 0; i < 4; ++i) gg[i] = *(const f32x4*)(g + i * 256 + lane * 4);
#pragma unroll
  for (int r = 0; r < NR; ++r) {
    float ss = 0.f;
#pragma unroll
    for (int i = 0; i < 4; ++i) ss += v[r][i][0] * v[r][i][0] + v[r][i][1] * v[r][i][1] + v[r][i][2] * v[r][i][2] + v[r][i][3] * v[r][i][3];
    ss = wave_sum(ss);
    const float rr = rsqrtf(ss * (1.f / 1024.f) + 1e-6f);
#pragma unroll
    for (int i = 0; i < 4; ++i) {
      float o0 = v[r][i][0] * rr * gg[i][0], o1 = v[r][i][1] * rr * gg[i][1], o2 = v[r][i][2] * rr * gg[i][2], o3 = v[r][i][3] * rr * gg[i][3];
      if (OUTF) { *(f32x4*)((float*)dst + (long)r * 1024 + i * 256 + lane * 4) = (f32x4){o0, o1, o2, o3}; }
      else { u32x2 p; p[0] = pack2(o0, o1); p[1] = pack2(o2, o3); *(u32x2*)((bf16_t*)dst + (long)r * 1024 + i * 256 + lane * 4) = p; }
    }
  }
}

__device__ void phase0(const Params& P, char* smem) {
  float* lds = (float*)smem;
  const int tid = tidx();
  const int NJ = 8 + 1024 + 32 + 32 + 4384;
  for (int job = blockIdx.x; job < NJ; job += gridDim.x) {
    int j = job;
    if (j < 8) {
      int n = j * 32 + (tid & 31), sl = tid >> 5; int kv = n >> 7, nn = n & 127;
      const float* pe = kv ? P.pe_v : P.pe_k; const float* w1 = kv ? P.w_cv1 : P.w_ck1;
      float s = 0.f;
      for (int k = sl * 256; k < sl * 256 + 256; ++k) s += pe[k] * w1[(long)k * 128 + nn];
      lds[sl * 32 + (tid & 31)] = s;
      __syncthreads();
      if (tid < 32) { float t = 0.f; for (int q = 0; q < 8; ++q) t += lds[q * 32 + tid]; ((float*)(P.ws + OFF_BIAS1))[j * 32 + tid] = t; }
      __syncthreads();
      continue;
    }
    j -= 8;
    if (j < 1024) { int row = j * 16 + (tid >> 6) * 4; rownorm_rows<false, 4>(P.x + (long)row * 1024, P.norm_mix, (bf16_t*)(P.ws + OFF_A) + (long)row * 1024); continue; }
    j -= 1024;
    if (j < 32) { int row = j * 16 + (tid >> 6) * 4; rownorm_rows<false, 4>(P.mem + (long)row * 1024, P.norm_mkv, (bf16_t*)(P.ws + OFF_MEMN) + (long)row * 1024); continue; }
    j -= 32;
    if (j < 32) {
      int e0 = j * 2048 + tid * 8; float v[8];
#pragma unroll
      for (int i = 0; i < 8; ++i) { int e = e0 + i; int t = (e >> 7) & 127, s = e & 127; v[i] = s <= t ? P.w_sp[e] : 0.f; }
      *(u32x4*)((bf16_t*)(P.ws + OFF_WM) + e0) = pack8(v);
      continue;
    }
    j -= 32;
#define TRJ(KT, NT, W, NSRC, WT, KD, MODE) \
    if (j < (KT) * (NT)) { transpose_tile<MODE>(W, NSRC, (bf16_t*)(P.ws + (WT)), KD, (j % (KT)) * 64, (j / (KT)) * 64, lds); continue; } \
    j -= (KT) * (NT);
    TRJ(16, 88, P.w_gu, 5632, OFF_WGU, 1024, 1)
    TRJ(44, 16, P.w_dn, 1024, OFF_WDN, 2816, 0)
    TRJ(16, 38, P.w_in, 2328, OFF_W1, 1024, 0)
    TRJ(16, 32, P.w_merge, 2048, OFF_W1 + 2432L * 1024 * 2, 1024, 0)
    TRJ(16, 16, P.w_mkv, 1024, OFF_WMKV, 1024, 0)
    TRJ(16, 16, P.w_out, 1024, OFF_WOUT, 1024, 0)
    TRJ(8, 16, P.w_pa, 1024, OFF_WPA, 512, 0)
    TRJ(8, 16, P.w_pb, 1024, OFF_WPB, 512, 0)
    TRJ(16, 8, P.w_mq, 512, OFF_WMQ, 1024, 0)
    TRJ(8, 16, P.w_mo, 1024, OFF_WMO, 512, 0)
    TRJ(32, 2, P.w_ck1, 128, OFF_WCK1, 2048, 0)
    TRJ(32, 2, P.w_cv1, 128, OFF_WCV1, 2048, 0)
#undef TRJ
  }
}

__device__ void phase1(const Params& P, char* smem) {
  char* ws = P.ws;
  const int NG1 = 128 * 18;
  const int xq = blockIdx.x & 7, lq = blockIdx.x >> 3, sq = gridDim.x >> 3;
  for (int t = lq; t < 16 * 18 + 4; t += sq) {
    const int job = t < 16 * 18 ? 0 : NG1 + xq * 4 + (t - 16 * 18);
    if (t < 16 * 18) {
      const int mt = xq * 16 + (t & 15), nt2 = t >> 4; const int brow = mt * 128;
      RowLin ar{(const bf16_t*)(ws + OFF_A) + (long)brow * 1024, 1024};
      RowClamp br{(const bf16_t*)(ws + OFF_W1) + (long)nt2 * 256 * 1024, 1024, 4479 - nt2 * 256};
      gemm_tile2(smem, ar, br, 16, [&](const float* Cs, int p) {
        const int nt = nt2 * 2 + p; if (nt >= 35) return;
        char* C = ws + OFF_C;
        if (nt < 4) {
          store_rows_bf16(Cs, (bf16_t*)(C + C_Q) + (long)brow * 512 + nt * 128, 512, [](float v, int) { return v * (0.125f * LOG2E); });
        } else if (nt == 4 || nt == 5 || nt == 6 || nt == 8) {
          long off = nt == 4 ? C_KC : nt == 5 ? C_VC : nt == 6 ? C_KS : C_KW;
          store_rows_bf16(Cs, (bf16_t*)(C + off) + (long)brow * 128, 128, [](float v, int) { return v; });
        } else if (nt == 7 || nt == 9) {
          long off = nt == 7 ? C_VST : C_VWT; int b = brow >> 13, tl = brow & 8191;
          store_T_bf16(Cs, (bf16_t*)(C + off) + (long)b * 128 * T_ + tl, T_, [](float v) { return v; });
        } else if (nt < 14) {
          store_rows_bf16(Cs, (bf16_t*)(C + C_U) + (long)brow * 512 + (nt - 10) * 128, 512, [](float v, int) { return gelu_tanh(v); });
        } else if (nt < 18) {
          store_T_bf16(Cs, (bf16_t*)(C + C_GVT) + ((long)(brow >> 7) * 512 + (nt - 14) * 128) * 128, 128, [](float v) { return gelu_tanh(v); });
        } else if (nt == 18) {
          float* gates = (float*)(C + C_GATES);
          for (int id = tidx(); id < 128 * 24; id += 256) { int r = id / 24, c = id % 24; gates[(long)(brow + r) * 24 + c] = sigm(Cs[r * CS_LD + c]); }
        } else {
          const float* bm = P.b_merge + (nt - 19) * 128;
          store_rows_bf16(Cs, (bf16_t*)(ws + OFF_B) + (long)brow * 2048 + (nt - 19) * 128, 2048, [bm](float v, int c) { return sigm(v + bm[c]); });
        }
      });
    } else {
      const int j = job - NG1; const int mt = j >> 3, nt = j & 7; const int brow = mt * 128;
      RowLin ar{(const bf16_t*)(ws + OFF_MEMN) + (long)brow * 1024, 1024};
      RowLin br{(const bf16_t*)(ws + OFF_WMKV) + (long)nt * 128 * 1024, 1024};
      gemm_tile(smem, ar, br, 16, 64, 64, [&](const float* Cs) {
        if (nt < 4) store_rows_bf16(Cs, (bf16_t*)(ws + OFF_MK) + (long)brow * 512 + nt * 128, 512, [](float v, int) { return v; });
        else { int b = mt >> 1, n0 = (mt & 1) * 128; store_T_bf16(Cs, (bf16_t*)(ws + OFF_MVT) + ((long)b * 512 + (nt - 4) * 128) * 256 + n0, 256, [](float v) { return v; }); }
      });
    }
  }
}

__device__ void phase2(const Params& P, char* smem) {
  char* ws = P.ws; const int tid = tidx();
  for (int job = blockIdx.x; job < 32 + 128; job += gridDim.x) {
    if (job < 32) {
      const int kv = job >> 4, mt = job & 15, brow = mt * 128;
      RowCmp ar{(const bf16_t*)(ws + OFF_C + (kv ? C_VC : C_KC)), brow};
      RowLin br{(const bf16_t*)(ws + (kv ? OFF_WCV1 : OFF_WCK1)), 2048};
      const float* bias1 = (const float*)(ws + OFF_BIAS1) + kv * 128;
      const float* w2 = kv ? P.w_cv2 : P.w_ck2;
      gemm_tile(smem, ar, br, 32, 128, 64, [&](const float* Csc) {
        float* Cs = (float*)Csc;
        for (int it = 0; it < 64; ++it) { int id = it * 256 + tid; int r = id >> 7, n = id & 127; Cs[r * CS_LD + n] = gelu_tanh(Cs[r * CS_LD + n] + bias1[n]); }
        __syncthreads();
        const int r = tid >> 1, half = tid & 1;
        float acc[32];
#pragma unroll
        for (int i = 0; i < 32; ++i) acc[i] = 0.f;
        for (int n = 0; n < 128; ++n) {
          float h = Cs[r * CS_LD + n]; const float* wr = w2 + n * 64 + half * 32;
#pragma unroll
          for (int q = 0; q < 8; ++q) { f32x4 w = *(const f32x4*)(wr + q * 4); acc[q * 4] += h * w[0]; acc[q * 4 + 1] += h * w[1]; acc[q * 4 + 2] += h * w[2]; acc[q * 4 + 3] += h * w[3]; }
        }
        const int R = brow + r; const int b = R >> 10, rem = R & 1023, i = rem >> 1, g = rem & 1;
        if (i >= 511) {
#pragma unroll
          for (int q = 0; q < 32; ++q) acc[q] = 0.f;
        }
        if (kv == 0) {
          bf16_t* dst = (bf16_t*)(ws + OFF_KCMP) + (long)(b * 512 + i) * 128 + g * 64 + half * 32;
#pragma unroll
          for (int q = 0; q < 4; ++q) { float v[8];
#pragma unroll
            for (int e = 0; e < 8; ++e) v[e] = acc[q * 8 + e];
            *(u32x4*)(dst + q * 8) = pack8(v); }
        } else {
          bf16_t* dst = (bf16_t*)(ws + OFF_VCT) + ((long)(b * 128 + g * 64 + half * 32)) * 512 + i;
#pragma unroll
          for (int q = 0; q < 32; ++q) dst[(long)q * 512] = (bf16_t)f2bf(acc[q]);
        }
      });
    } else {
      const int bc = job - 32; bf16_t* base = (bf16_t*)(ws + OFF_C + C_GVT) + (long)bc * 512 * 128;
      float* ssum = (float*)smem; float* ssq = ssum + 128;
      float* psum = ssum + 256; float* psq = psum + 16 * 128;
      const int cs = tid >> 4, s8 = (tid & 15) * 8;
      float a[8], q[8];
#pragma unroll
      for (int i = 0; i < 8; ++i) { a[i] = 0.f; q[i] = 0.f; }
      for (int it = 0; it < 32; ++it) {
        u32x4 d = *(const u32x4*)(base + (long)(it * 16 + cs) * 128 + s8);
#pragma unroll
        for (int i = 0; i < 4; ++i) { float lo = bf2f(d[i] & 0xffffu), hi = bf2f(d[i] >> 16); a[2 * i] += lo; q[2 * i] += lo * lo; a[2 * i + 1] += hi; q[2 * i + 1] += hi * hi; }
      }
#pragma unroll
      for (int i = 0; i < 8; ++i) { psum[cs * 128 + s8 + i] = a[i]; psq[cs * 128 + s8 + i] = q[i]; }
      __syncthreads();
      if (tid < 128) {
        float su = 0.f, sq = 0.f;
        for (int c = 0; c < 16; ++c) { su += psum[c * 128 + tid]; sq += psq[c * 128 + tid]; }
        float mean_t = su * (1.f / 512.f); float var = sq * (1.f / 512.f) - mean_t * mean_t; if (var < 0.f) var = 0.f;
        ssum[tid] = mean_t; ssq[tid] = rsqrtf(var + 1e-6f);
      }
      __syncthreads();
      float mean[8], rs[8];
#pragma unroll
      for (int i = 0; i < 8; ++i) { mean[i] = ssum[s8 + i]; rs[i] = ssq[s8 + i]; }
      for (int it = 0; it < 32; ++it) {
        int ch = it * 16 + cs; float gg = P.ln_sgu[ch];
        u32x4 d = *(const u32x4*)(base + (long)ch * 128 + s8); float v[8];
#pragma unroll
        for (int i = 0; i < 4; ++i) { v[2 * i] = bf2f(d[i] & 0xffffu); v[2 * i + 1] = bf2f(d[i] >> 16); }
#pragma unroll
        for (int i = 0; i < 8; ++i) v[i] = (v[i] - mean[i]) * rs[i] * gg;
        *(u32x4*)(base + (long)ch * 128 + s8) = pack8(v);
      }
      __syncthreads();
    }
  }
}

template <int MODE>
__device__ __forceinline__ void nsa_block(const bf16x8 (&qf)[4][2], f32x4 (&oacc)[4][4], float (&m)[4], float (&l)[4],
                                          const float (&sl2)[4], const float (&inv)[4], const bf16_t* kp, const bf16_t* vp, long vdt,
                                          int dist0, bool rowok, float (&asum)[2], float (&bsum)[2]) {
  constexpr int DSTEP = (MODE <= 1) ? 16 : 1;
  bf16x8 kf[2][2];
#pragma unroll
  for (int kt = 0; kt < 2; ++kt)
#pragma unroll
    for (int ks = 0; ks < 2; ++ks) kf[kt][ks] = *(const bf16x8*)(kp + kt * 16 * 128 + ks * 32);
  bf16x8 vf[4];
  if (MODE != 0) {
#pragma unroll
    for (int dt = 0; dt < 4; ++dt) {
      u32x2 lo = *(const u32x2*)(vp + dt * vdt); u32x2 hi = *(const u32x2*)(vp + dt * vdt + 16);
      u32x4 c; c[0] = lo[0]; c[1] = lo[1]; c[2] = hi[0]; c[3] = hi[1];
      vf[dt] = __builtin_bit_cast(bf16x8, c);
    }
  }
  const float fd0 = (float)dist0;
#pragma unroll
  for (int h = 0; h < 4; ++h) {
    f32x4 s[2];
#pragma unroll
    for (int kt = 0; kt < 2; ++kt) {
      s[kt] = __builtin_amdgcn_mfma_f32_16x16x32_bf16(kf[kt][0], qf[h][0], (f32x4){0.f, 0.f, 0.f, 0.f}, 0, 0, 0);
      s[kt] = __builtin_amdgcn_mfma_f32_16x16x32_bf16(kf[kt][1], qf[h][1], s[kt], 0, 0, 0);
    }
    float sc[8]; bool ok[8];
#pragma unroll
    for (int kt = 0; kt < 2; ++kt)
#pragma unroll
      for (int r = 0; r < 4; ++r) {
        const int e = kt * 16 + r; const int dist = dist0 - DSTEP * e;
        sc[kt * 4 + r] = s[kt][r] - sl2[h] * (fd0 - (float)(DSTEP * e));
        bool o = dist >= 0;
        if (MODE == 2) o = o && rowok;
        if (MODE == 3) o = o && (dist < 512);
        ok[kt * 4 + r] = o;
      }
    float p[8];
    if (MODE != 1) {
      float ml = NEGF;
#pragma unroll
      for (int i = 0; i < 8; ++i) ml = fmaxf(ml, ok[i] ? sc[i] : NEGF);
      ml = fmaxf(ml, __shfl_xor(ml, 16, 64)); ml = fmaxf(ml, __shfl_xor(ml, 32, 64));
      const float mn = fmaxf(m[h], ml); const float alpha = __builtin_amdgcn_exp2f(m[h] - mn); m[h] = mn;
      float ps = 0.f;
#pragma unroll
      for (int i = 0; i < 8; ++i) { p[i] = ok[i] ? __builtin_amdgcn_exp2f(sc[i] - mn) : 0.f; ps += p[i]; }
      l[h] = l[h] * alpha + ps;
      if (MODE != 0) {
        if (__builtin_amdgcn_ballot_w64(alpha != 1.f) != 0ull) {
#pragma unroll
          for (int dt = 0; dt < 4; ++dt) oacc[h][dt] *= alpha;
        }
      }
    } else {
#pragma unroll
      for (int i = 0; i < 8; ++i) p[i] = ok[i] ? __builtin_amdgcn_exp2f(sc[i] - m[h]) * l[h] : 0.f;
      asum[0] += (p[0] + p[1]) + (p[2] + p[3]); bsum[0] += p[3];
      asum[1] += (p[4] + p[5]) + (p[6] + p[7]); bsum[1] += p[7];
    }
    if (MODE != 0) {
      u32x4 pk; pk[0] = pack2(p[0], p[1]); pk[1] = pack2(p[2], p[3]); pk[2] = pack2(p[4], p[5]); pk[3] = pack2(p[6], p[7]);
      const bf16x8 pf = __builtin_bit_cast(bf16x8, pk);
#pragma unroll
      for (int dt = 0; dt < 4; ++dt) oacc[h][dt] = __builtin_amdgcn_mfma_f32_16x16x32_bf16(vf[dt], pf, oacc[h][dt], 0, 0, 0);
    }
    __builtin_amdgcn_sched_barrier(0);
  }
}

__device__ void nsa_tile(const Params& P, int wt, char* wl) {
  char* C = P.ws + OFF_C;
  const bf16_t* Q = (const bf16_t*)(C + C_Q);
  const bf16_t* KCMP = (const bf16_t*)(P.ws + OFF_KCMP); const bf16_t* VCT = (const bf16_t*)(P.ws + OFF_VCT);
  const bf16_t* KS = (const bf16_t*)(C + C_KS); const bf16_t* VST = (const bf16_t*)(C + C_VST);
  const bf16_t* KW = (const bf16_t*)(C + C_KW); const bf16_t* VWT = (const bf16_t*)(C + C_VWT);
  const float* GATES = (const float*)(C + C_GATES);
  bf16_t* O = (bf16_t*)(P.ws + OFF_D);
  const int lane = tidx() & 63, qi = lane & 15, quad = lane >> 4;
  wt = __builtin_amdgcn_readfirstlane(wt);
  const int jb = wt >> 2, wv4 = wt & 3;
  const int bg = jb & 3, b = bg >> 1, g = bg & 1;
  const int gq = jb >> 2;
  const int tq = (gq < 64 ? 127 - gq : gq - 64) * 4 + wv4;
  const int t0 = tq * 16;
  const int t = t0 + qi;
  const long row = (long)b * T_ + t;
  bf16x8 qf[4][2];
#pragma unroll
  for (int h = 0; h < 4; ++h)
#pragma unroll
    for (int ks = 0; ks < 2; ++ks) qf[h][ks] = *(const bf16x8*)(Q + row * 512 + (g * 4 + h) * 64 + ks * 32 + quad * 8);
  float sl2[4];
#pragma unroll
  for (int h = 0; h < 4; ++h) sl2[h] = __builtin_amdgcn_exp2f(-(float)(g * 4 + h + 1)) * LOG2E;
  f32x4 oacc[4][4]; float m[4], l[4], inv[4]; float asum[2], bsum[2];
  float* imp = (float*)wl; float* outl = (float*)wl;
  unsigned* sel = (unsigned*)(wl + 16384); unsigned* uni = sel + 64;
#pragma unroll
  for (int h = 0; h < 4; ++h) { m[h] = NEGF; l[h] = 0.f; inv[h] = 0.f; }
  asum[0] = asum[1] = bsum[0] = bsum[1] = 0.f;

  const int nI = t0 >> 4; const int nblk = (nI + 31) >> 5;
  for (int blk = nblk - 1; blk >= 0; --blk) {
    const int key0 = blk * 32;
    const bf16_t* kp = KCMP + (long)(b * 512 + key0 + qi) * 128 + g * 64 + quad * 8;
    nsa_block<0>(qf, oacc, m, l, sl2, inv, kp, nullptr, 0, t - 31 - 16 * (key0 + quad * 4), true, asum, bsum);
  }
#pragma unroll
  for (int h = 0; h < 4; ++h) { float lt = l[h]; lt += __shfl_xor(lt, 16, 64); lt += __shfl_xor(lt, 32, 64); l[h] = 1.f / fmaxf(lt, 1e-30f); }
  for (int i = lane; i < 16 * 132; i += 64) imp[i] = 0.f;
#pragma unroll
  for (int h = 0; h < 4; ++h)
#pragma unroll
    for (int dt = 0; dt < 4; ++dt) oacc[h][dt] = (f32x4){0.f, 0.f, 0.f, 0.f};
  for (int blk = 0; blk < nblk; ++blk) {
    const int key0 = blk * 32;
    const bf16_t* kp = KCMP + (long)(b * 512 + key0 + qi) * 128 + g * 64 + quad * 8;
    const bf16_t* vp = VCT + (long)(b * 128 + g * 64 + qi) * 512 + key0 + quad * 4;
    asum[0] = asum[1] = bsum[0] = bsum[1] = 0.f;
    nsa_block<1>(qf, oacc, m, l, sl2, inv, kp, vp, 16 * 512, t - 31 - 16 * (key0 + quad * 4), true, asum, bsum);
    const int J = (key0 >> 2) + quad;
    atomicAdd(&imp[qi * 132 + J], asum[0]); atomicAdd(&imp[qi * 132 + J + 1], bsum[0]);
    atomicAdd(&imp[qi * 132 + J + 4], asum[1]); atomicAdd(&imp[qi * 132 + J + 5], bsum[1]);
  }
  const int cur = t0 >> 6;
  if (lane < 16) {
    unsigned w0 = 0, w1 = 0, w2 = 0, w3 = 0;
    if (cur < 16) { w0 = (1u << (cur + 1)) - 1u; }
    else {
      w0 = 1u;
      { int j = cur; unsigned bit = 1u << (j & 31); int w = j >> 5; if (w == 0) w0 |= bit; else if (w == 1) w1 |= bit; else if (w == 2) w2 |= bit; else w3 |= bit; }
      { int j = cur - 1; unsigned bit = 1u << (j & 31); int w = j >> 5; if (w == 0) w0 |= bit; else if (w == 1) w1 |= bit; else if (w == 2) w2 |= bit; else w3 |= bit; }
    }
    sel[lane * 4 + 0] = w0; sel[lane * 4 + 1] = w1; sel[lane * 4 + 2] = w2; sel[lane * 4 + 3] = w3;
  }
  if (lane < 4) uni[lane] = 0u;
  if (cur >= 16) {
    for (int rnd = 0; rnd < 4; ++rnd) {
      const int qq = rnd * 4 + quad;
      unsigned key[8];
#pragma unroll
      for (int c = 0; c < 8; ++c) {
        const int j = qi + 16 * c;
        const bool v = (j <= cur) && (j != 0) && (j != cur) && (j != cur - 1);
        const unsigned bits = __float_as_uint(imp[qq * 132 + j]);
        key[c] = v ? ((bits & 0xFFFFFF00u) | (unsigned)(128 - j)) : 0u;
      }
      for (int it = 0; it < 13; ++it) {
        unsigned mx = key[0];
#pragma unroll
        for (int c = 1; c < 8; ++c) mx = key[c] > mx ? key[c] : mx;
#pragma unroll
        for (int o = 1; o < 16; o <<= 1) { unsigned ot = (unsigned)__shfl_xor((int)mx, o, 64); mx = ot > mx ? ot : mx; }
        if (mx != 0u) {
#pragma unroll
          for (int c = 0; c < 8; ++c) {
            if (key[c] == mx) { key[c] = 0u; const int j = qi + 16 * c; atomicOr(&sel[qq * 4 + (j >> 5)], 1u << (j & 31)); }
          }
        }
      }
    }
  }
  unsigned mym[4];
#pragma unroll
  for (int w = 0; w < 4; ++w) mym[w] = sel[qi * 4 + w];
  if (lane < 16) {
#pragma unroll
    for (int w = 0; w < 4; ++w) atomicOr(&uni[w], mym[w]);
  }
  const float* gp = GATES + row * 24 + g * 12;
#pragma unroll
  for (int h = 0; h < 4; ++h) {
    const float gt = gp[h * 3 + 0] * NSA_G0;
#pragma unroll
    for (int dt = 0; dt < 4; ++dt) *(f32x4*)(outl + ((h * 16 + qi) * 64 + (((dt * 4 + quad) ^ qi) << 2))) = oacc[h][dt] * gt;
  }
#pragma unroll
  for (int h = 0; h < 4; ++h) { m[h] = NEGF; l[h] = 0.f;
#pragma unroll
    for (int dt = 0; dt < 4; ++dt) oacc[h][dt] = (f32x4){0.f, 0.f, 0.f, 0.f}; }
#pragma unroll 1
  for (int w = 3; w >= 0; --w) {
    unsigned bits = __builtin_amdgcn_readfirstlane(uni[w]);
    const unsigned myw = sel[qi * 4 + w];
    while (bits) {
      const int jj = 31 - __builtin_clz(bits); bits &= ~(1u << jj);
      const int j = w * 32 + jj; const bool rowok = (myw >> jj) & 1u;
#pragma unroll 1
      for (int half = 1; half >= 0; --half) {
        const int key0 = j * 64 + half * 32;
        const bf16_t* kp = KS + (long)(b * T_ + key0 + qi) * 128 + g * 64 + quad * 8;
        const bf16_t* vp = VST + (long)(b * 128 + g * 64 + qi) * T_ + key0 + quad * 4;
        nsa_block<2>(qf, oacc, m, l, sl2, inv, kp, vp, 16L * T_, t - (key0 + quad * 4), rowok, asum, bsum);
      }
    }
  }
#pragma unroll
  for (int h = 0; h < 4; ++h) {
    float lt = l[h]; lt += __shfl_xor(lt, 16, 64); lt += __shfl_xor(lt, 32, 64);
    const float sc = NSA_G1 * gp[h * 3 + 1] / fmaxf(lt, 1e-30f);
#pragma unroll
    for (int dt = 0; dt < 4; ++dt) { f32x4* d = (f32x4*)(outl + ((h * 16 + qi) * 64 + (((dt * 4 + quad) ^ qi) << 2))); *d = *d + oacc[h][dt] * sc; }
  }
#pragma unroll
  for (int h = 0; h < 4; ++h) { m[h] = NEGF; l[h] = 0.f;
#pragma unroll
    for (int dt = 0; dt < 4; ++dt) oacc[h][dt] = (f32x4){0.f, 0.f, 0.f, 0.f}; }
  {
    const int kstart = t0 >= 512 ? ((t0 - 511) & ~31) : 0;
    for (int key0 = (t0 + 15) & ~31; key0 >= kstart; key0 -= 32) {
      const bf16_t* kp = KW + (long)(b * T_ + key0 + qi) * 128 + g * 64 + quad * 8;
      const bf16_t* vp = VWT + (long)(b * 128 + g * 64 + qi) * T_ + key0 + quad * 4;
      nsa_block<3>(qf, oacc, m, l, sl2, inv, kp, vp, 16L * T_, t - (key0 + quad * 4), true, asum, bsum);
    }
  }
#pragma unroll
  for (int h = 0; h < 4; ++h) {
    float lt = l[h]; lt += __shfl_xor(lt, 16, 64); lt += __shfl_xor(lt, 32, 64);
    const float sc = NSA_G2 * gp[h * 3 + 2] / fmaxf(lt, 1e-30f);
#pragma unroll
    for (int dt = 0; dt < 4; ++dt) { f32x4* d = (f32x4*)(outl + ((h * 16 + qi) * 64 + (((dt * 4 + quad) ^ qi) << 2))); *d = *d + oacc[h][dt] * sc; }
  }
#pragma unroll
  for (int it = 0; it < 8; ++it) {
    const int id = it * 64 + lane; const int h = id >> 7, rem = id & 127, q2 = rem >> 3, c8 = rem & 7;
    f32x4 a = *(const f32x4*)(outl + ((h * 16 + q2) * 64 + (((2 * c8) ^ q2) << 2)));
    f32x4 bb = *(const f32x4*)(outl + ((h * 16 + q2) * 64 + (((2 * c8 + 1) ^ q2) << 2)));
    float v[8] = {a[0], a[1], a[2], a[3], bb[0], bb[1], bb[2], bb[3]};
    *(u32x4*)(O + ((long)b * T_ + t0 + q2) * 512 + (g * 4 + h) * 64 + c8 * 8) = pack8(v);
  }
}

__device__ void xattn_tile(const Params& P, int wt) {
  const bf16_t* HQ = (const bf16_t*)(P.ws + OFF_D);
  const bf16_t* MK = (const bf16_t*)(P.ws + OFF_MK); const bf16_t* MVT = (const bf16_t*)(P.ws + OFF_MVT);
  bf16_t* OX = (bf16_t*)(P.ws + OFF_D) + (long)M_ * 512;
  const int lane = tidx() & 63, qi = lane & 15, quad = lane >> 4;
  wt = __builtin_amdgcn_readfirstlane(wt);
  const int h = wt & 3; const int row0 = (wt >> 2) * 32; const int b = row0 >> 13;
  bf16x8 qf[2][4];
#pragma unroll
  for (int nt = 0; nt < 2; ++nt)
#pragma unroll
    for (int ks = 0; ks < 4; ++ks) qf[nt][ks] = *(const bf16x8*)(HQ + (long)(row0 + nt * 16 + qi) * 512 + h * 128 + ks * 32 + quad * 8);
  f32x4 oacc[2][8]; float m[2], l[2];
#pragma unroll
  for (int nt = 0; nt < 2; ++nt) { m[nt] = NEGF; l[nt] = 0.f;
#pragma unroll
    for (int dt = 0; dt < 8; ++dt) oacc[nt][dt] = (f32x4){0.f, 0.f, 0.f, 0.f}; }
  for (int blk = 0; blk < 8; ++blk) {
    const int key0 = blk * 32;
    f32x4 s[2][2];
#pragma unroll
    for (int nt = 0; nt < 2; ++nt)
#pragma unroll
      for (int kt = 0; kt < 2; ++kt) s[nt][kt] = (f32x4){0.f, 0.f, 0.f, 0.f};
#pragma unroll
    for (int ks = 0; ks < 4; ++ks) {
#pragma unroll
      for (int kt = 0; kt < 2; ++kt) {
        bf16x8 kf = *(const bf16x8*)(MK + (long)(b * 256 + key0 + kt * 16 + qi) * 512 + h * 128 + ks * 32 + quad * 8);
#pragma unroll
        for (int nt = 0; nt < 2; ++nt) s[nt][kt] = __builtin_amdgcn_mfma_f32_16x16x32_bf16(kf, qf[nt][ks], s[nt][kt], 0, 0, 0);
      }
    }
    bf16x8 pf[2];
#pragma unroll
    for (int nt = 0; nt < 2; ++nt) {
      float ml = NEGF;
#pragma unroll
      for (int kt = 0; kt < 2; ++kt)
#pragma unroll
        for (int r = 0; r < 4; ++r) ml = fmaxf(ml, s[nt][kt][r]);
      ml = fmaxf(ml, __shfl_xor(ml, 16, 64)); ml = fmaxf(ml, __shfl_xor(ml, 32, 64));
      const float mn = fmaxf(m[nt], ml); const float alpha = __builtin_amdgcn_exp2f(m[nt] - mn); m[nt] = mn;
      float p[8]; float ps = 0.f;
#pragma unroll
      for (int kt = 0; kt < 2; ++kt)
#pragma unroll
        for (int r = 0; r < 4; ++r) { p[kt * 4 + r] = __builtin_amdgcn_exp2f(s[nt][kt][r] - mn); ps += p[kt * 4 + r]; }
      l[nt] = l[nt] * alpha + ps;
#pragma unroll
      for (int dt = 0; dt < 8; ++dt) oacc[nt][dt] *= alpha;
      u32x4 pk; pk[0] = pack2(p[0], p[1]); pk[1] = pack2(p[2], p[3]); pk[2] = pack2(p[4], p[5]); pk[3] = pack2(p[6], p[7]);
      pf[nt] = __builtin_bit_cast(bf16x8, pk);
    }
#pragma unroll
    for (int dt = 0; dt < 8; ++dt) {
      const bf16_t* vp = MVT + (long)(b * 512 + h * 128 + dt * 16 + qi) * 256 + key0 + quad * 4;
      u32x2 lo = *(const u32x2*)(vp); u32x2 hi = *(const u32x2*)(vp + 16);
      u32x4 c; c[0] = lo[0]; c[1] = lo[1]; c[2] = hi[0]; c[3] = hi[1];
      const bf16x8 vf = __builtin_bit_cast(bf16x8, c);
#pragma unroll
      for (int nt = 0; nt < 2; ++nt) oacc[nt][dt] = __builtin_amdgcn_mfma_f32_16x16x32_bf16(vf, pf[nt], oacc[nt][dt], 0, 0, 0);
    }
  }
#pragma unroll
  for (int nt = 0; nt < 2; ++nt) {
    float lt = l[nt]; lt += __shfl_xor(lt, 16, 64); lt += __shfl_xor(lt, 32, 64);
    const float iv = 1.f / lt;
#pragma unroll
    for (int dt = 0; dt < 8; ++dt) {
      f32x4 v = oacc[nt][dt] * iv; u32x2 pk; pk[0] = pack2(v[0], v[1]); pk[1] = pack2(v[2], v[3]);
      *(u32x2*)(OX + (long)(row0 + nt * 16 + qi) * 512 + h * 128 + dt * 16 + quad * 4) = pk;
    }
  }
}


#define XB_TMO      128
#define XB_XCNT(j)  (256  + 64 * (j))
#define XB_XSUB(j)  (1280 + 64 * (j))
#define XB_XGEN(j)  (2304 + 64 * (j))
#define XB_TOP      3328
#define XB_TOPGEN   3392
#define XCD_BAR_WORDS 3456
#define XB_SPIN_CAP (1u << 18)
#define LAS __attribute__((address_space(3)))
__device__ __forceinline__ unsigned xb_ld(unsigned* p) { return __hip_atomic_load(p, __ATOMIC_RELAXED, __HIP_MEMORY_SCOPE_AGENT); }
__device__ __forceinline__ unsigned xb_add(unsigned* p, unsigned v) { return __hip_atomic_fetch_add(p, v, __ATOMIC_RELAXED, __HIP_MEMORY_SCOPE_AGENT); }
__device__ __forceinline__ unsigned xb_xcc_id() { return (unsigned)__builtin_amdgcn_s_getreg((3 << 11) | 20) & 0xFu; }
#define XB_SPIN(cond, bar) do { unsigned _sp = 0; while (cond) { __builtin_amdgcn_s_sleep(1); \
    if ((++_sp & 255u) == 0u) { if (xb_ld(&(bar)[XB_TMO])) break; if (_sp > XB_SPIN_CAP) { atomicAdd(&(bar)[XB_TMO], 1u); break; } } } } while (0)
__device__ __forceinline__ void xcd_barrier_complete(unsigned* bar, unsigned x, unsigned& nloc, unsigned& nx) {
  const unsigned G = gridDim.x * gridDim.y * gridDim.z;
  unsigned sum, cnt, mine, sp = 0u;
  for (;;) {
    sum = 0u; cnt = 0u; mine = 0u;
#pragma unroll
    for (unsigned j = 0; j < 16; ++j) { const unsigned c = xb_ld(&bar[XB_XCNT(j)]); sum += c; cnt += (c > 0u) ? 1u : 0u; mine = (j == x) ? c : mine; }
    if (sum == G) break;
    __builtin_amdgcn_s_sleep(1);
    if ((++sp & 255u) == 0u) { if (xb_ld(&bar[XB_TMO])) break; if (sp > XB_SPIN_CAP) { atomicAdd(&bar[XB_TMO], 1u); break; } }
  }
  nloc = mine > 0u ? mine : 1u; nx = cnt > 0u ? cnt : 1u;
}
__device__ __forceinline__ void xcd_barrier(unsigned* bar, unsigned x, volatile LAS unsigned* st) {
  asm volatile("s_waitcnt vmcnt(0)" ::: "memory");
  __syncthreads();
  if (threadIdx.x == 0) {
    __builtin_amdgcn_s_waitcnt(0);
    unsigned nloc = st[0], nx = st[1];
    if (nloc == 0u) { xcd_barrier_complete(bar, x, nloc, nx); st[0] = nloc; st[1] = nx; }
    const unsigned old = xb_add(&bar[XB_XSUB(x)], 1u);
    const unsigned gen = old / nloc;
    if (old + 1u == (gen + 1u) * nloc) {
      __builtin_amdgcn_fence(__ATOMIC_RELEASE, "agent");
      asm volatile("s_waitcnt vmcnt(0)" ::: "memory");
      const unsigned og = xb_add(&bar[XB_TOP], 1u);
      const unsigned tg = og / nx;
      if (og + 1u == (tg + 1u) * nx) xb_add(&bar[XB_TOPGEN], 1u);
      else XB_SPIN(xb_ld(&bar[XB_TOPGEN]) == tg, bar);
      __builtin_amdgcn_fence(__ATOMIC_ACQUIRE, "agent");
      xb_add(&bar[XB_XGEN(x)], 1u);
      asm volatile("s_waitcnt vmcnt(0)" ::: "memory");
    } else {
      XB_SPIN(xb_ld(&bar[XB_XGEN(x)]) == gen, bar);
      __builtin_amdgcn_fence(__ATOMIC_ACQUIRE, "agent");
      asm volatile("s_waitcnt vmcnt(0)" ::: "memory");
    }
  }
  __syncthreads();
}

__device__ void run_phase(const Params& P, int ph, char* smem) {
  char* ws = P.ws; const int tid = tidx();
  switch (ph) {
    case 0: phase0(P, smem); break;
    case 1: phase1(P, smem); break;
    case 2: phase2(P, smem); break;
    case 3: {
      for (int job = blockIdx.x; job < 512; job += gridDim.x) { const int wv = tidx() >> 6; nsa_tile(P, job * 4 + wv, smem + wv * 16896); }
      __syncthreads();
      for (int job = blockIdx.x; job < 512; job += gridDim.x) {
        {
          const int tid = tidx();
          const int s = job; const int bc = s >> 2, g = s & 3;
          RowLin ar{(const bf16_t*)(ws + OFF_WM) + g * 16384, 128};
          RowLin br{(const bf16_t*)(ws + OFF_C + C_GVT) + ((long)bc * 512 + g * 128) * 128, 128};
          const float* bs = P.b_sp + g * 128;
          const bf16_t* U = (const bf16_t*)(ws + OFF_C + C_U) + (long)bc * 128 * 512 + g * 128;
          bf16_t* OS = (bf16_t*)(ws + OFF_D) + (long)M_ * 512 + (long)bc * 128 * 512 + g * 128;
          gemm_tile(smem, ar, br, 2, 64, 64, [&](const float* Cs) {
#pragma unroll 2
            for (int it = 0; it < 8; ++it) {
              int id = it * 256 + tid; int r = id >> 4, c = (id & 15) * 8; float v[8]; ld8(Cs, r, c, v);
              u32x4 d = *(const u32x4*)(U + (long)r * 512 + c); const float bb = bs[r];
#pragma unroll
              for (int i = 0; i < 4; ++i) { v[2 * i] = (v[2 * i] + bb) * bf2f(d[i] & 0xffffu); v[2 * i + 1] = (v[2 * i + 1] + bb) * bf2f(d[i] >> 16); }
              *(u32x4*)(OS + (long)r * 512 + c) = pack8(v);
            }
          });
        }
      }
    } break;
    case 4: {
      float* scr = (float*)(ws + OFF_C + C_SCR) + (long)blockIdx.x * 16384;
      const int xq = blockIdx.x & 7, lq = blockIdx.x >> 3, sq = gridDim.x >> 3;
      for (int t = lq; t < 16 * 8; t += sq) {
        const int mt = xq * 16 + (t & 15), nt = t >> 4, brow = mt * 128, bcol = nt * 128;
        const bf16_t* MG = (const bf16_t*)(ws + OFF_B) + (long)brow * 2048 + bcol;
        RowLin a1{(const bf16_t*)(ws + OFF_D) + (long)brow * 512, 512};
        RowLin b1{(const bf16_t*)(ws + OFF_WPA) + (long)bcol * 512, 512};
        gemm_tile(smem, a1, b1, 8, 64, 64, [&](const float* Cs) {
#pragma unroll 2
          for (int it = 0; it < 8; ++it) {
            int id = it * 256 + tid; int r = id >> 4, c = (id & 15) * 8; float v[8]; ld8(Cs, r, c, v);
            u32x4 d = *(const u32x4*)(MG + (long)r * 2048 + c);
#pragma unroll
            for (int i = 0; i < 4; ++i) { v[2 * i] *= bf2f(d[i] & 0xffffu); v[2 * i + 1] *= bf2f(d[i] >> 16); }
            *(f32x4*)(scr + id * 8) = (f32x4){v[0], v[1], v[2], v[3]}; *(f32x4*)(scr + id * 8 + 4) = (f32x4){v[4], v[5], v[6], v[7]};
          }
        });
        RowLin a2{(const bf16_t*)(ws + OFF_D) + (long)M_ * 512 + (long)brow * 512, 512};
        RowLin b2{(const bf16_t*)(ws + OFF_WPB) + (long)bcol * 512, 512};
        bf16_t* MX = (bf16_t*)(ws + OFF_C + C_MIXED) + (long)brow * 1024 + bcol;
        gemm_tile(smem, a2, b2, 8, 64, 64, [&](const float* Cs) {
#pragma unroll 2
          for (int it = 0; it < 8; ++it) {
            int id = it * 256 + tid; int r = id >> 4, c = (id & 15) * 8; float v[8]; ld8(Cs, r, c, v);
            u32x4 d = *(const u32x4*)(MG + (long)r * 2048 + 1024 + c);
            f32x4 p0 = *(const f32x4*)(scr + id * 8), p1 = *(const f32x4*)(scr + id * 8 + 4);
            float pv[8] = {p0[0], p0[1], p0[2], p0[3], p1[0], p1[1], p1[2], p1[3]};
#pragma unroll
            for (int i = 0; i < 4; ++i) { v[2 * i] = pv[2 * i] + v[2 * i] * bf2f(d[i] & 0xffffu); v[2 * i + 1] = pv[2 * i + 1] + v[2 * i + 1] * bf2f(d[i] >> 16); }
            *(u32x4*)(MX + (long)r * 1024 + c) = pack8(v);
          }
        });
      }
    } break;
    case 5: case 9: case 12: {
      const bf16_t* A; const bf16_t* W; const float* RES; float* DST; int K;
      if (ph == 5) { A = (const bf16_t*)(ws + OFF_C + C_MIXED); W = (const bf16_t*)(ws + OFF_WOUT); RES = P.x; DST = (float*)(ws + OFF_B); K = 1024; }
      else if (ph == 9) { A = (const bf16_t*)(ws + OFF_D) + (long)M_ * 512; W = (const bf16_t*)(ws + OFF_WMO); RES = (const float*)(ws + OFF_B); DST = (float*)(ws + OFF_C + C_H2); K = 512; }
      else { A = (const bf16_t*)(ws + OFF_B); W = (const bf16_t*)(ws + OFF_WDN); RES = (const float*)(ws + OFF_C + C_H2); DST = P.out; K = 2816; }
      const int xq = blockIdx.x & 7, lq = blockIdx.x >> 3, sq = gridDim.x >> 3;
      for (int t = lq; t < 16 * 4; t += sq) {
        const int mt = xq * 16 + (t & 15), nt2 = t >> 4, brow = mt * 128;
        RowLin ar{A + (long)brow * K, K}; RowLin br{W + (long)nt2 * 256 * K, K};
        gemm_tile2(smem, ar, br, K / 64, [&](const float* Cs, int p) {
          const int bcol = nt2 * 256 + p * 128;
          const float* rs = RES + (long)brow * 1024 + bcol; float* ds = DST + (long)brow * 1024 + bcol;
#pragma unroll 4
          for (int it = 0; it < 8; ++it) {
            int id = it * 256 + tid; int r = id >> 4, c = (id & 15) * 8;
            f32x4 a = *(const f32x4*)(Cs + r * CS_LD + c), bq = *(const f32x4*)(Cs + r * CS_LD + c + 4);
            f32x4 r0 = *(const f32x4*)(rs + (long)r * 1024 + c), r1 = *(const f32x4*)(rs + (long)r * 1024 + c + 4);
            const f32x4 h0 = a + r0, h1v = bq + r1;
            *(f32x4*)(ds + (long)r * 1024 + c) = h0; *(f32x4*)(ds + (long)r * 1024 + c + 4) = h1v;
            if (ph != 12) {
              const float* gn = (ph == 5 ? P.norm_mq : P.norm_ffn) + bcol + c;
              const f32x4 g0 = *(const f32x4*)gn, g1 = *(const f32x4*)(gn + 4);
              float v[8] = {h0[0] * g0[0], h0[1] * g0[1], h0[2] * g0[2], h0[3] * g0[3], h1v[0] * g1[0], h1v[1] * g1[1], h1v[2] * g1[2], h1v[3] * g1[3]};
              *(u32x4*)((bf16_t*)(ws + OFF_A) + (long)(brow + r) * 1024 + bcol + c) = pack8(v);
              float ss = (h0[0] * h0[0] + h0[1] * h0[1]) + (h0[2] * h0[2] + h0[3] * h0[3]) + (h1v[0] * h1v[0] + h1v[1] * h1v[1]) + (h1v[2] * h1v[2] + h1v[3] * h1v[3]);
              ss += __shfl_xor(ss, 1, 64); ss += __shfl_xor(ss, 2, 64); ss += __shfl_xor(ss, 4, 64); ss += __shfl_xor(ss, 8, 64);
              if ((tid & 15) == 0) ((float*)(ws + (ph == 5 ? OFF_SSQ1 : OFF_SSQ2)))[(long)(brow + r) * 8 + nt2 * 2 + p] = ss;
            }
          }
        });
      }
    } break;
    case 6: case 10: {
      const float* src = ph == 6 ? (const float*)(ws + OFF_B) : (const float*)(ws + OFF_C + C_H2);
      const float* g = ph == 6 ? P.norm_mq : P.norm_ffn;
      (void)src; (void)g;
    } break;
    case 7: {
      const int xq = blockIdx.x & 7, lq = blockIdx.x >> 3, sq = gridDim.x >> 3;
      for (int t = lq; t < 16 * 2; t += sq) {
        const int mt = xq * 16 + (t & 15), nt2 = t >> 4, brow = mt * 128;
        RowLin ar{(const bf16_t*)(ws + OFF_A) + (long)brow * 1024, 1024}; RowLin br{(const bf16_t*)(ws + OFF_WMQ) + (long)nt2 * 256 * 1024, 1024};
        gemm_tile2(smem, ar, br, 16, [&](const float* Cs, int p) {
          const int nt = nt2 * 2 + p;
          bf16_t* dq = (bf16_t*)(ws + OFF_D) + (long)brow * 512 + nt * 128; const float* sq1 = (const float*)(ws + OFF_SSQ1) + (long)brow * 8;
#pragma unroll 2
          for (int it = 0; it < 8; ++it) {
            int id = it * 256 + tid; int r = id >> 4, c = (id & 15) * 8; float v[8]; ld8(Cs, r, c, v);
            const f32x4 s0 = *(const f32x4*)(sq1 + r * 8), s1 = *(const f32x4*)(sq1 + r * 8 + 4);
            const float ssum = ((s0[0] + s0[1]) + (s0[2] + s0[3])) + ((s1[0] + s1[1]) + (s1[2] + s1[3]));
            const float rr = rsqrtf(ssum * (1.f / 1024.f) + 1e-6f) * (0.08838834764831845f * LOG2E);
#pragma unroll
            for (int i = 0; i < 8; ++i) v[i] *= rr;
            *(u32x4*)(dq + (long)r * 512 + c) = pack8(v);
          }
        });
      }
    } break;
    case 8: {
      for (int job = blockIdx.x; job < 512; job += gridDim.x) xattn_tile(P, job * 4 + (tid >> 6));
    } break;
    case 11: {
      const int xq = blockIdx.x & 7, lq = blockIdx.x >> 3, sq = gridDim.x >> 3;
      for (int t = lq; t < 16 * 22; t += sq) {
        const int mt = xq * 16 + (t & 15), nt2 = t >> 4, brow = mt * 128;
        RowLin ar{(const bf16_t*)(ws + OFF_A) + (long)brow * 1024, 1024}; RowLin br{(const bf16_t*)(ws + OFF_WGU) + (long)nt2 * 256 * 1024, 1024};
        gemm_tile2(smem, ar, br, 16, [&](const float* Cs, int p) {
          bf16_t* ACT = (bf16_t*)(ws + OFF_B) + (long)brow * 2816 + (nt2 * 2 + p) * 64;
#pragma unroll 2
          for (int it = 0; it < 4; ++it) {
            int id = it * 256 + tid; int r = id >> 3, c = (id & 7) * 8; float gt[8], up[8]; ld8(Cs, r, c, gt); ld8(Cs, r, c + 64, up);
            const float* sq2 = (const float*)(ws + OFF_SSQ2) + (long)(brow + r) * 8;
            const f32x4 s0 = *(const f32x4*)(sq2), s1 = *(const f32x4*)(sq2 + 4);
            const float ssum = ((s0[0] + s0[1]) + (s0[2] + s0[3])) + ((s1[0] + s1[1]) + (s1[2] + s1[3]));
            const float rr = rsqrtf(ssum * (1.f / 1024.f) + 1e-6f);
#pragma unroll
            for (int i = 0; i < 8; ++i) { const float gg = gt[i] * rr; gt[i] = gg * sigm(gg) * (up[i] * rr); }
            *(u32x4*)(ACT + (long)r * 2816 + c) = pack8(gt);
          }
        });
      }
    } break;
    case 13: {
      for (int job = blockIdx.x; job < 1024; job += gridDim.x) { int row = job * 16 + (tid >> 6) * 4; rownorm_rows<true, 4>(P.out + (long)row * 1024, P.norm_final, P.out + (long)row * 1024); }
    } break;
#ifdef PROBE_K
    case 14: {
      const bf16_t* s0 = (const bf16_t*)(ws + PROBE_SRC0); const bf16_t* s1 = (const bf16_t*)(ws + PROBE_SRC1);
      for (long i = (long)blockIdx.x * 256 + tid; i < (long)M_ * 512; i += (long)gridDim.x * 256) {
        long row = i >> 9; int c = (int)(i & 511);
        P.out[row * 1024 + c] = bf2f(s0[i]); P.out[row * 1024 + 512 + c] = bf2f(s1[i]);
      }
    } break;
    case 15: {
      const float* s0 = (const float*)(ws + PROBE_SRC0);
      for (long i = (long)blockIdx.x * 256 + tid; i < (long)M_ * 1024; i += (long)gridDim.x * 256) P.out[i] = s0[i];
    } break;
#endif
  }
}

__global__ void __launch_bounds__(256, 2) fwd_kernel(Params P, int ph_lo, int ph_hi) {
  __shared__ __attribute__((aligned(16))) char smem[73728 + 16];
  volatile LAS unsigned* st = (volatile LAS unsigned*)(smem + 73728);
  const unsigned xcc = xb_xcc_id();
  if (ph_lo < ph_hi) {
    if (threadIdx.x == 0) { st[0] = 0u; st[1] = 0u; }
    __syncthreads();
    if (threadIdx.x == 0) (void)xb_add(&((unsigned*)(P.ws + OFF_BAR))[XB_XCNT(xcc)], 1u);
  }
  if (ph_hi < 0) cg::this_grid().sync();
  for (int ph = ph_lo; ph <= ph_hi; ++ph) {
    const uint64_t __attribute__((address_space(4)))* ka = (const uint64_t __attribute__((address_space(4)))*)__builtin_amdgcn_kernarg_segment_ptr();
    asm volatile("" : "+s"(ka));
    Params Pl; uint64_t* pd = (uint64_t*)&Pl;
#pragma unroll
    for (int i = 0; i < (int)(sizeof(Params) / 8); ++i) pd[i] = ka[i];
    if (ph_lo < ph_hi && (ph == 6 || ph == 10)) continue;
    run_phase(Pl, ph, smem);
    if (ph < ph_hi) xcd_barrier((unsigned*)(Pl.ws + OFF_BAR), xcc, st);
  }
}

extern "C" void kernel_launch(void* const* d_in, const int* in_sizes, int n_in, void* d_out, int out_size, void* d_ws, size_t ws_size,
                              hipStream_t stream) {
  static int grid_blocks = 0;
  if (!grid_blocks) {
    int dev = 0, cus = 0, per_cu = 0;
    hipGetDevice(&dev);
    hipDeviceGetAttribute(&cus, hipDeviceAttributeMultiprocessorCount, dev);
    hipOccupancyMaxActiveBlocksPerMultiprocessor(&per_cu, fwd_kernel, 256, 0);
    if (per_cu > 2) per_cu = 2;
    if (per_cu < 1) per_cu = 1;
    grid_blocks = cus * per_cu;
  }
  if (ws_size < (size_t)WS_NEED) fprintf(stderr, "workspace too small: %zu < %ld\n", ws_size, (long)WS_NEED);
  Params P{};
  const float** pp = (const float**)&P;
  for (int i = 0; i < 27; ++i) pp[i] = (const float*)d_in[i];
  P.out = (float*)d_out; P.ws = (char*)d_ws;
#if ONE_LAUNCH
  hipMemsetAsync((char*)d_ws + OFF_BAR, 0, XCD_BAR_WORDS * 4, stream);
#ifdef PROBE_K
  int lo = 0, hi = PROBE_DUMP;
#else
  int lo = 0, hi = 13;
#endif
  void* args[] = {&P, &lo, &hi};
  hipError_t e = hipLaunchCooperativeKernel((void*)fwd_kernel, dim3(grid_blocks), dim3(256), args, 0, stream);
  if (e != hipSuccess) fprintf(stderr, "cooperative launch failed: %s (grid %d)\n", hipGetErrorString(e), grid_blocks);
#else
  for (int ph = 0; ph <= 13; ++ph) fwd_kernel<<<grid_blocks, 256, 0, stream>>>(P, ph, ph);
#endif
}
```

```cpp
#include <hip/hip_runtime.h>
#include <hip/hip_cooperative_groups.h>
#include <stdint.h>
#include <stdio.h>
namespace cg = cooperative_groups;

#ifndef NSA_G0
#define NSA_G0 1.f
#define NSA_G1 1.f
#define NSA_G2 1.f
#endif
#ifndef ONE_LAUNCH
#define ONE_LAUNCH 1
#endif

typedef unsigned short bf16_t;
using bf16x8 = __attribute__((ext_vector_type(8))) short;
using f32x4 = __attribute__((ext_vector_type(4))) float;
using u32x4 = __attribute__((ext_vector_type(4))) unsigned;
using u32x2 = __attribute__((ext_vector_type(2))) unsigned;

#define T_ 8192
#define M_ 16384
#define NEGF (-1e30f)
#define LOG2E 1.4426950408889634f

constexpr long OFF_W1 = 0;
constexpr long OFF_WMKV = OFF_W1 + 9175040;
constexpr long OFF_WPA = OFF_WMKV + 2097152;
constexpr long OFF_WPB = OFF_WPA + 1048576;
constexpr long OFF_WOUT = OFF_WPB + 1048576;
constexpr long OFF_WMQ = OFF_WOUT + 2097152;
constexpr long OFF_WMO = OFF_WMQ + 1048576;
constexpr long OFF_WGU = OFF_WMO + 1048576;
constexpr long OFF_WDN = OFF_WGU + 11534336;
constexpr long OFF_WCK1 = OFF_WDN + 5767168;
constexpr long OFF_WCV1 = OFF_WCK1 + 524288;
constexpr long OFF_WM = OFF_WCV1 + 524288;
constexpr long OFF_BIAS1 = OFF_WM + 131072;
constexpr long OFF_MEMN = OFF_BIAS1 + 1024;
constexpr long OFF_MK = OFF_MEMN + 1048576;
constexpr long OFF_MVT = OFF_MK + 524288;
constexpr long OFF_KCMP = OFF_MVT + 524288;
constexpr long OFF_VCT = OFF_KCMP + 262144;
constexpr long OFF_A = OFF_VCT + 262144;
constexpr long OFF_B = OFF_A + 33554432;
constexpr long OFF_D = OFF_B + 67108864;
constexpr long OFF_C = OFF_D + 33554432;
constexpr long C_Q = 0, C_U = 16777216, C_GVT = 33554432, C_KC = 50331648, C_VC = 54525952, C_KS = 58720256,
               C_KW = 62914560, C_VST = 67108864, C_VWT = 71303168, C_GATES = 75497472;
constexpr long C_MIXED = 0, C_SCR = 33554432, C_H2 = 0;
constexpr long OFF_BAR = OFF_C + 77070336;
constexpr long OFF_SSQ1 = OFF_BAR + 16384;
constexpr long OFF_SSQ2 = OFF_SSQ1 + 524288;
constexpr long WS_NEED = OFF_SSQ2 + 524288;

struct Params {
  const float *x, *mem, *norm_mix, *w_in, *w_ck1, *w_ck2, *w_cv1, *w_cv2, *pe_k, *pe_v, *ln_sgu, *w_sp, *b_sp,
      *w_pa, *w_pb, *w_merge, *b_merge, *w_out, *norm_mq, *norm_mkv, *w_mq, *w_mkv, *w_mo, *norm_ffn, *w_gu, *w_dn, *norm_final;
  float* out;
  char* ws;
};

__device__ __forceinline__ int tidx() { int t = threadIdx.x; asm volatile("" : "+v"(t)); return t; }
__device__ __forceinline__ unsigned f2bf(float f) { unsigned u = __float_as_uint(f); u += 0x7fffu + ((u >> 16) & 1u); return u >> 16; }
__device__ __forceinline__ unsigned pack2(float a, float b) { unsigned r; asm("v_cvt_pk_bf16_f32 %0, %1, %2" : "=v"(r) : "v"(a), "v"(b)); return r; }
__device__ __forceinline__ float bf2f(unsigned h) { return __uint_as_float(h << 16); }
__device__ __forceinline__ float gelu_tanh(float x) { float u = 0.7978845608028654f * (x + 0.044715f * x * x * x); return x / (1.f + __expf(-2.f * u)); }
__device__ __forceinline__ float sigm(float x) { return 1.f / (1.f + __expf(-x)); }
__device__ __forceinline__ float wave_sum(float v) {
#pragma unroll
  for (int o = 32; o > 0; o >>= 1) v += __shfl_xor(v, o, 64);
  return v;
}
__device__ __forceinline__ u32x4 pack8(const float (&v)[8]) {
  u32x4 r; r[0] = pack2(v[0], v[1]); r[1] = pack2(v[2], v[3]); r[2] = pack2(v[4], v[5]); r[3] = pack2(v[6], v[7]); return r;
}

__device__ __forceinline__ int lds_byte(int r, int c) {
  int st = (r >> 4) * 2 + (c >> 5), rr = r & 15, cc = c & 31, ob = rr * 64 + cc * 2;
  return st * 1024 + (ob ^ (((ob >> 9) & 1) << 5));
}
__device__ __forceinline__ void stage_rc(int b, int& R, int& C) {
  int st = b >> 10, sb = b & 1023, swz = sb ^ (((sb >> 9) & 1) << 5);
  R = (st >> 1) * 16 + (swz >> 6); C = (st & 1) * 32 + ((swz & 63) >> 1);
}

#define CS_LD 132
__device__ __forceinline__ void ld8(const float* Cs, int r, int c, float (&v)[8]) {
  f32x4 a = *(const f32x4*)(Cs + r * CS_LD + c); f32x4 b = *(const f32x4*)(Cs + r * CS_LD + c + 4);
  v[0] = a[0]; v[1] = a[1]; v[2] = a[2]; v[3] = a[3]; v[4] = b[0]; v[5] = b[1]; v[6] = b[2]; v[7] = b[3];
}
__device__ __forceinline__ void ld8T(const float* Cs, int r8, int c, float (&v)[8]) {
#pragma unroll
  for (int i = 0; i < 8; ++i) v[i] = Cs[(r8 + i) * CS_LD + c];
}

struct RowLin {
  const bf16_t* base; long ld;
  __device__ __forceinline__ const bf16_t* operator()(int r) const { return base + (long)r * ld; }
};
struct RowCmp {
  const bf16_t* base; int brow;
  __device__ __forceinline__ const bf16_t* operator()(int r) const {
    int R = brow + r; int b = R >> 10, rem = R & 1023, i = rem >> 1, g = rem & 1; if (i > 510) i = 510;
    return base + ((long)(b * T_ + 16 * i) * 128 + g * 64);
  }
};

template <int AUX = 0, class ARow, class BRow, class Epi>
__device__ __forceinline__ void gemm_tile(char* smem, ARow arow, BRow brow, int nkt, int kstepA, int kstepB, Epi epi) {
  const int tid = tidx(), lane = tid & 63, wave = tid >> 6, wr = wave >> 1, wc = wave & 1, fr = lane & 15, fq = lane >> 4;
  const bf16_t* pa[4]; const bf16_t* pb[4];
#pragma unroll
  for (int i = 0; i < 4; ++i) { int b = tid * 16 + i * 4096; int R, C; stage_rc(b, R, C); pa[i] = arow(R) + C; pb[i] = brow(R) + C; }
  f32x4 acc[4][4];
#pragma unroll
  for (int m = 0; m < 4; ++m)
#pragma unroll
    for (int n = 0; n < 4; ++n) acc[m][n] = (f32x4){0.f, 0.f, 0.f, 0.f};
  {
#pragma unroll
    for (int i = 0; i < 4; ++i) {
      __builtin_amdgcn_global_load_lds((const unsigned*)(pa[i]), (unsigned*)(smem + tid * 16 + i * 4096), 16, 0, AUX);
      __builtin_amdgcn_global_load_lds((const unsigned*)(pb[i]), (unsigned*)(smem + 16384 + tid * 16 + i * 4096), 16, 0, AUX);
    }
  }
  for (int kt = 0; kt < nkt; ++kt) {
    asm volatile("s_waitcnt vmcnt(0)" ::: "memory");
    __syncthreads();
    if (kt + 1 < nkt) {
      char* la = smem + ((kt + 1) & 1) * 32768;
#pragma unroll
      for (int i = 0; i < 4; ++i) {
        __builtin_amdgcn_global_load_lds((const unsigned*)(pa[i] + (long)(kt + 1) * kstepA), (unsigned*)(la + tid * 16 + i * 4096), 16, 0, AUX);
        __builtin_amdgcn_global_load_lds((const unsigned*)(pb[i] + (long)(kt + 1) * kstepB), (unsigned*)(la + 16384 + tid * 16 + i * 4096), 16, 0, AUX);
      }
    }
    const char* la = smem + (kt & 1) * 32768; const char* lb = la + 16384;
#pragma unroll
    for (int ks = 0; ks < 2; ++ks) {
      bf16x8 a[4], b[4];
#pragma unroll
      for (int m = 0; m < 4; ++m) a[m] = *(const bf16x8*)(la + lds_byte(wr * 64 + m * 16 + fr, ks * 32 + fq * 8));
#pragma unroll
      for (int n = 0; n < 4; ++n) b[n] = *(const bf16x8*)(lb + lds_byte(wc * 64 + n * 16 + fr, ks * 32 + fq * 8));
#pragma unroll
      for (int m = 0; m < 4; ++m)
#pragma unroll
        for (int n = 0; n < 4; ++n) acc[m][n] = __builtin_amdgcn_mfma_f32_16x16x32_bf16(a[m], b[n], acc[m][n], 0, 0, 0);
    }
  }
  __syncthreads();
  float* Cs = (float*)smem;
#pragma unroll
  for (int m = 0; m < 4; ++m)
#pragma unroll
    for (int n = 0; n < 4; ++n)
#pragma unroll
      for (int r = 0; r < 4; ++r) Cs[(wr * 64 + m * 16 + fq * 4 + r) * CS_LD + wc * 64 + n * 16 + fr] = acc[m][n][r];
  __syncthreads();
  epi(Cs);
  __syncthreads();
}

template <class F>
__device__ __forceinline__ void store_rows_bf16(const float* Cs, bf16_t* dst, long ld, F f) {
#pragma unroll 2
  for (int it = 0; it < 8; ++it) {
    int id = it * 256 + tidx(); int r = id >> 4, c = (id & 15) * 8;
    float v[8]; ld8(Cs, r, c, v);
#pragma unroll
    for (int i = 0; i < 8; ++i) v[i] = f(v[i], c + i);
    *(u32x4*)(dst + (long)r * ld + c) = pack8(v);
  }
}
template <class F>
__device__ __forceinline__ void store_T_bf16(const float* Cs, bf16_t* dst, long cstride, F f) {
#pragma unroll 2
  for (int it = 0; it < 8; ++it) {
    int id = it * 256 + tidx(); int c = id >> 4, r8 = (id & 15) * 8;
    float v[8]; ld8T(Cs, r8, c, v);
#pragma unroll
    for (int i = 0; i < 8; ++i) v[i] = f(v[i]);
    *(u32x4*)(dst + (long)c * cstride + r8) = pack8(v);
  }
}


__device__ __forceinline__ int lds_byte32(int r, int c) { int rr = r & 15; return (r >> 4) * 1024 + rr * 64 + ((((c >> 3) ^ ((-(rr >> 2)) & 3)) & 3) << 4); }
__device__ __forceinline__ void stage_rc32(int b, int& R, int& C) { int st = b >> 10, sb = b & 1023, rr = sb >> 6, cp = (sb >> 4) & 3; R = st * 16 + rr; C = ((cp ^ ((-(rr >> 2)) & 3)) & 3) * 8; }
struct RowClamp {
  const bf16_t* base; long ld; int maxr;
  __device__ __forceinline__ const bf16_t* operator()(int r) const { return base + (long)(r < maxr ? r : maxr) * ld; }
};
__device__ __forceinline__ int lds_byte64(int r, int c) { int rr = r & 15; return (r >> 4) * 2048 + rr * 128 + ((((c >> 3) ^ (rr >> 1)) & 7) << 4); }
__device__ __forceinline__ void stage_rc64(int b, int& R, int& C) { int st = b >> 11, sb = b & 2047, rr = sb >> 7, cp = (sb >> 4) & 7; R = st * 16 + rr; C = ((cp ^ (rr >> 1)) & 7) * 8; }
template <class ARow, class BRow, class Epi>
__device__ __forceinline__ void gemm_tile2(char* smem, ARow arow, BRow brow, int nkt, Epi epi) {
  const int tid = tidx(), lane = tid & 63, wave = tid >> 6, wr = wave >> 1, wc = wave & 1, fr = lane & 15, fq = lane >> 4;
  const bf16_t* pa[4]; const bf16_t* pb[8];
#pragma unroll
  for (int i = 0; i < 4; ++i) { int R, C; stage_rc64(tid * 16 + i * 4096, R, C); pa[i] = arow(R) + C; }
#pragma unroll
  for (int i = 0; i < 8; ++i) { int R, C; stage_rc64(tid * 16 + i * 4096, R, C); pb[i] = brow(R) + C; }
  f32x4 acc[4][8];
#pragma unroll
  for (int m = 0; m < 4; ++m)
#pragma unroll
    for (int n = 0; n < 8; ++n) acc[m][n] = (f32x4){0.f, 0.f, 0.f, 0.f};
  for (int kt = 0; kt < nkt; ++kt) {
    __syncthreads();
#pragma unroll
    for (int i = 0; i < 4; ++i) __builtin_amdgcn_global_load_lds((const unsigned*)(pa[i] + (long)kt * 64), (unsigned*)(smem + tid * 16 + i * 4096), 16, 0, 0);
#pragma unroll
    for (int i = 0; i < 8; ++i) __builtin_amdgcn_global_load_lds((const unsigned*)(pb[i] + (long)kt * 64), (unsigned*)(smem + 16384 + tid * 16 + i * 4096), 16, 0, 0);
    asm volatile("s_waitcnt vmcnt(0)" ::: "memory");
    __syncthreads();
    {
      const char* pA = smem + lds_byte64(wr * 64 + fr, fq * 8);
      const char* pB = smem + 16384 + lds_byte64(wc * 128 + fr, fq * 8);
      const int k1 = lds_byte64(fr, 32 + fq * 8) - lds_byte64(fr, fq * 8);
      bf16x8 a[4], bl[4], bh[4];
#define SB __builtin_amdgcn_sched_barrier(0)
#define LDA(K) _Pragma("unroll") for (int m = 0; m < 4; ++m) a[m] = *(const bf16x8*)(pA + m * 2048 + (K))
#define LDBL(K) _Pragma("unroll") for (int n = 0; n < 4; ++n) bl[n] = *(const bf16x8*)(pB + n * 2048 + (K))
#define LDBH(K) _Pragma("unroll") for (int n = 0; n < 4; ++n) bh[n] = *(const bf16x8*)(pB + (n + 4) * 2048 + (K))
#define MML _Pragma("unroll") for (int m = 0; m < 4; ++m) _Pragma("unroll") for (int n = 0; n < 4; ++n) acc[m][n] = __builtin_amdgcn_mfma_f32_16x16x32_bf16(a[m], bl[n], acc[m][n], 0, 0, 0)
#define MMH _Pragma("unroll") for (int m = 0; m < 4; ++m) _Pragma("unroll") for (int n = 0; n < 4; ++n) acc[m][n + 4] = __builtin_amdgcn_mfma_f32_16x16x32_bf16(a[m], bh[n], acc[m][n + 4], 0, 0, 0)
      LDA(0); LDBL(0); SB;
      LDBH(0); SB;
      MML; SB;
      LDBL(k1); SB;
      MMH; SB;
      LDA(k1); SB;
      LDBH(k1); SB;
      MML; SB;
      MMH; SB;
#undef SB
#undef LDA
#undef LDBL
#undef LDBH
#undef MML
#undef MMH
    }
  }
  float* Cs = (float*)smem;
#pragma unroll
  for (int p = 0; p < 2; ++p) {
    __syncthreads();
    if (wc == p) {
#pragma unroll
      for (int m = 0; m < 4; ++m)
#pragma unroll
        for (int n = 0; n < 8; ++n)
#pragma unroll
          for (int r = 0; r < 4; ++r) Cs[(wr * 64 + m * 16 + fq * 4 + r) * CS_LD + n * 16 + fr] = acc[m][n][r];
    }
    __syncthreads();
    epi(Cs, p);
  }
  __syncthreads();
}

template <int MODE>
__device__ __forceinline__ void transpose_tile(const float* W, int Nsrc, bf16_t* Wt, int Kd, int k0, int n0, float* lds) {
  const int tid = tidx();
  {
    int tx = tid & 63, ty = tid >> 6; int np = n0 + tx; int sc;
    if (MODE == 0) sc = np < Nsrc ? np : -1;
    else { int x = np & 127, tl = np >> 7; sc = x < 64 ? tl * 64 + x : 2816 + tl * 64 + x - 64; }
#pragma unroll
    for (int kk = ty; kk < 64; kk += 4) lds[kk * 65 + tx] = sc >= 0 ? W[(long)(k0 + kk) * Nsrc + sc] : 0.f;
  }
  __syncthreads();
  {
    int nrow = tid >> 2, kseg = (tid & 3) * 16; float v[8];
#pragma unroll
    for (int i = 0; i < 8; ++i) v[i] = lds[(kseg + i) * 65 + nrow];
    *(u32x4*)(Wt + (long)(n0 + nrow) * Kd + k0 + kseg) = pack8(v);
#pragma unroll
    for (int i = 0; i < 8; ++i) v[i] = lds[(kseg + 8 + i) * 65 + nrow];
    *(u32x4*)(Wt + (long)(n0 + nrow) * Kd + k0 + kseg + 8) = pack8(v);
  }
  __syncthreads();
}

template <bool OUTF, int NR>
__device__ __forceinline__ void rownorm_rows(const float* src, const float* g, void* dst) {
  const int lane = tidx() & 63;
  f32x4 v[NR][4];
#pragma unroll
  for (int r = 0; r < NR; ++r)
#pragma unroll
    for (int i = 0; i < 4; ++i) v[r][i] = *(const f32x4*)(src + (long)r * 1024 + i * 256 + lane * 4);
  f32x4 gg[4];
#pragma unroll
  for (int i = 0; i < 4; ++i) gg[i] = *(const f32x4*)(g + i * 256 + lane * 4);
#pragma unroll
  for (int r = 0; r < NR; ++r) {
    float ss = 0.f;
#pragma unroll
    for (int i = 0; i < 4; ++i) ss += v[r][i][0] * v[r][i][0] + v[r][i][1] * v[r][i][1] + v[r][i][2] * v[r][i][2] + v[r][i][3] * v[r][i][3];
    ss = wave_sum(ss);
    const float rr = rsqrtf(ss * (1.f / 1024.f) + 1e-6f);
#pragma unroll
    for (int i = 0; i < 4; ++i) {
      float o0 = v[r][i][0] * rr * gg[i][0], o1 = v[r][i][1] * rr * gg[i][1], o2 = v[r][i][2] * rr * gg[i][2], o3 = v[r][i][3] * rr * gg[i][3];
      if (OUTF) { *(f32x4*)((float*)dst + (long)r * 1024 + i * 256 + lane * 4) = (f32x4){o0, o1, o2, o3}; }
      else { u32x2 p; p[0] = pack2(o0, o1); p[1] = pack2(o2, o3); *(u32x2*)((bf16_t*)dst + (long)r * 1024 + i * 256 + lane * 4) = p; }
    }
  }
}

__device__ void phase0(const Params& P, char* smem) {
  float* lds = (float*)smem;
  const int tid = tidx();
  const int NJ = 8 + 1024 + 32 + 32 + 4384;
  for (int job = blockIdx.x; job < NJ; job += gridDim.x) {
    int j = job;
    if (j < 8) {
      int n = j * 32 + (tid & 31), sl = tid >> 5; int kv = n >> 7, nn = n & 127;
      const float* pe = kv ? P.pe_v : P.pe_k; const float* w1 = kv ? P.w_cv1 : P.w_ck1;
      float s = 0.f;
      for (int k = sl * 256; k < sl * 256 + 256; ++k) s += pe[k] * w1[(long)k * 128 + nn];
      lds[sl * 32 + (tid & 31)] = s;
      __syncthreads();
      if (tid < 32) { float t = 0.f; for (int q = 0; q < 8; ++q) t += lds[q * 32 + tid]; ((float*)(P.ws + OFF_BIAS1))[j * 32 + tid] = t; }
      __syncthreads();
      continue;
    }
    j -= 8;
    if (j < 1024) { int row = j * 16 + (tid >> 6) * 4; rownorm_rows<false, 4>(P.x + (long)row * 1024, P.norm_mix, (bf16_t*)(P.ws + OFF_A) + (long)row * 1024); continue; }
    j -= 1024;
    if (j < 32) { int row = j * 16 + (tid >> 6) * 4; rownorm_rows<false, 4>(P.mem + (long)row * 1024, P.norm_mkv, (bf16_t*)(P.ws + OFF_MEMN) + (long)row * 1024); continue; }
    j -= 32;
    if (j < 32) {
      int e0 = j * 2048 + tid * 8; float v[8];
#pragma unroll
      for (int i = 0; i < 8; ++i) { int e = e0 + i; int t = (e >> 7) & 127, s = e & 127; v[i] = s <= t ? P.w_sp[e] : 0.f; }
      *(u32x4*)((bf16_t*)(P.ws + OFF_WM) + e0) = pack8(v);
      continue;
    }
    j -= 32;
#define TRJ(KT, NT, W, NSRC, WT, KD, MODE) \
    if (j < (KT) * (NT)) { transpose_tile<MODE>(W, NSRC, (bf16_t*)(P.ws + (WT)), KD, (j % (KT)) * 64, (j / (KT)) * 64, lds); continue; } \
    j -= (KT) * (NT);
    TRJ(16, 88, P.w_gu, 5632, OFF_WGU, 1024, 1)
    TRJ(44, 16, P.w_dn, 1024, OFF_WDN, 2816, 0)
    TRJ(16, 38, P.w_in, 2328, OFF_W1, 1024, 0)
    TRJ(16, 32, P.w_merge, 2048, OFF_W1 + 2432L * 1024 * 2, 1024, 0)
    TRJ(16, 16, P.w_mkv, 1024, OFF_WMKV, 1024, 0)
    TRJ(16, 16, P.w_out, 1024, OFF_WOUT, 1024, 0)
    TRJ(8, 16, P.w_pa, 1024, OFF_WPA, 512, 0)
    TRJ(8, 16, P.w_pb, 1024, OFF_WPB, 512, 0)
    TRJ(16, 8, P.w_mq, 512, OFF_WMQ, 1024, 0)
    TRJ(8, 16, P.w_mo, 1024, OFF_WMO, 512, 0)
    TRJ(32, 2, P.w_ck1, 128, OFF_WCK1, 2048, 0)
    TRJ(32, 2, P.w_cv1, 128, OFF_WCV1, 2048, 0)
#undef TRJ
  }
}

__device__ void phase1(const Params& P, char* smem) {
  char* ws = P.ws;
  const int NG1 = 128 * 18;
  const int xq = blockIdx.x & 7, lq = blockIdx.x >> 3, sq = gridDim.x >> 3;
  for (int t = lq; t < 16 * 12; t += sq) {
    {
      const int mt = xq * 16 + (t & 15), nt2 = t >> 4; const int brow = mt * 128;
      RowLin ar{(const bf16_t*)(ws + OFF_A) + (long)brow * 1024, 1024};
      RowClamp br{(const bf16_t*)(ws + OFF_W1) + (long)nt2 * 256 * 1024, 1024, 4479 - nt2 * 256};
      gemm_tile2(smem, ar, br, 16, [&](const float* Cs, int p) {
        const int nt = nt2 * 2 + p; if (nt >= 35) return;
        char* C = ws + OFF_C;
        if (nt < 4) {
          store_rows_bf16(Cs, (bf16_t*)(C + C_Q) + (long)brow * 512 + nt * 128, 512, [](float v, int) { return v * (0.125f * LOG2E); });
        } else if (nt == 4 || nt == 5 || nt == 6 || nt == 8) {
          long off = nt == 4 ? C_KC : nt == 5 ? C_VC : nt == 6 ? C_KS : C_KW;
          store_rows_bf16(Cs, (bf16_t*)(C + off) + (long)brow * 128, 128, [](float v, int) { return v; });
        } else if (nt == 7 || nt == 9) {
          long off = nt == 7 ? C_VST : C_VWT; int b = brow >> 13, tl = brow & 8191;
          store_T_bf16(Cs, (bf16_t*)(C + off) + (long)b * 128 * T_ + tl, T_, [](float v) { return v; });
        } else if (nt < 14) {
          store_rows_bf16(Cs, (bf16_t*)(C + C_U) + (long)brow * 512 + (nt - 10) * 128, 512, [](float v, int) { return gelu_tanh(v); });
        } else if (nt < 18) {
          store_T_bf16(Cs, (bf16_t*)(C + C_GVT) + ((long)(brow >> 7) * 512 + (nt - 14) * 128) * 128, 128, [](float v) { return gelu_tanh(v); });
        } else if (nt == 18) {
          float* gates = (float*)(C + C_GATES);
          for (int id = tidx(); id < 128 * 24; id += 256) { int r = id / 24, c = id % 24; gates[(long)(brow + r) * 24 + c] = sigm(Cs[r * CS_LD + c]); }
        } else {
          const float* bm = P.b_merge + (nt - 19) * 128;
          store_rows_bf16(Cs, (bf16_t*)(ws + OFF_B) + (long)brow * 2048 + (nt - 19) * 128, 2048, [bm](float v, int c) { return sigm(v + bm[c]); });
        }
      });
    }
  }
}

__device__ void phase2(const Params& P, char* smem) {
  char* ws = P.ws; const int tid = tidx();
  for (int job = blockIdx.x; job < 32 + 128; job += gridDim.x) {
    if (job < 32) {
      const int kv = job >> 4, mt = job & 15, brow = mt * 128;
      RowCmp ar{(const bf16_t*)(ws + OFF_C + (kv ? C_VC : C_KC)), brow};
      RowLin br{(const bf16_t*)(ws + (kv ? OFF_WCV1 : OFF_WCK1)), 2048};
      const float* bias1 = (const float*)(ws + OFF_BIAS1) + kv * 128;
      const float* w2 = kv ? P.w_cv2 : P.w_ck2;
      gemm_tile(smem, ar, br, 32, 128, 64, [&](const float* Csc) {
        float* Cs = (float*)Csc;
        for (int it = 0; it < 64; ++it) { int id = it * 256 + tid; int r = id >> 7, n = id & 127; Cs[r * CS_LD + n] = gelu_tanh(Cs[r * CS_LD + n] + bias1[n]); }
        __syncthreads();
        const int r = tid >> 1, half = tid & 1;
        float acc[32];
#pragma unroll
        for (int i = 0; i < 32; ++i) acc[i] = 0.f;
        for (int n = 0; n < 128; ++n) {
          float h = Cs[r * CS_LD + n]; const float* wr = w2 + n * 64 + half * 32;
#pragma unroll
          for (int q = 0; q < 8; ++q) { f32x4 w = *(const f32x4*)(wr + q * 4); acc[q * 4] += h * w[0]; acc[q * 4 + 1] += h * w[1]; acc[q * 4 + 2] += h * w[2]; acc[q * 4 + 3] += h * w[3]; }
        }
        const int R = brow + r; const int b = R >> 10, rem = R & 1023, i = rem >> 1, g = rem & 1;
        if (i >= 511) {
#pragma unroll
          for (int q = 0; q < 32; ++q) acc[q] = 0.f;
        }
        if (kv == 0) {
          bf16_t* dst = (bf16_t*)(ws + OFF_KCMP) + (long)(b * 512 + i) * 128 + g * 64 + half * 32;
#pragma unroll
          for (int q = 0; q < 4; ++q) { float v[8];
#pragma unroll
            for (int e = 0; e < 8; ++e) v[e] = acc[q * 8 + e];
            *(u32x4*)(dst + q * 8) = pack8(v); }
        } else {
          bf16_t* dst = (bf16_t*)(ws + OFF_VCT) + ((long)(b * 128 + g * 64 + half * 32)) * 512 + i;
#pragma unroll
          for (int q = 0; q < 32; ++q) dst[(long)q * 512] = (bf16_t)f2bf(acc[q]);
        }
      });
    } else {
      const int bc = job - 32; bf16_t* base = (bf16_t*)(ws + OFF_C + C_GVT) + (long)bc * 512 * 128;
      float* ssum = (float*)smem; float* ssq = ssum + 128;
      float* psum = ssum + 256; float* psq = psum + 16 * 128;
      const int cs = tid >> 4, s8 = (tid & 15) * 8;
      float a[8], q[8];
#pragma unroll
      for (int i = 0; i < 8; ++i) { a[i] = 0.f; q[i] = 0.f; }
      for (int it = 0; it < 32; ++it) {
        u32x4 d = *(const u32x4*)(base + (long)(it * 16 + cs) * 128 + s8);
#pragma unroll
        for (int i = 0; i < 4; ++i) { float lo = bf2f(d[i] & 0xffffu), hi = bf2f(d[i] >> 16); a[2 * i] += lo; q[2 * i] += lo * lo; a[2 * i + 1] += hi; q[2 * i + 1] += hi * hi; }
      }
#pragma unroll
      for (int i = 0; i < 8; ++i) { psum[cs * 128 + s8 + i] = a[i]; psq[cs * 128 + s8 + i] = q[i]; }
      __syncthreads();
      if (tid < 128) {
        float su = 0.f, sq = 0.f;
        for (int c = 0; c < 16; ++c) { su += psum[c * 128 + tid]; sq += psq[c * 128 + tid]; }
        float mean_t = su * (1.f / 512.f); float var = sq * (1.f / 512.f) - mean_t * mean_t; if (var < 0.f) var = 0.f;
        ssum[tid] = mean_t; ssq[tid] = rsqrtf(var + 1e-6f);
      }
      __syncthreads();
      float mean[8], rs[8];
#pragma unroll
      for (int i = 0; i < 8; ++i) { mean[i] = ssum[s8 + i]; rs[i] = ssq[s8 + i]; }
      for (int it = 0; it < 32; ++it) {
        int ch = it * 16 + cs; float gg = P.ln_sgu[ch];
        u32x4 d = *(const u32x4*)(base + (long)ch * 128 + s8); float v[8];
#pragma unroll
        for (int i = 0; i < 4; ++i) { v[2 * i] = bf2f(d[i] & 0xffffu); v[2 * i + 1] = bf2f(d[i] >> 16); }
#pragma unroll
        for (int i = 0; i < 8; ++i) v[i] = (v[i] - mean[i]) * rs[i] * gg;
        *(u32x4*)(base + (long)ch * 128 + s8) = pack8(v);
      }
      __syncthreads();
    }
  }
  if (blockIdx.x >= 32) {
    for (int mtile = blockIdx.x - 32; mtile < 768 + 32; mtile += gridDim.x - 32) {
      if (mtile >= 768) {
        const int j = mtile - 768; const int mt = j >> 3, nt = j & 7; const int brow = mt * 128;
        RowLin ar{(const bf16_t*)(ws + OFF_MEMN) + (long)brow * 1024, 1024};
        RowLin br{(const bf16_t*)(ws + OFF_WMKV) + (long)nt * 128 * 1024, 1024};
        gemm_tile(smem, ar, br, 16, 64, 64, [&](const float* Cs) {
          if (nt < 4) store_rows_bf16(Cs, (bf16_t*)(ws + OFF_MK) + (long)brow * 512 + nt * 128, 512, [](float v, int) { return v; });
          else { int b = mt >> 1, n0 = (mt & 1) * 128; store_T_bf16(Cs, (bf16_t*)(ws + OFF_MVT) + ((long)b * 512 + (nt - 4) * 128) * 256 + n0, 256, [](float v) { return v; }); }
        });
        continue;
      }
      const int mt = mtile & 127, nt2 = 12 + (mtile >> 7), brow = mt * 128;
      RowLin ar{(const bf16_t*)(ws + OFF_A) + (long)brow * 1024, 1024};
      RowClamp br{(const bf16_t*)(ws + OFF_W1) + (long)nt2 * 256 * 1024, 1024, 4479 - nt2 * 256};
      gemm_tile2(smem, ar, br, 16, [&](const float* Cs, int p) {
        const int nt = nt2 * 2 + p; if (nt >= 35) return;
        const float* bm = P.b_merge + (nt - 19) * 128;
        store_rows_bf16(Cs, (bf16_t*)(ws + OFF_B) + (long)brow * 2048 + (nt - 19) * 128, 2048, [bm](float v, int c) { return sigm(v + bm[c]); });
      });
    }
  }
}

template <int MODE>
__device__ __forceinline__ void nsa_block(const bf16x8 (&qf)[4][2], f32x4 (&oacc)[4][4], float (&m)[4], float (&l)[4],
                                          const float (&sl2)[4], const float (&inv)[4], const bf16_t* kp, const bf16_t* vp, long vdt,
                                          int dist0, bool rowok, float (&asum)[2], float (&bsum)[2]) {
  constexpr int DSTEP = (MODE <= 1) ? 16 : 1;
  bf16x8 kf[2][2];
#pragma unroll
  for (int kt = 0; kt < 2; ++kt)
#pragma unroll
    for (int ks = 0; ks < 2; ++ks) kf[kt][ks] = *(const bf16x8*)(kp + kt * 16 * 128 + ks * 32);
  bf16x8 vf[4];
  if (MODE != 0) {
#pragma unroll
    for (int dt = 0; dt < 4; ++dt) {
      u32x2 lo = *(const u32x2*)(vp + dt * vdt); u32x2 hi = *(const u32x2*)(vp + dt * vdt + 16);
      u32x4 c; c[0] = lo[0]; c[1] = lo[1]; c[2] = hi[0]; c[3] = hi[1];
      vf[dt] = __builtin_bit_cast(bf16x8, c);
    }
  }
  const float fd0 = (float)dist0;
#pragma unroll
  for (int h = 0; h < 4; ++h) {
    f32x4 s[2];
#pragma unroll
    for (int kt = 0; kt < 2; ++kt) {
      s[kt] = __builtin_amdgcn_mfma_f32_16x16x32_bf16(kf[kt][0], qf[h][0], (f32x4){0.f, 0.f, 0.f, 0.f}, 0, 0, 0);
      s[kt] = __builtin_amdgcn_mfma_f32_16x16x32_bf16(kf[kt][1], qf[h][1], s[kt], 0, 0, 0);
    }
    float sc[8]; bool ok[8];
#pragma unroll
    for (int kt = 0; kt < 2; ++kt)
#pragma unroll
      for (int r = 0; r < 4; ++r) {
        const int e = kt * 16 + r; const int dist = dist0 - DSTEP * e;
        bool o = dist >= 0;
        if (MODE == 2) o = o && rowok;
        if (MODE == 3) o = o && (dist < 512);
        ok[kt * 4 + r] = o;
        sc[kt * 4 + r] = o ? s[kt][r] - sl2[h] * (fd0 - (float)(DSTEP * e)) : NEGF;
      }
    float p[8];
    if (MODE != 1) {
      float ml = NEGF;
#pragma unroll
      for (int i = 0; i < 8; ++i) ml = fmaxf(ml, sc[i]);
      ml = fmaxf(ml, __shfl_xor(ml, 16, 64)); ml = fmaxf(ml, __shfl_xor(ml, 32, 64));
      const float mn = fmaxf(m[h], ml); const float alpha = __builtin_amdgcn_exp2f(m[h] - mn); m[h] = mn;
      const float mref = fmaxf(mn, -1e29f);
      float ps = 0.f;
#pragma unroll
      for (int i = 0; i < 8; ++i) { p[i] = __builtin_amdgcn_exp2f(sc[i] - mref); ps += p[i]; }
      l[h] = l[h] * alpha + ps;
      if (MODE != 0) {
        if (__builtin_amdgcn_ballot_w64(alpha != 1.f) != 0ull) {
#pragma unroll
          for (int dt = 0; dt < 4; ++dt) oacc[h][dt] *= alpha;
        }
      }
    } else {
      const float mref1 = fmaxf(m[h], -1e29f);
#pragma unroll
      for (int i = 0; i < 8; ++i) p[i] = __builtin_amdgcn_exp2f(sc[i] - mref1) * l[h];
      asum[0] += (p[0] + p[1]) + (p[2] + p[3]); bsum[0] += p[3];
      asum[1] += (p[4] + p[5]) + (p[6] + p[7]); bsum[1] += p[7];
    }
    if (MODE != 0) {
      u32x4 pk; pk[0] = pack2(p[0], p[1]); pk[1] = pack2(p[2], p[3]); pk[2] = pack2(p[4], p[5]); pk[3] = pack2(p[6], p[7]);
      const bf16x8 pf = __builtin_bit_cast(bf16x8, pk);
#pragma unroll
      for (int dt = 0; dt < 4; ++dt) oacc[h][dt] = __builtin_amdgcn_mfma_f32_16x16x32_bf16(vf[dt], pf, oacc[h][dt], 0, 0, 0);
    }
    __builtin_amdgcn_sched_barrier(0);
  }
}

__device__ void nsa_tile(const Params& P, int wt, char* wl) {
  char* C = P.ws + OFF_C;
  const bf16_t* Q = (const bf16_t*)(C + C_Q);
  const bf16_t* KCMP = (const bf16_t*)(P.ws + OFF_KCMP); const bf16_t* VCT = (const bf16_t*)(P.ws + OFF_VCT);
  const bf16_t* KS = (const bf16_t*)(C + C_KS); const bf16_t* VST = (const bf16_t*)(C + C_VST);
  const bf16_t* KW = (const bf16_t*)(C + C_KW); const bf16_t* VWT = (const bf16_t*)(C + C_VWT);
  const float* GATES = (const float*)(C + C_GATES);
  bf16_t* O = (bf16_t*)(P.ws + OFF_D);
  const int lane = tidx() & 63, qi = lane & 15, quad = lane >> 4;
  wt = __builtin_amdgcn_readfirstlane(wt);
  const int jb = wt >> 2, wv4 = wt & 3;
  const int bg = jb & 3, b = bg >> 1, g = bg & 1;
  const int gq = jb >> 2;
  const int tq = (gq < 64 ? 127 - gq : gq - 64) * 4 + wv4;
  const int t0 = tq * 16;
  const int t = t0 + qi;
  const long row = (long)b * T_ + t;
  bf16x8 qf[4][2];
#pragma unroll
  for (int h = 0; h < 4; ++h)
#pragma unroll
    for (int ks = 0; ks < 2; ++ks) qf[h][ks] = *(const bf16x8*)(Q + row * 512 + (g * 4 + h) * 64 + ks * 32 + quad * 8);
  float sl2[4];
#pragma unroll
  for (int h = 0; h < 4; ++h) sl2[h] = __builtin_amdgcn_exp2f(-(float)(g * 4 + h + 1)) * LOG2E;
  f32x4 oacc[4][4]; float m[4], l[4], inv[4]; float asum[2], bsum[2];
  float* imp = (float*)wl; float* outl = (float*)wl;
  unsigned* sel = (unsigned*)(wl + 16384); unsigned* uni = sel + 64;
#pragma unroll
  for (int h = 0; h < 4; ++h) { m[h] = NEGF; l[h] = 0.f; inv[h] = 0.f; }
  asum[0] = asum[1] = bsum[0] = bsum[1] = 0.f;

  const int nI = t0 >> 4; const int nblk = (nI + 31) >> 5;
  for (int blk = nblk - 1; blk >= 0; --blk) {
    const int key0 = blk * 32;
    const bf16_t* kp = KCMP + (long)(b * 512 + key0 + qi) * 128 + g * 64 + quad * 8;
    nsa_block<0>(qf, oacc, m, l, sl2, inv, kp, nullptr, 0, t - 31 - 16 * (key0 + quad * 4), true, asum, bsum);
  }
#pragma unroll
  for (int h = 0; h < 4; ++h) { float lt = l[h]; lt += __shfl_xor(lt, 16, 64); lt += __shfl_xor(lt, 32, 64); l[h] = 1.f / fmaxf(lt, 1e-30f); }
  for (int i = lane; i < 16 * 132; i += 64) imp[i] = 0.f;
#pragma unroll
  for (int h = 0; h < 4; ++h)
#pragma unroll
    for (int dt = 0; dt < 4; ++dt) oacc[h][dt] = (f32x4){0.f, 0.f, 0.f, 0.f};
  for (int blk = 0; blk < nblk; ++blk) {
    const int key0 = blk * 32;
    const bf16_t* kp = KCMP + (long)(b * 512 + key0 + qi) * 128 + g * 64 + quad * 8;
    const bf16_t* vp = VCT + (long)(b * 128 + g * 64 + qi) * 512 + key0 + quad * 4;
    asum[0] = asum[1] = bsum[0] = bsum[1] = 0.f;
    nsa_block<1>(qf, oacc, m, l, sl2, inv, kp, vp, 16 * 512, t - 31 - 16 * (key0 + quad * 4), true, asum, bsum);
    const int J = (key0 >> 2) + quad;
    atomicAdd(&imp[qi * 132 + J], asum[0]); atomicAdd(&imp[qi * 132 + J + 1], bsum[0]);
    atomicAdd(&imp[qi * 132 + J + 4], asum[1]); atomicAdd(&imp[qi * 132 + J + 5], bsum[1]);
  }
  const int cur = t0 >> 6;
  if (lane < 16) {
    unsigned w0 = 0, w1 = 0, w2 = 0, w3 = 0;
    if (cur < 16) { w0 = (1u << (cur + 1)) - 1u; }
    else {
      w0 = 1u;
      { int j = cur; unsigned bit = 1u << (j & 31); int w = j >> 5; if (w == 0) w0 |= bit; else if (w == 1) w1 |= bit; else if (w == 2) w2 |= bit; else w3 |= bit; }
      { int j = cur - 1; unsigned bit = 1u << (j & 31); int w = j >> 5; if (w == 0) w0 |= bit; else if (w == 1) w1 |= bit; else if (w == 2) w2 |= bit; else w3 |= bit; }
    }
    sel[lane * 4 + 0] = w0; sel[lane * 4 + 1] = w1; sel[lane * 4 + 2] = w2; sel[lane * 4 + 3] = w3;
  }
  if (lane < 4) uni[lane] = 0u;
  if (cur >= 16) {
    for (int rnd = 0; rnd < 4; ++rnd) {
      const int qq = rnd * 4 + quad;
      unsigned key[8];
#pragma unroll
      for (int c = 0; c < 8; ++c) {
        const int j = qi + 16 * c;
        const bool v = (j <= cur) && (j != 0) && (j != cur) && (j != cur - 1);
        const unsigned bits = __float_as_uint(imp[qq * 132 + j]);
        key[c] = v ? ((bits & 0xFFFFFF00u) | (unsigned)(128 - j)) : 0u;
      }
      for (int it = 0; it < 13; ++it) {
        unsigned mx = key[0];
#pragma unroll
        for (int c = 1; c < 8; ++c) mx = key[c] > mx ? key[c] : mx;
#pragma unroll
        for (int o = 1; o < 16; o <<= 1) { unsigned ot = (unsigned)__shfl_xor((int)mx, o, 64); mx = ot > mx ? ot : mx; }
        if (mx != 0u) {
#pragma unroll
          for (int c = 0; c < 8; ++c) {
            if (key[c] == mx) { key[c] = 0u; const int j = qi + 16 * c; atomicOr(&sel[qq * 4 + (j >> 5)], 1u << (j & 31)); }
          }
        }
      }
    }
  }
  unsigned mym[4];
#pragma unroll
  for (int w = 0; w < 4; ++w) mym[w] = sel[qi * 4 + w];
  if (lane < 16) {
#pragma unroll
    for (int w = 0; w < 4; ++w) atomicOr(&uni[w], mym[w]);
  }
  const float* gp = GATES + row * 24 + g * 12;
#pragma unroll
  for (int h = 0; h < 4; ++h) {
    const float gt = gp[h * 3 + 0] * NSA_G0;
#pragma unroll
    for (int dt = 0; dt < 4; ++dt) *(f32x4*)(outl + ((h * 16 + qi) * 64 + (((dt * 4 + quad) ^ qi) << 2))) = oacc[h][dt] * gt;
  }
#pragma unroll
  for (int h = 0; h < 4; ++h) { m[h] = NEGF; l[h] = 0.f;
#pragma unroll
    for (int dt = 0; dt < 4; ++dt) oacc[h][dt] = (f32x4){0.f, 0.f, 0.f, 0.f}; }
#pragma unroll 1
  for (int w = 3; w >= 0; --w) {
    unsigned bits = __builtin_amdgcn_readfirstlane(uni[w]);
    const unsigned myw = sel[qi * 4 + w];
    while (bits) {
      const int jj = 31 - __builtin_clz(bits); bits &= ~(1u << jj);
      const int j = w * 32 + jj; const bool rowok = (myw >> jj) & 1u;
#pragma unroll 1
      for (int half = 1; half >= 0; --half) {
        const int key0 = j * 64 + half * 32;
        const bf16_t* kp = KS + (long)(b * T_ + key0 + qi) * 128 + g * 64 + quad * 8;
        const bf16_t* vp = VST + (long)(b * 128 + g * 64 + qi) * T_ + key0 + quad * 4;
        nsa_block<2>(qf, oacc, m, l, sl2, inv, kp, vp, 16L * T_, t - (key0 + quad * 4), rowok, asum, bsum);
      }
    }
  }
#pragma unroll
  for (int h = 0; h < 4; ++h) {
    float lt = l[h]; lt += __shfl_xor(lt, 16, 64); lt += __shfl_xor(lt, 32, 64);
    const float sc = NSA_G1 * gp[h * 3 + 1] / fmaxf(lt, 1e-30f);
#pragma unroll
    for (int dt = 0; dt < 4; ++dt) { f32x4* d = (f32x4*)(outl + ((h * 16 + qi) * 64 + (((dt * 4 + quad) ^ qi) << 2))); *d = *d + oacc[h][dt] * sc; }
  }
#pragma unroll
  for (int h = 0; h < 4; ++h) { m[h] = NEGF; l[h] = 0.f;
#pragma unroll
    for (int dt = 0; dt < 4; ++dt) oacc[h][dt] = (f32x4){0.f, 0.f, 0.f, 0.f}; }
  {
    const int kstart = t0 >= 512 ? ((t0 - 511) & ~31) : 0;
    for (int key0 = (t0 + 15) & ~31; key0 >= kstart; key0 -= 32) {
      const bf16_t* kp = KW + (long)(b * T_ + key0 + qi) * 128 + g * 64 + quad * 8;
      const bf16_t* vp = VWT + (long)(b * 128 + g * 64 + qi) * T_ + key0 + quad * 4;
      nsa_block<3>(qf, oacc, m, l, sl2, inv, kp, vp, 16L * T_, t - (key0 + quad * 4), true, asum, bsum);
    }
  }
#pragma unroll
  for (int h = 0; h < 4; ++h) {
    float lt = l[h]; lt += __shfl_xor(lt, 16, 64); lt += __shfl_xor(lt, 32, 64);
    const float sc = NSA_G2 * gp[h * 3 + 2] / fmaxf(lt, 1e-30f);
#pragma unroll
    for (int dt = 0; dt < 4; ++dt) { f32x4* d = (f32x4*)(outl + ((h * 16 + qi) * 64 + (((dt * 4 + quad) ^ qi) << 2))); *d = *d + oacc[h][dt] * sc; }
  }
#pragma unroll
  for (int it = 0; it < 8; ++it) {
    const int id = it * 64 + lane; const int h = id >> 7, rem = id & 127, q2 = rem >> 3, c8 = rem & 7;
    f32x4 a = *(const f32x4*)(outl + ((h * 16 + q2) * 64 + (((2 * c8) ^ q2) << 2)));
    f32x4 bb = *(const f32x4*)(outl + ((h * 16 + q2) * 64 + (((2 * c8 + 1) ^ q2) << 2)));
    float v[8] = {a[0], a[1], a[2], a[3], bb[0], bb[1], bb[2], bb[3]};
    *(u32x4*)(O + ((long)b * T_ + t0 + q2) * 512 + (g * 4 + h) * 64 + c8 * 8) = pack8(v);
  }
}

__device__ void xattn_tile(const Params& P, int wt) {
  const bf16_t* HQ = (const bf16_t*)(P.ws + OFF_D);
  const bf16_t* MK = (const bf16_t*)(P.ws + OFF_MK); const bf16_t* MVT = (const bf16_t*)(P.ws + OFF_MVT);
  bf16_t* OX = (bf16_t*)(P.ws + OFF_D) + (long)M_ * 512;
  const int lane = tidx() & 63, qi = lane & 15, quad = lane >> 4;
  wt = __builtin_amdgcn_readfirstlane(wt);
  const int h = wt & 3; const int row0 = (wt >> 2) * 32; const int b = row0 >> 13;
  bf16x8 qf[2][4];
#pragma unroll
  for (int nt = 0; nt < 2; ++nt)
#pragma unroll
    for (int ks = 0; ks < 4; ++ks) qf[nt][ks] = *(const bf16x8*)(HQ + (long)(row0 + nt * 16 + qi) * 512 + h * 128 + ks * 32 + quad * 8);
  f32x4 oacc[2][8]; float m[2], l[2];
#pragma unroll
  for (int nt = 0; nt < 2; ++nt) { m[nt] = NEGF; l[nt] = 0.f;
#pragma unroll
    for (int dt = 0; dt < 8; ++dt) oacc[nt][dt] = (f32x4){0.f, 0.f, 0.f, 0.f}; }
  for (int blk = 0; blk < 8; ++blk) {
    const int key0 = blk * 32;
    f32x4 s[2][2];
#pragma unroll
    for (int nt = 0; nt < 2; ++nt)
#pragma unroll
      for (int kt = 0; kt < 2; ++kt) s[nt][kt] = (f32x4){0.f, 0.f, 0.f, 0.f};
#pragma unroll
    for (int ks = 0; ks < 4; ++ks) {
#pragma unroll
      for (int kt = 0; kt < 2; ++kt) {
        bf16x8 kf = *(const bf16x8*)(MK + (long)(b * 256 + key0 + kt * 16 + qi) * 512 + h * 128 + ks * 32 + quad * 8);
#pragma unroll
        for (int nt = 0; nt < 2; ++nt) s[nt][kt] = __builtin_amdgcn_mfma_f32_16x16x32_bf16(kf, qf[nt][ks], s[nt][kt], 0, 0, 0);
      }
    }
    bf16x8 pf[2];
#pragma unroll
    for (int nt = 0; nt < 2; ++nt) {
      float ml = NEGF;
#pragma unroll
      for (int kt = 0; kt < 2; ++kt)
#pragma unroll
        for (int r = 0; r < 4; ++r) ml = fmaxf(ml, s[nt][kt][r]);
      ml = fmaxf(ml, __shfl_xor(ml, 16, 64)); ml = fmaxf(ml, __shfl_xor(ml, 32, 64));
      const float mn = fmaxf(m[nt], ml); const float alpha = __builtin_amdgcn_exp2f(m[nt] - mn); m[nt] = mn;
      float p[8]; float ps = 0.f;
#pragma unroll
      for (int kt = 0; kt < 2; ++kt)
#pragma unroll
        for (int r = 0; r < 4; ++r) { p[kt * 4 + r] = __builtin_amdgcn_exp2f(s[nt][kt][r] - mn); ps += p[kt * 4 + r]; }
      l[nt] = l[nt] * alpha + ps;
#pragma unroll
      for (int dt = 0; dt < 8; ++dt) oacc[nt][dt] *= alpha;
      u32x4 pk; pk[0] = pack2(p[0], p[1]); pk[1] = pack2(p[2], p[3]); pk[2] = pack2(p[4], p[5]); pk[3] = pack2(p[6], p[7]);
      pf[nt] = __builtin_bit_cast(bf16x8, pk);
    }
#pragma unroll
    for (int dt = 0; dt < 8; ++dt) {
      const bf16_t* vp = MVT + (long)(b * 512 + h * 128 + dt * 16 + qi) * 256 + key0 + quad * 4;
      u32x2 lo = *(const u32x2*)(vp); u32x2 hi = *(const u32x2*)(vp + 16);
      u32x4 c; c[0] = lo[0]; c[1] = lo[1]; c[2] = hi[0]; c[3] = hi[1];
      const bf16x8 vf = __builtin_bit_cast(bf16x8, c);
#pragma unroll
      for (int nt = 0; nt < 2; ++nt) oacc[nt][dt] = __builtin_amdgcn_mfma_f32_16x16x32_bf16(vf, pf[nt], oacc[nt][dt], 0, 0, 0);
    }
  }
#pragma unroll
  for (int nt = 0; nt < 2; ++nt) {
    float lt = l[nt]; lt += __shfl_xor(lt, 16, 64); lt += __shfl_xor(lt, 32, 64);
    const float iv = 1.f / lt;
#pragma unroll
    for (int dt = 0; dt < 8; ++dt) {
      f32x4 v = oacc[nt][dt] * iv; u32x2 pk; pk[0] = pack2(v[0], v[1]); pk[1] = pack2(v[2], v[3]);
      *(u32x2*)(OX + (long)(row0 + nt * 16 + qi) * 512 + h * 128 + dt * 16 + quad * 4) = pk;
    }
  }
}


#define XB_TMO      128
#define XB_XCNT(j)  (256  + 64 * (j))
#define XB_XSUB(j)  (1280 + 64 * (j))
#define XB_XGEN(j)  (2304 + 64 * (j))
#define XB_TOP      3328
#define XB_TOPGEN   3392
#define XCD_BAR_WORDS 3456
#define XB_SPIN_CAP (1u << 18)
#define LAS __attribute__((address_space(3)))
__device__ __forceinline__ unsigned xb_ld(unsigned* p) { return __hip_atomic_load(p, __ATOMIC_RELAXED, __HIP_MEMORY_SCOPE_AGENT); }
__device__ __forceinline__ unsigned xb_add(unsigned* p, unsigned v) { return __hip_atomic_fetch_add(p, v, __ATOMIC_RELAXED, __HIP_MEMORY_SCOPE_AGENT); }
__device__ __forceinline__ unsigned xb_xcc_id() { return (unsigned)__builtin_amdgcn_s_getreg((3 << 11) | 20) & 0xFu; }
#define XB_SPIN(cond, bar) do { unsigned _sp = 0; while (cond) { __builtin_amdgcn_s_sleep(1); \
    if ((++_sp & 255u) == 0u) { if (xb_ld(&(bar)[XB_TMO])) break; if (_sp > XB_SPIN_CAP) { atomicAdd(&(bar)[XB_TMO], 1u); break; } } } } while (0)
__device__ __forceinline__ void xcd_barrier_complete(unsigned* bar, unsigned x, unsigned& nloc, unsigned& nx) {
  const unsigned G = gridDim.x * gridDim.y * gridDim.z;
  unsigned sum, cnt, mine, sp = 0u;
  for (;;) {
    sum = 0u; cnt = 0u; mine = 0u;
#pragma unroll
    for (unsigned j = 0; j < 16; ++j) { const unsigned c = xb_ld(&bar[XB_XCNT(j)]); sum += c; cnt += (c > 0u) ? 1u : 0u; mine = (j == x) ? c : mine; }
    if (sum == G) break;
    __builtin_amdgcn_s_sleep(1);
    if ((++sp & 255u) == 0u) { if (xb_ld(&bar[XB_TMO])) break; if (sp > XB_SPIN_CAP) { atomicAdd(&bar[XB_TMO], 1u); break; } }
  }
  nloc = mine > 0u ? mine : 1u; nx = cnt > 0u ? cnt : 1u;
}
__device__ __forceinline__ void xcd_barrier(unsigned* bar, unsigned x, volatile LAS unsigned* st) {
  asm volatile("s_waitcnt vmcnt(0)" ::: "memory");
  __syncthreads();
  if (threadIdx.x == 0) {
    __builtin_amdgcn_s_waitcnt(0);
    unsigned nloc = st[0], nx = st[1];
    if (nloc == 0u) { xcd_barrier_complete(bar, x, nloc, nx); st[0] = nloc; st[1] = nx; }
    const unsigned old = xb_add(&bar[XB_XSUB(x)], 1u);
    const unsigned gen = old / nloc;
    if (old + 1u == (gen + 1u) * nloc) {
      __builtin_amdgcn_fence(__ATOMIC_RELEASE, "agent");
      asm volatile("s_waitcnt vmcnt(0)" ::: "memory");
      const unsigned og = xb_add(&bar[XB_TOP], 1u);
      const unsigned tg = og / nx;
      if (og + 1u == (tg + 1u) * nx) xb_add(&bar[XB_TOPGEN], 1u);
      else XB_SPIN(xb_ld(&bar[XB_TOPGEN]) == tg, bar);
      __builtin_amdgcn_fence(__ATOMIC_ACQUIRE, "agent");
      xb_add(&bar[XB_XGEN(x)], 1u);
      asm volatile("s_waitcnt vmcnt(0)" ::: "memory");
    } else {
      XB_SPIN(xb_ld(&bar[XB_XGEN(x)]) == gen, bar);
      __builtin_amdgcn_fence(__ATOMIC_ACQUIRE, "agent");
      asm volatile("s_waitcnt vmcnt(0)" ::: "memory");
    }
  }
  __syncthreads();
}

__device__ void run_phase(const Params& P, int ph, char* smem) {
  char* ws = P.ws; const int tid = tidx();
  switch (ph) {
    case 0: phase0(P, smem); break;
    case 1: phase1(P, smem); break;
    case 2: phase2(P, smem); break;
    case 3: {
      for (int job = blockIdx.x; job < 512; job += gridDim.x) { const int wv = tidx() >> 6; nsa_tile(P, job * 4 + wv, smem + wv * 16896); }
      __syncthreads();
      for (int job = blockIdx.x; job < 512; job += gridDim.x) {
        {
          const int tid = tidx();
          const int s = job; const int bc = s >> 2, g = s & 3;
          RowLin ar{(const bf16_t*)(ws + OFF_WM) + g * 16384, 128};
          RowLin br{(const bf16_t*)(ws + OFF_C + C_GVT) + ((long)bc * 512 + g * 128) * 128, 128};
          const float* bs = P.b_sp + g * 128;
          const bf16_t* U = (const bf16_t*)(ws + OFF_C + C_U) + (long)bc * 128 * 512 + g * 128;
          bf16_t* OS = (bf16_t*)(ws + OFF_D) + (long)M_ * 512 + (long)bc * 128 * 512 + g * 128;
          gemm_tile(smem, ar, br, 2, 64, 64, [&](const float* Cs) {
#pragma unroll 2
            for (int it = 0; it < 8; ++it) {
              int id = it * 256 + tid; int r = id >> 4, c = (id & 15) * 8; float v[8]; ld8(Cs, r, c, v);
              u32x4 d = *(const u32x4*)(U + (long)r * 512 + c); const float bb = bs[r];
#pragma unroll
              for (int i = 0; i < 4; ++i) { v[2 * i] = (v[2 * i] + bb) * bf2f(d[i] & 0xffffu); v[2 * i + 1] = (v[2 * i + 1] + bb) * bf2f(d[i] >> 16); }
              *(u32x4*)(OS + (long)r * 512 + c) = pack8(v);
            }
          });
        }
      }
    } break;
    case 4: {
      float* scr = (float*)(ws + OFF_C + C_SCR) + (long)blockIdx.x * 16384;
      const int xq = blockIdx.x & 7, lq = blockIdx.x >> 3, sq = gridDim.x >> 3;
      for (int t = lq; t < 16 * 8; t += sq) {
        const int mt = xq * 16 + (t & 15), nt = t >> 4, brow = mt * 128, bcol = nt * 128;
        const bf16_t* MG = (const bf16_t*)(ws + OFF_B) + (long)brow * 2048 + bcol;
        RowLin a1{(const bf16_t*)(ws + OFF_D) + (long)brow * 512, 512};
        RowLin b1{(const bf16_t*)(ws + OFF_WPA) + (long)bcol * 512, 512};
        gemm_tile(smem, a1, b1, 8, 64, 64, [&](const float* Cs) {
#pragma unroll 2
          for (int it = 0; it < 8; ++it) {
            int id = it * 256 + tid; int r = id >> 4, c = (id & 15) * 8; float v[8]; ld8(Cs, r, c, v);
            u32x4 d = *(const u32x4*)(MG + (long)r * 2048 + c);
#pragma unroll
            for (int i = 0; i < 4; ++i) { v[2 * i] *= bf2f(d[i] & 0xffffu); v[2 * i + 1] *= bf2f(d[i] >> 16); }
            *(f32x4*)(scr + id * 8) = (f32x4){v[0], v[1], v[2], v[3]}; *(f32x4*)(scr + id * 8 + 4) = (f32x4){v[4], v[5], v[6], v[7]};
          }
        });
        RowLin a2{(const bf16_t*)(ws + OFF_D) + (long)M_ * 512 + (long)brow * 512, 512};
        RowLin b2{(const bf16_t*)(ws + OFF_WPB) + (long)bcol * 512, 512};
        bf16_t* MX = (bf16_t*)(ws + OFF_C + C_MIXED) + (long)brow * 1024 + bcol;
        gemm_tile(smem, a2, b2, 8, 64, 64, [&](const float* Cs) {
#pragma unroll 2
          for (int it = 0; it < 8; ++it) {
            int id = it * 256 + tid; int r = id >> 4, c = (id & 15) * 8; float v[8]; ld8(Cs, r, c, v);
            u32x4 d = *(const u32x4*)(MG + (long)r * 2048 + 1024 + c);
            f32x4 p0 = *(const f32x4*)(scr + id * 8), p1 = *(const f32x4*)(scr + id * 8 + 4);
            float pv[8] = {p0[0], p0[1], p0[2], p0[3], p1[0], p1[1], p1[2], p1[3]};
#pragma unroll
            for (int i = 0; i < 4; ++i) { v[2 * i] = pv[2 * i] + v[2 * i] * bf2f(d[i] & 0xffffu); v[2 * i + 1] = pv[2 * i + 1] + v[2 * i + 1] * bf2f(d[i] >> 16); }
            *(u32x4*)(MX + (long)r * 1024 + c) = pack8(v);
          }
        });
      }
    } break;
    case 5: case 9: case 12: {
      const bf16_t* A; const bf16_t* W; const float* RES; float* DST; int K;
      if (ph == 5) { A = (const bf16_t*)(ws + OFF_C + C_MIXED); W = (const bf16_t*)(ws + OFF_WOUT); RES = P.x; DST = (float*)(ws + OFF_B); K = 1024; }
      else if (ph == 9) { A = (const bf16_t*)(ws + OFF_D) + (long)M_ * 512; W = (const bf16_t*)(ws + OFF_WMO); RES = (const float*)(ws + OFF_B); DST = (float*)(ws + OFF_C + C_H2); K = 512; }
      else { A = (const bf16_t*)(ws + OFF_B); W = (const bf16_t*)(ws + OFF_WDN); RES = (const float*)(ws + OFF_C + C_H2); DST = P.out; K = 2816; }
      const int xq = blockIdx.x & 7, lq = blockIdx.x >> 3, sq = gridDim.x >> 3;
      for (int t = lq; t < 16 * 4; t += sq) {
        const int mt = xq * 16 + (t & 15), nt2 = t >> 4, brow = mt * 128;
        RowLin ar{A + (long)brow * K, K}; RowLin br{W + (long)nt2 * 256 * K, K};
        gemm_tile2(smem, ar, br, K / 64, [&](const float* Cs, int p) {
          const int bcol = nt2 * 256 + p * 128;
          const float* rs = RES + (long)brow * 1024 + bcol; float* ds = DST + (long)brow * 1024 + bcol;
#pragma unroll 4
          for (int it = 0; it < 8; ++it) {
            int id = it * 256 + tid; int r = id >> 4, c = (id & 15) * 8;
            f32x4 a = *(const f32x4*)(Cs + r * CS_LD + c), bq = *(const f32x4*)(Cs + r * CS_LD + c + 4);
            f32x4 r0 = *(const f32x4*)(rs + (long)r * 1024 + c), r1 = *(const f32x4*)(rs + (long)r * 1024 + c + 4);
            const f32x4 h0 = a + r0, h1v = bq + r1;
            *(f32x4*)(ds + (long)r * 1024 + c) = h0; *(f32x4*)(ds + (long)r * 1024 + c + 4) = h1v;
            if (ph != 12) {
              const float* gn = (ph == 5 ? P.norm_mq : P.norm_ffn) + bcol + c;
              const f32x4 g0 = *(const f32x4*)gn, g1 = *(const f32x4*)(gn + 4);
              float v[8] = {h0[0] * g0[0], h0[1] * g0[1], h0[2] * g0[2], h0[3] * g0[3], h1v[0] * g1[0], h1v[1] * g1[1], h1v[2] * g1[2], h1v[3] * g1[3]};
              *(u32x4*)((bf16_t*)(ws + OFF_A) + (long)(brow + r) * 1024 + bcol + c) = pack8(v);
              float ss = (h0[0] * h0[0] + h0[1] * h0[1]) + (h0[2] * h0[2] + h0[3] * h0[3]) + (h1v[0] * h1v[0] + h1v[1] * h1v[1]) + (h1v[2] * h1v[2] + h1v[3] * h1v[3]);
              ss += __shfl_xor(ss, 1, 64); ss += __shfl_xor(ss, 2, 64); ss += __shfl_xor(ss, 4, 64); ss += __shfl_xor(ss, 8, 64);
              if ((tid & 15) == 0) ((float*)(ws + (ph == 5 ? OFF_SSQ1 : OFF_SSQ2)))[(long)(brow + r) * 8 + nt2 * 2 + p] = ss;
            }
          }
        });
      }
    } break;
    case 6: case 10: {
      const float* src = ph == 6 ? (const float*)(ws + OFF_B) : (const float*)(ws + OFF_C + C_H2);
      const float* g = ph == 6 ? P.norm_mq : P.norm_ffn;
      (void)src; (void)g;
    } break;
    case 7: {
      const int xq = blockIdx.x & 7, lq = blockIdx.x >> 3, sq = gridDim.x >> 3;
      for (int t = lq; t < 16 * 4; t += sq) {
        const int mt = xq * 16 + (t & 15), nt = t >> 4, brow = mt * 128;
        RowLin ar{(const bf16_t*)(ws + OFF_A) + (long)brow * 1024, 1024}; RowLin br{(const bf16_t*)(ws + OFF_WMQ) + (long)nt * 128 * 1024, 1024};
        gemm_tile(smem, ar, br, 16, 64, 64, [&](const float* Cs) {
          bf16_t* dq = (bf16_t*)(ws + OFF_D) + (long)brow * 512 + nt * 128; const float* sq1 = (const float*)(ws + OFF_SSQ1) + (long)brow * 8;
#pragma unroll 2
          for (int it = 0; it < 8; ++it) {
            int id = it * 256 + tid; int r = id >> 4, c = (id & 15) * 8; float v[8]; ld8(Cs, r, c, v);
            const f32x4 s0 = *(const f32x4*)(sq1 + r * 8), s1 = *(const f32x4*)(sq1 + r * 8 + 4);
            const float ssum = ((s0[0] + s0[1]) + (s0[2] + s0[3])) + ((s1[0] + s1[1]) + (s1[2] + s1[3]));
            const float rr = rsqrtf(ssum * (1.f / 1024.f) + 1e-6f) * (0.08838834764831845f * LOG2E);
#pragma unroll
            for (int i = 0; i < 8; ++i) v[i] *= rr;
            *(u32x4*)(dq + (long)r * 512 + c) = pack8(v);
          }
        });
      }
    } break;
    case 8: {
      for (int job = blockIdx.x; job < 512; job += gridDim.x) xattn_tile(P, job * 4 + (tid >> 6));
    } break;
    case 11: {
      const int xq = blockIdx.x & 7, lq = blockIdx.x >> 3, sq = gridDim.x >> 3;
      for (int t = lq; t < 16 * 22; t += sq) {
        const int mt = xq * 16 + (t & 15), nt2 = t >> 4, brow = mt * 128;
        RowLin ar{(const bf16_t*)(ws + OFF_A) + (long)brow * 1024, 1024}; RowLin br{(const bf16_t*)(ws + OFF_WGU) + (long)nt2 * 256 * 1024, 1024};
        gemm_tile2(smem, ar, br, 16, [&](const float* Cs, int p) {
          bf16_t* ACT = (bf16_t*)(ws + OFF_B) + (long)brow * 2816 + (nt2 * 2 + p) * 64;
#pragma unroll 2
          for (int it = 0; it < 4; ++it) {
            int id = it * 256 + tid; int r = id >> 3, c = (id & 7) * 8; float gt[8], up[8]; ld8(Cs, r, c, gt); ld8(Cs, r, c + 64, up);
            const float* sq2 = (const float*)(ws + OFF_SSQ2) + (long)(brow + r) * 8;
            const f32x4 s0 = *(const f32x4*)(sq2), s1 = *(const f32x4*)(sq2 + 4);
            const float ssum = ((s0[0] + s0[1]) + (s0[2] + s0[3])) + ((s1[0] + s1[1]) + (s1[2] + s1[3]));
            const float rr = rsqrtf(ssum * (1.f / 1024.f) + 1e-6f);
#pragma unroll
            for (int i = 0; i < 8; ++i) { const float gg = gt[i] * rr; gt[i] = gg * sigm(gg) * (up[i] * rr); }
            *(u32x4*)(ACT + (long)r * 2816 + c) = pack8(gt);
          }
        });
      }
    } break;
    case 13: {
      for (int job = blockIdx.x; job < 1024; job += gridDim.x) { int row = job * 16 + (tid >> 6) * 4; rownorm_rows<true, 4>(P.out + (long)row * 1024, P.norm_final, P.out + (long)row * 1024); }
    } break;
#ifdef PROBE_K
    case 14: {
      const bf16_t* s0 = (const bf16_t*)(ws + PROBE_SRC0); const bf16_t* s1 = (const bf16_t*)(ws + PROBE_SRC1);
      for (long i = (long)blockIdx.x * 256 + tid; i < (long)M_ * 512; i += (long)gridDim.x * 256) {
        long row = i >> 9; int c = (int)(i & 511);
        P.out[row * 1024 + c] = bf2f(s0[i]); P.out[row * 1024 + 512 + c] = bf2f(s1[i]);
      }
    } break;
    case 15: {
      const float* s0 = (const float*)(ws + PROBE_SRC0);
      for (long i = (long)blockIdx.x * 256 + tid; i < (long)M_ * 1024; i += (long)gridDim.x * 256) P.out[i] = s0[i];
    } break;
#endif
  }
}

__global__ void __launch_bounds__(256, 2) fwd_kernel(Params P, int ph_lo, int ph_hi) {
  __shared__ __attribute__((aligned(16))) char smem[73728 + 16];
  volatile LAS unsigned* st = (volatile LAS unsigned*)(smem + 73728);
  const unsigned xcc = xb_xcc_id();
  if (ph_lo < ph_hi) {
    if (threadIdx.x == 0) { st[0] = 0u; st[1] = 0u; }
    __syncthreads();
    if (threadIdx.x == 0) (void)xb_add(&((unsigned*)(P.ws + OFF_BAR))[XB_XCNT(xcc)], 1u);
  }
  if (ph_hi < 0) cg::this_grid().sync();
  for (int ph = ph_lo; ph <= ph_hi; ++ph) {
    const uint64_t __attribute__((address_space(4)))* ka = (const uint64_t __attribute__((address_space(4)))*)__builtin_amdgcn_kernarg_segment_ptr();
    asm volatile("" : "+s"(ka));
    Params Pl; uint64_t* pd = (uint64_t*)&Pl;
#pragma unroll
    for (int i = 0; i < (int)(sizeof(Params) / 8); ++i) pd[i] = ka[i];
    if (ph_lo < ph_hi && (ph == 6 || ph == 10)) continue;
    run_phase(Pl, ph, smem);
    if (ph < ph_hi) xcd_barrier((unsigned*)(Pl.ws + OFF_BAR), xcc, st);
  }
}

extern "C" void kernel_launch(void* const* d_in, const int* in_sizes, int n_in, void* d_out, int out_size, void* d_ws, size_t ws_size,
                              hipStream_t stream) {
  static int grid_blocks = 0;
  if (!grid_blocks) {
    int dev = 0, cus = 0, per_cu = 0;
    hipGetDevice(&dev);
    hipDeviceGetAttribute(&cus, hipDeviceAttributeMultiprocessorCount, dev);
    hipOccupancyMaxActiveBlocksPerMultiprocessor(&per_cu, fwd_kernel, 256, 0);
    if (per_cu > 2) per_cu = 2;
    if (per_cu < 1) per_cu = 1;
    grid_blocks = cus * per_cu;
  }
  if (ws_size < (size_t)WS_NEED) fprintf(stderr, "workspace too small: %zu < %ld\n", ws_size, (long)WS_NEED);
  Params P{};
  const float** pp = (const float**)&P;
  for (int i = 0; i < 27; ++i) pp[i] = (const float*)d_in[i];
  P.out = (float*)d_out; P.ws = (char*)d_ws;
#if ONE_LAUNCH
  hipMemsetAsync((char*)d_ws + OFF_BAR, 0, XCD_BAR_WORDS * 4, stream);
#ifdef PROBE_K
  int lo = 0, hi = PROBE_DUMP;
#else
  int lo = 0, hi = 13;
#endif
  void* args[] = {&P, &lo, &hi};
  hipError_t e = hipLaunchCooperativeKernel((void*)fwd_kernel, dim3(grid_blocks), dim3(256), args, 0, stream);
  if (e != hipSuccess) fprintf(stderr, "cooperative launch failed: %s (grid %d)\n", hipGetErrorString(e), grid_blocks);
#else
  for (int ph = 0; ph <= 13; ++ph) fwd_kernel<<<grid_blocks, 256, 0, stream>>>(P, ph, ph);
#endif
}
```

```cpp
#include <hip/hip_runtime.h>
#include <hip/hip_cooperative_groups.h>
#include <stdint.h>
#include <stdio.h>
namespace cg = cooperative_groups;

#ifndef NSA_G0
#define NSA_G0 1.f
#define NSA_G1 1.f
#define NSA_G2 1.f
#endif
#ifndef ONE_LAUNCH
#define ONE_LAUNCH 1
#endif

typedef unsigned short bf16_t;
using bf16x8 = __attribute__((ext_vector_type(8))) short;
using f32x4 = __attribute__((ext_vector_type(4))) float;
using u32x4 = __attribute__((ext_vector_type(4))) unsigned;
using u32x2 = __attribute__((ext_vector_type(2))) unsigned;

#define T_ 8192
#define M_ 16384
#define NEGF (-1e30f)
#define LOG2E 1.4426950408889634f

constexpr long OFF_W1 = 0;
constexpr long OFF_WMKV = OFF_W1 + 9175040;
constexpr long OFF_WPA = OFF_WMKV + 2097152;
constexpr long OFF_WPB = OFF_WPA + 1048576;
constexpr long OFF_WOUT = OFF_WPB + 1048576;
constexpr long OFF_WMQ = OFF_WOUT + 2097152;
constexpr long OFF_WMO = OFF_WMQ + 1048576;
constexpr long OFF_WGU = OFF_WMO + 1048576;
constexpr long OFF_WDN = OFF_WGU + 11534336;
constexpr long OFF_WCK1 = OFF_WDN + 5767168;
constexpr long OFF_WCV1 = OFF_WCK1 + 524288;
constexpr long OFF_WM = OFF_WCV1 + 524288;
constexpr long OFF_BIAS1 = OFF_WM + 131072;
constexpr long OFF_MEMN = OFF_BIAS1 + 1024;
constexpr long OFF_MK = OFF_MEMN + 1048576;
constexpr long OFF_MVT = OFF_MK + 524288;
constexpr long OFF_KCMP = OFF_MVT + 524288;
constexpr long OFF_VCT = OFF_KCMP + 262144;
constexpr long OFF_A = OFF_VCT + 262144;
constexpr long OFF_B = OFF_A + 33554432;
constexpr long OFF_D = OFF_B + 67108864;
constexpr long OFF_C = OFF_D + 33554432;
constexpr long C_Q = 0, C_U = 16777216, C_GVT = 33554432, C_KC = 50331648, C_VC = 54525952, C_KS = 58720256,
               C_KW = 62914560, C_VST = 67108864, C_VWT = 71303168, C_GATES = 75497472;
constexpr long C_MIXED = 0, C_SCR = 33554432, C_H2 = 0;
constexpr long OFF_BAR = OFF_C + 77070336;
constexpr long OFF_SSQ1 = OFF_BAR + 16384;
constexpr long OFF_SSQ2 = OFF_SSQ1 + 524288;
constexpr long WS_NEED = OFF_SSQ2 + 524288;

struct Params {
  const float *x, *mem, *norm_mix, *w_in, *w_ck1, *w_ck2, *w_cv1, *w_cv2, *pe_k, *pe_v, *ln_sgu, *w_sp, *b_sp,
      *w_pa, *w_pb, *w_merge, *b_merge, *w_out, *norm_mq, *norm_mkv, *w_mq, *w_mkv, *w_mo, *norm_ffn, *w_gu, *w_dn, *norm_final;
  float* out;
  char* ws;
};

__device__ __forceinline__ int tidx() { int t = threadIdx.x; asm volatile("" : "+v"(t)); return t; }
__device__ __forceinline__ unsigned f2bf(float f) { unsigned u = __float_as_uint(f); u += 0x7fffu + ((u >> 16) & 1u); return u >> 16; }
__device__ __forceinline__ unsigned pack2(float a, float b) { unsigned r; asm("v_cvt_pk_bf16_f32 %0, %1, %2" : "=v"(r) : "v"(a), "v"(b)); return r; }
__device__ __forceinline__ float bf2f(unsigned h) { return __uint_as_float(h << 16); }
__device__ __forceinline__ float gelu_tanh(float x) { float u = 0.7978845608028654f * (x + 0.044715f * x * x * x); return x / (1.f + __expf(-2.f * u)); }
__device__ __forceinline__ float sigm(float x) { return 1.f / (1.f + __expf(-x)); }
__device__ __forceinline__ float wave_sum(float v) {
#pragma unroll
  for (int o = 32; o > 0; o >>= 1) v += __shfl_xor(v, o, 64);
  return v;
}
__device__ __forceinline__ u32x4 pack8(const float (&v)[8]) {
  u32x4 r; r[0] = pack2(v[0], v[1]); r[1] = pack2(v[2], v[3]); r[2] = pack2(v[4], v[5]); r[3] = pack2(v[6], v[7]); return r;
}

__device__ __forceinline__ int lds_byte(int r, int c) {
  int st = (r >> 4) * 2 + (c >> 5), rr = r & 15, cc = c & 31, ob = rr * 64 + cc * 2;
  return st * 1024 + (ob ^ (((ob >> 9) & 1) << 5));
}
__device__ __forceinline__ void stage_rc(int b, int& R, int& C) {
  int st = b >> 10, sb = b & 1023, swz = sb ^ (((sb >> 9) & 1) << 5);
  R = (st >> 1) * 16 + (swz >> 6); C = (st & 1) * 32 + ((swz & 63) >> 1);
}

#define CS_LD 132
__device__ __forceinline__ void ld8(const float* Cs, int r, int c, float (&v)[8]) {
  f32x4 a = *(const f32x4*)(Cs + r * CS_LD + c); f32x4 b = *(const f32x4*)(Cs + r * CS_LD + c + 4);
  v[0] = a[0]; v[1] = a[1]; v[2] = a[2]; v[3] = a[3]; v[4] = b[0]; v[5] = b[1]; v[6] = b[2]; v[7] = b[3];
}
__device__ __forceinline__ void ld8T(const float* Cs, int r8, int c, float (&v)[8]) {
#pragma unroll
  for (int i = 0; i < 8; ++i) v[i] = Cs[(r8 + i) * CS_LD + c];
}

struct RowLin {
  const bf16_t* base; long ld;
  __device__ __forceinline__ const bf16_t* operator()(int r) const { return base + (long)r * ld; }
};
struct RowCmp {
  const bf16_t* base; int brow;
  __device__ __forceinline__ const bf16_t* operator()(int r) const {
    int R = brow + r; int b = R >> 10, rem = R & 1023, i = rem >> 1, g = rem & 1; if (i > 510) i = 510;
    return base + ((long)(b * T_ + 16 * i) * 128 + g * 64);
  }
};

template <int AUX = 0, class ARow, class BRow, class Epi>
__device__ __forceinline__ void gemm_tile(char* smem, ARow arow, BRow brow, int nkt, int kstepA, int kstepB, Epi epi) {
  const int tid = tidx(), lane = tid & 63, wave = tid >> 6, wr = wave >> 1, wc = wave & 1, fr = lane & 15, fq = lane >> 4;
  const bf16_t* pa[4]; const bf16_t* pb[4];
#pragma unroll
  for (int i = 0; i < 4; ++i) { int b = tid * 16 + i * 4096; int R, C; stage_rc(b, R, C); pa[i] = arow(R) + C; pb[i] = brow(R) + C; }
  f32x4 acc[4][4];
#pragma unroll
  for (int m = 0; m < 4; ++m)
#pragma unroll
    for (int n = 0; n < 4; ++n) acc[m][n] = (f32x4){0.f, 0.f, 0.f, 0.f};
  {
#pragma unroll
    for (int i = 0; i < 4; ++i) {
      __builtin_amdgcn_global_load_lds((const unsigned*)(pa[i]), (unsigned*)(smem + tid * 16 + i * 4096), 16, 0, AUX);
      __builtin_amdgcn_global_load_lds((const unsigned*)(pb[i]), (unsigned*)(smem + 16384 + tid * 16 + i * 4096), 16, 0, AUX);
    }
  }
  for (int kt = 0; kt < nkt; ++kt) {
    asm volatile("s_waitcnt vmcnt(0)" ::: "memory");
    __syncthreads();
    if (kt + 1 < nkt) {
      char* la = smem + ((kt + 1) & 1) * 32768;
#pragma unroll
      for (int i = 0; i < 4; ++i) {
        __builtin_amdgcn_global_load_lds((const unsigned*)(pa[i] + (long)(kt + 1) * kstepA), (unsigned*)(la + tid * 16 + i * 4096), 16, 0, AUX);
        __builtin_amdgcn_global_load_lds((const unsigned*)(pb[i] + (long)(kt + 1) * kstepB), (unsigned*)(la + 16384 + tid * 16 + i * 4096), 16, 0, AUX);
      }
    }
    const char* la = smem + (kt & 1) * 32768; const char* lb = la + 16384;
#pragma unroll
    for (int ks = 0; ks < 2; ++ks) {
      bf16x8 a[4], b[4];
#pragma unroll
      for (int m = 0; m < 4; ++m) a[m] = *(const bf16x8*)(la + lds_byte(wr * 64 + m * 16 + fr, ks * 32 + fq * 8));
#pragma unroll
      for (int n = 0; n < 4; ++n) b[n] = *(const bf16x8*)(lb + lds_byte(wc * 64 + n * 16 + fr, ks * 32 + fq * 8));
#pragma unroll
      for (int m = 0; m < 4; ++m)
#pragma unroll
        for (int n = 0; n < 4; ++n) acc[m][n] = __builtin_amdgcn_mfma_f32_16x16x32_bf16(a[m], b[n], acc[m][n], 0, 0, 0);
    }
  }
  __syncthreads();
  float* Cs = (float*)smem;
#pragma unroll
  for (int m = 0; m < 4; ++m)
#pragma unroll
    for (int n = 0; n < 4; ++n)
#pragma unroll
      for (int r = 0; r < 4; ++r) Cs[(wr * 64 + m * 16 + fq * 4 + r) * CS_LD + wc * 64 + n * 16 + fr] = acc[m][n][r];
  __syncthreads();
  epi(Cs);
  __syncthreads();
}

template <class F>
__device__ __forceinline__ void store_rows_bf16(const float* Cs, bf16_t* dst, long ld, F f) {
#pragma unroll 2
  for (int it = 0; it < 8; ++it) {
    int id = it * 256 + tidx(); int r = id >> 4, c = (id & 15) * 8;
    float v[8]; ld8(Cs, r, c, v);
#pragma unroll
    for (int i = 0; i < 8; ++i) v[i] = f(v[i], c + i);
    *(u32x4*)(dst + (long)r * ld + c) = pack8(v);
  }
}
template <class F>
__device__ __forceinline__ void store_T_bf16(const float* Cs, bf16_t* dst, long cstride, F f) {
#pragma unroll 2
  for (int it = 0; it < 8; ++it) {
    int id = it * 256 + tidx(); int c = id >> 4, r8 = (id & 15) * 8;
    float v[8]; ld8T(Cs, r8, c, v);
#pragma unroll
    for (int i = 0; i < 8; ++i) v[i] = f(v[i]);
    *(u32x4*)(dst + (long)c * cstride + r8) = pack8(v);
  }
}


__device__ __forceinline__ int lds_byte32(int r, int c) { int rr = r & 15; return (r >> 4) * 1024 + rr * 64 + ((((c >> 3) ^ ((-(rr >> 2)) & 3)) & 3) << 4); }
__device__ __forceinline__ void stage_rc32(int b, int& R, int& C) { int st = b >> 10, sb = b & 1023, rr = sb >> 6, cp = (sb >> 4) & 3; R = st * 16 + rr; C = ((cp ^ ((-(rr >> 2)) & 3)) & 3) * 8; }
struct RowClamp {
  const bf16_t* base; long ld; int maxr;
  __device__ __forceinline__ const bf16_t* operator()(int r) const { return base + (long)(r < maxr ? r : maxr) * ld; }
};
__device__ __forceinline__ int lds_byte64(int r, int c) { int rr = r & 15; return (r >> 4) * 2048 + rr * 128 + ((((c >> 3) ^ (rr >> 1)) & 7) << 4); }
__device__ __forceinline__ void stage_rc64(int b, int& R, int& C) { int st = b >> 11, sb = b & 2047, rr = sb >> 7, cp = (sb >> 4) & 7; R = st * 16 + rr; C = ((cp ^ (rr >> 1)) & 7) * 8; }
template <class ARow, class BRow, class Epi>
__device__ __forceinline__ void gemm_tile2(char* smem, ARow arow, BRow brow, int nkt, Epi epi) {
  const int tid = tidx(), lane = tid & 63, wave = tid >> 6, wr = wave >> 1, wc = wave & 1, fr = lane & 15, fq = lane >> 4;
  const bf16_t* pa[4]; const bf16_t* pb[8];
#pragma unroll
  for (int i = 0; i < 4; ++i) { int R, C; stage_rc64(tid * 16 + i * 4096, R, C); pa[i] = arow(R) + C; }
#pragma unroll
  for (int i = 0; i < 8; ++i) { int R, C; stage_rc64(tid * 16 + i * 4096, R, C); pb[i] = brow(R) + C; }
  f32x4 acc[4][8];
#pragma unroll
  for (int m = 0; m < 4; ++m)
#pragma unroll
    for (int n = 0; n < 8; ++n) acc[m][n] = (f32x4){0.f, 0.f, 0.f, 0.f};
  for (int kt = 0; kt < nkt; ++kt) {
    __syncthreads();
#pragma unroll
    for (int i = 0; i < 4; ++i) __builtin_amdgcn_global_load_lds((const unsigned*)(pa[i] + (long)kt * 64), (unsigned*)(smem + tid * 16 + i * 4096), 16, 0, 0);
#pragma unroll
    for (int i = 0; i < 8; ++i) __builtin_amdgcn_global_load_lds((const unsigned*)(pb[i] + (long)kt * 64), (unsigned*)(smem + 16384 + tid * 16 + i * 4096), 16, 0, 0);
    asm volatile("s_waitcnt vmcnt(0)" ::: "memory");
    __syncthreads();
    {
      const char* pA = smem + lds_byte64(wr * 64 + fr, fq * 8);
      const char* pB = smem + 16384 + lds_byte64(wc * 128 + fr, fq * 8);
      const int k1 = lds_byte64(fr, 32 + fq * 8) - lds_byte64(fr, fq * 8);
      bf16x8 a[4], bl[4], bh[4];
#define SB __builtin_amdgcn_sched_barrier(0)
#define LDA(K) _Pragma("unroll") for (int m = 0; m < 4; ++m) a[m] = *(const bf16x8*)(pA + m * 2048 + (K))
#define LDBL(K) _Pragma("unroll") for (int n = 0; n < 4; ++n) bl[n] = *(const bf16x8*)(pB + n * 2048 + (K))
#define LDBH(K) _Pragma("unroll") for (int n = 0; n < 4; ++n) bh[n] = *(const bf16x8*)(pB + (n + 4) * 2048 + (K))
#define MML _Pragma("unroll") for (int m = 0; m < 4; ++m) _Pragma("unroll") for (int n = 0; n < 4; ++n) acc[m][n] = __builtin_amdgcn_mfma_f32_16x16x32_bf16(a[m], bl[n], acc[m][n], 0, 0, 0)
#define MMH _Pragma("unroll") for (int m = 0; m < 4; ++m) _Pragma("unroll") for (int n = 0; n < 4; ++n) acc[m][n + 4] = __builtin_amdgcn_mfma_f32_16x16x32_bf16(a[m], bh[n], acc[m][n + 4], 0, 0, 0)
      LDA(0); LDBL(0); SB;
      LDBH(0); SB;
      MML; SB;
      LDBL(k1); SB;
      MMH; SB;
      LDA(k1); SB;
      LDBH(k1); SB;
      MML; SB;
      MMH; SB;
#undef SB
#undef LDA
#undef LDBL
#undef LDBH
#undef MML
#undef MMH
    }
  }
  float* Cs = (float*)smem;
#pragma unroll
  for (int p = 0; p < 2; ++p) {
    __syncthreads();
    if (wc == p) {
#pragma unroll
      for (int m = 0; m < 4; ++m)
#pragma unroll
        for (int n = 0; n < 8; ++n)
#pragma unroll
          for (int r = 0; r < 4; ++r) Cs[(wr * 64 + m * 16 + fq * 4 + r) * CS_LD + n * 16 + fr] = acc[m][n][r];
    }
    __syncthreads();
    epi(Cs, p);
  }
  __syncthreads();
}

template <int MODE>
__device__ __forceinline__ void transpose_tile(const float* W, int Nsrc, bf16_t* Wt, int Kd, int k0, int n0, float* lds) {
  const int tid = tidx();
  {
    int tx = tid & 63, ty = tid >> 6; int np = n0 + tx; int sc;
    if (MODE == 0) sc = np < Nsrc ? np : -1;
    else { int x = np & 127, tl = np >> 7; sc = x < 64 ? tl * 64 + x : 2816 + tl * 64 + x - 64; }
    float v[32];
#pragma unroll
    for (int i = 0; i < 32; ++i) v[i] = sc >= 0 ? W[(long)(k0 + ty + 4 * i) * Nsrc + sc] : 0.f;
#pragma unroll
    for (int i = 0; i < 32; ++i) lds[(ty + 4 * i) * 65 + tx] = v[i];
  }
  __syncthreads();
  {
    int nrow = tid >> 2, kseg = (tid & 3) * 32;
#pragma unroll
    for (int q = 0; q < 4; ++q) {
      float v[8];
#pragma unroll
      for (int i = 0; i < 8; ++i) v[i] = lds[(kseg + q * 8 + i) * 65 + nrow];
      *(u32x4*)(Wt + (long)(n0 + nrow) * Kd + k0 + kseg + q * 8) = pack8(v);
    }
  }
  __syncthreads();
}

template <bool OUTF, int NR>
__device__ __forceinline__ void rownorm_rows(const float* src, const float* g, void* dst) {
  const int lane = tidx() & 63;
  f32x4 v[NR][4];
#pragma unroll
  for (int r = 0; r < NR; ++r)
#pragma unroll
    for (int i = 0; i < 4; ++i) v[r][i] = *(const f32x4*)(src + (long)r * 1024 + i * 256 + lane * 4);
  f32x4 gg[4];
#pragma unroll
  for (int i = 0; i < 4; ++i) gg[i] = *(const f32x4*)(g + i * 256 + lane * 4);
#pragma unroll
  for (int r = 0; r < NR; ++r) {
    float ss = 0.f;
#pragma unroll
    for (int i = 0; i < 4; ++i) ss += v[r][i][0] * v[r][i][0] + v[r][i][1] * v[r][i][1] + v[r][i][2] * v[r][i][2] + v[r][i][3] * v[r][i][3];
    ss = wave_sum(ss);
    const float rr = rsqrtf(ss * (1.f / 1024.f) + 1e-6f);
#pragma unroll
    for (int i = 0; i < 4; ++i) {
      float o0 = v[r][i][0] * rr * gg[i][0], o1 = v[r][i][1] * rr * gg[i][1], o2 = v[r][i][2] * rr * gg[i][2], o3 = v[r][i][3] * rr * gg[i][3];
      if (OUTF) { *(f32x4*)((float*)dst + (long)r * 1024 + i * 256 + lane * 4) = (f32x4){o0, o1, o2, o3}; }
      else { u32x2 p; p[0] = pack2(o0, o1); p[1] = pack2(o2, o3); *(u32x2*)((bf16_t*)dst + (long)r * 1024 + i * 256 + lane * 4) = p; }
    }
  }
}

__device__ void phase0(const Params& P, char* smem) {
  float* lds = (float*)smem;
  const int tid = tidx();
  const int NJ = 8 + 1024 + 32 + 32 + 2192;
  for (int job = blockIdx.x; job < NJ; job += gridDim.x) {
    int j = job;
    if (j < 8) {
      int n = j * 32 + (tid & 31), sl = tid >> 5; int kv = n >> 7, nn = n & 127;
      const float* pe = kv ? P.pe_v : P.pe_k; const float* w1 = kv ? P.w_cv1 : P.w_ck1;
      float s = 0.f;
      for (int k = sl * 256; k < sl * 256 + 256; ++k) s += pe[k] * w1[(long)k * 128 + nn];
      lds[sl * 32 + (tid & 31)] = s;
      __syncthreads();
      if (tid < 32) { float t = 0.f; for (int q = 0; q < 8; ++q) t += lds[q * 32 + tid]; ((float*)(P.ws + OFF_BIAS1))[j * 32 + tid] = t; }
      __syncthreads();
      continue;
    }
    j -= 8;
    if (j < 1024) { int row = j * 16 + (tid >> 6) * 4; rownorm_rows<false, 4>(P.x + (long)row * 1024, P.norm_mix, (bf16_t*)(P.ws + OFF_A) + (long)row * 1024); continue; }
    j -= 1024;
    if (j < 32) { int row = j * 16 + (tid >> 6) * 4; rownorm_rows<false, 4>(P.mem + (long)row * 1024, P.norm_mkv, (bf16_t*)(P.ws + OFF_MEMN) + (long)row * 1024); continue; }
    j -= 32;
    if (j < 32) {
      int e0 = j * 2048 + tid * 8; float v[8];
#pragma unroll
      for (int i = 0; i < 8; ++i) { int e = e0 + i; int t = (e >> 7) & 127, s = e & 127; v[i] = s <= t ? P.w_sp[e] : 0.f; }
      *(u32x4*)((bf16_t*)(P.ws + OFF_WM) + e0) = pack8(v);
      continue;
    }
    j -= 32;
#define TRJ(KT, NT, W, NSRC, WT, KD, MODE) \
    if (j < (KT) * (NT)) { transpose_tile<MODE>(W, NSRC, (bf16_t*)(P.ws + (WT)), KD, (j % (KT)) * 128, (j / (KT)) * 64, lds); continue; } \
    j -= (KT) * (NT);
    TRJ(8, 88, P.w_gu, 5632, OFF_WGU, 1024, 1)
    TRJ(22, 16, P.w_dn, 1024, OFF_WDN, 2816, 0)
    TRJ(8, 38, P.w_in, 2328, OFF_W1, 1024, 0)
    TRJ(8, 32, P.w_merge, 2048, OFF_W1 + 2432L * 1024 * 2, 1024, 0)
    TRJ(8, 16, P.w_mkv, 1024, OFF_WMKV, 1024, 0)
    TRJ(8, 16, P.w_out, 1024, OFF_WOUT, 1024, 0)
    TRJ(4, 16, P.w_pa, 1024, OFF_WPA, 512, 0)
    TRJ(4, 16, P.w_pb, 1024, OFF_WPB, 512, 0)
    TRJ(8, 8, P.w_mq, 512, OFF_WMQ, 1024, 0)
    TRJ(4, 16, P.w_mo, 1024, OFF_WMO, 512, 0)
    TRJ(16, 2, P.w_ck1, 128, OFF_WCK1, 2048, 0)
    TRJ(16, 2, P.w_cv1, 128, OFF_WCV1, 2048, 0)
#undef TRJ
  }
}

__device__ void phase1(const Params& P, char* smem) {
  char* ws = P.ws;
  const int NG1 = 128 * 18;
  const int xq = blockIdx.x & 7, lq = blockIdx.x >> 3, sq = gridDim.x >> 3;
  for (int t = lq; t < 16 * 12; t += sq) {
    {
      const int mt = xq * 16 + (t & 15), nt2 = t >> 4; const int brow = mt * 128;
      RowLin ar{(const bf16_t*)(ws + OFF_A) + (long)brow * 1024, 1024};
      RowClamp br{(const bf16_t*)(ws + OFF_W1) + (long)nt2 * 256 * 1024, 1024, 4479 - nt2 * 256};
      gemm_tile2(smem, ar, br, 16, [&](const float* Cs, int p) {
        const int nt = nt2 * 2 + p; if (nt >= 35) return;
        char* C = ws + OFF_C;
        if (nt < 4) {
          store_rows_bf16(Cs, (bf16_t*)(C + C_Q) + (long)brow * 512 + nt * 128, 512, [](float v, int) { return v * (0.125f * LOG2E); });
        } else if (nt == 4 || nt == 5 || nt == 6 || nt == 8) {
          long off = nt == 4 ? C_KC : nt == 5 ? C_VC : nt == 6 ? C_KS : C_KW;
          store_rows_bf16(Cs, (bf16_t*)(C + off) + (long)brow * 128, 128, [](float v, int) { return v; });
        } else if (nt == 7 || nt == 9) {
          long off = nt == 7 ? C_VST : C_VWT; int b = brow >> 13, tl = brow & 8191;
          store_T_bf16(Cs, (bf16_t*)(C + off) + (long)b * 128 * T_ + tl, T_, [](float v) { return v; });
        } else if (nt < 14) {
          store_rows_bf16(Cs, (bf16_t*)(C + C_U) + (long)brow * 512 + (nt - 10) * 128, 512, [](float v, int) { return gelu_tanh(v); });
        } else if (nt < 18) {
          store_T_bf16(Cs, (bf16_t*)(C + C_GVT) + ((long)(brow >> 7) * 512 + (nt - 14) * 128) * 128, 128, [](float v) { return gelu_tanh(v); });
        } else if (nt == 18) {
          float* gates = (float*)(C + C_GATES);
          for (int id = tidx(); id < 128 * 24; id += 256) { int r = id / 24, c = id % 24; gates[(long)(brow + r) * 24 + c] = sigm(Cs[r * CS_LD + c]); }
        } else {
          const float* bm = P.b_merge + (nt - 19) * 128;
          store_rows_bf16(Cs, (bf16_t*)(ws + OFF_B) + (long)brow * 2048 + (nt - 19) * 128, 2048, [bm](float v, int c) { return sigm(v + bm[c]); });
        }
      });
    }
  }
}

__device__ void phase2(const Params& P, char* smem) {
  char* ws = P.ws; const int tid = tidx();
  for (int job = blockIdx.x; job < 32 + 128; job += gridDim.x) {
    if (job < 32) {
      const int kv = job >> 4, mt = job & 15, brow = mt * 128;
      RowCmp ar{(const bf16_t*)(ws + OFF_C + (kv ? C_VC : C_KC)), brow};
      RowLin br{(const bf16_t*)(ws + (kv ? OFF_WCV1 : OFF_WCK1)), 2048};
      const float* bias1 = (const float*)(ws + OFF_BIAS1) + kv * 128;
      const float* w2 = kv ? P.w_cv2 : P.w_ck2;
      gemm_tile(smem, ar, br, 32, 128, 64, [&](const float* Csc) {
        float* Cs = (float*)Csc;
        for (int it = 0; it < 64; ++it) { int id = it * 256 + tid; int r = id >> 7, n = id & 127; Cs[r * CS_LD + n] = gelu_tanh(Cs[r * CS_LD + n] + bias1[n]); }
        __syncthreads();
        const int r = tid >> 1, half = tid & 1;
        float acc[32];
#pragma unroll
        for (int i = 0; i < 32; ++i) acc[i] = 0.f;
        for (int n = 0; n < 128; ++n) {
          float h = Cs[r * CS_LD + n]; const float* wr = w2 + n * 64 + half * 32;
#pragma unroll
          for (int q = 0; q < 8; ++q) { f32x4 w = *(const f32x4*)(wr + q * 4); acc[q * 4] += h * w[0]; acc[q * 4 + 1] += h * w[1]; acc[q * 4 + 2] += h * w[2]; acc[q * 4 + 3] += h * w[3]; }
        }
        const int R = brow + r; const int b = R >> 10, rem = R & 1023, i = rem >> 1, g = rem & 1;
        if (i >= 511) {
#pragma unroll
          for (int q = 0; q < 32; ++q) acc[q] = 0.f;
        }
        if (kv == 0) {
          bf16_t* dst = (bf16_t*)(ws + OFF_KCMP) + (long)(b * 512 + i) * 128 + g * 64 + half * 32;
#pragma unroll
          for (int q = 0; q < 4; ++q) { float v[8];
#pragma unroll
            for (int e = 0; e < 8; ++e) v[e] = acc[q * 8 + e];
            *(u32x4*)(dst + q * 8) = pack8(v); }
        } else {
          bf16_t* dst = (bf16_t*)(ws + OFF_VCT) + ((long)(b * 128 + g * 64 + half * 32)) * 512 + i;
#pragma unroll
          for (int q = 0; q < 32; ++q) dst[(long)q * 512] = (bf16_t)f2bf(acc[q]);
        }
      });
    } else {
      const int bc = job - 32; bf16_t* base = (bf16_t*)(ws + OFF_C + C_GVT) + (long)bc * 512 * 128;
      float* ssum = (float*)smem; float* ssq = ssum + 128;
      float* psum = ssum + 256; float* psq = psum + 16 * 128;
      const int cs = tid >> 4, s8 = (tid & 15) * 8;
      float a[8], q[8];
#pragma unroll
      for (int i = 0; i < 8; ++i) { a[i] = 0.f; q[i] = 0.f; }
      for (int it = 0; it < 32; ++it) {
        u32x4 d = *(const u32x4*)(base + (long)(it * 16 + cs) * 128 + s8);
#pragma unroll
        for (int i = 0; i < 4; ++i) { float lo = bf2f(d[i] & 0xffffu), hi = bf2f(d[i] >> 16); a[2 * i] += lo; q[2 * i] += lo * lo; a[2 * i + 1] += hi; q[2 * i + 1] += hi * hi; }
      }
#pragma unroll
      for (int i = 0; i < 8; ++i) { psum[cs * 128 + s8 + i] = a[i]; psq[cs * 128 + s8 + i] = q[i]; }
      __syncthreads();
      if (tid < 128) {
        float su = 0.f, sq = 0.f;
        for (int c = 0; c < 16; ++c) { su += psum[c * 128 + tid]; sq += psq[c * 128 + tid]; }
        float mean_t = su * (1.f / 512.f); float var = sq * (1.f / 512.f) - mean_t * mean_t; if (var < 0.f) var = 0.f;
        ssum[tid] = mean_t; ssq[tid] = rsqrtf(var + 1e-6f);
      }
      __syncthreads();
      float mean[8], rs[8];
#pragma unroll
      for (int i = 0; i < 8; ++i) { mean[i] = ssum[s8 + i]; rs[i] = ssq[s8 + i]; }
      for (int it = 0; it < 32; ++it) {
        int ch = it * 16 + cs; float gg = P.ln_sgu[ch];
        u32x4 d = *(const u32x4*)(base + (long)ch * 128 + s8); float v[8];
#pragma unroll
        for (int i = 0; i < 4; ++i) { v[2 * i] = bf2f(d[i] & 0xffffu); v[2 * i + 1] = bf2f(d[i] >> 16); }
#pragma unroll
        for (int i = 0; i < 8; ++i) v[i] = (v[i] - mean[i]) * rs[i] * gg;
        *(u32x4*)(base + (long)ch * 128 + s8) = pack8(v);
      }
      __syncthreads();
    }
  }
  if (blockIdx.x >= 32) {
    for (int mtile = blockIdx.x - 32; mtile < 768 + 32; mtile += gridDim.x - 32) {
      if (mtile >= 768) {
        const int j = mtile - 768; const int mt = j >> 3, nt = j & 7; const int brow = mt * 128;
        RowLin ar{(const bf16_t*)(ws + OFF_MEMN) + (long)brow * 1024, 1024};
        RowLin br{(const bf16_t*)(ws + OFF_WMKV) + (long)nt * 128 * 1024, 1024};
        gemm_tile(smem, ar, br, 16, 64, 64, [&](const float* Cs) {
          if (nt < 4) store_rows_bf16(Cs, (bf16_t*)(ws + OFF_MK) + (long)brow * 512 + nt * 128, 512, [](float v, int) { return v; });
          else { int b = mt >> 1, n0 = (mt & 1) * 128; store_T_bf16(Cs, (bf16_t*)(ws + OFF_MVT) + ((long)b * 512 + (nt - 4) * 128) * 256 + n0, 256, [](float v) { return v; }); }
        });
        continue;
      }
      const int mt = mtile & 127, nt2 = 12 + (mtile >> 7), brow = mt * 128;
      RowLin ar{(const bf16_t*)(ws + OFF_A) + (long)brow * 1024, 1024};
      RowClamp br{(const bf16_t*)(ws + OFF_W1) + (long)nt2 * 256 * 1024, 1024, 4479 - nt2 * 256};
      gemm_tile2(smem, ar, br, 16, [&](const float* Cs, int p) {
        const int nt = nt2 * 2 + p; if (nt >= 35) return;
        const float* bm = P.b_merge + (nt - 19) * 128;
        store_rows_bf16(Cs, (bf16_t*)(ws + OFF_B) + (long)brow * 2048 + (nt - 19) * 128, 2048, [bm](float v, int c) { return sigm(v + bm[c]); });
      });
    }
  }
}

template <int MODE>
__device__ __forceinline__ void nsa_block(const bf16x8 (&qf)[4][2], f32x4 (&oacc)[4][4], float (&m)[4], float (&l)[4],
                                          const float (&sl2)[4], const float (&inv)[4], const bf16_t* kp, const bf16_t* vp, long vdt,
                                          int dist0, bool rowok, float (&asum)[2], float (&bsum)[2]) {
  constexpr int DSTEP = (MODE <= 1) ? 16 : 1;
  bf16x8 kf[2][2];
#pragma unroll
  for (int kt = 0; kt < 2; ++kt)
#pragma unroll
    for (int ks = 0; ks < 2; ++ks) kf[kt][ks] = *(const bf16x8*)(kp + kt * 16 * 128 + ks * 32);
  bf16x8 vf[4];
  if (MODE != 0) {
#pragma unroll
    for (int dt = 0; dt < 4; ++dt) {
      u32x2 lo = *(const u32x2*)(vp + dt * vdt); u32x2 hi = *(const u32x2*)(vp + dt * vdt + 16);
      u32x4 c; c[0] = lo[0]; c[1] = lo[1]; c[2] = hi[0]; c[3] = hi[1];
      vf[dt] = __builtin_bit_cast(bf16x8, c);
    }
  }
  const float fd0 = (float)dist0;
#pragma unroll
  for (int h = 0; h < 4; ++h) {
    f32x4 s[2];
#pragma unroll
    for (int kt = 0; kt < 2; ++kt) {
      s[kt] = __builtin_amdgcn_mfma_f32_16x16x32_bf16(kf[kt][0], qf[h][0], (f32x4){0.f, 0.f, 0.f, 0.f}, 0, 0, 0);
      s[kt] = __builtin_amdgcn_mfma_f32_16x16x32_bf16(kf[kt][1], qf[h][1], s[kt], 0, 0, 0);
    }
    float sc[8]; bool ok[8];
#pragma unroll
    for (int kt = 0; kt < 2; ++kt)
#pragma unroll
      for (int r = 0; r < 4; ++r) {
        const int e = kt * 16 + r; const int dist = dist0 - DSTEP * e;
        bool o = dist >= 0;
        if (MODE == 2) o = o && rowok;
        if (MODE == 3) o = o && (dist < 512);
        ok[kt * 4 + r] = o;
        sc[kt * 4 + r] = o ? s[kt][r] - sl2[h] * (fd0 - (float)(DSTEP * e)) : NEGF;
      }
    float p[8];
    if (MODE != 1) {
      float ml = NEGF;
#pragma unroll
      for (int i = 0; i < 8; ++i) ml = fmaxf(ml, sc[i]);
      ml = fmaxf(ml, __shfl_xor(ml, 16, 64)); ml = fmaxf(ml, __shfl_xor(ml, 32, 64));
      const float mn = fmaxf(m[h], ml); const float alpha = __builtin_amdgcn_exp2f(m[h] - mn); m[h] = mn;
      const float mref = fmaxf(mn, -1e29f);
      float ps = 0.f;
#pragma unroll
      for (int i = 0; i < 8; ++i) { p[i] = __builtin_amdgcn_exp2f(sc[i] - mref); ps += p[i]; }
      l[h] = l[h] * alpha + ps;
      if (MODE != 0) {
        if (__builtin_amdgcn_ballot_w64(alpha != 1.f) != 0ull) {
#pragma unroll
          for (int dt = 0; dt < 4; ++dt) oacc[h][dt] *= alpha;
        }
      }
    } else {
      const float mref1 = fmaxf(m[h], -1e29f);
#pragma unroll
      for (int i = 0; i < 8; ++i) p[i] = __builtin_amdgcn_exp2f(sc[i] - mref1) * l[h];
      asum[0] += (p[0] + p[1]) + (p[2] + p[3]); bsum[0] += p[3];
      asum[1] += (p[4] + p[5]) + (p[6] + p[7]); bsum[1] += p[7];
    }
    if (MODE != 0) {
      u32x4 pk; pk[0] = pack2(p[0], p[1]); pk[1] = pack2(p[2], p[3]); pk[2] = pack2(p[4], p[5]); pk[3] = pack2(p[6], p[7]);
      const bf16x8 pf = __builtin_bit_cast(bf16x8, pk);
#pragma unroll
      for (int dt = 0; dt < 4; ++dt) oacc[h][dt] = __builtin_amdgcn_mfma_f32_16x16x32_bf16(vf[dt], pf, oacc[h][dt], 0, 0, 0);
    }
    __builtin_amdgcn_sched_barrier(0);
  }
}

__device__ void nsa_tile(const Params& P, int wt, char* wl) {
  char* C = P.ws + OFF_C;
  const bf16_t* Q = (const bf16_t*)(C + C_Q);
  const bf16_t* KCMP = (const bf16_t*)(P.ws + OFF_KCMP); const bf16_t* VCT = (const bf16_t*)(P.ws + OFF_VCT);
  const bf16_t* KS = (const bf16_t*)(C + C_KS); const bf16_t* VST = (const bf16_t*)(C + C_VST);
  const bf16_t* KW = (const bf16_t*)(C + C_KW); const bf16_t* VWT = (const bf16_t*)(C + C_VWT);
  const float* GATES = (const float*)(C + C_GATES);
  bf16_t* O = (bf16_t*)(P.ws + OFF_D);
  const int lane = tidx() & 63, qi = lane & 15, quad = lane >> 4;
  wt = __builtin_amdgcn_readfirstlane(wt);
  const int jb = wt >> 2, wv4 = wt & 3;
  const int bg = jb & 3, b = bg >> 1, g = bg & 1;
  const int gq = jb >> 2;
  const int tq = (gq < 64 ? 127 - gq : gq - 64) * 4 + wv4;
  const int t0 = tq * 16;
  const int t = t0 + qi;
  const long row = (long)b * T_ + t;
  bf16x8 qf[4][2];
#pragma unroll
  for (int h = 0; h < 4; ++h)
#pragma unroll
    for (int ks = 0; ks < 2; ++ks) qf[h][ks] = *(const bf16x8*)(Q + row * 512 + (g * 4 + h) * 64 + ks * 32 + quad * 8);
  float sl2[4];
#pragma unroll
  for (int h = 0; h < 4; ++h) sl2[h] = __builtin_amdgcn_exp2f(-(float)(g * 4 + h + 1)) * LOG2E;
  f32x4 oacc[4][4]; float m[4], l[4], inv[4]; float asum[2], bsum[2];
  float* imp = (float*)wl; float* outl = (float*)wl;
  unsigned* sel = (unsigned*)(wl + 16384); unsigned* uni = sel + 64;
#pragma unroll
  for (int h = 0; h < 4; ++h) { m[h] = NEGF; l[h] = 0.f; inv[h] = 0.f; }
  asum[0] = asum[1] = bsum[0] = bsum[1] = 0.f;

  const int nI = t0 >> 4; const int nblk = (nI + 31) >> 5;
  for (int blk = nblk - 1; blk >= 0; --blk) {
    const int key0 = blk * 32;
    const bf16_t* kp = KCMP + (long)(b * 512 + key0 + qi) * 128 + g * 64 + quad * 8;
    nsa_block<0>(qf, oacc, m, l, sl2, inv, kp, nullptr, 0, t - 31 - 16 * (key0 + quad * 4), true, asum, bsum);
  }
#pragma unroll
  for (int h = 0; h < 4; ++h) { float lt = l[h]; lt += __shfl_xor(lt, 16, 64); lt += __shfl_xor(lt, 32, 64); l[h] = 1.f / fmaxf(lt, 1e-30f); }
  for (int i = lane; i < 16 * 132; i += 64) imp[i] = 0.f;
#pragma unroll
  for (int h = 0; h < 4; ++h)
#pragma unroll
    for (int dt = 0; dt < 4; ++dt) oacc[h][dt] = (f32x4){0.f, 0.f, 0.f, 0.f};
  for (int blk = 0; blk < nblk; ++blk) {
    const int key0 = blk * 32;
    const bf16_t* kp = KCMP + (long)(b * 512 + key0 + qi) * 128 + g * 64 + quad * 8;
    const bf16_t* vp = VCT + (long)(b * 128 + g * 64 + qi) * 512 + key0 + quad * 4;
    asum[0] = asum[1] = bsum[0] = bsum[1] = 0.f;
    nsa_block<1>(qf, oacc, m, l, sl2, inv, kp, vp, 16 * 512, t - 31 - 16 * (key0 + quad * 4), true, asum, bsum);
    const int J = (key0 >> 2) + quad;
    atomicAdd(&imp[qi * 132 + J], asum[0]); atomicAdd(&imp[qi * 132 + J + 1], bsum[0]);
    atomicAdd(&imp[qi * 132 + J + 4], asum[1]); atomicAdd(&imp[qi * 132 + J + 5], bsum[1]);
  }
  const int cur = t0 >> 6;
  if (lane < 16) {
    unsigned w0 = 0, w1 = 0, w2 = 0, w3 = 0;
    if (cur < 16) { w0 = (1u << (cur + 1)) - 1u; }
    else {
      w0 = 1u;
      { int j = cur; unsigned bit = 1u << (j & 31); int w = j >> 5; if (w == 0) w0 |= bit; else if (w == 1) w1 |= bit; else if (w == 2) w2 |= bit; else w3 |= bit; }
      { int j = cur - 1; unsigned bit = 1u << (j & 31); int w = j >> 5; if (w == 0) w0 |= bit; else if (w == 1) w1 |= bit; else if (w == 2) w2 |= bit; else w3 |= bit; }
    }
    sel[lane * 4 + 0] = w0; sel[lane * 4 + 1] = w1; sel[lane * 4 + 2] = w2; sel[lane * 4 + 3] = w3;
  }
  if (lane < 4) uni[lane] = 0u;
  if (cur >= 16) {
    for (int rnd = 0; rnd < 4; ++rnd) {
      const int qq = rnd * 4 + quad;
      unsigned key[8];
#pragma unroll
      for (int c = 0; c < 8; ++c) {
        const int j = qi + 16 * c;
        const bool v = (j <= cur) && (j != 0) && (j != cur) && (j != cur - 1);
        const unsigned bits = __float_as_uint(imp[qq * 132 + j]);
        key[c] = v ? ((bits & 0xFFFFFF00u) | (unsigned)(128 - j)) : 0u;
      }
      for (int it = 0; it < 13; ++it) {
        unsigned mx = key[0];
#pragma unroll
        for (int c = 1; c < 8; ++c) mx = key[c] > mx ? key[c] : mx;
#pragma unroll
        for (int o = 1; o < 16; o <<= 1) { unsigned ot = (unsigned)__shfl_xor((int)mx, o, 64); mx = ot > mx ? ot : mx; }
        if (mx != 0u) {
#pragma unroll
          for (int c = 0; c < 8; ++c) {
            if (key[c] == mx) { key[c] = 0u; const int j = qi + 16 * c; atomicOr(&sel[qq * 4 + (j >> 5)], 1u << (j & 31)); }
          }
        }
      }
    }
  }
  unsigned mym[4];
#pragma unroll
  for (int w = 0; w < 4; ++w) mym[w] = sel[qi * 4 + w];
  if (lane < 16) {
#pragma unroll
    for (int w = 0; w < 4; ++w) atomicOr(&uni[w], mym[w]);
  }
  const float* gp = GATES + row * 24 + g * 12;
#pragma unroll
  for (int h = 0; h < 4; ++h) {
    const float gt = gp[h * 3 + 0] * NSA_G0;
#pragma unroll
    for (int dt = 0; dt < 4; ++dt) *(f32x4*)(outl + ((h * 16 + qi) * 64 + (((dt * 4 + quad) ^ qi) << 2))) = oacc[h][dt] * gt;
  }
#pragma unroll
  for (int h = 0; h < 4; ++h) { m[h] = NEGF; l[h] = 0.f;
#pragma unroll
    for (int dt = 0; dt < 4; ++dt) oacc[h][dt] = (f32x4){0.f, 0.f, 0.f, 0.f}; }
#pragma unroll 1
  for (int w = 3; w >= 0; --w) {
    unsigned bits = __builtin_amdgcn_readfirstlane(uni[w]);
    const unsigned myw = sel[qi * 4 + w];
    while (bits) {
      const int jj = 31 - __builtin_clz(bits); bits &= ~(1u << jj);
      const int j = w * 32 + jj; const bool rowok = (myw >> jj) & 1u;
#pragma unroll 1
      for (int half = 1; half >= 0; --half) {
        const int key0 = j * 64 + half * 32;
        const bf16_t* kp = KS + (long)(b * T_ + key0 + qi) * 128 + g * 64 + quad * 8;
        const bf16_t* vp = VST + (long)(b * 128 + g * 64 + qi) * T_ + key0 + quad * 4;
        nsa_block<2>(qf, oacc, m, l, sl2, inv, kp, vp, 16L * T_, t - (key0 + quad * 4), rowok, asum, bsum);
      }
    }
  }
#pragma unroll
  for (int h = 0; h < 4; ++h) {
    float lt = l[h]; lt += __shfl_xor(lt, 16, 64); lt += __shfl_xor(lt, 32, 64);
    const float sc = NSA_G1 * gp[h * 3 + 1] / fmaxf(lt, 1e-30f);
#pragma unroll
    for (int dt = 0; dt < 4; ++dt) { f32x4* d = (f32x4*)(outl + ((h * 16 + qi) * 64 + (((dt * 4 + quad) ^ qi) << 2))); *d = *d + oacc[h][dt] * sc; }
  }
#pragma unroll
  for (int h = 0; h < 4; ++h) { m[h] = NEGF; l[h] = 0.f;
#pragma unroll
    for (int dt = 0; dt < 4; ++dt) oacc[h][dt] = (f32x4){0.f, 0.f, 0.f, 0.f}; }
  {
    const int kstart = t0 >= 512 ? ((t0 - 511) & ~31) : 0;
    for (int key0 = (t0 + 15) & ~31; key0 >= kstart; key0 -= 32) {
      const bf16_t* kp = KW + (long)(b * T_ + key0 + qi) * 128 + g * 64 + quad * 8;
      const bf16_t* vp = VWT + (long)(b * 128 + g * 64 + qi) * T_ + key0 + quad * 4;
      nsa_block<3>(qf, oacc, m, l, sl2, inv, kp, vp, 16L * T_, t - (key0 + quad * 4), true, asum, bsum);
    }
  }
#pragma unroll
  for (int h = 0; h < 4; ++h) {
    float lt = l[h]; lt += __shfl_xor(lt, 16, 64); lt += __shfl_xor(lt, 32, 64);
    const float sc = NSA_G2 * gp[h * 3 + 2] / fmaxf(lt, 1e-30f);
#pragma unroll
    for (int dt = 0; dt < 4; ++dt) { f32x4* d = (f32x4*)(outl + ((h * 16 + qi) * 64 + (((dt * 4 + quad) ^ qi) << 2))); *d = *d + oacc[h][dt] * sc; }
  }
#pragma unroll
  for (int it = 0; it < 8; ++it) {
    const int id = it * 64 + lane; const int h = id >> 7, rem = id & 127, q2 = rem >> 3, c8 = rem & 7;
    f32x4 a = *(const f32x4*)(outl + ((h * 16 + q2) * 64 + (((2 * c8) ^ q2) << 2)));
    f32x4 bb = *(const f32x4*)(outl + ((h * 16 + q2) * 64 + (((2 * c8 + 1) ^ q2) << 2)));
    float v[8] = {a[0], a[1], a[2], a[3], bb[0], bb[1], bb[2], bb[3]};
    *(u32x4*)(O + ((long)b * T_ + t0 + q2) * 512 + (g * 4 + h) * 64 + c8 * 8) = pack8(v);
  }
}

__device__ void xattn_tile(const Params& P, int wt) {
  const bf16_t* HQ = (const bf16_t*)(P.ws + OFF_D);
  const bf16_t* MK = (const bf16_t*)(P.ws + OFF_MK); const bf16_t* MVT = (const bf16_t*)(P.ws + OFF_MVT);
  bf16_t* OX = (bf16_t*)(P.ws + OFF_D) + (long)M_ * 512;
  const int lane = tidx() & 63, qi = lane & 15, quad = lane >> 4;
  wt = __builtin_amdgcn_readfirstlane(wt);
  const int h = wt & 3; const int row0 = (wt >> 2) * 32; const int b = row0 >> 13;
  bf16x8 qf[2][4];
#pragma unroll
  for (int nt = 0; nt < 2; ++nt)
#pragma unroll
    for (int ks = 0; ks < 4; ++ks) qf[nt][ks] = *(const bf16x8*)(HQ + (long)(row0 + nt * 16 + qi) * 512 + h * 128 + ks * 32 + quad * 8);
  f32x4 oacc[2][8]; float m[2], l[2];
#pragma unroll
  for (int nt = 0; nt < 2; ++nt) { m[nt] = NEGF; l[nt] = 0.f;
#pragma unroll
    for (int dt = 0; dt < 8; ++dt) oacc[nt][dt] = (f32x4){0.f, 0.f, 0.f, 0.f}; }
  for (int blk = 0; blk < 8; ++blk) {
    const int key0 = blk * 32;
    f32x4 s[2][2];
#pragma unroll
    for (int nt = 0; nt < 2; ++nt)
#pragma unroll
      for (int kt = 0; kt < 2; ++kt) s[nt][kt] = (f32x4){0.f, 0.f, 0.f, 0.f};
#pragma unroll
    for (int ks = 0; ks < 4; ++ks) {
#pragma unroll
      for (int kt = 0; kt < 2; ++kt) {
        bf16x8 kf = *(const bf16x8*)(MK + (long)(b * 256 + key0 + kt * 16 + qi) * 512 + h * 128 + ks * 32 + quad * 8);
#pragma unroll
        for (int nt = 0; nt < 2; ++nt) s[nt][kt] = __builtin_amdgcn_mfma_f32_16x16x32_bf16(kf, qf[nt][ks], s[nt][kt], 0, 0, 0);
      }
    }
    bf16x8 pf[2];
#pragma unroll
    for (int nt = 0; nt < 2; ++nt) {
      float ml = NEGF;
#pragma unroll
      for (int kt = 0; kt < 2; ++kt)
#pragma unroll
        for (int r = 0; r < 4; ++r) ml = fmaxf(ml, s[nt][kt][r]);
      ml = fmaxf(ml, __shfl_xor(ml, 16, 64)); ml = fmaxf(ml, __shfl_xor(ml, 32, 64));
      const float mn = fmaxf(m[nt], ml); const float alpha = __builtin_amdgcn_exp2f(m[nt] - mn); m[nt] = mn;
      float p[8]; float ps = 0.f;
#pragma unroll
      for (int kt = 0; kt < 2; ++kt)
#pragma unroll
        for (int r = 0; r < 4; ++r) { p[kt * 4 + r] = __builtin_amdgcn_exp2f(s[nt][kt][r] - mn); ps += p[kt * 4 + r]; }
      l[nt] = l[nt] * alpha + ps;
#pragma unroll
      for (int dt = 0; dt < 8; ++dt) oacc[nt][dt] *= alpha;
      u32x4 pk; pk[0] = pack2(p[0], p[1]); pk[1] = pack2(p[2], p[3]); pk[2] = pack2(p[4], p[5]); pk[3] = pack2(p[6], p[7]);
      pf[nt] = __builtin_bit_cast(bf16x8, pk);
    }
#pragma unroll
    for (int dt = 0; dt < 8; ++dt) {
      const bf16_t* vp = MVT + (long)(b * 512 + h * 128 + dt * 16 + qi) * 256 + key0 + quad * 4;
      u32x2 lo = *(const u32x2*)(vp); u32x2 hi = *(const u32x2*)(vp + 16);
      u32x4 c; c[0] = lo[0]; c[1] = lo[1]; c[2] = hi[0]; c[3] = hi[1];
      const bf16x8 vf = __builtin_bit_cast(bf16x8, c);
#pragma unroll
      for (int nt = 0; nt < 2; ++nt) oacc[nt][dt] = __builtin_amdgcn_mfma_f32_16x16x32_bf16(vf, pf[nt], oacc[nt][dt], 0, 0, 0);
    }
  }
#pragma unroll
  for (int nt = 0; nt < 2; ++nt) {
    float lt = l[nt]; lt += __shfl_xor(lt, 16, 64); lt += __shfl_xor(lt, 32, 64);
    const float iv = 1.f / lt;
#pragma unroll
    for (int dt = 0; dt < 8; ++dt) {
      f32x4 v = oacc[nt][dt] * iv; u32x2 pk; pk[0] = pack2(v[0], v[1]); pk[1] = pack2(v[2], v[3]);
      *(u32x2*)(OX + (long)(row0 + nt * 16 + qi) * 512 + h * 128 + dt * 16 + quad * 4) = pk;
    }
  }
}


#define XB_TMO      128
#define XB_XCNT(j)  (256  + 64 * (j))
#define XB_XSUB(j)  (1280 + 64 * (j))
#define XB_XGEN(j)  (2304 + 64 * (j))
#define XB_TOP      3328
#define XB_TOPGEN   3392
#define XCD_BAR_WORDS 3456
#define XB_SPIN_CAP (1u << 18)
#define LAS __attribute__((address_space(3)))
__device__ __forceinline__ unsigned xb_ld(unsigned* p) { return __hip_atomic_load(p, __ATOMIC_RELAXED, __HIP_MEMORY_SCOPE_AGENT); }
__device__ __forceinline__ unsigned xb_add(unsigned* p, unsigned v) { return __hip_atomic_fetch_add(p, v, __ATOMIC_RELAXED, __HIP_MEMORY_SCOPE_AGENT); }
__device__ __forceinline__ unsigned xb_xcc_id() { return (unsigned)__builtin_amdgcn_s_getreg((3 << 11) | 20) & 0xFu; }
#define XB_SPIN(cond, bar) do { unsigned _sp = 0; while (cond) { __builtin_amdgcn_s_sleep(1); \
    if ((++_sp & 255u) == 0u) { if (xb_ld(&(bar)[XB_TMO])) break; if (_sp > XB_SPIN_CAP) { atomicAdd(&(bar)[XB_TMO], 1u); break; } } } } while (0)
__device__ __forceinline__ void xcd_barrier_complete(unsigned* bar, unsigned x, unsigned& nloc, unsigned& nx) {
  const unsigned G = gridDim.x * gridDim.y * gridDim.z;
  unsigned sum, cnt, mine, sp = 0u;
  for (;;) {
    sum = 0u; cnt = 0u; mine = 0u;
#pragma unroll
    for (unsigned j = 0; j < 16; ++j) { const unsigned c = xb_ld(&bar[XB_XCNT(j)]); sum += c; cnt += (c > 0u) ? 1u : 0u; mine = (j == x) ? c : mine; }
    if (sum == G) break;
    __builtin_amdgcn_s_sleep(1);
    if ((++sp & 255u) == 0u) { if (xb_ld(&bar[XB_TMO])) break; if (sp > XB_SPIN_CAP) { atomicAdd(&bar[XB_TMO], 1u); break; } }
  }
  nloc = mine > 0u ? mine : 1u; nx = cnt > 0u ? cnt : 1u;
}
__device__ __forceinline__ void xcd_barrier(unsigned* bar, unsigned x, volatile LAS unsigned* st) {
  asm volatile("s_waitcnt vmcnt(0)" ::: "memory");
  __syncthreads();
  if (threadIdx.x == 0) {
    __builtin_amdgcn_s_waitcnt(0);
    unsigned nloc = st[0], nx = st[1];
    if (nloc == 0u) { xcd_barrier_complete(bar, x, nloc, nx); st[0] = nloc; st[1] = nx; }
    const unsigned old = xb_add(&bar[XB_XSUB(x)], 1u);
    const unsigned gen = old / nloc;
    if (old + 1u == (gen + 1u) * nloc) {
      __builtin_amdgcn_fence(__ATOMIC_RELEASE, "agent");
      asm volatile("s_waitcnt vmcnt(0)" ::: "memory");
      const unsigned og = xb_add(&bar[XB_TOP], 1u);
      const unsigned tg = og / nx;
      if (og + 1u == (tg + 1u) * nx) xb_add(&bar[XB_TOPGEN], 1u);
      else XB_SPIN(xb_ld(&bar[XB_TOPGEN]) == tg, bar);
      __builtin_amdgcn_fence(__ATOMIC_ACQUIRE, "agent");
      xb_add(&bar[XB_XGEN(x)], 1u);
      asm volatile("s_waitcnt vmcnt(0)" ::: "memory");
    } else {
      XB_SPIN(xb_ld(&bar[XB_XGEN(x)]) == gen, bar);
      __builtin_amdgcn_fence(__ATOMIC_ACQUIRE, "agent");
      asm volatile("s_waitcnt vmcnt(0)" ::: "memory");
    }
  }
  __syncthreads();
}

__device__ void run_phase(const Params& P, int ph, char* smem, bool ph_fused) {
  char* ws = P.ws; const int tid = tidx();
  switch (ph) {
    case 0: phase0(P, smem); break;
    case 1: phase1(P, smem); break;
    case 2: phase2(P, smem); break;
    case 3: {
      for (int job = blockIdx.x; job < 512; job += gridDim.x) { const int wv = tidx() >> 6; nsa_tile(P, job * 4 + wv, smem + wv * 16896); }
      __syncthreads();
      for (int job = blockIdx.x; job < 512; job += gridDim.x) {
        {
          const int tid = tidx();
          const int s = job; const int bc = s >> 2, g = s & 3;
          RowLin ar{(const bf16_t*)(ws + OFF_WM) + g * 16384, 128};
          RowLin br{(const bf16_t*)(ws + OFF_C + C_GVT) + ((long)bc * 512 + g * 128) * 128, 128};
          const float* bs = P.b_sp + g * 128;
          const bf16_t* U = (const bf16_t*)(ws + OFF_C + C_U) + (long)bc * 128 * 512 + g * 128;
          bf16_t* OS = (bf16_t*)(ws + OFF_D) + (long)M_ * 512 + (long)bc * 128 * 512 + g * 128;
          gemm_tile(smem, ar, br, 2, 64, 64, [&](const float* Cs) {
#pragma unroll 2
            for (int it = 0; it < 8; ++it) {
              int id = it * 256 + tid; int r = id >> 4, c = (id & 15) * 8; float v[8]; ld8(Cs, r, c, v);
              u32x4 d = *(const u32x4*)(U + (long)r * 512 + c); const float bb = bs[r];
#pragma unroll
              for (int i = 0; i < 4; ++i) { v[2 * i] = (v[2 * i] + bb) * bf2f(d[i] & 0xffffu); v[2 * i + 1] = (v[2 * i + 1] + bb) * bf2f(d[i] >> 16); }
              *(u32x4*)(OS + (long)r * 512 + c) = pack8(v);
            }
          });
        }
      }
    } break;
    case 4: {
      float* scr = (float*)(ws + OFF_C + C_SCR) + (long)blockIdx.x * 16384;
      const int xq = blockIdx.x & 7, lq = blockIdx.x >> 3, sq = gridDim.x >> 3;
      for (int t = lq; t < 16 * 8; t += sq) {
        const int mt = xq * 16 + (t & 15), nt = t >> 4, brow = mt * 128, bcol = nt * 128;
        const bf16_t* MG = (const bf16_t*)(ws + OFF_B) + (long)brow * 2048 + bcol;
        RowLin a1{(const bf16_t*)(ws + OFF_D) + (long)brow * 512, 512};
        RowLin b1{(const bf16_t*)(ws + OFF_WPA) + (long)bcol * 512, 512};
        gemm_tile(smem, a1, b1, 8, 64, 64, [&](const float* Cs) {
#pragma unroll 2
          for (int it = 0; it < 8; ++it) {
            int id = it * 256 + tid; int r = id >> 4, c = (id & 15) * 8; float v[8]; ld8(Cs, r, c, v);
            u32x4 d = *(const u32x4*)(MG + (long)r * 2048 + c);
#pragma unroll
            for (int i = 0; i < 4; ++i) { v[2 * i] *= bf2f(d[i] & 0xffffu); v[2 * i + 1] *= bf2f(d[i] >> 16); }
            *(f32x4*)(scr + id * 8) = (f32x4){v[0], v[1], v[2], v[3]}; *(f32x4*)(scr + id * 8 + 4) = (f32x4){v[4], v[5], v[6], v[7]};
          }
        });
        RowLin a2{(const bf16_t*)(ws + OFF_D) + (long)M_ * 512 + (long)brow * 512, 512};
        RowLin b2{(const bf16_t*)(ws + OFF_WPB) + (long)bcol * 512, 512};
        bf16_t* MX = (bf16_t*)(ws + OFF_C + C_MIXED) + (long)brow * 1024 + bcol;
        gemm_tile(smem, a2, b2, 8, 64, 64, [&](const float* Cs) {
#pragma unroll 2
          for (int it = 0; it < 8; ++it) {
            int id = it * 256 + tid; int r = id >> 4, c = (id & 15) * 8; float v[8]; ld8(Cs, r, c, v);
            u32x4 d = *(const u32x4*)(MG + (long)r * 2048 + 1024 + c);
            f32x4 p0 = *(const f32x4*)(scr + id * 8), p1 = *(const f32x4*)(scr + id * 8 + 4);
            float pv[8] = {p0[0], p0[1], p0[2], p0[3], p1[0], p1[1], p1[2], p1[3]};
#pragma unroll
            for (int i = 0; i < 4; ++i) { v[2 * i] = pv[2 * i] + v[2 * i] * bf2f(d[i] & 0xffffu); v[2 * i + 1] = pv[2 * i + 1] + v[2 * i + 1] * bf2f(d[i] >> 16); }
            *(u32x4*)(MX + (long)r * 1024 + c) = pack8(v);
          }
        });
      }
    } break;
    case 5: case 9: case 12: {
      const bf16_t* A; const bf16_t* W; const float* RES; float* DST; int K;
      if (ph == 5) { A = (const bf16_t*)(ws + OFF_C + C_MIXED); W = (const bf16_t*)(ws + OFF_WOUT); RES = P.x; DST = (float*)(ws + OFF_B); K = 1024; }
      else if (ph == 9) { A = (const bf16_t*)(ws + OFF_D) + (long)M_ * 512; W = (const bf16_t*)(ws + OFF_WMO); RES = (const float*)(ws + OFF_B); DST = (float*)(ws + OFF_C + C_H2); K = 512; }
      else { A = (const bf16_t*)(ws + OFF_B); W = (const bf16_t*)(ws + OFF_WDN); RES = (const float*)(ws + OFF_C + C_H2); DST = P.out; K = 2816; }
      const int xq = blockIdx.x & 7, lq = blockIdx.x >> 3, sq = gridDim.x >> 3;
      for (int t = lq; t < 16 * 4; t += sq) {
        const int mt = xq * 16 + (t & 15), nt2 = t >> 4, brow = mt * 128;
        RowLin ar{A + (long)brow * K, K}; RowLin br{W + (long)nt2 * 256 * K, K};
        gemm_tile2(smem, ar, br, K / 64, [&](const float* Cs, int p) {
          const int bcol = nt2 * 256 + p * 128;
          const float* rs = RES + (long)brow * 1024 + bcol; float* ds = DST + (long)brow * 1024 + bcol;
#pragma unroll 4
          for (int it = 0; it < 8; ++it) {
            int id = it * 256 + tid; int r = id >> 4, c = (id & 15) * 8;
            f32x4 a = *(const f32x4*)(Cs + r * CS_LD + c), bq = *(const f32x4*)(Cs + r * CS_LD + c + 4);
            f32x4 r0 = *(const f32x4*)(rs + (long)r * 1024 + c), r1 = *(const f32x4*)(rs + (long)r * 1024 + c + 4);
            const f32x4 h0 = a + r0, h1v = bq + r1;
            *(f32x4*)(ds + (long)r * 1024 + c) = h0; *(f32x4*)(ds + (long)r * 1024 + c + 4) = h1v;
            if (ph != 12) {
              const float* gn = (ph == 5 ? P.norm_mq : P.norm_ffn) + bcol + c;
              const f32x4 g0 = *(const f32x4*)gn, g1 = *(const f32x4*)(gn + 4);
              float v[8] = {h0[0] * g0[0], h0[1] * g0[1], h0[2] * g0[2], h0[3] * g0[3], h1v[0] * g1[0], h1v[1] * g1[1], h1v[2] * g1[2], h1v[3] * g1[3]};
              *(u32x4*)((bf16_t*)(ws + OFF_A) + (long)(brow + r) * 1024 + bcol + c) = pack8(v);
              float ss = (h0[0] * h0[0] + h0[1] * h0[1]) + (h0[2] * h0[2] + h0[3] * h0[3]) + (h1v[0] * h1v[0] + h1v[1] * h1v[1]) + (h1v[2] * h1v[2] + h1v[3] * h1v[3]);
              ss += __shfl_xor(ss, 1, 64); ss += __shfl_xor(ss, 2, 64); ss += __shfl_xor(ss, 4, 64); ss += __shfl_xor(ss, 8, 64);
              if ((tid & 15) == 0) ((float*)(ws + (ph == 5 ? OFF_SSQ1 : OFF_SSQ2)))[(long)(brow + r) * 8 + nt2 * 2 + p] = ss;
            }
          }
        });
      }
    } break;
    case 6: case 10: {
      const float* src = ph == 6 ? (const float*)(ws + OFF_B) : (const float*)(ws + OFF_C + C_H2);
      const float* g = ph == 6 ? P.norm_mq : P.norm_ffn;
      (void)src; (void)g;
    } break;
    case 7: {
      const int xq = blockIdx.x & 7, lq = blockIdx.x >> 3, sq = gridDim.x >> 3;
      for (int t = lq; t < 16 * 4; t += sq) {
        const int mt = xq * 16 + (t & 15), nt = t >> 4, brow = mt * 128;
        RowLin ar{(const bf16_t*)(ws + OFF_A) + (long)brow * 1024, 1024}; RowLin br{(const bf16_t*)(ws + OFF_WMQ) + (long)nt * 128 * 1024, 1024};
        gemm_tile(smem, ar, br, 16, 64, 64, [&](const float* Cs) {
          bf16_t* dq = (bf16_t*)(ws + OFF_D) + (long)brow * 512 + nt * 128; const float* sq1 = (const float*)(ws + OFF_SSQ1) + (long)brow * 8;
#pragma unroll 2
          for (int it = 0; it < 8; ++it) {
            int id = it * 256 + tid; int r = id >> 4, c = (id & 15) * 8; float v[8]; ld8(Cs, r, c, v);
            const f32x4 s0 = *(const f32x4*)(sq1 + r * 8), s1 = *(const f32x4*)(sq1 + r * 8 + 4);
            const float ssum = ((s0[0] + s0[1]) + (s0[2] + s0[3])) + ((s1[0] + s1[1]) + (s1[2] + s1[3]));
            const float rr = rsqrtf(ssum * (1.f / 1024.f) + 1e-6f) * (0.08838834764831845f * LOG2E);
#pragma unroll
            for (int i = 0; i < 8; ++i) v[i] *= rr;
            *(u32x4*)(dq + (long)r * 512 + c) = pack8(v);
          }
        });
        asm volatile("s_waitcnt vmcnt(0)" ::: "memory");
        __syncthreads();
        xattn_tile(P, ((brow >> 5) + (tid >> 6)) * 4 + nt);
      }
    } break;
    case 8: {
      if (ph_fused) break;
      for (int job = blockIdx.x; job < 512; job += gridDim.x) xattn_tile(P, job * 4 + (tid >> 6));
    } break;
    case 11: {
      const int xq = blockIdx.x & 7, lq = blockIdx.x >> 3, sq = gridDim.x >> 3;
      for (int t = lq; t < 16 * 22; t += sq) {
        const int mt = xq * 16 + (t & 15), nt2 = t >> 4, brow = mt * 128;
        RowLin ar{(const bf16_t*)(ws + OFF_A) + (long)brow * 1024, 1024}; RowLin br{(const bf16_t*)(ws + OFF_WGU) + (long)nt2 * 256 * 1024, 1024};
        gemm_tile2(smem, ar, br, 16, [&](const float* Cs, int p) {
          bf16_t* ACT = (bf16_t*)(ws + OFF_B) + (long)brow * 2816 + (nt2 * 2 + p) * 64;
#pragma unroll 2
          for (int it = 0; it < 4; ++it) {
            int id = it * 256 + tid; int r = id >> 3, c = (id & 7) * 8; float gt[8], up[8]; ld8(Cs, r, c, gt); ld8(Cs, r, c + 64, up);
            const float* sq2 = (const float*)(ws + OFF_SSQ2) + (long)(brow + r) * 8;
            const f32x4 s0 = *(const f32x4*)(sq2), s1 = *(const f32x4*)(sq2 + 4);
            const float ssum = ((s0[0] + s0[1]) + (s0[2] + s0[3])) + ((s1[0] + s1[1]) + (s1[2] + s1[3]));
            const float rr = rsqrtf(ssum * (1.f / 1024.f) + 1e-6f);
#pragma unroll
            for (int i = 0; i < 8; ++i) { const float gg = gt[i] * rr; gt[i] = gg * sigm(gg) * (up[i] * rr); }
            *(u32x4*)(ACT + (long)r * 2816 + c) = pack8(gt);
          }
        });
      }
    } break;
    case 13: {
      for (int job = blockIdx.x; job < 1024; job += gridDim.x) { int row = job * 16 + (tid >> 6) * 4; rownorm_rows<true, 4>(P.out + (long)row * 1024, P.norm_final, P.out + (long)row * 1024); }
    } break;
#ifdef PROBE_K
    case 14: {
      const bf16_t* s0 = (const bf16_t*)(ws + PROBE_SRC0); const bf16_t* s1 = (const bf16_t*)(ws + PROBE_SRC1);
      for (long i = (long)blockIdx.x * 256 + tid; i < (long)M_ * 512; i += (long)gridDim.x * 256) {
        long row = i >> 9; int c = (int)(i & 511);
        P.out[row * 1024 + c] = bf2f(s0[i]); P.out[row * 1024 + 512 + c] = bf2f(s1[i]);
      }
    } break;
    case 15: {
      const float* s0 = (const float*)(ws + PROBE_SRC0);
      for (long i = (long)blockIdx.x * 256 + tid; i < (long)M_ * 1024; i += (long)gridDim.x * 256) P.out[i] = s0[i];
    } break;
#endif
  }
}

__global__ void __launch_bounds__(256, 2) fwd_kernel(Params P, int ph_lo, int ph_hi) {
  __shared__ __attribute__((aligned(16))) char smem[73728 + 16];
  volatile LAS unsigned* st = (volatile LAS unsigned*)(smem + 73728);
  const unsigned xcc = xb_xcc_id();
  if (ph_lo < ph_hi) {
    if (threadIdx.x == 0) { st[0] = 0u; st[1] = 0u; }
    __syncthreads();
    if (threadIdx.x == 0) (void)xb_add(&((unsigned*)(P.ws + OFF_BAR))[XB_XCNT(xcc)], 1u);
  }
  if (ph_hi < 0) cg::this_grid().sync();
  for (int ph = ph_lo; ph <= ph_hi; ++ph) {
    const uint64_t __attribute__((address_space(4)))* ka = (const uint64_t __attribute__((address_space(4)))*)__builtin_amdgcn_kernarg_segment_ptr();
    asm volatile("" : "+s"(ka));
    Params Pl; uint64_t* pd = (uint64_t*)&Pl;
#pragma unroll
    for (int i = 0; i < (int)(sizeof(Params) / 8); ++i) pd[i] = ka[i];
    if (ph == 6 || ph == 10 || ph == 8) continue;
    run_phase(Pl, ph, smem, true);
    if (ph < ph_hi) xcd_barrier((unsigned*)(Pl.ws + OFF_BAR), xcc, st);
  }
}

extern "C" void kernel_launch(void* const* d_in, const int* in_sizes, int n_in, void* d_out, int out_size, void* d_ws, size_t ws_size,
                              hipStream_t stream) {
  static int grid_blocks = 0;
  if (!grid_blocks) {
    int dev = 0, cus = 0, per_cu = 0;
    hipGetDevice(&dev);
    hipDeviceGetAttribute(&cus, hipDeviceAttributeMultiprocessorCount, dev);
    hipOccupancyMaxActiveBlocksPerMultiprocessor(&per_cu, fwd_kernel, 256, 0);
    if (per_cu > 2) per_cu = 2;
    if (per_cu < 1) per_cu = 1;
    grid_blocks = cus * per_cu;
  }
  if (ws_size < (size_t)WS_NEED) fprintf(stderr, "workspace too small: %zu < %ld\n", ws_size, (long)WS_NEED);
  Params P{};
  const float** pp = (const float**)&P;
  for (int i = 0; i < 27; ++i) pp[i] = (const float*)d_in[i];
  P.out = (float*)d_out; P.ws = (char*)d_ws;
#if ONE_LAUNCH
  hipMemsetAsync((char*)d_ws + OFF_BAR, 0, XCD_BAR_WORDS * 4, stream);
#ifdef PROBE_K
  int lo = 0, hi = PROBE_DUMP;
#else
  int lo = 0, hi = 13;
#endif
  void* args[] = {&P, &lo, &hi};
  hipError_t e = hipLaunchCooperativeKernel((void*)fwd_kernel, dim3(grid_blocks), dim3(256), args, 0, stream);
  if (e != hipSuccess) fprintf(stderr, "cooperative launch failed: %s (grid %d)\n", hipGetErrorString(e), grid_blocks);
#else
  for (int ph = 0; ph <= 13; ++ph) fwd_kernel<<<grid_blocks, 256, 0, stream>>>(P, ph, ph);
#endif
}
```

```cpp
#include <hip/hip_runtime.h>
#include <hip/hip_cooperative_groups.h>
#include <stdint.h>
#include <stdio.h>
namespace cg = cooperative_groups;

#ifndef NSA_G0
#define NSA_G0 1.f
#define NSA_G1 1.f
#define NSA_G2 1.f
#endif
#ifndef ONE_LAUNCH
#define ONE_LAUNCH 1
#endif

typedef unsigned short bf16_t;
using bf16x8 = __attribute__((ext_vector_type(8))) short;
using f32x4 = __attribute__((ext_vector_type(4))) float;
using u32x4 = __attribute__((ext_vector_type(4))) unsigned;
using u32x2 = __attribute__((ext_vector_type(2))) unsigned;

#define T_ 8192
#define M_ 16384
#define NEGF (-1e30f)
#define LOG2E 1.4426950408889634f

constexpr long OFF_W1 = 0;
constexpr long OFF_WMKV = OFF_W1 + 9175040;
constexpr long OFF_WPA = OFF_WMKV + 2097152;
constexpr long OFF_WPB = OFF_WPA + 1048576;
constexpr long OFF_WOUT = OFF_WPB + 1048576;
constexpr long OFF_WMQ = OFF_WOUT + 2097152;
constexpr long OFF_WMO = OFF_WMQ + 1048576;
constexpr long OFF_WGU = OFF_WMO + 1048576;
constexpr long OFF_WDN = OFF_WGU + 11534336;
constexpr long OFF_WCK1 = OFF_WDN + 5767168;
constexpr long OFF_WCV1 = OFF_WCK1 + 524288;
constexpr long OFF_WM = OFF_WCV1 + 524288;
constexpr long OFF_BIAS1 = OFF_WM + 131072;
constexpr long OFF_MEMN = OFF_BIAS1 + 1024;
constexpr long OFF_MK = OFF_MEMN + 1048576;
constexpr long OFF_MVT = OFF_MK + 524288;
constexpr long OFF_KCMP = OFF_MVT + 524288;
constexpr long OFF_VCT = OFF_KCMP + 262144;
constexpr long OFF_A = OFF_VCT + 262144;
constexpr long OFF_B = OFF_A + 33554432;
constexpr long OFF_D = OFF_B + 67108864;
constexpr long OFF_C = OFF_D + 33554432;
constexpr long C_Q = 0, C_U = 16777216, C_GVT = 33554432, C_KC = 50331648, C_VC = 54525952, C_KS = 58720256,
               C_KW = 62914560, C_VST = 67108864, C_VWT = 71303168, C_GATES = 75497472;
constexpr long C_MIXED = 0, C_SCR = 33554432, C_H2 = 0;
constexpr long OFF_BAR = OFF_C + 77070336;
constexpr long OFF_SSQ1 = OFF_BAR + 16384;
constexpr long OFF_SSQ2 = OFF_SSQ1 + 524288;
constexpr long WS_NEED = OFF_SSQ2 + 524288;

struct Params {
  const float *x, *mem, *norm_mix, *w_in, *w_ck1, *w_ck2, *w_cv1, *w_cv2, *pe_k, *pe_v, *ln_sgu, *w_sp, *b_sp,
      *w_pa, *w_pb, *w_merge, *b_merge, *w_out, *norm_mq, *norm_mkv, *w_mq, *w_mkv, *w_mo, *norm_ffn, *w_gu, *w_dn, *norm_final;
  float* out;
  char* ws;
};

__device__ __forceinline__ int tidx() { int t = threadIdx.x; asm volatile("" : "+v"(t)); return t; }
__device__ __forceinline__ unsigned f2bf(float f) { unsigned u = __float_as_uint(f); u += 0x7fffu + ((u >> 16) & 1u); return u >> 16; }
__device__ __forceinline__ unsigned pack2(float a, float b) { unsigned r; asm("v_cvt_pk_bf16_f32 %0, %1, %2" : "=v"(r) : "v"(a), "v"(b)); return r; }
__device__ __forceinline__ float bf2f(unsigned h) { return __uint_as_float(h << 16); }
__device__ __forceinline__ float gelu_tanh(float x) { float u = 0.7978845608028654f * (x + 0.044715f * x * x * x); return x / (1.f + __expf(-2.f * u)); }
__device__ __forceinline__ float sigm(float x) { return 1.f / (1.f + __expf(-x)); }
__device__ __forceinline__ float wave_sum(float v) {
#pragma unroll
  for (int o = 32; o > 0; o >>= 1) v += __shfl_xor(v, o, 64);
  return v;
}
__device__ __forceinline__ u32x4 pack8(const float (&v)[8]) {
  u32x4 r; r[0] = pack2(v[0], v[1]); r[1] = pack2(v[2], v[3]); r[2] = pack2(v[4], v[5]); r[3] = pack2(v[6], v[7]); return r;
}

__device__ __forceinline__ int lds_byte(int r, int c) {
  int st = (r >> 4) * 2 + (c >> 5), rr = r & 15, cc = c & 31, ob = rr * 64 + cc * 2;
  return st * 1024 + (ob ^ (((ob >> 9) & 1) << 5));
}
__device__ __forceinline__ void stage_rc(int b, int& R, int& C) {
  int st = b >> 10, sb = b & 1023, swz = sb ^ (((sb >> 9) & 1) << 5);
  R = (st >> 1) * 16 + (swz >> 6); C = (st & 1) * 32 + ((swz & 63) >> 1);
}

#define CS_LD 132
__device__ __forceinline__ void ld8(const float* Cs, int r, int c, float (&v)[8]) {
  f32x4 a = *(const f32x4*)(Cs + r * CS_LD + c); f32x4 b = *(const f32x4*)(Cs + r * CS_LD + c + 4);
  v[0] = a[0]; v[1] = a[1]; v[2] = a[2]; v[3] = a[3]; v[4] = b[0]; v[5] = b[1]; v[6] = b[2]; v[7] = b[3];
}
__device__ __forceinline__ void ld8T(const float* Cs, int r8, int c, float (&v)[8]) {
#pragma unroll
  for (int i = 0; i < 8; ++i) v[i] = Cs[(r8 + i) * CS_LD + c];
}

struct RowLin {
  const bf16_t* base; long ld;
  __device__ __forceinline__ const bf16_t* operator()(int r) const { return base + (long)r * ld; }
};
struct RowCmp {
  const bf16_t* base; int brow;
  __device__ __forceinline__ const bf16_t* operator()(int r) const {
    int R = brow + r; int b = R >> 10, rem = R & 1023, i = rem >> 1, g = rem & 1; if (i > 510) i = 510;
    return base + ((long)(b * T_ + 16 * i) * 128 + g * 64);
  }
};

template <int AUX = 0, class ARow, class BRow, class Epi>
__device__ __forceinline__ void gemm_tile(char* smem, ARow arow, BRow brow, int nkt, int kstepA, int kstepB, Epi epi) {
  const int tid = tidx(), lane = tid & 63, wave = tid >> 6, wr = wave >> 1, wc = wave & 1, fr = lane & 15, fq = lane >> 4;
  const bf16_t* pa[4]; const bf16_t* pb[4];
#pragma unroll
  for (int i = 0; i < 4; ++i) { int b = tid * 16 + i * 4096; int R, C; stage_rc(b, R, C); pa[i] = arow(R) + C; pb[i] = brow(R) + C; }
  f32x4 acc[4][4];
#pragma unroll
  for (int m = 0; m < 4; ++m)
#pragma unroll
    for (int n = 0; n < 4; ++n) acc[m][n] = (f32x4){0.f, 0.f, 0.f, 0.f};
  {
#pragma unroll
    for (int i = 0; i < 4; ++i) {
      __builtin_amdgcn_global_load_lds((const unsigned*)(pa[i]), (unsigned*)(smem + tid * 16 + i * 4096), 16, 0, AUX);
      __builtin_amdgcn_global_load_lds((const unsigned*)(pb[i]), (unsigned*)(smem + 16384 + tid * 16 + i * 4096), 16, 0, AUX);
    }
  }
  for (int kt = 0; kt < nkt; ++kt) {
    asm volatile("s_waitcnt vmcnt(0)" ::: "memory");
    __syncthreads();
    if (kt + 1 < nkt) {
      char* la = smem + ((kt + 1) & 1) * 32768;
#pragma unroll
      for (int i = 0; i < 4; ++i) {
        __builtin_amdgcn_global_load_lds((const unsigned*)(pa[i] + (long)(kt + 1) * kstepA), (unsigned*)(la + tid * 16 + i * 4096), 16, 0, AUX);
        __builtin_amdgcn_global_load_lds((const unsigned*)(pb[i] + (long)(kt + 1) * kstepB), (unsigned*)(la + 16384 + tid * 16 + i * 4096), 16, 0, AUX);
      }
    }
    const char* la = smem + (kt & 1) * 32768; const char* lb = la + 16384;
#pragma unroll
    for (int ks = 0; ks < 2; ++ks) {
      bf16x8 a[4], b[4];
#pragma unroll
      for (int m = 0; m < 4; ++m) a[m] = *(const bf16x8*)(la + lds_byte(wr * 64 + m * 16 + fr, ks * 32 + fq * 8));
#pragma unroll
      for (int n = 0; n < 4; ++n) b[n] = *(const bf16x8*)(lb + lds_byte(wc * 64 + n * 16 + fr, ks * 32 + fq * 8));
#pragma unroll
      for (int m = 0; m < 4; ++m)
#pragma unroll
        for (int n = 0; n < 4; ++n) acc[m][n] = __builtin_amdgcn_mfma_f32_16x16x32_bf16(a[m], b[n], acc[m][n], 0, 0, 0);
    }
  }
  __syncthreads();
  float* Cs = (float*)smem;
#pragma unroll
  for (int m = 0; m < 4; ++m)
#pragma unroll
    for (int n = 0; n < 4; ++n)
#pragma unroll
      for (int r = 0; r < 4; ++r) Cs[(wr * 64 + m * 16 + fq * 4 + r) * CS_LD + wc * 64 + n * 16 + fr] = acc[m][n][r];
  __syncthreads();
  epi(Cs);
  __syncthreads();
}

template <class F>
__device__ __forceinline__ void store_rows_bf16(const float* Cs, bf16_t* dst, long ld, F f) {
#pragma unroll 2
  for (int it = 0; it < 8; ++it) {
    int id = it * 256 + tidx(); int r = id >> 4, c = (id & 15) * 8;
    float v[8]; ld8(Cs, r, c, v);
#pragma unroll
    for (int i = 0; i < 8; ++i) v[i] = f(v[i], c + i);
    *(u32x4*)(dst + (long)r * ld + c) = pack8(v);
  }
}
template <class F>
__device__ __forceinline__ void store_T_bf16(const float* Cs, bf16_t* dst, long cstride, F f) {
#pragma unroll 2
  for (int it = 0; it < 8; ++it) {
    int id = it * 256 + tidx(); int c = id >> 4, r8 = (id & 15) * 8;
    float v[8]; ld8T(Cs, r8, c, v);
#pragma unroll
    for (int i = 0; i < 8; ++i) v[i] = f(v[i]);
    *(u32x4*)(dst + (long)c * cstride + r8) = pack8(v);
  }
}


__device__ __forceinline__ int lds_byte32(int r, int c) { int rr = r & 15; return (r >> 4) * 1024 + rr * 64 + ((((c >> 3) ^ ((-(rr >> 2)) & 3)) & 3) << 4); }
__device__ __forceinline__ void stage_rc32(int b, int& R, int& C) { int st = b >> 10, sb = b & 1023, rr = sb >> 6, cp = (sb >> 4) & 3; R = st * 16 + rr; C = ((cp ^ ((-(rr >> 2)) & 3)) & 3) * 8; }
struct RowClamp {
  const bf16_t* base; long ld; int maxr;
  __device__ __forceinline__ const bf16_t* operator()(int r) const { return base + (long)(r < maxr ? r : maxr) * ld; }
};
__device__ __forceinline__ int lds_byte64(int r, int c) { int rr = r & 15; return (r >> 4) * 2048 + rr * 128 + ((((c >> 3) ^ (rr >> 1)) & 7) << 4); }
__device__ __forceinline__ void stage_rc64(int b, int& R, int& C) { int st = b >> 11, sb = b & 2047, rr = sb >> 7, cp = (sb >> 4) & 7; R = st * 16 + rr; C = ((cp ^ (rr >> 1)) & 7) * 8; }
template <class ARow, class BRow, class Epi>
__device__ __forceinline__ void gemm_tile2(char* smem, ARow arow, BRow brow, int nkt, Epi epi) {
  const int tid = tidx(), lane = tid & 63, wave = tid >> 6, wr = wave >> 1, wc = wave & 1, fr = lane & 15, fq = lane >> 4;
  const bf16_t* pa[4]; const bf16_t* pb[8];
#pragma unroll
  for (int i = 0; i < 4; ++i) { int R, C; stage_rc64(tid * 16 + i * 4096, R, C); pa[i] = arow(R) + C; }
#pragma unroll
  for (int i = 0; i < 8; ++i) { int R, C; stage_rc64(tid * 16 + i * 4096, R, C); pb[i] = brow(R) + C; }
  f32x4 acc[4][8];
#pragma unroll
  for (int m = 0; m < 4; ++m)
#pragma unroll
    for (int n = 0; n < 8; ++n) acc[m][n] = (f32x4){0.f, 0.f, 0.f, 0.f};
  for (int kt = 0; kt < nkt; ++kt) {
    __syncthreads();
#pragma unroll
    for (int i = 0; i < 4; ++i) __builtin_amdgcn_global_load_lds((const unsigned*)(pa[i] + (long)kt * 64), (unsigned*)(smem + tid * 16 + i * 4096), 16, 0, 0);
#pragma unroll
    for (int i = 0; i < 8; ++i) __builtin_amdgcn_global_load_lds((const unsigned*)(pb[i] + (long)kt * 64), (unsigned*)(smem + 16384 + tid * 16 + i * 4096), 16, 0, 0);
    asm volatile("s_waitcnt vmcnt(0)" ::: "memory");
    __syncthreads();
    {
      const char* pA = smem + lds_byte64(wr * 64 + fr, fq * 8);
      const char* pB = smem + 16384 + lds_byte64(wc * 128 + fr, fq * 8);
      const int k1 = lds_byte64(fr, 32 + fq * 8) - lds_byte64(fr, fq * 8);
      bf16x8 a[4], bl[4], bh[4];
#define SB __builtin_amdgcn_sched_barrier(0)
#define LDA(K) _Pragma("unroll") for (int m = 0; m < 4; ++m) a[m] = *(const bf16x8*)(pA + m * 2048 + (K))
#define LDBL(K) _Pragma("unroll") for (int n = 0; n < 4; ++n) bl[n] = *(const bf16x8*)(pB + n * 2048 + (K))
#define LDBH(K) _Pragma("unroll") for (int n = 0; n < 4; ++n) bh[n] = *(const bf16x8*)(pB + (n + 4) * 2048 + (K))
#define MML _Pragma("unroll") for (int m = 0; m < 4; ++m) _Pragma("unroll") for (int n = 0; n < 4; ++n) acc[m][n] = __builtin_amdgcn_mfma_f32_16x16x32_bf16(a[m], bl[n], acc[m][n], 0, 0, 0)
#define MMH _Pragma("unroll") for (int m = 0; m < 4; ++m) _Pragma("unroll") for (int n = 0; n < 4; ++n) acc[m][n + 4] = __builtin_amdgcn_mfma_f32_16x16x32_bf16(a[m], bh[n], acc[m][n + 4], 0, 0, 0)
      LDA(0); LDBL(0); SB;
      LDBH(0); SB;
      MML; SB;
      LDBL(k1); SB;
      MMH; SB;
      LDA(k1); SB;
      LDBH(k1); SB;
      MML; SB;
      MMH; SB;
#undef SB
#undef LDA
#undef LDBL
#undef LDBH
#undef MML
#undef MMH
    }
  }
  float* Cs = (float*)smem;
#pragma unroll
  for (int p = 0; p < 2; ++p) {
    __syncthreads();
    if (wc == p) {
#pragma unroll
      for (int m = 0; m < 4; ++m)
#pragma unroll
        for (int n = 0; n < 8; ++n)
#pragma unroll
          for (int r = 0; r < 4; ++r) Cs[(wr * 64 + m * 16 + fq * 4 + r) * CS_LD + n * 16 + fr] = acc[m][n][r];
    }
    __syncthreads();
    epi(Cs, p);
  }
  __syncthreads();
}

template <int MODE>
__device__ __forceinline__ void transpose_tile(const float* W, int Nsrc, bf16_t* Wt, int Kd, int k0, int n0, float* lds) {
  const int tid = tidx();
  {
    int tx = tid & 63, ty = tid >> 6; int np = n0 + tx; int sc;
    if (MODE == 0) sc = np < Nsrc ? np : -1;
    else { int x = np & 127, tl = np >> 7; sc = x < 64 ? tl * 64 + x : 2816 + tl * 64 + x - 64; }
    float v[32];
#pragma unroll
    for (int i = 0; i < 32; ++i) v[i] = sc >= 0 ? W[(long)(k0 + ty + 4 * i) * Nsrc + sc] : 0.f;
#pragma unroll
    for (int i = 0; i < 32; ++i) lds[(ty + 4 * i) * 65 + tx] = v[i];
  }
  __syncthreads();
  {
    int nrow = tid >> 2, kseg = (tid & 3) * 32;
#pragma unroll
    for (int q = 0; q < 4; ++q) {
      float v[8];
#pragma unroll
      for (int i = 0; i < 8; ++i) v[i] = lds[(kseg + q * 8 + i) * 65 + nrow];
      *(u32x4*)(Wt + (long)(n0 + nrow) * Kd + k0 + kseg + q * 8) = pack8(v);
    }
  }
  __syncthreads();
}

template <bool OUTF, int NR>
__device__ __forceinline__ void rownorm_rows(const float* src, const float* g, void* dst) {
  const int lane = tidx() & 63;
  f32x4 v[NR][4];
#pragma unroll
  for (int r = 0; r < NR; ++r)
#pragma unroll
    for (int i = 0; i < 4; ++i) v[r][i] = *(const f32x4*)(src + (long)r * 1024 + i * 256 + lane * 4);
  f32x4 gg[4];
#pragma unroll
  for (int i = 0; i < 4; ++i) gg[i] = *(const f32x4*)(g + i * 256 + lane * 4);
#pragma unroll
  for (int r = 0; r < NR; ++r) {
    float ss = 0.f;
#pragma unroll
    for (int i = 0; i < 4; ++i) ss += v[r][i][0] * v[r][i][0] + v[r][i][1] * v[r][i][1] + v[r][i][2] * v[r][i][2] + v[r][i][3] * v[r][i][3];
    ss = wave_sum(ss);
    const float rr = rsqrtf(ss * (1.f / 1024.f) + 1e-6f);
#pragma unroll
    for (int i = 0; i < 4; ++i) {
      float o0 = v[r][i][0] * rr * gg[i][0], o1 = v[r][i][1] * rr * gg[i][1], o2 = v[r][i][2] * rr * gg[i][2], o3 = v[r][i][3] * rr * gg[i][3];
      if (OUTF) { *(f32x4*)((float*)dst + (long)r * 1024 + i * 256 + lane * 4) = (f32x4){o0, o1, o2, o3}; }
      else { u32x2 p; p[0] = pack2(o0, o1); p[1] = pack2(o2, o3); *(u32x2*)((bf16_t*)dst + (long)r * 1024 + i * 256 + lane * 4) = p; }
    }
  }
}

__device__ void phase0(const Params& P, char* smem) {
  float* lds = (float*)smem;
  const int tid = tidx();
  const int NJ = 8 + 1024 + 32 + 32 + 2192;
  for (int job = blockIdx.x; job < NJ; job += gridDim.x) {
    int j = job;
    if (j < 8) {
      int n = j * 32 + (tid & 31), sl = tid >> 5; int kv = n >> 7, nn = n & 127;
      const float* pe = kv ? P.pe_v : P.pe_k; const float* w1 = kv ? P.w_cv1 : P.w_ck1;
      float s = 0.f;
      for (int k = sl * 256; k < sl * 256 + 256; ++k) s += pe[k] * w1[(long)k * 128 + nn];
      lds[sl * 32 + (tid & 31)] = s;
      __syncthreads();
      if (tid < 32) { float t = 0.f; for (int q = 0; q < 8; ++q) t += lds[q * 32 + tid]; ((float*)(P.ws + OFF_BIAS1))[j * 32 + tid] = t; }
      __syncthreads();
      continue;
    }
    j -= 8;
    if (j < 1024) { int row = j * 16 + (tid >> 6) * 4; rownorm_rows<false, 4>(P.x + (long)row * 1024, P.norm_mix, (bf16_t*)(P.ws + OFF_A) + (long)row * 1024); continue; }
    j -= 1024;
    if (j < 32) { int row = j * 16 + (tid >> 6) * 4; rownorm_rows<false, 4>(P.mem + (long)row * 1024, P.norm_mkv, (bf16_t*)(P.ws + OFF_MEMN) + (long)row * 1024); continue; }
    j -= 32;
    if (j < 32) {
      int e0 = j * 2048 + tid * 8; float v[8];
#pragma unroll
      for (int i = 0; i < 8; ++i) { int e = e0 + i; int t = (e >> 7) & 127, s = e & 127; v[i] = s <= t ? P.w_sp[e] : 0.f; }
      *(u32x4*)((bf16_t*)(P.ws + OFF_WM) + e0) = pack8(v);
      continue;
    }
    j -= 32;
#define TRJ(KT, NT, W, NSRC, WT, KD, MODE) \
    if (j < (KT) * (NT)) { transpose_tile<MODE>(W, NSRC, (bf16_t*)(P.ws + (WT)), KD, (j % (KT)) * 128, (j / (KT)) * 64, lds); continue; } \
    j -= (KT) * (NT);
    TRJ(8, 88, P.w_gu, 5632, OFF_WGU, 1024, 1)
    TRJ(22, 16, P.w_dn, 1024, OFF_WDN, 2816, 0)
    TRJ(8, 38, P.w_in, 2328, OFF_W1, 1024, 0)
    TRJ(8, 32, P.w_merge, 2048, OFF_W1 + 2432L * 1024 * 2, 1024, 0)
    TRJ(8, 16, P.w_mkv, 1024, OFF_WMKV, 1024, 0)
    TRJ(8, 16, P.w_out, 1024, OFF_WOUT, 1024, 0)
    TRJ(4, 16, P.w_pa, 1024, OFF_WPA, 512, 0)
    TRJ(4, 16, P.w_pb, 1024, OFF_WPB, 512, 0)
    TRJ(8, 8, P.w_mq, 512, OFF_WMQ, 1024, 0)
    TRJ(4, 16, P.w_mo, 1024, OFF_WMO, 512, 0)
    TRJ(16, 2, P.w_ck1, 128, OFF_WCK1, 2048, 0)
    TRJ(16, 2, P.w_cv1, 128, OFF_WCV1, 2048, 0)
#undef TRJ
  }
}

__device__ void phase1(const Params& P, char* smem) {
  char* ws = P.ws;
  const int NG1 = 128 * 18;
  const int xq = blockIdx.x & 7, lq = blockIdx.x >> 3, sq = gridDim.x >> 3;
  for (int t = lq; t < 16 * 12; t += sq) {
    {
      const int mt = xq * 16 + (t & 15), nt2 = t >> 4; const int brow = mt * 128;
      RowLin ar{(const bf16_t*)(ws + OFF_A) + (long)brow * 1024, 1024};
      RowClamp br{(const bf16_t*)(ws + OFF_W1) + (long)nt2 * 256 * 1024, 1024, 4479 - nt2 * 256};
      gemm_tile2(smem, ar, br, 16, [&](const float* Cs, int p) {
        const int nt = nt2 * 2 + p; if (nt >= 35) return;
        char* C = ws + OFF_C;
        if (nt < 4) {
          store_rows_bf16(Cs, (bf16_t*)(C + C_Q) + (long)brow * 512 + nt * 128, 512, [](float v, int) { return v * (0.125f * LOG2E); });
        } else if (nt == 4 || nt == 5 || nt == 6 || nt == 8) {
          long off = nt == 4 ? C_KC : nt == 5 ? C_VC : nt == 6 ? C_KS : C_KW;
          store_rows_bf16(Cs, (bf16_t*)(C + off) + (long)brow * 128, 128, [](float v, int) { return v; });
        } else if (nt == 7 || nt == 9) {
          long off = nt == 7 ? C_VST : C_VWT; int b = brow >> 13, tl = brow & 8191;
          store_T_bf16(Cs, (bf16_t*)(C + off) + (long)b * 128 * T_ + tl, T_, [](float v) { return v; });
        } else if (nt < 14) {
          store_rows_bf16(Cs, (bf16_t*)(C + C_U) + (long)brow * 512 + (nt - 10) * 128, 512, [](float v, int) { return gelu_tanh(v); });
        } else if (nt < 18) {
          store_T_bf16(Cs, (bf16_t*)(C + C_GVT) + ((long)(brow >> 7) * 512 + (nt - 14) * 128) * 128, 128, [](float v) { return gelu_tanh(v); });
        } else if (nt == 18) {
          float* gates = (float*)(C + C_GATES);
          for (int id = tidx(); id < 128 * 24; id += 256) { int r = id / 24, c = id % 24; gates[(long)(brow + r) * 24 + c] = sigm(Cs[r * CS_LD + c]); }
        } else {
          const float* bm = P.b_merge + (nt - 19) * 128;
          store_rows_bf16(Cs, (bf16_t*)(ws + OFF_B) + (long)brow * 2048 + (nt - 19) * 128, 2048, [bm](float v, int c) { return sigm(v + bm[c]); });
        }
      });
    }
  }
}

__device__ void phase2(const Params& P, char* smem) {
  char* ws = P.ws; const int tid = tidx();
  for (int job = blockIdx.x; job < 32 + 128; job += gridDim.x) {
    if (job < 32) {
      const int kv = job >> 4, mt = job & 15, brow = mt * 128;
      RowCmp ar{(const bf16_t*)(ws + OFF_C + (kv ? C_VC : C_KC)), brow};
      RowLin br{(const bf16_t*)(ws + (kv ? OFF_WCV1 : OFF_WCK1)), 2048};
      const float* bias1 = (const float*)(ws + OFF_BIAS1) + kv * 128;
      const float* w2 = kv ? P.w_cv2 : P.w_ck2;
      gemm_tile(smem, ar, br, 32, 128, 64, [&](const float* Csc) {
        float* Cs = (float*)Csc;
        for (int it = 0; it < 64; ++it) { int id = it * 256 + tid; int r = id >> 7, n = id & 127; Cs[r * CS_LD + n] = gelu_tanh(Cs[r * CS_LD + n] + bias1[n]); }
        __syncthreads();
        const int r = tid >> 1, half = tid & 1;
        float acc[32];
#pragma unroll
        for (int i = 0; i < 32; ++i) acc[i] = 0.f;
        for (int n = 0; n < 128; ++n) {
          float h = Cs[r * CS_LD + n]; const float* wr = w2 + n * 64 + half * 32;
#pragma unroll
          for (int q = 0; q < 8; ++q) { f32x4 w = *(const f32x4*)(wr + q * 4); acc[q * 4] += h * w[0]; acc[q * 4 + 1] += h * w[1]; acc[q * 4 + 2] += h * w[2]; acc[q * 4 + 3] += h * w[3]; }
        }
        const int R = brow + r; const int b = R >> 10, rem = R & 1023, i = rem >> 1, g = rem & 1;
        if (i >= 511) {
#pragma unroll
          for (int q = 0; q < 32; ++q) acc[q] = 0.f;
        }
        if (kv == 0) {
          bf16_t* dst = (bf16_t*)(ws + OFF_KCMP) + (long)(b * 512 + i) * 128 + g * 64 + half * 32;
#pragma unroll
          for (int q = 0; q < 4; ++q) { float v[8];
#pragma unroll
            for (int e = 0; e < 8; ++e) v[e] = acc[q * 8 + e];
            *(u32x4*)(dst + q * 8) = pack8(v); }
        } else {
          bf16_t* dst = (bf16_t*)(ws + OFF_VCT) + ((long)(b * 128 + g * 64 + half * 32)) * 512 + i;
#pragma unroll
          for (int q = 0; q < 32; ++q) dst[(long)q * 512] = (bf16_t)f2bf(acc[q]);
        }
      });
    } else {
      const int bc = job - 32; bf16_t* base = (bf16_t*)(ws + OFF_C + C_GVT) + (long)bc * 512 * 128;
      float* ssum = (float*)smem; float* ssq = ssum + 128;
      float* psum = ssum + 256; float* psq = psum + 16 * 128;
      const int cs = tid >> 4, s8 = (tid & 15) * 8;
      float a[8], q[8];
#pragma unroll
      for (int i = 0; i < 8; ++i) { a[i] = 0.f; q[i] = 0.f; }
      for (int it = 0; it < 32; ++it) {
        u32x4 d = *(const u32x4*)(base + (long)(it * 16 + cs) * 128 + s8);
#pragma unroll
        for (int i = 0; i < 4; ++i) { float lo = bf2f(d[i] & 0xffffu), hi = bf2f(d[i] >> 16); a[2 * i] += lo; q[2 * i] += lo * lo; a[2 * i + 1] += hi; q[2 * i + 1] += hi * hi; }
      }
#pragma unroll
      for (int i = 0; i < 8; ++i) { psum[cs * 128 + s8 + i] = a[i]; psq[cs * 128 + s8 + i] = q[i]; }
      __syncthreads();
      if (tid < 128) {
        float su = 0.f, sq = 0.f;
        for (int c = 0; c < 16; ++c) { su += psum[c * 128 + tid]; sq += psq[c * 128 + tid]; }
        float mean_t = su * (1.f / 512.f); float var = sq * (1.f / 512.f) - mean_t * mean_t; if (var < 0.f) var = 0.f;
        ssum[tid] = mean_t; ssq[tid] = rsqrtf(var + 1e-6f);
      }
      __syncthreads();
      float mean[8], rs[8];
#pragma unroll
      for (int i = 0; i < 8; ++i) { mean[i] = ssum[s8 + i]; rs[i] = ssq[s8 + i]; }
      for (int it = 0; it < 32; ++it) {
        int ch = it * 16 + cs; float gg = P.ln_sgu[ch];
        u32x4 d = *(const u32x4*)(base + (long)ch * 128 + s8); float v[8];
#pragma unroll
        for (int i = 0; i < 4; ++i) { v[2 * i] = bf2f(d[i] & 0xffffu); v[2 * i + 1] = bf2f(d[i] >> 16); }
#pragma unroll
        for (int i = 0; i < 8; ++i) v[i] = (v[i] - mean[i]) * rs[i] * gg;
        *(u32x4*)(base + (long)ch * 128 + s8) = pack8(v);
      }
      __syncthreads();
    }
  }
  if (blockIdx.x >= 32) {
    for (int mtile = blockIdx.x - 32; mtile < 768 + 32; mtile += gridDim.x - 32) {
      if (mtile >= 768) {
        const int j = mtile - 768; const int mt = j >> 3, nt = j & 7; const int brow = mt * 128;
        RowLin ar{(const bf16_t*)(ws + OFF_MEMN) + (long)brow * 1024, 1024};
        RowLin br{(const bf16_t*)(ws + OFF_WMKV) + (long)nt * 128 * 1024, 1024};
        gemm_tile(smem, ar, br, 16, 64, 64, [&](const float* Cs) {
          if (nt < 4) store_rows_bf16(Cs, (bf16_t*)(ws + OFF_MK) + (long)brow * 512 + nt * 128, 512, [](float v, int) { return v; });
          else { int b = mt >> 1, n0 = (mt & 1) * 128; store_T_bf16(Cs, (bf16_t*)(ws + OFF_MVT) + ((long)b * 512 + (nt - 4) * 128) * 256 + n0, 256, [](float v) { return v; }); }
        });
        continue;
      }
      const int mt = mtile & 127, nt2 = 12 + (mtile >> 7), brow = mt * 128;
      RowLin ar{(const bf16_t*)(ws + OFF_A) + (long)brow * 1024, 1024};
      RowClamp br{(const bf16_t*)(ws + OFF_W1) + (long)nt2 * 256 * 1024, 1024, 4479 - nt2 * 256};
      gemm_tile2(smem, ar, br, 16, [&](const float* Cs, int p) {
        const int nt = nt2 * 2 + p; if (nt >= 35) return;
        const float* bm = P.b_merge + (nt - 19) * 128;
        store_rows_bf16(Cs, (bf16_t*)(ws + OFF_B) + (long)brow * 2048 + (nt - 19) * 128, 2048, [bm](float v, int c) { return sigm(v + bm[c]); });
      });
    }
  }
}

template <int MODE>
__device__ __forceinline__ void nsa_block(const bf16x8 (&qf)[4][2], f32x4 (&oacc)[4][4], float (&m)[4], float (&l)[4],
                                          const float (&sl2)[4], const float (&inv)[4], const bf16_t* kp, const bf16_t* vp, long vdt,
                                          int dist0, bool rowok, float (&asum)[2], float (&bsum)[2]) {
  constexpr int DSTEP = (MODE <= 1) ? 16 : 1;
  bf16x8 kf[2][2];
#pragma unroll
  for (int kt = 0; kt < 2; ++kt)
#pragma unroll
    for (int ks = 0; ks < 2; ++ks) kf[kt][ks] = *(const bf16x8*)(kp + kt * 16 * 128 + ks * 32);
  bf16x8 vf[4];
  if (MODE != 0) {
#pragma unroll
    for (int dt = 0; dt < 4; ++dt) {
      u32x2 lo = *(const u32x2*)(vp + dt * vdt); u32x2 hi = *(const u32x2*)(vp + dt * vdt + 16);
      u32x4 c; c[0] = lo[0]; c[1] = lo[1]; c[2] = hi[0]; c[3] = hi[1];
      vf[dt] = __builtin_bit_cast(bf16x8, c);
    }
  }
  const float fd0 = (float)dist0;
#pragma unroll
  for (int h = 0; h < 4; ++h) {
    f32x4 s[2];
#pragma unroll
    for (int kt = 0; kt < 2; ++kt) {
      s[kt] = __builtin_amdgcn_mfma_f32_16x16x32_bf16(kf[kt][0], qf[h][0], (f32x4){0.f, 0.f, 0.f, 0.f}, 0, 0, 0);
      s[kt] = __builtin_amdgcn_mfma_f32_16x16x32_bf16(kf[kt][1], qf[h][1], s[kt], 0, 0, 0);
    }
    float sc[8]; bool ok[8];
#pragma unroll
    for (int kt = 0; kt < 2; ++kt)
#pragma unroll
      for (int r = 0; r < 4; ++r) {
        const int e = kt * 16 + r; const int dist = dist0 - DSTEP * e;
        bool o = dist >= 0;
        if (MODE == 2) o = o && rowok;
        if (MODE == 3) o = o && (dist < 512);
        ok[kt * 4 + r] = o;
        sc[kt * 4 + r] = o ? s[kt][r] - sl2[h] * (fd0 - (float)(DSTEP * e)) : NEGF;
      }
    float p[8];
    if (MODE != 1) {
      float ml = NEGF;
#pragma unroll
      for (int i = 0; i < 8; ++i) ml = fmaxf(ml, sc[i]);
      ml = fmaxf(ml, __shfl_xor(ml, 16, 64)); ml = fmaxf(ml, __shfl_xor(ml, 32, 64));
      const float mn = fmaxf(m[h], ml); const float alpha = __builtin_amdgcn_exp2f(m[h] - mn); m[h] = mn;
      const float mref = fmaxf(mn, -1e29f);
      float ps = 0.f;
#pragma unroll
      for (int i = 0; i < 8; ++i) { p[i] = __builtin_amdgcn_exp2f(sc[i] - mref); ps += p[i]; }
      l[h] = l[h] * alpha + ps;
      if (MODE != 0) {
        if (__builtin_amdgcn_ballot_w64(alpha != 1.f) != 0ull) {
#pragma unroll
          for (int dt = 0; dt < 4; ++dt) oacc[h][dt] *= alpha;
        }
      }
    } else {
      const float mref1 = fmaxf(m[h], -1e29f);
#pragma unroll
      for (int i = 0; i < 8; ++i) p[i] = __builtin_amdgcn_exp2f(sc[i] - mref1) * l[h];
      asum[0] += (p[0] + p[1]) + (p[2] + p[3]); bsum[0] += p[3];
      asum[1] += (p[4] + p[5]) + (p[6] + p[7]); bsum[1] += p[7];
    }
    if (MODE != 0) {
      u32x4 pk; pk[0] = pack2(p[0], p[1]); pk[1] = pack2(p[2], p[3]); pk[2] = pack2(p[4], p[5]); pk[3] = pack2(p[6], p[7]);
      const bf16x8 pf = __builtin_bit_cast(bf16x8, pk);
#pragma unroll
      for (int dt = 0; dt < 4; ++dt) oacc[h][dt] = __builtin_amdgcn_mfma_f32_16x16x32_bf16(vf[dt], pf, oacc[h][dt], 0, 0, 0);
    }
    __builtin_amdgcn_sched_barrier(0);
  }
}

__device__ void nsa_tile(const Params& P, int wt, char* wl) {
  char* C = P.ws + OFF_C;
  const bf16_t* Q = (const bf16_t*)(C + C_Q);
  const bf16_t* KCMP = (const bf16_t*)(P.ws + OFF_KCMP); const bf16_t* VCT = (const bf16_t*)(P.ws + OFF_VCT);
  const bf16_t* KS = (const bf16_t*)(C + C_KS); const bf16_t* VST = (const bf16_t*)(C + C_VST);
  const bf16_t* KW = (const bf16_t*)(C + C_KW); const bf16_t* VWT = (const bf16_t*)(C + C_VWT);
  const float* GATES = (const float*)(C + C_GATES);
  bf16_t* O = (bf16_t*)(P.ws + OFF_D);
  const int lane = tidx() & 63, qi = lane & 15, quad = lane >> 4;
  wt = __builtin_amdgcn_readfirstlane(wt);
  const int jb = wt >> 2, wv4 = wt & 3;
  const int bg = jb & 3, b = bg >> 1, g = bg & 1;
  const int gq = jb >> 2;
  const int tq = (gq < 64 ? 127 - gq : gq - 64) * 4 + wv4;
  const int t0 = tq * 16;
  const int t = t0 + qi;
  const long row = (long)b * T_ + t;
  bf16x8 qf[4][2];
#pragma unroll
  for (int h = 0; h < 4; ++h)
#pragma unroll
    for (int ks = 0; ks < 2; ++ks) qf[h][ks] = *(const bf16x8*)(Q + row * 512 + (g * 4 + h) * 64 + ks * 32 + quad * 8);
  float sl2[4];
#pragma unroll
  for (int h = 0; h < 4; ++h) sl2[h] = __builtin_amdgcn_exp2f(-(float)(g * 4 + h + 1)) * LOG2E;
  f32x4 oacc[4][4]; float m[4], l[4], inv[4]; float asum[2], bsum[2];
  float* imp = (float*)wl; float* outl = (float*)wl;
  unsigned* sel = (unsigned*)(wl + 16384); unsigned* uni = sel + 64;
#pragma unroll
  for (int h = 0; h < 4; ++h) { m[h] = NEGF; l[h] = 0.f; inv[h] = 0.f; }
  asum[0] = asum[1] = bsum[0] = bsum[1] = 0.f;

  const int nI = t0 >> 4; const int nblk = (nI + 31) >> 5;
  for (int blk = nblk - 1; blk >= 0; --blk) {
    const int key0 = blk * 32;
    const bf16_t* kp = KCMP + (long)(b * 512 + key0 + qi) * 128 + g * 64 + quad * 8;
    nsa_block<0>(qf, oacc, m, l, sl2, inv, kp, nullptr, 0, t - 31 - 16 * (key0 + quad * 4), true, asum, bsum);
  }
#pragma unroll
  for (int h = 0; h < 4; ++h) { float lt = l[h]; lt += __shfl_xor(lt, 16, 64); lt += __shfl_xor(lt, 32, 64); l[h] = 1.f / fmaxf(lt, 1e-30f); }
  for (int i = lane; i < 16 * 132; i += 64) imp[i] = 0.f;
#pragma unroll
  for (int h = 0; h < 4; ++h)
#pragma unroll
    for (int dt = 0; dt < 4; ++dt) oacc[h][dt] = (f32x4){0.f, 0.f, 0.f, 0.f};
  for (int blk = 0; blk < nblk; ++blk) {
    const int key0 = blk * 32;
    const bf16_t* kp = KCMP + (long)(b * 512 + key0 + qi) * 128 + g * 64 + quad * 8;
    const bf16_t* vp = VCT + (long)(b * 128 + g * 64 + qi) * 512 + key0 + quad * 4;
    asum[0] = asum[1] = bsum[0] = bsum[1] = 0.f;
    nsa_block<1>(qf, oacc, m, l, sl2, inv, kp, vp, 16 * 512, t - 31 - 16 * (key0 + quad * 4), true, asum, bsum);
    const int J = (key0 >> 2) + quad;
    atomicAdd(&imp[qi * 132 + J], asum[0]); atomicAdd(&imp[qi * 132 + J + 1], bsum[0]);
    atomicAdd(&imp[qi * 132 + J + 4], asum[1]); atomicAdd(&imp[qi * 132 + J + 5], bsum[1]);
  }
  const int cur = t0 >> 6;
  if (lane < 16) {
    unsigned w0 = 0, w1 = 0, w2 = 0, w3 = 0;
    if (cur < 16) { w0 = (1u << (cur + 1)) - 1u; }
    else {
      w0 = 1u;
      { int j = cur; unsigned bit = 1u << (j & 31); int w = j >> 5; if (w == 0) w0 |= bit; else if (w == 1) w1 |= bit; else if (w == 2) w2 |= bit; else w3 |= bit; }
      { int j = cur - 1; unsigned bit = 1u << (j & 31); int w = j >> 5; if (w == 0) w0 |= bit; else if (w == 1) w1 |= bit; else if (w == 2) w2 |= bit; else w3 |= bit; }
    }
    sel[lane * 4 + 0] = w0; sel[lane * 4 + 1] = w1; sel[lane * 4 + 2] = w2; sel[lane * 4 + 3] = w3;
  }
  if (lane < 4) uni[lane] = 0u;
  if (cur >= 16) {
    for (int rnd = 0; rnd < 4; ++rnd) {
      const int qq = rnd * 4 + quad;
      unsigned key[8];
#pragma unroll
      for (int c = 0; c < 8; ++c) {
        const int j = qi + 16 * c;
        const bool v = (j <= cur) && (j != 0) && (j != cur) && (j != cur - 1);
        const unsigned bits = __float_as_uint(imp[qq * 132 + j]);
        key[c] = v ? ((bits & 0xFFFFFF00u) | (unsigned)(128 - j)) : 0u;
      }
      for (int it = 0; it < 13; ++it) {
        unsigned mx = key[0];
#pragma unroll
        for (int c = 1; c < 8; ++c) mx = key[c] > mx ? key[c] : mx;
#pragma unroll
        for (int o = 1; o < 16; o <<= 1) { unsigned ot = (unsigned)__shfl_xor((int)mx, o, 64); mx = ot > mx ? ot : mx; }
        if (mx != 0u) {
#pragma unroll
          for (int c = 0; c < 8; ++c) {
            if (key[c] == mx) { key[c] = 0u; const int j = qi + 16 * c; atomicOr(&sel[qq * 4 + (j >> 5)], 1u << (j & 31)); }
          }
        }
      }
    }
  }
  unsigned mym[4];
#pragma unroll
  for (int w = 0; w < 4; ++w) mym[w] = sel[qi * 4 + w];
  if (lane < 16) {
#pragma unroll
    for (int w = 0; w < 4; ++w) atomicOr(&uni[w], mym[w]);
  }
  const float* gp = GATES + row * 24 + g * 12;
#pragma unroll
  for (int h = 0; h < 4; ++h) {
    const float gt = gp[h * 3 + 0] * NSA_G0;
#pragma unroll
    for (int dt = 0; dt < 4; ++dt) *(f32x4*)(outl + ((h * 16 + qi) * 64 + (((dt * 4 + quad) ^ qi) << 2))) = oacc[h][dt] * gt;
  }
#pragma unroll
  for (int h = 0; h < 4; ++h) { m[h] = NEGF; l[h] = 0.f;
#pragma unroll
    for (int dt = 0; dt < 4; ++dt) oacc[h][dt] = (f32x4){0.f, 0.f, 0.f, 0.f}; }
#pragma unroll 1
  for (int w = 3; w >= 0; --w) {
    unsigned bits = __builtin_amdgcn_readfirstlane(uni[w]);
    const unsigned myw = sel[qi * 4 + w];
    while (bits) {
      const int jj = 31 - __builtin_clz(bits); bits &= ~(1u << jj);
      const int j = w * 32 + jj; const bool rowok = (myw >> jj) & 1u;
#pragma unroll 1
      for (int half = 1; half >= 0; --half) {
        const int key0 = j * 64 + half * 32;
        const bf16_t* kp = KS + (long)(b * T_ + key0 + qi) * 128 + g * 64 + quad * 8;
        const bf16_t* vp = VST + (long)(b * 128 + g * 64 + qi) * T_ + key0 + quad * 4;
        nsa_block<2>(qf, oacc, m, l, sl2, inv, kp, vp, 16L * T_, t - (key0 + quad * 4), rowok, asum, bsum);
      }
    }
  }
#pragma unroll
  for (int h = 0; h < 4; ++h) {
    float lt = l[h]; lt += __shfl_xor(lt, 16, 64); lt += __shfl_xor(lt, 32, 64);
    const float sc = NSA_G1 * gp[h * 3 + 1] / fmaxf(lt, 1e-30f);
#pragma unroll
    for (int dt = 0; dt < 4; ++dt) { f32x4* d = (f32x4*)(outl + ((h * 16 + qi) * 64 + (((dt * 4 + quad) ^ qi) << 2))); *d = *d + oacc[h][dt] * sc; }
  }
#pragma unroll
  for (int h = 0; h < 4; ++h) { m[h] = NEGF; l[h] = 0.f;
#pragma unroll
    for (int dt = 0; dt < 4; ++dt) oacc[h][dt] = (f32x4){0.f, 0.f, 0.f, 0.f}; }
  {
    const int kstart = t0 >= 512 ? ((t0 - 511) & ~31) : 0;
    for (int key0 = (t0 + 15) & ~31; key0 >= kstart; key0 -= 32) {
      const bf16_t* kp = KW + (long)(b * T_ + key0 + qi) * 128 + g * 64 + quad * 8;
      const bf16_t* vp = VWT + (long)(b * 128 + g * 64 + qi) * T_ + key0 + quad * 4;
      nsa_block<3>(qf, oacc, m, l, sl2, inv, kp, vp, 16L * T_, t - (key0 + quad * 4), true, asum, bsum);
    }
  }
#pragma unroll
  for (int h = 0; h < 4; ++h) {
    float lt = l[h]; lt += __shfl_xor(lt, 16, 64); lt += __shfl_xor(lt, 32, 64);
    const float sc = NSA_G2 * gp[h * 3 + 2] / fmaxf(lt, 1e-30f);
#pragma unroll
    for (int dt = 0; dt < 4; ++dt) { f32x4* d = (f32x4*)(outl + ((h * 16 + qi) * 64 + (((dt * 4 + quad) ^ qi) << 2))); *d = *d + oacc[h][dt] * sc; }
  }
#pragma unroll
  for (int it = 0; it < 8; ++it) {
    const int id = it * 64 + lane; const int h = id >> 7, rem = id & 127, q2 = rem >> 3, c8 = rem & 7;
    f32x4 a = *(const f32x4*)(outl + ((h * 16 + q2) * 64 + (((2 * c8) ^ q2) << 2)));
    f32x4 bb = *(const f32x4*)(outl + ((h * 16 + q2) * 64 + (((2 * c8 + 1) ^ q2) << 2)));
    float v[8] = {a[0], a[1], a[2], a[3], bb[0], bb[1], bb[2], bb[3]};
    *(u32x4*)(O + ((long)b * T_ + t0 + q2) * 512 + (g * 4 + h) * 64 + c8 * 8) = pack8(v);
  }
}

__device__ void xattn_tile(const Params& P, int wt) {
  const bf16_t* HQ = (const bf16_t*)(P.ws + OFF_D);
  const bf16_t* MK = (const bf16_t*)(P.ws + OFF_MK); const bf16_t* MVT = (const bf16_t*)(P.ws + OFF_MVT);
  bf16_t* OX = (bf16_t*)(P.ws + OFF_D) + (long)M_ * 512;
  const int lane = tidx() & 63, qi = lane & 15, quad = lane >> 4;
  wt = __builtin_amdgcn_readfirstlane(wt);
  const int h = wt & 3; const int row0 = (wt >> 2) * 32; const int b = row0 >> 13;
  bf16x8 qf[2][4];
#pragma unroll
  for (int nt = 0; nt < 2; ++nt)
#pragma unroll
    for (int ks = 0; ks < 4; ++ks) qf[nt][ks] = *(const bf16x8*)(HQ + (long)(row0 + nt * 16 + qi) * 512 + h * 128 + ks * 32 + quad * 8);
  f32x4 oacc[2][8]; float m[2], l[2];
#pragma unroll
  for (int nt = 0; nt < 2; ++nt) { m[nt] = NEGF; l[nt] = 0.f;
#pragma unroll
    for (int dt = 0; dt < 8; ++dt) oacc[nt][dt] = (f32x4){0.f, 0.f, 0.f, 0.f}; }
  for (int blk = 0; blk < 8; ++blk) {
    const int key0 = blk * 32;
    f32x4 s[2][2];
#pragma unroll
    for (int nt = 0; nt < 2; ++nt)
#pragma unroll
      for (int kt = 0; kt < 2; ++kt) s[nt][kt] = (f32x4){0.f, 0.f, 0.f, 0.f};
#pragma unroll
    for (int ks = 0; ks < 4; ++ks) {
#pragma unroll
      for (int kt = 0; kt < 2; ++kt) {
        bf16x8 kf = *(const bf16x8*)(MK + (long)(b * 256 + key0 + kt * 16 + qi) * 512 + h * 128 + ks * 32 + quad * 8);
#pragma unroll
        for (int nt = 0; nt < 2; ++nt) s[nt][kt] = __builtin_amdgcn_mfma_f32_16x16x32_bf16(kf, qf[nt][ks], s[nt][kt], 0, 0, 0);
      }
    }
    bf16x8 pf[2];
#pragma unroll
    for (int nt = 0; nt < 2; ++nt) {
      float ml = NEGF;
#pragma unroll
      for (int kt = 0; kt < 2; ++kt)
#pragma unroll
        for (int r = 0; r < 4; ++r) ml = fmaxf(ml, s[nt][kt][r]);
      ml = fmaxf(ml, __shfl_xor(ml, 16, 64)); ml = fmaxf(ml, __shfl_xor(ml, 32, 64));
      const float mn = fmaxf(m[nt], ml); const float alpha = __builtin_amdgcn_exp2f(m[nt] - mn); m[nt] = mn;
      float p[8]; float ps = 0.f;
#pragma unroll
      for (int kt = 0; kt < 2; ++kt)
#pragma unroll
        for (int r = 0; r < 4; ++r) { p[kt * 4 + r] = __builtin_amdgcn_exp2f(s[nt][kt][r] - mn); ps += p[kt * 4 + r]; }
      l[nt] = l[nt] * alpha + ps;
#pragma unroll
      for (int dt = 0; dt < 8; ++dt) oacc[nt][dt] *= alpha;
      u32x4 pk; pk[0] = pack2(p[0], p[1]); pk[1] = pack2(p[2], p[3]); pk[2] = pack2(p[4], p[5]); pk[3] = pack2(p[6], p[7]);
      pf[nt] = __builtin_bit_cast(bf16x8, pk);
    }
#pragma unroll
    for (int dt = 0; dt < 8; ++dt) {
      const bf16_t* vp = MVT + (long)(b * 512 + h * 128 + dt * 16 + qi) * 256 + key0 + quad * 4;
      u32x2 lo = *(const u32x2*)(vp); u32x2 hi = *(const u32x2*)(vp + 16);
      u32x4 c; c[0] = lo[0]; c[1] = lo[1]; c[2] = hi[0]; c[3] = hi[1];
      const bf16x8 vf = __builtin_bit_cast(bf16x8, c);
#pragma unroll
      for (int nt = 0; nt < 2; ++nt) oacc[nt][dt] = __builtin_amdgcn_mfma_f32_16x16x32_bf16(vf, pf[nt], oacc[nt][dt], 0, 0, 0);
    }
  }
#pragma unroll
  for (int nt = 0; nt < 2; ++nt) {
    float lt = l[nt]; lt += __shfl_xor(lt, 16, 64); lt += __shfl_xor(lt, 32, 64);
    const float iv = 1.f / lt;
#pragma unroll
    for (int dt = 0; dt < 8; ++dt) {
      f32x4 v = oacc[nt][dt] * iv; u32x2 pk; pk[0] = pack2(v[0], v[1]); pk[1] = pack2(v[2], v[3]);
      *(u32x2*)(OX + (long)(row0 + nt * 16 + qi) * 512 + h * 128 + dt * 16 + quad * 4) = pk;
    }
  }
}


#define XB_TMO      128
#define XB_XCNT(j)  (256  + 64 * (j))
#define XB_XSUB(j)  (1280 + 64 * (j))
#define XB_XGEN(j)  (2304 + 64 * (j))
#define XB_TOP      3328
#define XB_TOPGEN   3392
#define XCD_BAR_WORDS 3456
#define XB_SPIN_CAP (1u << 18)
#define LAS __attribute__((address_space(3)))
__device__ __forceinline__ unsigned xb_ld(unsigned* p) { return __hip_atomic_load(p, __ATOMIC_RELAXED, __HIP_MEMORY_SCOPE_AGENT); }
__device__ __forceinline__ unsigned xb_add(unsigned* p, unsigned v) { return __hip_atomic_fetch_add(p, v, __ATOMIC_RELAXED, __HIP_MEMORY_SCOPE_AGENT); }
__device__ __forceinline__ unsigned xb_xcc_id() { return (unsigned)__builtin_amdgcn_s_getreg((3 << 11) | 20) & 0xFu; }
#define XB_SPIN(cond, bar) do { unsigned _sp = 0; while (cond) { __builtin_amdgcn_s_sleep(1); \
    if ((++_sp & 255u) == 0u) { if (xb_ld(&(bar)[XB_TMO])) break; if (_sp > XB_SPIN_CAP) { atomicAdd(&(bar)[XB_TMO], 1u); break; } } } } while (0)
__device__ __forceinline__ void xcd_barrier_complete(unsigned* bar, unsigned x, unsigned& nloc, unsigned& nx) {
  const unsigned G = gridDim.x * gridDim.y * gridDim.z;
  unsigned sum, cnt, mine, sp = 0u;
  for (;;) {
    sum = 0u; cnt = 0u; mine = 0u;
#pragma unroll
    for (unsigned j = 0; j < 16; ++j) { const unsigned c = xb_ld(&bar[XB_XCNT(j)]); sum += c; cnt += (c > 0u) ? 1u : 0u; mine = (j == x) ? c : mine; }
    if (sum == G) break;
    __builtin_amdgcn_s_sleep(1);
    if ((++sp & 255u) == 0u) { if (xb_ld(&bar[XB_TMO])) break; if (sp > XB_SPIN_CAP) { atomicAdd(&bar[XB_TMO], 1u); break; } }
  }
  nloc = mine > 0u ? mine : 1u; nx = cnt > 0u ? cnt : 1u;
}
__device__ __forceinline__ void xcd_barrier(unsigned* bar, unsigned x, volatile LAS unsigned* st) {
  asm volatile("s_waitcnt vmcnt(0)" ::: "memory");
  __syncthreads();
  if (threadIdx.x == 0) {
    __builtin_amdgcn_s_waitcnt(0);
    unsigned nloc = st[0], nx = st[1];
    if (nloc == 0u) { xcd_barrier_complete(bar, x, nloc, nx); st[0] = nloc; st[1] = nx; }
    const unsigned old = xb_add(&bar[XB_XSUB(x)], 1u);
    const unsigned gen = old / nloc;
    if (old + 1u == (gen + 1u) * nloc) {
      __builtin_amdgcn_fence(__ATOMIC_RELEASE, "agent");
      asm volatile("s_waitcnt vmcnt(0)" ::: "memory");
      const unsigned og = xb_add(&bar[XB_TOP], 1u);
      const unsigned tg = og / nx;
      if (og + 1u == (tg + 1u) * nx) xb_add(&bar[XB_TOPGEN], 1u);
      else XB_SPIN(xb_ld(&bar[XB_TOPGEN]) == tg, bar);
      __builtin_amdgcn_fence(__ATOMIC_ACQUIRE, "agent");
      xb_add(&bar[XB_XGEN(x)], 1u);
      asm volatile("s_waitcnt vmcnt(0)" ::: "memory");
    } else {
      XB_SPIN(xb_ld(&bar[XB_XGEN(x)]) == gen, bar);
      __builtin_amdgcn_fence(__ATOMIC_ACQUIRE, "agent");
      asm volatile("s_waitcnt vmcnt(0)" ::: "memory");
    }
  }
  __syncthreads();
}

__device__ void run_phase(const Params& P, int ph, char* smem, bool ph_fused) {
  char* ws = P.ws; const int tid = tidx();
  switch (ph) {
    case 0: phase0(P, smem); break;
    case 1: phase1(P, smem); break;
    case 2: phase2(P, smem); break;
    case 3: {
      for (int job = blockIdx.x; job < 512; job += gridDim.x) { const int wv = tidx() >> 6; nsa_tile(P, job * 4 + wv, smem + wv * 16896); }
      __syncthreads();
      for (int job = blockIdx.x; job < 512; job += gridDim.x) {
        {
          const int tid = tidx();
          const int s = job; const int bc = s >> 2, g = s & 3;
          RowLin ar{(const bf16_t*)(ws + OFF_WM) + g * 16384, 128};
          RowLin br{(const bf16_t*)(ws + OFF_C + C_GVT) + ((long)bc * 512 + g * 128) * 128, 128};
          const float* bs = P.b_sp + g * 128;
          const bf16_t* U = (const bf16_t*)(ws + OFF_C + C_U) + (long)bc * 128 * 512 + g * 128;
          bf16_t* OS = (bf16_t*)(ws + OFF_D) + (long)M_ * 512 + (long)bc * 128 * 512 + g * 128;
          gemm_tile(smem, ar, br, 2, 64, 64, [&](const float* Cs) {
#pragma unroll 2
            for (int it = 0; it < 8; ++it) {
              int id = it * 256 + tid; int r = id >> 4, c = (id & 15) * 8; float v[8]; ld8(Cs, r, c, v);
              u32x4 d = *(const u32x4*)(U + (long)r * 512 + c); const float bb = bs[r];
#pragma unroll
              for (int i = 0; i < 4; ++i) { v[2 * i] = (v[2 * i] + bb) * bf2f(d[i] & 0xffffu); v[2 * i + 1] = (v[2 * i + 1] + bb) * bf2f(d[i] >> 16); }
              *(u32x4*)(OS + (long)r * 512 + c) = pack8(v);
            }
          });
        }
      }
    } break;
    case 4: {
      float* scr = (float*)(ws + OFF_C + C_SCR) + (long)blockIdx.x * 16384;
      const int xq = blockIdx.x & 7, lq = blockIdx.x >> 3, sq = gridDim.x >> 3;
      for (int t = lq; t < 16 * 8; t += sq) {
        const int mt = xq * 16 + (t & 15), nt = t >> 4, brow = mt * 128, bcol = nt * 128;
        const bf16_t* MG = (const bf16_t*)(ws + OFF_B) + (long)brow * 2048 + bcol;
        RowLin a1{(const bf16_t*)(ws + OFF_D) + (long)brow * 512, 512};
        RowLin b1{(const bf16_t*)(ws + OFF_WPA) + (long)bcol * 512, 512};
        gemm_tile(smem, a1, b1, 8, 64, 64, [&](const float* Cs) {
#pragma unroll 2
          for (int it = 0; it < 8; ++it) {
            int id = it * 256 + tid; int r = id >> 4, c = (id & 15) * 8; float v[8]; ld8(Cs, r, c, v);
            u32x4 d = *(const u32x4*)(MG + (long)r * 2048 + c);
#pragma unroll
            for (int i = 0; i < 4; ++i) { v[2 * i] *= bf2f(d[i] & 0xffffu); v[2 * i + 1] *= bf2f(d[i] >> 16); }
            *(f32x4*)(scr + id * 8) = (f32x4){v[0], v[1], v[2], v[3]}; *(f32x4*)(scr + id * 8 + 4) = (f32x4){v[4], v[5], v[6], v[7]};
          }
        });
        RowLin a2{(const bf16_t*)(ws + OFF_D) + (long)M_ * 512 + (long)brow * 512, 512};
        RowLin b2{(const bf16_t*)(ws + OFF_WPB) + (long)bcol * 512, 512};
        bf16_t* MX = (bf16_t*)(ws + OFF_C + C_MIXED) + (long)brow * 1024 + bcol;
        gemm_tile(smem, a2, b2, 8, 64, 64, [&](const float* Cs) {
#pragma unroll 2
          for (int it = 0; it < 8; ++it) {
            int id = it * 256 + tid; int r = id >> 4, c = (id & 15) * 8; float v[8]; ld8(Cs, r, c, v);
            u32x4 d = *(const u32x4*)(MG + (long)r * 2048 + 1024 + c);
            f32x4 p0 = *(const f32x4*)(scr + id * 8), p1 = *(const f32x4*)(scr + id * 8 + 4);
            float pv[8] = {p0[0], p0[1], p0[2], p0[3], p1[0], p1[1], p1[2], p1[3]};
#pragma unroll
            for (int i = 0; i < 4; ++i) { v[2 * i] = pv[2 * i] + v[2 * i] * bf2f(d[i] & 0xffffu); v[2 * i + 1] = pv[2 * i + 1] + v[2 * i + 1] * bf2f(d[i] >> 16); }
            *(u32x4*)(MX + (long)r * 1024 + c) = pack8(v);
          }
        });
      }
    } break;
    case 5: case 9: case 12: {
      const bf16_t* A; const bf16_t* W; const float* RES; float* DST; int K;
      if (ph == 5) { A = (const bf16_t*)(ws + OFF_C + C_MIXED); W = (const bf16_t*)(ws + OFF_WOUT); RES = P.x; DST = (float*)(ws + OFF_B); K = 1024; }
      else if (ph == 9) { A = (const bf16_t*)(ws + OFF_D) + (long)M_ * 512; W = (const bf16_t*)(ws + OFF_WMO); RES = (const float*)(ws + OFF_B); DST = (float*)(ws + OFF_C + C_H2); K = 512; }
      else { A = (const bf16_t*)(ws + OFF_B); W = (const bf16_t*)(ws + OFF_WDN); RES = (const float*)(ws + OFF_C + C_H2); DST = P.out; K = 2816; }
      const int xq = blockIdx.x & 7, lq = blockIdx.x >> 3, sq = gridDim.x >> 3;
      for (int t = lq; t < 16 * 4; t += sq) {
        const int mt = xq * 16 + (t & 15), nt2 = t >> 4, brow = mt * 128;
        RowLin ar{A + (long)brow * K, K}; RowLin br{W + (long)nt2 * 256 * K, K};
        gemm_tile2(smem, ar, br, K / 64, [&](const float* Cs, int p) {
          const int bcol = nt2 * 256 + p * 128;
          const float* rs = RES + (long)brow * 1024 + bcol; float* ds = DST + (long)brow * 1024 + bcol;
#pragma unroll 4
          for (int it = 0; it < 8; ++it) {
            int id = it * 256 + tid; int r = id >> 4, c = (id & 15) * 8;
            f32x4 a = *(const f32x4*)(Cs + r * CS_LD + c), bq = *(const f32x4*)(Cs + r * CS_LD + c + 4);
            f32x4 r0 = *(const f32x4*)(rs + (long)r * 1024 + c), r1 = *(const f32x4*)(rs + (long)r * 1024 + c + 4);
            const f32x4 h0 = a + r0, h1v = bq + r1;
            *(f32x4*)(ds + (long)r * 1024 + c) = h0; *(f32x4*)(ds + (long)r * 1024 + c + 4) = h1v;
            if (ph != 12) {
              const float* gn = (ph == 5 ? P.norm_mq : P.norm_ffn) + bcol + c;
              const f32x4 g0 = *(const f32x4*)gn, g1 = *(const f32x4*)(gn + 4);
              float v[8] = {h0[0] * g0[0], h0[1] * g0[1], h0[2] * g0[2], h0[3] * g0[3], h1v[0] * g1[0], h1v[1] * g1[1], h1v[2] * g1[2], h1v[3] * g1[3]};
              *(u32x4*)((bf16_t*)(ws + OFF_A) + (long)(brow + r) * 1024 + bcol + c) = pack8(v);
              float ss = (h0[0] * h0[0] + h0[1] * h0[1]) + (h0[2] * h0[2] + h0[3] * h0[3]) + (h1v[0] * h1v[0] + h1v[1] * h1v[1]) + (h1v[2] * h1v[2] + h1v[3] * h1v[3]);
              ss += __shfl_xor(ss, 1, 64); ss += __shfl_xor(ss, 2, 64); ss += __shfl_xor(ss, 4, 64); ss += __shfl_xor(ss, 8, 64);
              if ((tid & 15) == 0) ((float*)(ws + (ph == 5 ? OFF_SSQ1 : OFF_SSQ2)))[(long)(brow + r) * 8 + nt2 * 2 + p] = ss;
            }
          }
        });
      }
    } break;
    case 6: case 10: {
      const float* src = ph == 6 ? (const float*)(ws + OFF_B) : (const float*)(ws + OFF_C + C_H2);
      const float* g = ph == 6 ? P.norm_mq : P.norm_ffn;
      (void)src; (void)g;
    } break;
    case 7: {
      const int xq = blockIdx.x & 7, lq = blockIdx.x >> 3, sq = gridDim.x >> 3;
      for (int t = lq; t < 16 * 4; t += sq) {
        const int mt = xq * 16 + (t & 15), nt = t >> 4, brow = mt * 128;
        RowLin ar{(const bf16_t*)(ws + OFF_A) + (long)brow * 1024, 1024}; RowLin br{(const bf16_t*)(ws + OFF_WMQ) + (long)nt * 128 * 1024, 1024};
        gemm_tile(smem, ar, br, 16, 64, 64, [&](const float* Cs) {
          bf16_t* dq = (bf16_t*)(ws + OFF_D) + (long)brow * 512 + nt * 128; const float* sq1 = (const float*)(ws + OFF_SSQ1) + (long)brow * 8;
#pragma unroll 2
          for (int it = 0; it < 8; ++it) {
            int id = it * 256 + tid; int r = id >> 4, c = (id & 15) * 8; float v[8]; ld8(Cs, r, c, v);
            const f32x4 s0 = *(const f32x4*)(sq1 + r * 8), s1 = *(const f32x4*)(sq1 + r * 8 + 4);
            const float ssum = ((s0[0] + s0[1]) + (s0[2] + s0[3])) + ((s1[0] + s1[1]) + (s1[2] + s1[3]));
            const float rr = rsqrtf(ssum * (1.f / 1024.f) + 1e-6f) * (0.08838834764831845f * LOG2E);
#pragma unroll
            for (int i = 0; i < 8; ++i) v[i] *= rr;
            *(u32x4*)(dq + (long)r * 512 + c) = pack8(v);
          }
        });
        asm volatile("s_waitcnt vmcnt(0)" ::: "memory");
        __syncthreads();
        xattn_tile(P, ((brow >> 5) + (tid >> 6)) * 4 + nt);
      }
    } break;
    case 8: {
      if (ph_fused) break;
      for (int job = blockIdx.x; job < 512; job += gridDim.x) xattn_tile(P, job * 4 + (tid >> 6));
    } break;
    case 11: {
      const int xq = blockIdx.x & 7, lq = blockIdx.x >> 3, sq = gridDim.x >> 3;
      for (int t = lq; t < 16 * 22; t += sq) {
        const int mt = xq * 16 + (t & 15), nt2 = t >> 4, brow = mt * 128;
        RowLin ar{(const bf16_t*)(ws + OFF_A) + (long)brow * 1024, 1024}; RowLin br{(const bf16_t*)(ws + OFF_WGU) + (long)nt2 * 256 * 1024, 1024};
        gemm_tile2(smem, ar, br, 16, [&](const float* Cs, int p) {
          bf16_t* ACT = (bf16_t*)(ws + OFF_B) + (long)brow * 2816 + (nt2 * 2 + p) * 64;
#pragma unroll 2
          for (int it = 0; it < 4; ++it) {
            int id = it * 256 + tid; int r = id >> 3, c = (id & 7) * 8; float gt[8], up[8]; ld8(Cs, r, c, gt); ld8(Cs, r, c + 64, up);
            const float* sq2 = (const float*)(ws + OFF_SSQ2) + (long)(brow + r) * 8;
            const f32x4 s0 = *(const f32x4*)(sq2), s1 = *(const f32x4*)(sq2 + 4);
            const float ssum = ((s0[0] + s0[1]) + (s0[2] + s0[3])) + ((s1[0] + s1[1]) + (s1[2] + s1[3]));
            const float rr = rsqrtf(ssum * (1.f / 1024.f) + 1e-6f);
#pragma unroll
            for (int i = 0; i < 8; ++i) { const float gg = gt[i] * rr; gt[i] = gg * sigm(gg) * (up[i] * rr); }
            *(u32x4*)(ACT + (long)r * 2816 + c) = pack8(gt);
          }
        });
      }
    } break;
    case 13: {
      for (int job = blockIdx.x; job < 1024; job += gridDim.x) { int row = job * 16 + (tid >> 6) * 4; rownorm_rows<true, 4>(P.out + (long)row * 1024, P.norm_final, P.out + (long)row * 1024); }
    } break;
#ifdef PROBE_K
    case 14: {
      const bf16_t* s0 = (const bf16_t*)(ws + PROBE_SRC0); const bf16_t* s1 = (const bf16_t*)(ws + PROBE_SRC1);
      for (long i = (long)blockIdx.x * 256 + tid; i < (long)M_ * 512; i += (long)gridDim.x * 256) {
        long row = i >> 9; int c = (int)(i & 511);
        P.out[row * 1024 + c] = bf2f(s0[i]); P.out[row * 1024 + 512 + c] = bf2f(s1[i]);
      }
    } break;
    case 15: {
      const float* s0 = (const float*)(ws + PROBE_SRC0);
      for (long i = (long)blockIdx.x * 256 + tid; i < (long)M_ * 1024; i += (long)gridDim.x * 256) P.out[i] = s0[i];
    } break;
#endif
  }
}

__global__ void __launch_bounds__(256, 2) fwd_kernel(Params P, int ph_lo, int ph_hi) {
  __shared__ __attribute__((aligned(16))) char smem[73728 + 16];
  volatile LAS unsigned* st = (volatile LAS unsigned*)(smem + 73728);
  const unsigned xcc = xb_xcc_id();
  if (ph_lo < ph_hi) {
    if (threadIdx.x == 0) { st[0] = 0u; st[1] = 0u; }
    __syncthreads();
    if (threadIdx.x == 0) (void)xb_add(&((unsigned*)(P.ws + OFF_BAR))[XB_XCNT(xcc)], 1u);
  }
  if (ph_hi < 0) cg::this_grid().sync();
  for (int ph = ph_lo; ph <= ph_hi; ++ph) {
    const uint64_t __attribute__((address_space(4)))* ka = (const uint64_t __attribute__((address_space(4)))*)__builtin_amdgcn_kernarg_segment_ptr();
    asm volatile("" : "+s"(ka));
    Params Pl; uint64_t* pd = (uint64_t*)&Pl;
#pragma unroll
    for (int i = 0; i < (int)(sizeof(Params) / 8); ++i) {
      const char __attribute__((address_space(1)))* gp = (const char __attribute__((address_space(1)))*)ka[i];
      pd[i] = (uint64_t)(const char*)gp;
    }
    if (ph == 6 || ph == 10 || ph == 8) continue;
    run_phase(Pl, ph, smem, true);
    if (ph < ph_hi) xcd_barrier((unsigned*)(Pl.ws + OFF_BAR), xcc, st);
  }
}

extern "C" void kernel_launch(void* const* d_in, const int* in_sizes, int n_in, void* d_out, int out_size, void* d_ws, size_t ws_size,
                              hipStream_t stream) {
  static int grid_blocks = 0;
  if (!grid_blocks) {
    int dev = 0, cus = 0, per_cu = 0;
    hipGetDevice(&dev);
    hipDeviceGetAttribute(&cus, hipDeviceAttributeMultiprocessorCount, dev);
    hipOccupancyMaxActiveBlocksPerMultiprocessor(&per_cu, fwd_kernel, 256, 0);
    if (per_cu > 2) per_cu = 2;
    if (per_cu < 1) per_cu = 1;
    grid_blocks = cus * per_cu;
  }
  if (ws_size < (size_t)WS_NEED) fprintf(stderr, "workspace too small: %zu < %ld\n", ws_size, (long)WS_NEED);
  Params P{};
  const float** pp = (const float**)&P;
  for (int i = 0; i < 27; ++i) pp[i] = (const float*)d_in[i];
  P.out = (float*)d_out; P.ws = (char*)d_ws;
#if ONE_LAUNCH
  hipMemsetAsync((char*)d_ws + OFF_BAR, 0, XCD_BAR_WORDS * 4, stream);
#ifdef PROBE_K
  int lo = 0, hi = PROBE_DUMP;
#else
  int lo = 0, hi = 13;
#endif
  void* args[] = {&P, &lo, &hi};
  hipError_t e = hipLaunchCooperativeKernel((void*)fwd_kernel, dim3(grid_blocks), dim3(256), args, 0, stream);
  if (e != hipSuccess) fprintf(stderr, "cooperative launch failed: %s (grid %d)\n", hipGetErrorString(e), grid_blocks);
#else
  for (int ph = 0; ph <= 13; ++ph) fwd_kernel<<<grid_blocks, 256, 0, stream>>>(P, ph, ph);
#endif
}
```

```cpp
#include <hip/hip_runtime.h>
#include <hip/hip_cooperative_groups.h>
#include <stdint.h>
#include <stdio.h>
namespace cg = cooperative_groups;

#ifndef NSA_G0
#define NSA_G0 1.f
#define NSA_G1 1.f
#define NSA_G2 1.f
#endif
#ifndef ONE_LAUNCH
#define ONE_LAUNCH 1
#endif

typedef unsigned short bf16_t;
using bf16x8 = __attribute__((ext_vector_type(8))) short;
using f32x4 = __attribute__((ext_vector_type(4))) float;
using u32x4 = __attribute__((ext_vector_type(4))) unsigned;
using u32x2 = __attribute__((ext_vector_type(2))) unsigned;

#define T_ 8192
#define M_ 16384
#define NEGF (-1e30f)
#define LOG2E 1.4426950408889634f

constexpr long OFF_W1 = 0;
constexpr long OFF_WMKV = OFF_W1 + 4608L * 1024 * 2;
constexpr long OFF_WPA = OFF_WMKV + 2097152;
constexpr long OFF_WPB = OFF_WPA + 1048576;
constexpr long OFF_WOUT = OFF_WPB + 1048576;
constexpr long OFF_WMQ = OFF_WOUT + 2097152;
constexpr long OFF_WMO = OFF_WMQ + 1048576;
constexpr long OFF_WGU = OFF_WMO + 1048576;
constexpr long OFF_WDN = OFF_WGU + 11534336;
constexpr long OFF_WCK1 = OFF_WDN + 5767168;
constexpr long OFF_WCV1 = OFF_WCK1 + 524288;
constexpr long OFF_WM = OFF_WCV1 + 524288;
constexpr long OFF_BIAS1 = OFF_WM + 131072;
constexpr long OFF_MEMN = OFF_BIAS1 + 1024;
constexpr long OFF_MK = OFF_MEMN + 1048576;
constexpr long OFF_MVT = OFF_MK + 524288;
constexpr long OFF_KCMP = OFF_MVT + 524288;
constexpr long OFF_VCT = OFF_KCMP + 262144;
constexpr long OFF_A = OFF_VCT + 262144;
constexpr long OFF_B = OFF_A + 33554432;
constexpr long OFF_D = OFF_B + 67108864;
constexpr long OFF_C = OFF_D + 33554432;
constexpr long C_Q = 0, C_U = 16777216, C_GVT = 33554432, C_KC = 50331648, C_VC = 54525952, C_KS = 58720256,
               C_KW = 62914560, C_VST = 67108864, C_VWT = 71303168, C_GATES = 75497472;
constexpr long C_MIXED = 0, C_SCR = 33554432, C_H2 = 0;
constexpr long OFF_BAR = OFF_C + 77070336;
constexpr long OFF_SSQ1 = OFF_BAR + 16384;
constexpr long OFF_SSQ2 = OFF_SSQ1 + 524288;
constexpr long WS_NEED = OFF_SSQ2 + 524288;

struct Params {
  const float *x, *mem, *norm_mix, *w_in, *w_ck1, *w_ck2, *w_cv1, *w_cv2, *pe_k, *pe_v, *ln_sgu, *w_sp, *b_sp,
      *w_pa, *w_pb, *w_merge, *b_merge, *w_out, *norm_mq, *norm_mkv, *w_mq, *w_mkv, *w_mo, *norm_ffn, *w_gu, *w_dn, *norm_final;
  float* out;
  char* ws;
};

__device__ __forceinline__ int tidx() { int t = threadIdx.x; asm volatile("" : "+v"(t)); return t; }
__device__ __forceinline__ unsigned f2bf(float f) { unsigned u = __float_as_uint(f); u += 0x7fffu + ((u >> 16) & 1u); return u >> 16; }
__device__ __forceinline__ unsigned pack2(float a, float b) { unsigned r; asm("v_cvt_pk_bf16_f32 %0, %1, %2" : "=v"(r) : "v"(a), "v"(b)); return r; }
__device__ __forceinline__ float bf2f(unsigned h) { return __uint_as_float(h << 16); }
__device__ __forceinline__ float gelu_tanh(float x) { float u = 0.7978845608028654f * (x + 0.044715f * x * x * x); return x / (1.f + __expf(-2.f * u)); }
__device__ __forceinline__ float sigm(float x) { return 1.f / (1.f + __expf(-x)); }
__device__ __forceinline__ float wave_sum(float v) {
#pragma unroll
  for (int o = 32; o > 0; o >>= 1) v += __shfl_xor(v, o, 64);
  return v;
}
__device__ __forceinline__ u32x4 pack8(const float (&v)[8]) {
  u32x4 r; r[0] = pack2(v[0], v[1]); r[1] = pack2(v[2], v[3]); r[2] = pack2(v[4], v[5]); r[3] = pack2(v[6], v[7]); return r;
}

__device__ __forceinline__ int lds_byte(int r, int c) {
  int st = (r >> 4) * 2 + (c >> 5), rr = r & 15, cc = c & 31, ob = rr * 64 + cc * 2;
  return st * 1024 + (ob ^ (((ob >> 9) & 1) << 5));
}
__device__ __forceinline__ void stage_rc(int b, int& R, int& C) {
  int st = b >> 10, sb = b & 1023, swz = sb ^ (((sb >> 9) & 1) << 5);
  R = (st >> 1) * 16 + (swz >> 6); C = (st & 1) * 32 + ((swz & 63) >> 1);
}

#define CS_LD 132
__device__ __forceinline__ void ld8(const float* Cs, int r, int c, float (&v)[8]) {
  f32x4 a = *(const f32x4*)(Cs + r * CS_LD + c); f32x4 b = *(const f32x4*)(Cs + r * CS_LD + c + 4);
  v[0] = a[0]; v[1] = a[1]; v[2] = a[2]; v[3] = a[3]; v[4] = b[0]; v[5] = b[1]; v[6] = b[2]; v[7] = b[3];
}
__device__ __forceinline__ void ld8T(const float* Cs, int r8, int c, float (&v)[8]) {
#pragma unroll
  for (int i = 0; i < 8; ++i) v[i] = Cs[(r8 + i) * CS_LD + c];
}

struct RowLin {
  const bf16_t* base; long ld;
  __device__ __forceinline__ const bf16_t* operator()(int r) const { return base + (long)r * ld; }
};
struct RowCmp {
  const bf16_t* base; int brow;
  __device__ __forceinline__ const bf16_t* operator()(int r) const {
    int R = brow + r; int b = R >> 10, rem = R & 1023, i = rem >> 1, g = rem & 1; if (i > 510) i = 510;
    return base + ((long)(b * T_ + 16 * i) * 128 + g * 64);
  }
};

template <int AUX = 0, class ARow, class BRow, class Epi>
__device__ __forceinline__ void gemm_tile(char* smem, ARow arow, BRow brow, int nkt, int kstepA, int kstepB, Epi epi) {
  const int tid = tidx(), lane = tid & 63, wave = tid >> 6, wr = wave >> 1, wc = wave & 1, fr = lane & 15, fq = lane >> 4;
  const bf16_t* pa[4]; const bf16_t* pb[4];
#pragma unroll
  for (int i = 0; i < 4; ++i) { int b = tid * 16 + i * 4096; int R, C; stage_rc(b, R, C); pa[i] = arow(R) + C; pb[i] = brow(R) + C; }
  f32x4 acc[4][4];
#pragma unroll
  for (int m = 0; m < 4; ++m)
#pragma unroll
    for (int n = 0; n < 4; ++n) acc[m][n] = (f32x4){0.f, 0.f, 0.f, 0.f};
  {
#pragma unroll
    for (int i = 0; i < 4; ++i) {
      __builtin_amdgcn_global_load_lds((const unsigned*)(pa[i]), (unsigned*)(smem + tid * 16 + i * 4096), 16, 0, AUX);
      __builtin_amdgcn_global_load_lds((const unsigned*)(pb[i]), (unsigned*)(smem + 16384 + tid * 16 + i * 4096), 16, 0, AUX);
    }
  }
  for (int kt = 0; kt < nkt; ++kt) {
    asm volatile("s_waitcnt vmcnt(0)" ::: "memory");
    __syncthreads();
    if (kt + 1 < nkt) {
      char* la = smem + ((kt + 1) & 1) * 32768;
#pragma unroll
      for (int i = 0; i < 4; ++i) {
        __builtin_amdgcn_global_load_lds((const unsigned*)(pa[i] + (long)(kt + 1) * kstepA), (unsigned*)(la + tid * 16 + i * 4096), 16, 0, AUX);
        __builtin_amdgcn_global_load_lds((const unsigned*)(pb[i] + (long)(kt + 1) * kstepB), (unsigned*)(la + 16384 + tid * 16 + i * 4096), 16, 0, AUX);
      }
    }
    const char* la = smem + (kt & 1) * 32768; const char* lb = la + 16384;
#pragma unroll
    for (int ks = 0; ks < 2; ++ks) {
      bf16x8 a[4], b[4];
#pragma unroll
      for (int m = 0; m < 4; ++m) a[m] = *(const bf16x8*)(la + lds_byte(wr * 64 + m * 16 + fr, ks * 32 + fq * 8));
#pragma unroll
      for (int n = 0; n < 4; ++n) b[n] = *(const bf16x8*)(lb + lds_byte(wc * 64 + n * 16 + fr, ks * 32 + fq * 8));
#pragma unroll
      for (int m = 0; m < 4; ++m)
#pragma unroll
        for (int n = 0; n < 4; ++n) acc[m][n] = __builtin_amdgcn_mfma_f32_16x16x32_bf16(a[m], b[n], acc[m][n], 0, 0, 0);
    }
  }
  __syncthreads();
  float* Cs = (float*)smem;
#pragma unroll
  for (int m = 0; m < 4; ++m)
#pragma unroll
    for (int n = 0; n < 4; ++n)
#pragma unroll
      for (int r = 0; r < 4; ++r) Cs[(wr * 64 + m * 16 + fq * 4 + r) * CS_LD + wc * 64 + n * 16 + fr] = acc[m][n][r];
  __syncthreads();
  epi(Cs);
  __syncthreads();
}

template <class F>
__device__ __forceinline__ void store_rows_bf16(const float* Cs, bf16_t* dst, long ld, F f) {
#pragma unroll 2
  for (int it = 0; it < 8; ++it) {
    int id = it * 256 + tidx(); int r = id >> 4, c = (id & 15) * 8;
    float v[8]; ld8(Cs, r, c, v);
#pragma unroll
    for (int i = 0; i < 8; ++i) v[i] = f(v[i], c + i);
    *(u32x4*)(dst + (long)r * ld + c) = pack8(v);
  }
}
template <class F>
__device__ __forceinline__ void store_T_bf16(const float* Cs, bf16_t* dst, long cstride, F f) {
#pragma unroll 2
  for (int it = 0; it < 8; ++it) {
    int id = it * 256 + tidx(); int c = id >> 4, r8 = (id & 15) * 8;
    float v[8]; ld8T(Cs, r8, c, v);
#pragma unroll
    for (int i = 0; i < 8; ++i) v[i] = f(v[i]);
    *(u32x4*)(dst + (long)c * cstride + r8) = pack8(v);
  }
}


__device__ __forceinline__ int lds_byte32(int r, int c) { int rr = r & 15; return (r >> 4) * 1024 + rr * 64 + ((((c >> 3) ^ ((-(rr >> 2)) & 3)) & 3) << 4); }
__device__ __forceinline__ void stage_rc32(int b, int& R, int& C) { int st = b >> 10, sb = b & 1023, rr = sb >> 6, cp = (sb >> 4) & 3; R = st * 16 + rr; C = ((cp ^ ((-(rr >> 2)) & 3)) & 3) * 8; }
struct RowClamp {
  const bf16_t* base; long ld; int maxr;
  __device__ __forceinline__ const bf16_t* operator()(int r) const { return base + (long)(r < maxr ? r : maxr) * ld; }
};
__device__ __forceinline__ int lds_byte64(int r, int c) { int rr = r & 15; return (r >> 4) * 2048 + rr * 128 + ((((c >> 3) ^ (rr >> 1)) & 7) << 4); }
__device__ __forceinline__ void stage_rc64(int b, int& R, int& C) { int st = b >> 11, sb = b & 2047, rr = sb >> 7, cp = (sb >> 4) & 7; R = st * 16 + rr; C = ((cp ^ (rr >> 1)) & 7) * 8; }
template <class ARow, class BRow, class Epi>
__device__ __forceinline__ void gemm_tile2(char* smem, ARow arow, BRow brow, int nkt, Epi epi) {
  const int tid = tidx(), lane = tid & 63, wave = tid >> 6, wr = wave >> 1, wc = wave & 1, fr = lane & 15, fq = lane >> 4;
  int R0, C0; stage_rc64(tid * 16, R0, C0);
  const bf16_t* pa0 = arow(R0) + C0; const bf16_t* pb0 = brow(R0) + C0;
  const long sa32 = 32 * arow.ld, sb32 = 32 * brow.ld;
  f32x4 acc[4][8];
#pragma unroll
  for (int m = 0; m < 4; ++m)
#pragma unroll
    for (int n = 0; n < 8; ++n) acc[m][n] = (f32x4){0.f, 0.f, 0.f, 0.f};
  __syncthreads();
#pragma unroll
  for (int i = 0; i < 4; ++i) __builtin_amdgcn_global_load_lds((const unsigned*)(pa0 + i * sa32), (unsigned*)(smem + tid * 16 + i * 4096), 16, 0, 0);
#pragma unroll
  for (int i = 0; i < 8; ++i) __builtin_amdgcn_global_load_lds((const unsigned*)(pb0 + i * sb32), (unsigned*)(smem + 32768 + tid * 16 + i * 4096), 16, 0, 0);
  for (int kt = 0; kt < nkt; ++kt) {
    asm volatile("s_waitcnt vmcnt(0)" ::: "memory");
    __syncthreads();
    if (kt + 1 < nkt) {
      char* an = smem + ((kt + 1) & 1) * 16384;
#pragma unroll
      for (int i = 0; i < 4; ++i) __builtin_amdgcn_global_load_lds((const unsigned*)(pa0 + i * sa32 + (long)(kt + 1) * 64), (unsigned*)(an + tid * 16 + i * 4096), 16, 0, 0);
    }
    {
      const char* pA = smem + (kt & 1) * 16384 + lds_byte64(wr * 64 + fr, fq * 8);
      const char* pB = smem + 32768 + lds_byte64(wc * 128 + fr, fq * 8);
      const int k1 = lds_byte64(fr, 32 + fq * 8) - lds_byte64(fr, fq * 8);
#pragma unroll
      for (int ks = 0; ks < 2; ++ks) {
        bf16x8 a[4], bb[8];
#pragma unroll
        for (int m = 0; m < 4; ++m) a[m] = *(const bf16x8*)(pA + m * 2048 + ks * k1);
#pragma unroll
        for (int n = 0; n < 8; ++n) bb[n] = *(const bf16x8*)(pB + n * 2048 + ks * k1);
#pragma unroll
        for (int m = 0; m < 4; ++m)
#pragma unroll
          for (int n = 0; n < 8; ++n) acc[m][n] = __builtin_amdgcn_mfma_f32_16x16x32_bf16(a[m], bb[n], acc[m][n], 0, 0, 0);
      }
    }
    __syncthreads();
    if (kt + 1 < nkt) {
#pragma unroll
      for (int i = 0; i < 8; ++i) __builtin_amdgcn_global_load_lds((const unsigned*)(pb0 + i * sb32 + (long)(kt + 1) * 64), (unsigned*)(smem + 32768 + tid * 16 + i * 4096), 16, 0, 0);
    }
  }
  float* Cs = (float*)smem;
#pragma unroll
  for (int p = 0; p < 2; ++p) {
    __syncthreads();
    if (wc == p) {
#pragma unroll
      for (int m = 0; m < 4; ++m)
#pragma unroll
        for (int n = 0; n < 8; ++n)
#pragma unroll
          for (int r = 0; r < 4; ++r) Cs[(wr * 64 + m * 16 + fq * 4 + r) * CS_LD + n * 16 + fr] = acc[m][n][r];
    }
    __syncthreads();
    epi(Cs, p);
  }
  __syncthreads();
}

template <int MODE>
__device__ __forceinline__ void transpose_tile(const float* W, int Nsrc, bf16_t* Wt, int Kd, int k0, int n0, float* lds) {
  const int tid = tidx();
  {
    int tx = tid & 63, ty = tid >> 6; int np = n0 + tx; int sc;
    if (MODE == 0) sc = np < Nsrc ? np : -1;
    else { int x = np & 127, tl = np >> 7; sc = x < 64 ? tl * 64 + x : 2816 + tl * 64 + x - 64; }
    float v[32];
#pragma unroll
    for (int i = 0; i < 32; ++i) v[i] = sc >= 0 ? W[(long)(k0 + ty + 4 * i) * Nsrc + sc] : 0.f;
#pragma unroll
    for (int i = 0; i < 32; ++i) lds[(ty + 4 * i) * 65 + tx] = v[i];
  }
  __syncthreads();
  {
    int nrow = tid >> 2, kseg = (tid & 3) * 32;
#pragma unroll
    for (int q = 0; q < 4; ++q) {
      float v[8];
#pragma unroll
      for (int i = 0; i < 8; ++i) v[i] = lds[(kseg + q * 8 + i) * 65 + nrow];
      *(u32x4*)(Wt + (long)(n0 + nrow) * Kd + k0 + kseg + q * 8) = pack8(v);
    }
  }
  __syncthreads();
}

template <bool OUTF, int NR>
__device__ __forceinline__ void rownorm_rows(const float* src, const float* g, void* dst) {
  const int lane = tidx() & 63;
  f32x4 v[NR][4];
#pragma unroll
  for (int r = 0; r < NR; ++r)
#pragma unroll
    for (int i = 0; i < 4; ++i) v[r][i] = *(const f32x4*)(src + (long)r * 1024 + i * 256 + lane * 4);
  f32x4 gg[4];
#pragma unroll
  for (int i = 0; i < 4; ++i) gg[i] = *(const f32x4*)(g + i * 256 + lane * 4);
#pragma unroll
  for (int r = 0; r < NR; ++r) {
    float ss = 0.f;
#pragma unroll
    for (int i = 0; i < 4; ++i) ss += v[r][i][0] * v[r][i][0] + v[r][i][1] * v[r][i][1] + v[r][i][2] * v[r][i][2] + v[r][i][3] * v[r][i][3];
    ss = wave_sum(ss);
    const float rr = rsqrtf(ss * (1.f / 1024.f) + 1e-6f);
#pragma unroll
    for (int i = 0; i < 4; ++i) {
      float o0 = v[r][i][0] * rr * gg[i][0], o1 = v[r][i][1] * rr * gg[i][1], o2 = v[r][i][2] * rr * gg[i][2], o3 = v[r][i][3] * rr * gg[i][3];
      if (OUTF) { *(f32x4*)((float*)dst + (long)r * 1024 + i * 256 + lane * 4) = (f32x4){o0, o1, o2, o3}; }
      else { u32x2 p; p[0] = pack2(o0, o1); p[1] = pack2(o2, o3); *(u32x2*)((bf16_t*)dst + (long)r * 1024 + i * 256 + lane * 4) = p; }
    }
  }
}

__device__ void phase0(const Params& P, char* smem) {
  float* lds = (float*)smem;
  const int tid = tidx();
  const int NJ = 8 + 1024 + 32 + 32 + 2192;
  for (int job = blockIdx.x; job < NJ; job += gridDim.x) {
    int j = job;
    if (j < 8) {
      int n = j * 32 + (tid & 31), sl = tid >> 5; int kv = n >> 7, nn = n & 127;
      const float* pe = kv ? P.pe_v : P.pe_k; const float* w1 = kv ? P.w_cv1 : P.w_ck1;
      float s = 0.f;
      for (int k = sl * 256; k < sl * 256 + 256; ++k) s += pe[k] * w1[(long)k * 128 + nn];
      lds[sl * 32 + (tid & 31)] = s;
      __syncthreads();
      if (tid < 32) { float t = 0.f; for (int q = 0; q < 8; ++q) t += lds[q * 32 + tid]; ((float*)(P.ws + OFF_BIAS1))[j * 32 + tid] = t; }
      __syncthreads();
      continue;
    }
    j -= 8;
    if (j < 1024) { int row = j * 16 + (tid >> 6) * 4; rownorm_rows<false, 4>(P.x + (long)row * 1024, P.norm_mix, (bf16_t*)(P.ws + OFF_A) + (long)row * 1024); continue; }
    j -= 1024;
    if (j < 32) { int row = j * 16 + (tid >> 6) * 4; rownorm_rows<false, 4>(P.mem + (long)row * 1024, P.norm_mkv, (bf16_t*)(P.ws + OFF_MEMN) + (long)row * 1024); continue; }
    j -= 32;
    if (j < 32) {
      int e0 = j * 2048 + tid * 8; float v[8];
#pragma unroll
      for (int i = 0; i < 8; ++i) { int e = e0 + i; int t = (e >> 7) & 127, s = e & 127; v[i] = s <= t ? P.w_sp[e] : 0.f; }
      *(u32x4*)((bf16_t*)(P.ws + OFF_WM) + e0) = pack8(v);
      continue;
    }
    j -= 32;
#define TRJ(KT, NT, W, NSRC, WT, KD, MODE) \
    if (j < (KT) * (NT)) { transpose_tile<MODE>(W, NSRC, (bf16_t*)(P.ws + (WT)), KD, (j % (KT)) * 128, (j / (KT)) * 64, lds); continue; } \
    j -= (KT) * (NT);
    TRJ(8, 88, P.w_gu, 5632, OFF_WGU, 1024, 1)
    TRJ(22, 16, P.w_dn, 1024, OFF_WDN, 2816, 0)
    TRJ(8, 38, P.w_in, 2328, OFF_W1, 1024, 0)
    TRJ(8, 32, P.w_merge, 2048, OFF_W1 + 2432L * 1024 * 2, 1024, 0)
    TRJ(8, 16, P.w_mkv, 1024, OFF_WMKV, 1024, 0)
    TRJ(8, 16, P.w_out, 1024, OFF_WOUT, 1024, 0)
    TRJ(4, 16, P.w_pa, 1024, OFF_WPA, 512, 0)
    TRJ(4, 16, P.w_pb, 1024, OFF_WPB, 512, 0)
    TRJ(8, 8, P.w_mq, 512, OFF_WMQ, 1024, 0)
    TRJ(4, 16, P.w_mo, 1024, OFF_WMO, 512, 0)
    TRJ(16, 2, P.w_ck1, 128, OFF_WCK1, 2048, 0)
    TRJ(16, 2, P.w_cv1, 128, OFF_WCV1, 2048, 0)
#undef TRJ
  }
}

__device__ void phase1(const Params& P, char* smem) {
  char* ws = P.ws;
  const int NG1 = 128 * 18;
  const int xq = blockIdx.x & 7, lq = blockIdx.x >> 3, sq = gridDim.x >> 3;
  for (int t = lq; t < 16 * 12; t += sq) {
    {
      const int mt = xq * 16 + (t & 15), nt2 = t >> 4; const int brow = mt * 128;
      RowLin ar{(const bf16_t*)(ws + OFF_A) + (long)brow * 1024, 1024};
      RowLin br{(const bf16_t*)(ws + OFF_W1) + (long)nt2 * 256 * 1024, 1024};
      gemm_tile2(smem, ar, br, 16, [&](const float* Cs, int p) {
        const int nt = nt2 * 2 + p; if (nt >= 35) return;
        char* C = ws + OFF_C;
        if (nt < 4) {
          store_rows_bf16(Cs, (bf16_t*)(C + C_Q) + (long)brow * 512 + nt * 128, 512, [](float v, int) { return v * (0.125f * LOG2E); });
        } else if (nt == 4 || nt == 5 || nt == 6 || nt == 8) {
          long off = nt == 4 ? C_KC : nt == 5 ? C_VC : nt == 6 ? C_KS : C_KW;
          store_rows_bf16(Cs, (bf16_t*)(C + off) + (long)brow * 128, 128, [](float v, int) { return v; });
        } else if (nt == 7 || nt == 9) {
          long off = nt == 7 ? C_VST : C_VWT; int b = brow >> 13, tl = brow & 8191;
          store_T_bf16(Cs, (bf16_t*)(C + off) + (long)b * 128 * T_ + tl, T_, [](float v) { return v; });
        } else if (nt < 14) {
          store_rows_bf16(Cs, (bf16_t*)(C + C_U) + (long)brow * 512 + (nt - 10) * 128, 512, [](float v, int) { return gelu_tanh(v); });
        } else if (nt < 18) {
          store_T_bf16(Cs, (bf16_t*)(C + C_GVT) + ((long)(brow >> 7) * 512 + (nt - 14) * 128) * 128, 128, [](float v) { return gelu_tanh(v); });
        } else if (nt == 18) {
          float* gates = (float*)(C + C_GATES);
          for (int id = tidx(); id < 128 * 24; id += 256) { int r = id / 24, c = id % 24; gates[(long)(brow + r) * 24 + c] = sigm(Cs[r * CS_LD + c]); }
        } else {
          const float* bm = P.b_merge + (nt - 19) * 128;
          store_rows_bf16(Cs, (bf16_t*)(ws + OFF_B) + (long)brow * 2048 + (nt - 19) * 128, 2048, [bm](float v, int c) { return sigm(v + bm[c]); });
        }
      });
    }
  }
}

__device__ void phase2(const Params& P, char* smem) {
  char* ws = P.ws; const int tid = tidx();
  for (int job = blockIdx.x; job < 32 + 128; job += gridDim.x) {
    if (job < 32) {
      const int kv = job >> 4, mt = job & 15, brow = mt * 128;
      RowCmp ar{(const bf16_t*)(ws + OFF_C + (kv ? C_VC : C_KC)), brow};
      RowLin br{(const bf16_t*)(ws + (kv ? OFF_WCV1 : OFF_WCK1)), 2048};
      const float* bias1 = (const float*)(ws + OFF_BIAS1) + kv * 128;
      const float* w2 = kv ? P.w_cv2 : P.w_ck2;
      gemm_tile(smem, ar, br, 32, 128, 64, [&](const float* Csc) {
        float* Cs = (float*)Csc;
        for (int it = 0; it < 64; ++it) { int id = it * 256 + tid; int r = id >> 7, n = id & 127; Cs[r * CS_LD + n] = gelu_tanh(Cs[r * CS_LD + n] + bias1[n]); }
        __syncthreads();
        const int r = tid >> 1, half = tid & 1;
        float acc[32];
#pragma unroll
        for (int i = 0; i < 32; ++i) acc[i] = 0.f;
        for (int n = 0; n < 128; ++n) {
          float h = Cs[r * CS_LD + n]; const float* wr = w2 + n * 64 + half * 32;
#pragma unroll
          for (int q = 0; q < 8; ++q) { f32x4 w = *(const f32x4*)(wr + q * 4); acc[q * 4] += h * w[0]; acc[q * 4 + 1] += h * w[1]; acc[q * 4 + 2] += h * w[2]; acc[q * 4 + 3] += h * w[3]; }
        }
        const int R = brow + r; const int b = R >> 10, rem = R & 1023, i = rem >> 1, g = rem & 1;
        if (i >= 511) {
#pragma unroll
          for (int q = 0; q < 32; ++q) acc[q] = 0.f;
        }
        if (kv == 0) {
          bf16_t* dst = (bf16_t*)(ws + OFF_KCMP) + (long)(b * 512 + i) * 128 + g * 64 + half * 32;
#pragma unroll
          for (int q = 0; q < 4; ++q) { float v[8];
#pragma unroll
            for (int e = 0; e < 8; ++e) v[e] = acc[q * 8 + e];
            *(u32x4*)(dst + q * 8) = pack8(v); }
        } else {
          bf16_t* dst = (bf16_t*)(ws + OFF_VCT) + ((long)(b * 128 + g * 64 + half * 32)) * 512 + i;
#pragma unroll
          for (int q = 0; q < 32; ++q) dst[(long)q * 512] = (bf16_t)f2bf(acc[q]);
        }
      });
    } else {
      const int bc = job - 32; bf16_t* base = (bf16_t*)(ws + OFF_C + C_GVT) + (long)bc * 512 * 128;
      float* ssum = (float*)smem; float* ssq = ssum + 128;
      float* psum = ssum + 256; float* psq = psum + 16 * 128;
      const int cs = tid >> 4, s8 = (tid & 15) * 8;
      float a[8], q[8];
#pragma unroll
      for (int i = 0; i < 8; ++i) { a[i] = 0.f; q[i] = 0.f; }
      for (int it = 0; it < 32; ++it) {
        u32x4 d = *(const u32x4*)(base + (long)(it * 16 + cs) * 128 + s8);
#pragma unroll
        for (int i = 0; i < 4; ++i) { float lo = bf2f(d[i] & 0xffffu), hi = bf2f(d[i] >> 16); a[2 * i] += lo; q[2 * i] += lo * lo; a[2 * i + 1] += hi; q[2 * i + 1] += hi * hi; }
      }
#pragma unroll
      for (int i = 0; i < 8; ++i) { psum[cs * 128 + s8 + i] = a[i]; psq[cs * 128 + s8 + i] = q[i]; }
      __syncthreads();
      if (tid < 128) {
        float su = 0.f, sq = 0.f;
        for (int c = 0; c < 16; ++c) { su += psum[c * 128 + tid]; sq += psq[c * 128 + tid]; }
        float mean_t = su * (1.f / 512.f); float var = sq * (1.f / 512.f) - mean_t * mean_t; if (var < 0.f) var = 0.f;
        ssum[tid] = mean_t; ssq[tid] = rsqrtf(var + 1e-6f);
      }
      __syncthreads();
      float mean[8], rs[8];
#pragma unroll
      for (int i = 0; i < 8; ++i) { mean[i] = ssum[s8 + i]; rs[i] = ssq[s8 + i]; }
      for (int it = 0; it < 32; ++it) {
        int ch = it * 16 + cs; float gg = P.ln_sgu[ch];
        u32x4 d = *(const u32x4*)(base + (long)ch * 128 + s8); float v[8];
#pragma unroll
        for (int i = 0; i < 4; ++i) { v[2 * i] = bf2f(d[i] & 0xffffu); v[2 * i + 1] = bf2f(d[i] >> 16); }
#pragma unroll
        for (int i = 0; i < 8; ++i) v[i] = (v[i] - mean[i]) * rs[i] * gg;
        *(u32x4*)(base + (long)ch * 128 + s8) = pack8(v);
      }
      __syncthreads();
    }
  }
  if (blockIdx.x >= 32) {
    for (int mtile = blockIdx.x - 32; mtile < 768 + 32; mtile += gridDim.x - 32) {
      if (mtile >= 768) {
        const int j = mtile - 768; const int mt = j >> 3, nt = j & 7; const int brow = mt * 128;
        RowLin ar{(const bf16_t*)(ws + OFF_MEMN) + (long)brow * 1024, 1024};
        RowLin br{(const bf16_t*)(ws + OFF_WMKV) + (long)nt * 128 * 1024, 1024};
        gemm_tile(smem, ar, br, 16, 64, 64, [&](const float* Cs) {
          if (nt < 4) store_rows_bf16(Cs, (bf16_t*)(ws + OFF_MK) + (long)brow * 512 + nt * 128, 512, [](float v, int) { return v; });
          else { int b = mt >> 1, n0 = (mt & 1) * 128; store_T_bf16(Cs, (bf16_t*)(ws + OFF_MVT) + ((long)b * 512 + (nt - 4) * 128) * 256 + n0, 256, [](float v) { return v; }); }
        });
        continue;
      }
      const int mt = mtile & 127, nt2 = 12 + (mtile >> 7), brow = mt * 128;
      RowLin ar{(const bf16_t*)(ws + OFF_A) + (long)brow * 1024, 1024};
      RowLin br{(const bf16_t*)(ws + OFF_W1) + (long)nt2 * 256 * 1024, 1024};
      gemm_tile2(smem, ar, br, 16, [&](const float* Cs, int p) {
        const int nt = nt2 * 2 + p; if (nt >= 35) return;
        const float* bm = P.b_merge + (nt - 19) * 128;
        store_rows_bf16(Cs, (bf16_t*)(ws + OFF_B) + (long)brow * 2048 + (nt - 19) * 128, 2048, [bm](float v, int c) { return sigm(v + bm[c]); });
      });
    }
  }
}

template <int MODE>
__device__ __forceinline__ void nsa_block(const bf16x8 (&qf)[4][2], f32x4 (&oacc)[4][4], float (&m)[4], float (&l)[4],
                                          const float (&sl2)[4], const float (&inv)[4], const bf16_t* kp, const bf16_t* vp, long vdt,
                                          int dist0, bool rowok, float (&asum)[2], float (&bsum)[2]) {
  constexpr int DSTEP = (MODE <= 1) ? 16 : 1;
  bf16x8 kf[2][2];
#pragma unroll
  for (int kt = 0; kt < 2; ++kt)
#pragma unroll
    for (int ks = 0; ks < 2; ++ks) kf[kt][ks] = *(const bf16x8*)(kp + kt * 16 * 128 + ks * 32);
  bf16x8 vf[4];
  if (MODE != 0) {
#pragma unroll
    for (int dt = 0; dt < 4; ++dt) {
      u32x2 lo = *(const u32x2*)(vp + dt * vdt); u32x2 hi = *(const u32x2*)(vp + dt * vdt + 16);
      u32x4 c; c[0] = lo[0]; c[1] = lo[1]; c[2] = hi[0]; c[3] = hi[1];
      vf[dt] = __builtin_bit_cast(bf16x8, c);
    }
  }
  const float fd0 = (float)dist0;
#pragma unroll
  for (int h = 0; h < 4; ++h) {
    f32x4 s[2];
#pragma unroll
    for (int kt = 0; kt < 2; ++kt) {
      s[kt] = __builtin_amdgcn_mfma_f32_16x16x32_bf16(kf[kt][0], qf[h][0], (f32x4){0.f, 0.f, 0.f, 0.f}, 0, 0, 0);
      s[kt] = __builtin_amdgcn_mfma_f32_16x16x32_bf16(kf[kt][1], qf[h][1], s[kt], 0, 0, 0);
    }
    float sc[8]; bool ok[8];
#pragma unroll
    for (int kt = 0; kt < 2; ++kt)
#pragma unroll
      for (int r = 0; r < 4; ++r) {
        const int e = kt * 16 + r; const int dist = dist0 - DSTEP * e;
        bool o = dist >= 0;
        if (MODE == 2) o = o && rowok;
        if (MODE == 3) o = o && (dist < 512);
        ok[kt * 4 + r] = o;
        sc[kt * 4 + r] = o ? s[kt][r] - sl2[h] * (fd0 - (float)(DSTEP * e)) : NEGF;
      }
    float p[8];
    if (MODE != 1) {
      float ml = NEGF;
#pragma unroll
      for (int i = 0; i < 8; ++i) ml = fmaxf(ml, sc[i]);
      ml = fmaxf(ml, __shfl_xor(ml, 16, 64)); ml = fmaxf(ml, __shfl_xor(ml, 32, 64));
      const float mn = fmaxf(m[h], ml); const float alpha = __builtin_amdgcn_exp2f(m[h] - mn); m[h] = mn;
      const float mref = fmaxf(mn, -1e29f);
      float ps = 0.f;
#pragma unroll
      for (int i = 0; i < 8; ++i) { p[i] = __builtin_amdgcn_exp2f(sc[i] - mref); ps += p[i]; }
      l[h] = l[h] * alpha + ps;
      if (MODE != 0) {
        if (__builtin_amdgcn_ballot_w64(alpha != 1.f) != 0ull) {
#pragma unroll
          for (int dt = 0; dt < 4; ++dt) oacc[h][dt] *= alpha;
        }
      }
    } else {
      const float mref1 = fmaxf(m[h], -1e29f);
#pragma unroll
      for (int i = 0; i < 8; ++i) p[i] = __builtin_amdgcn_exp2f(sc[i] - mref1) * l[h];
      asum[0] += (p[0] + p[1]) + (p[2] + p[3]); bsum[0] += p[3];
      asum[1] += (p[4] + p[5]) + (p[6] + p[7]); bsum[1] += p[7];
    }
    if (MODE != 0) {
      u32x4 pk; pk[0] = pack2(p[0], p[1]); pk[1] = pack2(p[2], p[3]); pk[2] = pack2(p[4], p[5]); pk[3] = pack2(p[6], p[7]);
      const bf16x8 pf = __builtin_bit_cast(bf16x8, pk);
#pragma unroll
      for (int dt = 0; dt < 4; ++dt) oacc[h][dt] = __builtin_amdgcn_mfma_f32_16x16x32_bf16(vf[dt], pf, oacc[h][dt], 0, 0, 0);
    }
    __builtin_amdgcn_sched_barrier(0);
  }
}

__device__ void nsa_tile(const Params& P, int wt, char* wl) {
  char* C = P.ws + OFF_C;
  const bf16_t* Q = (const bf16_t*)(C + C_Q);
  const bf16_t* KCMP = (const bf16_t*)(P.ws + OFF_KCMP); const bf16_t* VCT = (const bf16_t*)(P.ws + OFF_VCT);
  const bf16_t* KS = (const bf16_t*)(C + C_KS); const bf16_t* VST = (const bf16_t*)(C + C_VST);
  const bf16_t* KW = (const bf16_t*)(C + C_KW); const bf16_t* VWT = (const bf16_t*)(C + C_VWT);
  const float* GATES = (const float*)(C + C_GATES);
  bf16_t* O = (bf16_t*)(P.ws + OFF_D);
  const int lane = tidx() & 63, qi = lane & 15, quad = lane >> 4;
  wt = __builtin_amdgcn_readfirstlane(wt);
  const int jb = wt >> 2, wv4 = wt & 3;
  const int bg = jb & 3, b = bg >> 1, g = bg & 1;
  const int gq = jb >> 2;
  const int tq = (gq < 64 ? 127 - gq : gq - 64) * 4 + wv4;
  const int t0 = tq * 16;
  const int t = t0 + qi;
  const long row = (long)b * T_ + t;
  bf16x8 qf[4][2];
#pragma unroll
  for (int h = 0; h < 4; ++h)
#pragma unroll
    for (int ks = 0; ks < 2; ++ks) qf[h][ks] = *(const bf16x8*)(Q + row * 512 + (g * 4 + h) * 64 + ks * 32 + quad * 8);
  float sl2[4];
#pragma unroll
  for (int h = 0; h < 4; ++h) sl2[h] = __builtin_amdgcn_exp2f(-(float)(g * 4 + h + 1)) * LOG2E;
  f32x4 oacc[4][4]; float m[4], l[4], inv[4]; float asum[2], bsum[2];
  float* imp = (float*)wl; float* outl = (float*)wl;
  unsigned* sel = (unsigned*)(wl + 16384); unsigned* uni = sel + 64;
#pragma unroll
  for (int h = 0; h < 4; ++h) { m[h] = NEGF; l[h] = 0.f; inv[h] = 0.f; }
  asum[0] = asum[1] = bsum[0] = bsum[1] = 0.f;

  const int nI = t0 >> 4; const int nblk = (nI + 31) >> 5;
  for (int blk = nblk - 1; blk >= 0; --blk) {
    const int key0 = blk * 32;
    const bf16_t* kp = KCMP + (long)(b * 512 + key0 + qi) * 128 + g * 64 + quad * 8;
    nsa_block<0>(qf, oacc, m, l, sl2, inv, kp, nullptr, 0, t - 31 - 16 * (key0 + quad * 4), true, asum, bsum);
  }
#pragma unroll
  for (int h = 0; h < 4; ++h) { float lt = l[h]; lt += __shfl_xor(lt, 16, 64); lt += __shfl_xor(lt, 32, 64); l[h] = 1.f / fmaxf(lt, 1e-30f); }
  for (int i = lane; i < 16 * 132; i += 64) imp[i] = 0.f;
#pragma unroll
  for (int h = 0; h < 4; ++h)
#pragma unroll
    for (int dt = 0; dt < 4; ++dt) oacc[h][dt] = (f32x4){0.f, 0.f, 0.f, 0.f};
  for (int blk = 0; blk < nblk; ++blk) {
    const int key0 = blk * 32;
    const bf16_t* kp = KCMP + (long)(b * 512 + key0 + qi) * 128 + g * 64 + quad * 8;
    const bf16_t* vp = VCT + (long)(b * 128 + g * 64 + qi) * 512 + key0 + quad * 4;
    asum[0] = asum[1] = bsum[0] = bsum[1] = 0.f;
    nsa_block<1>(qf, oacc, m, l, sl2, inv, kp, vp, 16 * 512, t - 31 - 16 * (key0 + quad * 4), true, asum, bsum);
    const int J = (key0 >> 2) + quad;
    atomicAdd(&imp[qi * 132 + J], asum[0]); atomicAdd(&imp[qi * 132 + J + 1], bsum[0]);
    atomicAdd(&imp[qi * 132 + J + 4], asum[1]); atomicAdd(&imp[qi * 132 + J + 5], bsum[1]);
  }
  const int cur = t0 >> 6;
  if (lane < 16) {
    unsigned w0 = 0, w1 = 0, w2 = 0, w3 = 0;
    if (cur < 16) { w0 = (1u << (cur + 1)) - 1u; }
    else {
      w0 = 1u;
      { int j = cur; unsigned bit = 1u << (j & 31); int w = j >> 5; if (w == 0) w0 |= bit; else if (w == 1) w1 |= bit; else if (w == 2) w2 |= bit; else w3 |= bit; }
      { int j = cur - 1; unsigned bit = 1u << (j & 31); int w = j >> 5; if (w == 0) w0 |= bit; else if (w == 1) w1 |= bit; else if (w == 2) w2 |= bit; else w3 |= bit; }
    }
    sel[lane * 4 + 0] = w0; sel[lane * 4 + 1] = w1; sel[lane * 4 + 2] = w2; sel[lane * 4 + 3] = w3;
  }
  if (lane < 4) uni[lane] = 0u;
  if (cur >= 16) {
    for (int rnd = 0; rnd < 4; ++rnd) {
      const int qq = rnd * 4 + quad;
      unsigned key[8];
#pragma unroll
      for (int c = 0; c < 8; ++c) {
        const int j = qi + 16 * c;
        const bool v = (j <= cur) && (j != 0) && (j != cur) && (j != cur - 1);
        const unsigned bits = __float_as_uint(imp[qq * 132 + j]);
        key[c] = v ? ((bits & 0xFFFFFF00u) | (unsigned)(128 - j)) : 0u;
      }
      for (int it = 0; it < 13; ++it) {
        unsigned mx = key[0];
#pragma unroll
        for (int c = 1; c < 8; ++c) mx = key[c] > mx ? key[c] : mx;
#pragma unroll
        for (int o = 1; o < 16; o <<= 1) { unsigned ot = (unsigned)__shfl_xor((int)mx, o, 64); mx = ot > mx ? ot : mx; }
        if (mx != 0u) {
#pragma unroll
          for (int c = 0; c < 8; ++c) {
            if (key[c] == mx) { key[c] = 0u; const int j = qi + 16 * c; atomicOr(&sel[qq * 4 + (j >> 5)], 1u << (j & 31)); }
          }
        }
      }
    }
  }
  unsigned mym[4];
#pragma unroll
  for (int w = 0; w < 4; ++w) mym[w] = sel[qi * 4 + w];
  if (lane < 16) {
#pragma unroll
    for (int w = 0; w < 4; ++w) atomicOr(&uni[w], mym[w]);
  }
  const float* gp = GATES + row * 24 + g * 12;
#pragma unroll
  for (int h = 0; h < 4; ++h) {
    const float gt = gp[h * 3 + 0] * NSA_G0;
#pragma unroll
    for (int dt = 0; dt < 4; ++dt) *(f32x4*)(outl + ((h * 16 + qi) * 64 + (((dt * 4 + quad) ^ qi) << 2))) = oacc[h][dt] * gt;
  }
#pragma unroll
  for (int h = 0; h < 4; ++h) { m[h] = NEGF; l[h] = 0.f;
#pragma unroll
    for (int dt = 0; dt < 4; ++dt) oacc[h][dt] = (f32x4){0.f, 0.f, 0.f, 0.f}; }
#pragma unroll 1
  for (int w = 3; w >= 0; --w) {
    unsigned bits = __builtin_amdgcn_readfirstlane(uni[w]);
    const unsigned myw = sel[qi * 4 + w];
    while (bits) {
      const int jj = 31 - __builtin_clz(bits); bits &= ~(1u << jj);
      const int j = w * 32 + jj; const bool rowok = (myw >> jj) & 1u;
#pragma unroll 1
      for (int half = 1; half >= 0; --half) {
        const int key0 = j * 64 + half * 32;
        const bf16_t* kp = KS + (long)(b * T_ + key0 + qi) * 128 + g * 64 + quad * 8;
        const bf16_t* vp = VST + (long)(b * 128 + g * 64 + qi) * T_ + key0 + quad * 4;
        nsa_block<2>(qf, oacc, m, l, sl2, inv, kp, vp, 16L * T_, t - (key0 + quad * 4), rowok, asum, bsum);
      }
    }
  }
#pragma unroll
  for (int h = 0; h < 4; ++h) {
    float lt = l[h]; lt += __shfl_xor(lt, 16, 64); lt += __shfl_xor(lt, 32, 64);
    const float sc = NSA_G1 * gp[h * 3 + 1] / fmaxf(lt, 1e-30f);
#pragma unroll
    for (int dt = 0; dt < 4; ++dt) { f32x4* d = (f32x4*)(outl + ((h * 16 + qi) * 64 + (((dt * 4 + quad) ^ qi) << 2))); *d = *d + oacc[h][dt] * sc; }
  }
#pragma unroll
  for (int h = 0; h < 4; ++h) { m[h] = NEGF; l[h] = 0.f;
#pragma unroll
    for (int dt = 0; dt < 4; ++dt) oacc[h][dt] = (f32x4){0.f, 0.f, 0.f, 0.f}; }
  {
    const int kstart = t0 >= 512 ? ((t0 - 511) & ~31) : 0;
    for (int key0 = (t0 + 15) & ~31; key0 >= kstart; key0 -= 32) {
      const bf16_t* kp = KW + (long)(b * T_ + key0 + qi) * 128 + g * 64 + quad * 8;
      const bf16_t* vp = VWT + (long)(b * 128 + g * 64 + qi) * T_ + key0 + quad * 4;
      nsa_block<3>(qf, oacc, m, l, sl2, inv, kp, vp, 16L * T_, t - (key0 + quad * 4), true, asum, bsum);
    }
  }
#pragma unroll
  for (int h = 0; h < 4; ++h) {
    float lt = l[h]; lt += __shfl_xor(lt, 16, 64); lt += __shfl_xor(lt, 32, 64);
    const float sc = NSA_G2 * gp[h * 3 + 2] / fmaxf(lt, 1e-30f);
#pragma unroll
    for (int dt = 0; dt < 4; ++dt) { f32x4* d = (f32x4*)(outl + ((h * 16 + qi) * 64 + (((dt * 4 + quad) ^ qi) << 2))); *d = *d + oacc[h][dt] * sc; }
  }
#pragma unroll
  for (int it = 0; it < 8; ++it) {
    const int id = it * 64 + lane; const int h = id >> 7, rem = id & 127, q2 = rem >> 3, c8 = rem & 7;
    f32x4 a = *(const f32x4*)(outl + ((h * 16 + q2) * 64 + (((2 * c8) ^ q2) << 2)));
    f32x4 bb = *(const f32x4*)(outl + ((h * 16 + q2) * 64 + (((2 * c8 + 1) ^ q2) << 2)));
    float v[8] = {a[0], a[1], a[2], a[3], bb[0], bb[1], bb[2], bb[3]};
    *(u32x4*)(O + ((long)b * T_ + t0 + q2) * 512 + (g * 4 + h) * 64 + c8 * 8) = pack8(v);
  }
}

__device__ void xattn_tile(const Params& P, int wt) {
  const bf16_t* HQ = (const bf16_t*)(P.ws + OFF_D);
  const bf16_t* MK = (const bf16_t*)(P.ws + OFF_MK); const bf16_t* MVT = (const bf16_t*)(P.ws + OFF_MVT);
  bf16_t* OX = (bf16_t*)(P.ws + OFF_D) + (long)M_ * 512;
  const int lane = tidx() & 63, qi = lane & 15, quad = lane >> 4;
  wt = __builtin_amdgcn_readfirstlane(wt);
  const int h = wt & 3; const int row0 = (wt >> 2) * 32; const int b = row0 >> 13;
  bf16x8 qf[2][4];
#pragma unroll
  for (int nt = 0; nt < 2; ++nt)
#pragma unroll
    for (int ks = 0; ks < 4; ++ks) qf[nt][ks] = *(const bf16x8*)(HQ + (long)(row0 + nt * 16 + qi) * 512 + h * 128 + ks * 32 + quad * 8);
  f32x4 oacc[2][8]; float m[2], l[2];
#pragma unroll
  for (int nt = 0; nt < 2; ++nt) { m[nt] = NEGF; l[nt] = 0.f;
#pragma unroll
    for (int dt = 0; dt < 8; ++dt) oacc[nt][dt] = (f32x4){0.f, 0.f, 0.f, 0.f}; }
  for (int blk = 0; blk < 8; ++blk) {
    const int key0 = blk * 32;
    f32x4 s[2][2];
#pragma unroll
    for (int nt = 0; nt < 2; ++nt)
#pragma unroll
      for (int kt = 0; kt < 2; ++kt) s[nt][kt] = (f32x4){0.f, 0.f, 0.f, 0.f};
#pragma unroll
    for (int ks = 0; ks < 4; ++ks) {
#pragma unroll
      for (int kt = 0; kt < 2; ++kt) {
        bf16x8 kf = *(const bf16x8*)(MK + (long)(b * 256 + key0 + kt * 16 + qi) * 512 + h * 128 + ks * 32 + quad * 8);
#pragma unroll
        for (int nt = 0; nt < 2; ++nt) s[nt][kt] = __builtin_amdgcn_mfma_f32_16x16x32_bf16(kf, qf[nt][ks], s[nt][kt], 0, 0, 0);
      }
    }
    bf16x8 pf[2];
#pragma unroll
    for (int nt = 0; nt < 2; ++nt) {
      float ml = NEGF;
#pragma unroll
      for (int kt = 0; kt < 2; ++kt)
#pragma unroll
        for (int r = 0; r < 4; ++r) ml = fmaxf(ml, s[nt][kt][r]);
      ml = fmaxf(ml, __shfl_xor(ml, 16, 64)); ml = fmaxf(ml, __shfl_xor(ml, 32, 64));
      const float mn = fmaxf(m[nt], ml); const float alpha = __builtin_amdgcn_exp2f(m[nt] - mn); m[nt] = mn;
      float p[8]; float ps = 0.f;
#pragma unroll
      for (int kt = 0; kt < 2; ++kt)
#pragma unroll
        for (int r = 0; r < 4; ++r) { p[kt * 4 + r] = __builtin_amdgcn_exp2f(s[nt][kt][r] - mn); ps += p[kt * 4 + r]; }
      l[nt] = l[nt] * alpha + ps;
#pragma unroll
      for (int dt = 0; dt < 8; ++dt) oacc[nt][dt] *= alpha;
      u32x4 pk; pk[0] = pack2(p[0], p[1]); pk[1] = pack2(p[2], p[3]); pk[2] = pack2(p[4], p[5]); pk[3] = pack2(p[6], p[7]);
      pf[nt] = __builtin_bit_cast(bf16x8, pk);
    }
#pragma unroll
    for (int dt = 0; dt < 8; ++dt) {
      const bf16_t* vp = MVT + (long)(b * 512 + h * 128 + dt * 16 + qi) * 256 + key0 + quad * 4;
      u32x2 lo = *(const u32x2*)(vp); u32x2 hi = *(const u32x2*)(vp + 16);
      u32x4 c; c[0] = lo[0]; c[1] = lo[1]; c[2] = hi[0]; c[3] = hi[1];
      const bf16x8 vf = __builtin_bit_cast(bf16x8, c);
#pragma unroll
      for (int nt = 0; nt < 2; ++nt) oacc[nt][dt] = __builtin_amdgcn_mfma_f32_16x16x32_bf16(vf, pf[nt], oacc[nt][dt], 0, 0, 0);
    }
  }
#pragma unroll
  for (int nt = 0; nt < 2; ++nt) {
    float lt = l[nt]; lt += __shfl_xor(lt, 16, 64); lt += __shfl_xor(lt, 32, 64);
    const float iv = 1.f / lt;
#pragma unroll
    for (int dt = 0; dt < 8; ++dt) {
      f32x4 v = oacc[nt][dt] * iv; u32x2 pk; pk[0] = pack2(v[0], v[1]); pk[1] = pack2(v[2], v[3]);
      *(u32x2*)(OX + (long)(row0 + nt * 16 + qi) * 512 + h * 128 + dt * 16 + quad * 4) = pk;
    }
  }
}


#define XB_TMO      128
#define XB_XCNT(j)  (256  + 64 * (j))
#define XB_XSUB(j)  (1280 + 64 * (j))
#define XB_XGEN(j)  (2304 + 64 * (j))
#define XB_TOP      3328
#define XB_TOPGEN   3392
#define XCD_BAR_WORDS 3456
#define XB_SPIN_CAP (1u << 18)
#define LAS __attribute__((address_space(3)))
__device__ __forceinline__ unsigned xb_ld(unsigned* p) { return __hip_atomic_load(p, __ATOMIC_RELAXED, __HIP_MEMORY_SCOPE_AGENT); }
__device__ __forceinline__ unsigned xb_add(unsigned* p, unsigned v) { return __hip_atomic_fetch_add(p, v, __ATOMIC_RELAXED, __HIP_MEMORY_SCOPE_AGENT); }
__device__ __forceinline__ unsigned xb_xcc_id() { return (unsigned)__builtin_amdgcn_s_getreg((3 << 11) | 20) & 0xFu; }
#define XB_SPIN(cond, bar) do { unsigned _sp = 0; while (cond) { __builtin_amdgcn_s_sleep(1); \
    if ((++_sp & 255u) == 0u) { if (xb_ld(&(bar)[XB_TMO])) break; if (_sp > XB_SPIN_CAP) { atomicAdd(&(bar)[XB_TMO], 1u); break; } } } } while (0)
__device__ __forceinline__ void xcd_barrier_complete(unsigned* bar, unsigned x, unsigned& nloc, unsigned& nx) {
  const unsigned G = gridDim.x * gridDim.y * gridDim.z;
  unsigned sum, cnt, mine, sp = 0u;
  for (;;) {
    sum = 0u; cnt = 0u; mine = 0u;
#pragma unroll
    for (unsigned j = 0; j < 16; ++j) { const unsigned c = xb_ld(&bar[XB_XCNT(j)]); sum += c; cnt += (c > 0u) ? 1u : 0u; mine = (j == x) ? c : mine; }
    if (sum == G) break;
    __builtin_amdgcn_s_sleep(1);
    if ((++sp & 255u) == 0u) { if (xb_ld(&bar[XB_TMO])) break; if (sp > XB_SPIN_CAP) { atomicAdd(&bar[XB_TMO], 1u); break; } }
  }
  nloc = mine > 0u ? mine : 1u; nx = cnt > 0u ? cnt : 1u;
}
__device__ __forceinline__ void xcd_barrier(unsigned* bar, unsigned x, volatile LAS unsigned* st) {
  asm volatile("s_waitcnt vmcnt(0)" ::: "memory");
  __syncthreads();
  if (threadIdx.x == 0) {
    __builtin_amdgcn_s_waitcnt(0);
    unsigned nloc = st[0], nx = st[1];
    if (nloc == 0u) { xcd_barrier_complete(bar, x, nloc, nx); st[0] = nloc; st[1] = nx; }
    const unsigned old = xb_add(&bar[XB_XSUB(x)], 1u);
    const unsigned gen = old / nloc;
    if (old + 1u == (gen + 1u) * nloc) {
      __builtin_amdgcn_fence(__ATOMIC_RELEASE, "agent");
      asm volatile("s_waitcnt vmcnt(0)" ::: "memory");
      const unsigned og = xb_add(&bar[XB_TOP], 1u);
      const unsigned tg = og / nx;
      if (og + 1u == (tg + 1u) * nx) xb_add(&bar[XB_TOPGEN], 1u);
      else XB_SPIN(xb_ld(&bar[XB_TOPGEN]) == tg, bar);
      __builtin_amdgcn_fence(__ATOMIC_ACQUIRE, "agent");
      xb_add(&bar[XB_XGEN(x)], 1u);
      asm volatile("s_waitcnt vmcnt(0)" ::: "memory");
    } else {
      XB_SPIN(xb_ld(&bar[XB_XGEN(x)]) == gen, bar);
      __builtin_amdgcn_fence(__ATOMIC_ACQUIRE, "agent");
      asm volatile("s_waitcnt vmcnt(0)" ::: "memory");
    }
  }
  __syncthreads();
}

__device__ void run_phase(const Params& P, int ph, char* smem, bool ph_fused) {
  char* ws = P.ws; const int tid = tidx();
  switch (ph) {
    case 0: phase0(P, smem); break;
    case 1: phase1(P, smem); break;
    case 2: phase2(P, smem); break;
    case 3: {
      for (int job = blockIdx.x; job < 512; job += gridDim.x) { const int wv = tidx() >> 6; nsa_tile(P, job * 4 + wv, smem + wv * 16896); }
      __syncthreads();
      for (int job = blockIdx.x; job < 512; job += gridDim.x) {
        {
          const int tid = tidx();
          const int s = job; const int bc = s >> 2, g = s & 3;
          RowLin ar{(const bf16_t*)(ws + OFF_WM) + g * 16384, 128};
          RowLin br{(const bf16_t*)(ws + OFF_C + C_GVT) + ((long)bc * 512 + g * 128) * 128, 128};
          const float* bs = P.b_sp + g * 128;
          const bf16_t* U = (const bf16_t*)(ws + OFF_C + C_U) + (long)bc * 128 * 512 + g * 128;
          bf16_t* OS = (bf16_t*)(ws + OFF_D) + (long)M_ * 512 + (long)bc * 128 * 512 + g * 128;
          gemm_tile(smem, ar, br, 2, 64, 64, [&](const float* Cs) {
#pragma unroll 2
            for (int it = 0; it < 8; ++it) {
              int id = it * 256 + tid; int r = id >> 4, c = (id & 15) * 8; float v[8]; ld8(Cs, r, c, v);
              u32x4 d = *(const u32x4*)(U + (long)r * 512 + c); const float bb = bs[r];
#pragma unroll
              for (int i = 0; i < 4; ++i) { v[2 * i] = (v[2 * i] + bb) * bf2f(d[i] & 0xffffu); v[2 * i + 1] = (v[2 * i + 1] + bb) * bf2f(d[i] >> 16); }
              *(u32x4*)(OS + (long)r * 512 + c) = pack8(v);
            }
          });
        }
      }
    } break;
    case 4: {
      float* scr = (float*)(ws + OFF_C + C_SCR) + (long)blockIdx.x * 16384;
      const int xq = blockIdx.x & 7, lq = blockIdx.x >> 3, sq = gridDim.x >> 3;
      for (int t = lq; t < 16 * 8; t += sq) {
        const int mt = xq * 16 + (t & 15), nt = t >> 4, brow = mt * 128, bcol = nt * 128;
        const bf16_t* MG = (const bf16_t*)(ws + OFF_B) + (long)brow * 2048 + bcol;
        RowLin a1{(const bf16_t*)(ws + OFF_D) + (long)brow * 512, 512};
        RowLin b1{(const bf16_t*)(ws + OFF_WPA) + (long)bcol * 512, 512};
        gemm_tile(smem, a1, b1, 8, 64, 64, [&](const float* Cs) {
#pragma unroll 2
          for (int it = 0; it < 8; ++it) {
            int id = it * 256 + tid; int r = id >> 4, c = (id & 15) * 8; float v[8]; ld8(Cs, r, c, v);
            u32x4 d = *(const u32x4*)(MG + (long)r * 2048 + c);
#pragma unroll
            for (int i = 0; i < 4; ++i) { v[2 * i] *= bf2f(d[i] & 0xffffu); v[2 * i + 1] *= bf2f(d[i] >> 16); }
            *(f32x4*)(scr + id * 8) = (f32x4){v[0], v[1], v[2], v[3]}; *(f32x4*)(scr + id * 8 + 4) = (f32x4){v[4], v[5], v[6], v[7]};
          }
        });
        RowLin a2{(const bf16_t*)(ws + OFF_D) + (long)M_ * 512 + (long)brow * 512, 512};
        RowLin b2{(const bf16_t*)(ws + OFF_WPB) + (long)bcol * 512, 512};
        bf16_t* MX = (bf16_t*)(ws + OFF_C + C_MIXED) + (long)brow * 1024 + bcol;
        gemm_tile(smem, a2, b2, 8, 64, 64, [&](const float* Cs) {
#pragma unroll 2
          for (int it = 0; it < 8; ++it) {
            int id = it * 256 + tid; int r = id >> 4, c = (id & 15) * 8; float v[8]; ld8(Cs, r, c, v);
            u32x4 d = *(const u32x4*)(MG + (long)r * 2048 + 1024 + c);
            f32x4 p0 = *(const f32x4*)(scr + id * 8), p1 = *(const f32x4*)(scr + id * 8 + 4);
            float pv[8] = {p0[0], p0[1], p0[2], p0[3], p1[0], p1[1], p1[2], p1[3]};
#pragma unroll
            for (int i = 0; i < 4; ++i) { v[2 * i] = pv[2 * i] + v[2 * i] * bf2f(d[i] & 0xffffu); v[2 * i + 1] = pv[2 * i + 1] + v[2 * i + 1] * bf2f(d[i] >> 16); }
            *(u32x4*)(MX + (long)r * 1024 + c) = pack8(v);
          }
        });
      }
    } break;
    case 5: case 9: case 12: {
      const bf16_t* A; const bf16_t* W; const float* RES; float* DST; int K;
      if (ph == 5) { A = (const bf16_t*)(ws + OFF_C + C_MIXED); W = (const bf16_t*)(ws + OFF_WOUT); RES = P.x; DST = (float*)(ws + OFF_B); K = 1024; }
      else if (ph == 9) { A = (const bf16_t*)(ws + OFF_D) + (long)M_ * 512; W = (const bf16_t*)(ws + OFF_WMO); RES = (const float*)(ws + OFF_B); DST = (float*)(ws + OFF_C + C_H2); K = 512; }
      else { A = (const bf16_t*)(ws + OFF_B); W = (const bf16_t*)(ws + OFF_WDN); RES = (const float*)(ws + OFF_C + C_H2); DST = P.out; K = 2816; }
      const int xq = blockIdx.x & 7, lq = blockIdx.x >> 3, sq = gridDim.x >> 3;
      for (int t = lq; t < 16 * 4; t += sq) {
        const int mt = xq * 16 + (t & 15), nt2 = t >> 4, brow = mt * 128;
        RowLin ar{A + (long)brow * K, K}; RowLin br{W + (long)nt2 * 256 * K, K};
        gemm_tile2(smem, ar, br, K / 64, [&](const float* Cs, int p) {
          const int bcol = nt2 * 256 + p * 128;
          const float* rs = RES + (long)brow * 1024 + bcol; float* ds = DST + (long)brow * 1024 + bcol;
#pragma unroll 2
          for (int it = 0; it < 8; ++it) {
            int id = it * 256 + tid; int r = id >> 4, c = (id & 15) * 8;
            f32x4 a = *(const f32x4*)(Cs + r * CS_LD + c), bq = *(const f32x4*)(Cs + r * CS_LD + c + 4);
            f32x4 r0 = *(const f32x4*)(rs + (long)r * 1024 + c), r1 = *(const f32x4*)(rs + (long)r * 1024 + c + 4);
            const f32x4 h0 = a + r0, h1v = bq + r1;
            *(f32x4*)(ds + (long)r * 1024 + c) = h0; *(f32x4*)(ds + (long)r * 1024 + c + 4) = h1v;
            if (ph != 12) {
              const float* gn = (ph == 5 ? P.norm_mq : P.norm_ffn) + bcol + c;
              const f32x4 g0 = *(const f32x4*)gn, g1 = *(const f32x4*)(gn + 4);
              float v[8] = {h0[0] * g0[0], h0[1] * g0[1], h0[2] * g0[2], h0[3] * g0[3], h1v[0] * g1[0], h1v[1] * g1[1], h1v[2] * g1[2], h1v[3] * g1[3]};
              *(u32x4*)((bf16_t*)(ws + OFF_A) + (long)(brow + r) * 1024 + bcol + c) = pack8(v);
              float ss = (h0[0] * h0[0] + h0[1] * h0[1]) + (h0[2] * h0[2] + h0[3] * h0[3]) + (h1v[0] * h1v[0] + h1v[1] * h1v[1]) + (h1v[2] * h1v[2] + h1v[3] * h1v[3]);
              ss += __shfl_xor(ss, 1, 64); ss += __shfl_xor(ss, 2, 64); ss += __shfl_xor(ss, 4, 64); ss += __shfl_xor(ss, 8, 64);
              if ((tid & 15) == 0) ((float*)(ws + (ph == 5 ? OFF_SSQ1 : OFF_SSQ2)))[(long)(brow + r) * 8 + nt2 * 2 + p] = ss;
            }
          }
        });
      }
    } break;
    case 6: case 10: {
      const float* src = ph == 6 ? (const float*)(ws + OFF_B) : (const float*)(ws + OFF_C + C_H2);
      const float* g = ph == 6 ? P.norm_mq : P.norm_ffn;
      (void)src; (void)g;
    } break;
    case 7: {
      const int xq = blockIdx.x & 7, lq = blockIdx.x >> 3, sq = gridDim.x >> 3;
      for (int t = lq; t < 16 * 4; t += sq) {
        const int mt = xq * 16 + (t & 15), nt = t >> 4, brow = mt * 128;
        RowLin ar{(const bf16_t*)(ws + OFF_A) + (long)brow * 1024, 1024}; RowLin br{(const bf16_t*)(ws + OFF_WMQ) + (long)nt * 128 * 1024, 1024};
        gemm_tile(smem, ar, br, 16, 64, 64, [&](const float* Cs) {
          bf16_t* dq = (bf16_t*)(ws + OFF_D) + (long)brow * 512 + nt * 128; const float* sq1 = (const float*)(ws + OFF_SSQ1) + (long)brow * 8;
#pragma unroll 2
          for (int it = 0; it < 8; ++it) {
            int id = it * 256 + tid; int r = id >> 4, c = (id & 15) * 8; float v[8]; ld8(Cs, r, c, v);
            const f32x4 s0 = *(const f32x4*)(sq1 + r * 8), s1 = *(const f32x4*)(sq1 + r * 8 + 4);
            const float ssum = ((s0[0] + s0[1]) + (s0[2] + s0[3])) + ((s1[0] + s1[1]) + (s1[2] + s1[3]));
            const float rr = rsqrtf(ssum * (1.f / 1024.f) + 1e-6f) * (0.08838834764831845f * LOG2E);
#pragma unroll
            for (int i = 0; i < 8; ++i) v[i] *= rr;
            *(u32x4*)(dq + (long)r * 512 + c) = pack8(v);
          }
        });
        asm volatile("s_waitcnt vmcnt(0)" ::: "memory");
        __syncthreads();
        xattn_tile(P, ((brow >> 5) + (tid >> 6)) * 4 + nt);
      }
    } break;
    case 8: {
      if (ph_fused) break;
      for (int job = blockIdx.x; job < 512; job += gridDim.x) xattn_tile(P, job * 4 + (tid >> 6));
    } break;
    case 11: {
      const int xq = blockIdx.x & 7, lq = blockIdx.x >> 3, sq = gridDim.x >> 3;
      for (int t = lq; t < 16 * 22; t += sq) {
        const int mt = xq * 16 + (t & 15), nt2 = t >> 4, brow = mt * 128;
        RowLin ar{(const bf16_t*)(ws + OFF_A) + (long)brow * 1024, 1024}; RowLin br{(const bf16_t*)(ws + OFF_WGU) + (long)nt2 * 256 * 1024, 1024};
        gemm_tile2(smem, ar, br, 16, [&](const float* Cs, int p) {
          bf16_t* ACT = (bf16_t*)(ws + OFF_B) + (long)brow * 2816 + (nt2 * 2 + p) * 64;
#pragma unroll 2
          for (int it = 0; it < 4; ++it) {
            int id = it * 256 + tid; int r = id >> 3, c = (id & 7) * 8; float gt[8], up[8]; ld8(Cs, r, c, gt); ld8(Cs, r, c + 64, up);
            const float* sq2 = (const float*)(ws + OFF_SSQ2) + (long)(brow + r) * 8;
            const f32x4 s0 = *(const f32x4*)(sq2), s1 = *(const f32x4*)(sq2 + 4);
            const float ssum = ((s0[0] + s0[1]) + (s0[2] + s0[3])) + ((s1[0] + s1[1]) + (s1[2] + s1[3]));
            const float rr = rsqrtf(ssum * (1.f / 1024.f) + 1e-6f);
#pragma unroll
            for (int i = 0; i < 8; ++i) { const float gg = gt[i] * rr; gt[i] = gg * sigm(gg) * (up[i] * rr); }
            *(u32x4*)(ACT + (long)r * 2816 + c) = pack8(gt);
          }
        });
      }
    } break;
    case 13: {
      for (int job = blockIdx.x; job < 1024; job += gridDim.x) { int row = job * 16 + (tid >> 6) * 4; rownorm_rows<true, 4>(P.out + (long)row * 1024, P.norm_final, P.out + (long)row * 1024); }
    } break;
#ifdef PROBE_K
    case 14: {
      const bf16_t* s0 = (const bf16_t*)(ws + PROBE_SRC0); const bf16_t* s1 = (const bf16_t*)(ws + PROBE_SRC1);
      for (long i = (long)blockIdx.x * 256 + tid; i < (long)M_ * 512; i += (long)gridDim.x * 256) {
        long row = i >> 9; int c = (int)(i & 511);
        P.out[row * 1024 + c] = bf2f(s0[i]); P.out[row * 1024 + 512 + c] = bf2f(s1[i]);
      }
    } break;
    case 15: {
      const float* s0 = (const float*)(ws + PROBE_SRC0);
      for (long i = (long)blockIdx.x * 256 + tid; i < (long)M_ * 1024; i += (long)gridDim.x * 256) P.out[i] = s0[i];
    } break;
#endif
  }
}

__global__ void __launch_bounds__(256, 2) fwd_kernel(Params P, int ph_lo, int ph_hi) {
  __shared__ __attribute__((aligned(16))) char smem[73728 + 16];
  volatile LAS unsigned* st = (volatile LAS unsigned*)(smem + 73728);
  const unsigned xcc = xb_xcc_id();
  if (ph_lo < ph_hi) {
    if (threadIdx.x == 0) { st[0] = 0u; st[1] = 0u; }
    __syncthreads();
    if (threadIdx.x == 0) (void)xb_add(&((unsigned*)(P.ws + OFF_BAR))[XB_XCNT(xcc)], 1u);
  }
  if (ph_hi < 0) cg::this_grid().sync();
  for (int ph = ph_lo; ph <= ph_hi; ++ph) {
    const uint64_t __attribute__((address_space(4)))* ka = (const uint64_t __attribute__((address_space(4)))*)__builtin_amdgcn_kernarg_segment_ptr();
    asm volatile("" : "+s"(ka));
    Params Pl; uint64_t* pd = (uint64_t*)&Pl;
#pragma unroll
    for (int i = 0; i < (int)(sizeof(Params) / 8); ++i) {
      const char __attribute__((address_space(1)))* gp = (const char __attribute__((address_space(1)))*)ka[i];
      pd[i] = (uint64_t)(const char*)gp;
    }
    if (ph == 6 || ph == 10 || ph == 8) continue;
    run_phase(Pl, ph, smem, true);
    if (ph < ph_hi) xcd_barrier((unsigned*)(Pl.ws + OFF_BAR), xcc, st);
  }
}

extern "C" void kernel_launch(void* const* d_in, const int* in_sizes, int n_in, void* d_out, int out_size, void* d_ws, size_t ws_size,
                              hipStream_t stream) {
  static int grid_blocks = 0;
  if (!grid_blocks) {
    int dev = 0, cus = 0, per_cu = 0;
    hipGetDevice(&dev);
    hipDeviceGetAttribute(&cus, hipDeviceAttributeMultiprocessorCount, dev);
    hipOccupancyMaxActiveBlocksPerMultiprocessor(&per_cu, fwd_kernel, 256, 0);
    if (per_cu > 2) per_cu = 2;
    if (per_cu < 1) per_cu = 1;
    grid_blocks = cus * per_cu;
  }
  if (ws_size < (size_t)WS_NEED) fprintf(stderr, "workspace too small: %zu < %ld\n", ws_size, (long)WS_NEED);
  Params P{};
  const float** pp = (const float**)&P;
  for (int i = 0; i < 27; ++i) pp[i] = (const float*)d_in[i];
  P.out = (float*)d_out; P.ws = (char*)d_ws;
#if ONE_LAUNCH
  hipMemsetAsync((char*)d_ws + OFF_BAR, 0, XCD_BAR_WORDS * 4, stream);
#ifdef PROBE_K
  int lo = 0, hi = PROBE_DUMP;
#else
  int lo = 0, hi = 13;
#endif
  void* args[] = {&P, &lo, &hi};
  hipError_t e = hipLaunchCooperativeKernel((void*)fwd_kernel, dim3(grid_blocks), dim3(256), args, 0, stream);
  if (e != hipSuccess) fprintf(stderr, "cooperative launch failed: %s (grid %d)\n", hipGetErrorString(e), grid_blocks);
#else
  for (int ph = 0; ph <= 13; ++ph) fwd_kernel<<<grid_blocks, 256, 0, stream>>>(P, ph, ph);
#endif
}
```

```cpp
#include <hip/hip_runtime.h>
#include <hip/hip_cooperative_groups.h>
#include <stdint.h>
#include <stdio.h>
namespace cg = cooperative_groups;

#ifndef NSA_G0
#define NSA_G0 1.f
#define NSA_G1 1.f
#define NSA_G2 1.f
#endif
#ifndef ONE_LAUNCH
#define ONE_LAUNCH 1
#endif

typedef unsigned short bf16_t;
using bf16x8 = __attribute__((ext_vector_type(8))) short;
using f32x4 = __attribute__((ext_vector_type(4))) float;
using u32x4 = __attribute__((ext_vector_type(4))) unsigned;
using u32x2 = __attribute__((ext_vector_type(2))) unsigned;

#define T_ 8192
#define M_ 16384
#define NEGF (-1e30f)
#define LOG2E 1.4426950408889634f

constexpr long OFF_W1 = 0;
constexpr long OFF_WMKV = OFF_W1 + 4608L * 1024 * 2;
constexpr long OFF_WPA = OFF_WMKV + 2097152;
constexpr long OFF_WPB = OFF_WPA + 1048576;
constexpr long OFF_WOUT = OFF_WPB + 1048576;
constexpr long OFF_WMQ = OFF_WOUT + 2097152;
constexpr long OFF_WMO = OFF_WMQ + 1048576;
constexpr long OFF_WGU = OFF_WMO + 1048576;
constexpr long OFF_WDN = OFF_WGU + 11534336;
constexpr long OFF_WCK1 = OFF_WDN + 5767168;
constexpr long OFF_WCV1 = OFF_WCK1 + 524288;
constexpr long OFF_WM = OFF_WCV1 + 524288;
constexpr long OFF_BIAS1 = OFF_WM + 131072;
constexpr long OFF_MEMN = OFF_BIAS1 + 1024;
constexpr long OFF_MK = OFF_MEMN + 1048576;
constexpr long OFF_MVT = OFF_MK + 524288;
constexpr long OFF_KCMP = OFF_MVT + 524288;
constexpr long OFF_VCT = OFF_KCMP + 262144;
constexpr long OFF_A = OFF_VCT + 262144;
constexpr long OFF_B = OFF_A + 33554432;
constexpr long OFF_D = OFF_B + 67108864;
constexpr long OFF_C = OFF_D + 33554432;
constexpr long C_Q = 0, C_U = 16777216, C_GVT = 33554432, C_KC = 50331648, C_VC = 54525952, C_KS = 58720256,
               C_KW = 62914560, C_VST = 67108864, C_VWT = 71303168, C_GATES = 75497472;
constexpr long C_MIXED = 0, C_SCR = 33554432, C_H2 = 0;
constexpr long OFF_BAR = OFF_C + 77070336;
constexpr long OFF_SSQ1 = OFF_BAR + 16384;
constexpr long OFF_SSQ2 = OFF_SSQ1 + 524288;
constexpr long WS_NEED = OFF_SSQ2 + 524288;

struct Params {
  const float *x, *mem, *norm_mix, *w_in, *w_ck1, *w_ck2, *w_cv1, *w_cv2, *pe_k, *pe_v, *ln_sgu, *w_sp, *b_sp,
      *w_pa, *w_pb, *w_merge, *b_merge, *w_out, *norm_mq, *norm_mkv, *w_mq, *w_mkv, *w_mo, *norm_ffn, *w_gu, *w_dn, *norm_final;
  float* out;
  char* ws;
};

__device__ __forceinline__ int tidx() { int t = threadIdx.x; asm volatile("" : "+v"(t)); return t; }
__device__ __forceinline__ unsigned f2bf(float f) { unsigned u = __float_as_uint(f); u += 0x7fffu + ((u >> 16) & 1u); return u >> 16; }
__device__ __forceinline__ unsigned pack2(float a, float b) { unsigned r; asm("v_cvt_pk_bf16_f32 %0, %1, %2" : "=v"(r) : "v"(a), "v"(b)); return r; }
__device__ __forceinline__ float bf2f(unsigned h) { return __uint_as_float(h << 16); }
__device__ __forceinline__ float gelu_tanh(float x) { float u = 0.7978845608028654f * (x + 0.044715f * x * x * x); return x / (1.f + __expf(-2.f * u)); }
__device__ __forceinline__ float sigm(float x) { return 1.f / (1.f + __expf(-x)); }
__device__ __forceinline__ float wave_sum(float v) {
#pragma unroll
  for (int o = 32; o > 0; o >>= 1) v += __shfl_xor(v, o, 64);
  return v;
}
__device__ __forceinline__ u32x4 pack8(const float (&v)[8]) {
  u32x4 r; r[0] = pack2(v[0], v[1]); r[1] = pack2(v[2], v[3]); r[2] = pack2(v[4], v[5]); r[3] = pack2(v[6], v[7]); return r;
}

__device__ __forceinline__ int lds_byte(int r, int c) {
  int st = (r >> 4) * 2 + (c >> 5), rr = r & 15, cc = c & 31, ob = rr * 64 + cc * 2;
  return st * 1024 + (ob ^ (((ob >> 9) & 1) << 5));
}
__device__ __forceinline__ void stage_rc(int b, int& R, int& C) {
  int st = b >> 10, sb = b & 1023, swz = sb ^ (((sb >> 9) & 1) << 5);
  R = (st >> 1) * 16 + (swz >> 6); C = (st & 1) * 32 + ((swz & 63) >> 1);
}

#define CS_LD 132
__device__ __forceinline__ void ld8(const float* Cs, int r, int c, float (&v)[8]) {
  f32x4 a = *(const f32x4*)(Cs + r * CS_LD + c); f32x4 b = *(const f32x4*)(Cs + r * CS_LD + c + 4);
  v[0] = a[0]; v[1] = a[1]; v[2] = a[2]; v[3] = a[3]; v[4] = b[0]; v[5] = b[1]; v[6] = b[2]; v[7] = b[3];
}
__device__ __forceinline__ void ld8T(const float* Cs, int r8, int c, float (&v)[8]) {
#pragma unroll
  for (int i = 0; i < 8; ++i) v[i] = Cs[(r8 + i) * CS_LD + c];
}

struct RowLin {
  const bf16_t* base; long ld;
  __device__ __forceinline__ const bf16_t* operator()(int r) const { return base + (long)r * ld; }
};
struct RowCmp {
  const bf16_t* base; int brow;
  __device__ __forceinline__ const bf16_t* operator()(int r) const {
    int R = brow + r; int b = R >> 10, rem = R & 1023, i = rem >> 1, g = rem & 1; if (i > 510) i = 510;
    return base + ((long)(b * T_ + 16 * i) * 128 + g * 64);
  }
};

template <int AUX = 0, class ARow, class BRow, class Epi>
__device__ __forceinline__ void gemm_tile(char* smem, ARow arow, BRow brow, int nkt, int kstepA, int kstepB, Epi epi) {
  const int tid = tidx(), lane = tid & 63, wave = tid >> 6, wr = wave >> 1, wc = wave & 1, fr = lane & 15, fq = lane >> 4;
  const bf16_t* pa[4]; const bf16_t* pb[4];
#pragma unroll
  for (int i = 0; i < 4; ++i) { int b = tid * 16 + i * 4096; int R, C; stage_rc(b, R, C); pa[i] = arow(R) + C; pb[i] = brow(R) + C; }
  f32x4 acc[4][4];
#pragma unroll
  for (int m = 0; m < 4; ++m)
#pragma unroll
    for (int n = 0; n < 4; ++n) acc[m][n] = (f32x4){0.f, 0.f, 0.f, 0.f};
  {
#pragma unroll
    for (int i = 0; i < 4; ++i) {
      __builtin_amdgcn_global_load_lds((const unsigned*)(pa[i]), (unsigned*)(smem + tid * 16 + i * 4096), 16, 0, AUX);
      __builtin_amdgcn_global_load_lds((const unsigned*)(pb[i]), (unsigned*)(smem + 16384 + tid * 16 + i * 4096), 16, 0, AUX);
    }
  }
  for (int kt = 0; kt < nkt; ++kt) {
    asm volatile("s_waitcnt vmcnt(0)" ::: "memory");
    __syncthreads();
    if (kt + 1 < nkt) {
      char* la = smem + ((kt + 1) & 1) * 32768;
#pragma unroll
      for (int i = 0; i < 4; ++i) {
        __builtin_amdgcn_global_load_lds((const unsigned*)(pa[i] + (long)(kt + 1) * kstepA), (unsigned*)(la + tid * 16 + i * 4096), 16, 0, AUX);
        __builtin_amdgcn_global_load_lds((const unsigned*)(pb[i] + (long)(kt + 1) * kstepB), (unsigned*)(la + 16384 + tid * 16 + i * 4096), 16, 0, AUX);
      }
    }
    const char* la = smem + (kt & 1) * 32768; const char* lb = la + 16384;
#pragma unroll
    for (int ks = 0; ks < 2; ++ks) {
      bf16x8 a[4], b[4];
#pragma unroll
      for (int m = 0; m < 4; ++m) a[m] = *(const bf16x8*)(la + lds_byte(wr * 64 + m * 16 + fr, ks * 32 + fq * 8));
#pragma unroll
      for (int n = 0; n < 4; ++n) b[n] = *(const bf16x8*)(lb + lds_byte(wc * 64 + n * 16 + fr, ks * 32 + fq * 8));
#pragma unroll
      for (int m = 0; m < 4; ++m)
#pragma unroll
        for (int n = 0; n < 4; ++n) acc[m][n] = __builtin_amdgcn_mfma_f32_16x16x32_bf16(a[m], b[n], acc[m][n], 0, 0, 0);
    }
  }
  __syncthreads();
  float* Cs = (float*)smem;
#pragma unroll
  for (int m = 0; m < 4; ++m)
#pragma unroll
    for (int n = 0; n < 4; ++n)
#pragma unroll
      for (int r = 0; r < 4; ++r) Cs[(wr * 64 + m * 16 + fq * 4 + r) * CS_LD + wc * 64 + n * 16 + fr] = acc[m][n][r];
  __syncthreads();
  epi(Cs);
  __syncthreads();
}

template <class F>
__device__ __forceinline__ void store_rows_bf16(const float* Cs, bf16_t* dst, long ld, F f) {
#pragma unroll 2
  for (int it = 0; it < 8; ++it) {
    int id = it * 256 + tidx(); int r = id >> 4, c = (id & 15) * 8;
    float v[8]; ld8(Cs, r, c, v);
#pragma unroll
    for (int i = 0; i < 8; ++i) v[i] = f(v[i], c + i);
    *(u32x4*)(dst + (long)r * ld + c) = pack8(v);
  }
}
template <class F>
__device__ __forceinline__ void store_T_bf16(const float* Cs, bf16_t* dst, long cstride, F f) {
#pragma unroll 2
  for (int it = 0; it < 8; ++it) {
    int id = it * 256 + tidx(); int c = id >> 4, r8 = (id & 15) * 8;
    float v[8]; ld8T(Cs, r8, c, v);
#pragma unroll
    for (int i = 0; i < 8; ++i) v[i] = f(v[i]);
    *(u32x4*)(dst + (long)c * cstride + r8) = pack8(v);
  }
}


__device__ __forceinline__ int lds_byte32(int r, int c) { int rr = r & 15; return (r >> 4) * 1024 + rr * 64 + ((((c >> 3) ^ ((-(rr >> 2)) & 3)) & 3) << 4); }
__device__ __forceinline__ void stage_rc32(int b, int& R, int& C) { int st = b >> 10, sb = b & 1023, rr = sb >> 6, cp = (sb >> 4) & 3; R = st * 16 + rr; C = ((cp ^ ((-(rr >> 2)) & 3)) & 3) * 8; }
struct RowClamp {
  const bf16_t* base; long ld; int maxr;
  __device__ __forceinline__ const bf16_t* operator()(int r) const { return base + (long)(r < maxr ? r : maxr) * ld; }
};
__device__ __forceinline__ int lds_byte64(int r, int c) { int rr = r & 15; return (r >> 4) * 2048 + rr * 128 + ((((c >> 3) ^ (rr >> 1)) & 7) << 4); }
__device__ __forceinline__ void stage_rc64(int b, int& R, int& C) { int st = b >> 11, sb = b & 2047, rr = sb >> 7, cp = (sb >> 4) & 7; R = st * 16 + rr; C = ((cp ^ (rr >> 1)) & 7) * 8; }
template <class ARow, class BRow, class Epi>
__device__ __forceinline__ void gemm_tile2(char* smem, ARow arow, BRow brow, int nkt, Epi epi) {
  const int tid = tidx(), lane = tid & 63, wave = tid >> 6, wr = wave >> 1, wc = wave & 1, fr = lane & 15, fq = lane >> 4;
  int R0, C0; stage_rc64(tid * 16, R0, C0);
  const bf16_t* pa0 = arow(R0) + C0; const bf16_t* pb0 = brow(R0) + C0;
  const long sa32 = 32 * arow.ld, sb32 = 32 * brow.ld;
  f32x4 acc[4][8];
#pragma unroll
  for (int m = 0; m < 4; ++m)
#pragma unroll
    for (int n = 0; n < 8; ++n) acc[m][n] = (f32x4){0.f, 0.f, 0.f, 0.f};
  __syncthreads();
#pragma unroll
  for (int i = 0; i < 4; ++i) __builtin_amdgcn_global_load_lds((const unsigned*)(pa0 + i * sa32), (unsigned*)(smem + tid * 16 + i * 4096), 16, 0, 0);
#pragma unroll
  for (int i = 0; i < 8; ++i) __builtin_amdgcn_global_load_lds((const unsigned*)(pb0 + i * sb32), (unsigned*)(smem + 16384 + tid * 16 + i * 4096), 16, 0, 0);
  for (int kt = 0; kt < nkt; ++kt) {
    asm volatile("s_waitcnt vmcnt(0)" ::: "memory");
    __syncthreads();
    if (kt + 1 < nkt) {
      char* bn = smem + 16384 + ((kt + 1) & 1) * 32768;
#pragma unroll
      for (int i = 0; i < 8; ++i) __builtin_amdgcn_global_load_lds((const unsigned*)(pb0 + i * sb32 + (long)(kt + 1) * 64), (unsigned*)(bn + tid * 16 + i * 4096), 16, 0, 0);
    }
    {
      const char* pA = smem + lds_byte64(wr * 64 + fr, fq * 8);
      const char* pB = smem + 16384 + (kt & 1) * 32768 + lds_byte64(wc * 128 + fr, fq * 8);
      const int k1 = lds_byte64(fr, 32 + fq * 8) - lds_byte64(fr, fq * 8);
#pragma unroll
      for (int ks = 0; ks < 2; ++ks) {
        bf16x8 a[4], bb[8];
#pragma unroll
        for (int m = 0; m < 4; ++m) a[m] = *(const bf16x8*)(pA + m * 2048 + ks * k1);
#pragma unroll
        for (int n = 0; n < 8; ++n) bb[n] = *(const bf16x8*)(pB + n * 2048 + ks * k1);
#pragma unroll
        for (int m = 0; m < 4; ++m)
#pragma unroll
          for (int n = 0; n < 8; ++n) acc[m][n] = __builtin_amdgcn_mfma_f32_16x16x32_bf16(a[m], bb[n], acc[m][n], 0, 0, 0);
      }
    }
    __syncthreads();
    if (kt + 1 < nkt) {
#pragma unroll
      for (int i = 0; i < 4; ++i) __builtin_amdgcn_global_load_lds((const unsigned*)(pa0 + i * sa32 + (long)(kt + 1) * 64), (unsigned*)(smem + tid * 16 + i * 4096), 16, 0, 0);
    }
  }
  float* Cs = (float*)smem;
#pragma unroll
  for (int p = 0; p < 2; ++p) {
    __syncthreads();
    if (wc == p) {
#pragma unroll
      for (int m = 0; m < 4; ++m)
#pragma unroll
        for (int n = 0; n < 8; ++n)
#pragma unroll
          for (int r = 0; r < 4; ++r) Cs[(wr * 64 + m * 16 + fq * 4 + r) * CS_LD + n * 16 + fr] = acc[m][n][r];
    }
    __syncthreads();
    epi(Cs, p);
  }
  __syncthreads();
}

template <int MODE>
__device__ __forceinline__ void transpose_tile(const float* W, int Nsrc, bf16_t* Wt, int Kd, int k0, int n0, float* lds) {
  const int tid = tidx();
  {
    int tx = tid & 63, ty = tid >> 6; int np = n0 + tx; int sc;
    if (MODE == 0) sc = np < Nsrc ? np : -1;
    else { int x = np & 127, tl = np >> 7; sc = x < 64 ? tl * 64 + x : 2816 + tl * 64 + x - 64; }
    float v[32];
#pragma unroll
    for (int i = 0; i < 32; ++i) v[i] = sc >= 0 ? W[(long)(k0 + ty + 4 * i) * Nsrc + sc] : 0.f;
#pragma unroll
    for (int i = 0; i < 32; ++i) lds[(ty + 4 * i) * 65 + tx] = v[i];
  }
  __syncthreads();
  {
    int nrow = tid >> 2, kseg = (tid & 3) * 32;
#pragma unroll
    for (int q = 0; q < 4; ++q) {
      float v[8];
#pragma unroll
      for (int i = 0; i < 8; ++i) v[i] = lds[(kseg + q * 8 + i) * 65 + nrow];
      *(u32x4*)(Wt + (long)(n0 + nrow) * Kd + k0 + kseg + q * 8) = pack8(v);
    }
  }
  __syncthreads();
}

template <bool OUTF, int NR>
__device__ __forceinline__ void rownorm_rows(const float* src, const float* g, void* dst) {
  const int lane = tidx() & 63;
  f32x4 v[NR][4];
#pragma unroll
  for (int r = 0; r < NR; ++r)
#pragma unroll
    for (int i = 0; i < 4; ++i) v[r][i] = *(const f32x4*)(src + (long)r * 1024 + i * 256 + lane * 4);
  f32x4 gg[4];
#pragma unroll
  for (int i = 0; i < 4; ++i) gg[i] = *(const f32x4*)(g + i * 256 + lane * 4);
#pragma unroll
  for (int r = 0; r < NR; ++r) {
    float ss = 0.f;
#pragma unroll
    for (int i = 0; i < 4; ++i) ss += v[r][i][0] * v[r][i][0] + v[r][i][1] * v[r][i][1] + v[r][i][2] * v[r][i][2] + v[r][i][3] * v[r][i][3];
    ss = wave_sum(ss);
    const float rr = rsqrtf(ss * (1.f / 1024.f) + 1e-6f);
#pragma unroll
    for (int i = 0; i < 4; ++i) {
      float o0 = v[r][i][0] * rr * gg[i][0], o1 = v[r][i][1] * rr * gg[i][1], o2 = v[r][i][2] * rr * gg[i][2], o3 = v[r][i][3] * rr * gg[i][3];
      if (OUTF) { *(f32x4*)((float*)dst + (long)r * 1024 + i * 256 + lane * 4) = (f32x4){o0, o1, o2, o3}; }
      else { u32x2 p; p[0] = pack2(o0, o1); p[1] = pack2(o2, o3); *(u32x2*)((bf16_t*)dst + (long)r * 1024 + i * 256 + lane * 4) = p; }
    }
  }
}

__device__ void phase0(const Params& P, char* smem) {
  float* lds = (float*)smem;
  const int tid = tidx();
  const int NJ = 8 + 1024 + 32 + 32 + 2192;
  for (int job = blockIdx.x; job < NJ; job += gridDim.x) {
    int j = job;
    if (j < 8) {
      int n = j * 32 + (tid & 31), sl = tid >> 5; int kv = n >> 7, nn = n & 127;
      const float* pe = kv ? P.pe_v : P.pe_k; const float* w1 = kv ? P.w_cv1 : P.w_ck1;
      float s = 0.f;
      for (int k = sl * 256; k < sl * 256 + 256; ++k) s += pe[k] * w1[(long)k * 128 + nn];
      lds[sl * 32 + (tid & 31)] = s;
      __syncthreads();
      if (tid < 32) { float t = 0.f; for (int q = 0; q < 8; ++q) t += lds[q * 32 + tid]; ((float*)(P.ws + OFF_BIAS1))[j * 32 + tid] = t; }
      __syncthreads();
      continue;
    }
    j -= 8;
    if (j < 1024) { int row = j * 16 + (tid >> 6) * 4; rownorm_rows<false, 4>(P.x + (long)row * 1024, P.norm_mix, (bf16_t*)(P.ws + OFF_A) + (long)row * 1024); continue; }
    j -= 1024;
    if (j < 32) { int row = j * 16 + (tid >> 6) * 4; rownorm_rows<false, 4>(P.mem + (long)row * 1024, P.norm_mkv, (bf16_t*)(P.ws + OFF_MEMN) + (long)row * 1024); continue; }
    j -= 32;
    if (j < 32) {
      int e0 = j * 2048 + tid * 8; float v[8];
#pragma unroll
      for (int i = 0; i < 8; ++i) { int e = e0 + i; int t = (e >> 7) & 127, s = e & 127; v[i] = s <= t ? P.w_sp[e] : 0.f; }
      *(u32x4*)((bf16_t*)(P.ws + OFF_WM) + e0) = pack8(v);
      continue;
    }
    j -= 32;
#define TRJ(KT, NT, W, NSRC, WT, KD, MODE) \
    if (j < (KT) * (NT)) { transpose_tile<MODE>(W, NSRC, (bf16_t*)(P.ws + (WT)), KD, (j % (KT)) * 128, (j / (KT)) * 64, lds); continue; } \
    j -= (KT) * (NT);
    TRJ(8, 88, P.w_gu, 5632, OFF_WGU, 1024, 1)
    TRJ(22, 16, P.w_dn, 1024, OFF_WDN, 2816, 0)
    TRJ(8, 38, P.w_in, 2328, OFF_W1, 1024, 0)
    TRJ(8, 32, P.w_merge, 2048, OFF_W1 + 2432L * 1024 * 2, 1024, 0)
    TRJ(8, 16, P.w_mkv, 1024, OFF_WMKV, 1024, 0)
    TRJ(8, 16, P.w_out, 1024, OFF_WOUT, 1024, 0)
    TRJ(4, 16, P.w_pa, 1024, OFF_WPA, 512, 0)
    TRJ(4, 16, P.w_pb, 1024, OFF_WPB, 512, 0)
    TRJ(8, 8, P.w_mq, 512, OFF_WMQ, 1024, 0)
    TRJ(4, 16, P.w_mo, 1024, OFF_WMO, 512, 0)
    TRJ(16, 2, P.w_ck1, 128, OFF_WCK1, 2048, 0)
    TRJ(16, 2, P.w_cv1, 128, OFF_WCV1, 2048, 0)
#undef TRJ
  }
}

__device__ void phase1(const Params& P, char* smem) {
  char* ws = P.ws;
  const int NG1 = 128 * 18;
  const int xq = blockIdx.x & 7, lq = blockIdx.x >> 3, sq = gridDim.x >> 3;
  for (int t = lq; t < 16 * 12; t += sq) {
    {
      const int mt = xq * 16 + (t & 15), nt2 = t >> 4; const int brow = mt * 128;
      RowLin ar{(const bf16_t*)(ws + OFF_A) + (long)brow * 1024, 1024};
      RowLin br{(const bf16_t*)(ws + OFF_W1) + (long)nt2 * 256 * 1024, 1024};
      gemm_tile2(smem, ar, br, 16, [&](const float* Cs, int p) {
        const int nt = nt2 * 2 + p; if (nt >= 35) return;
        char* C = ws + OFF_C;
        if (nt < 4) {
          store_rows_bf16(Cs, (bf16_t*)(C + C_Q) + (long)brow * 512 + nt * 128, 512, [](float v, int) { return v * (0.125f * LOG2E); });
        } else if (nt == 4 || nt == 5 || nt == 6 || nt == 8) {
          long off = nt == 4 ? C_KC : nt == 5 ? C_VC : nt == 6 ? C_KS : C_KW;
          store_rows_bf16(Cs, (bf16_t*)(C + off) + (long)brow * 128, 128, [](float v, int) { return v; });
        } else if (nt == 7 || nt == 9) {
          long off = nt == 7 ? C_VST : C_VWT; int b = brow >> 13, tl = brow & 8191;
          store_T_bf16(Cs, (bf16_t*)(C + off) + (long)b * 128 * T_ + tl, T_, [](float v) { return v; });
        } else if (nt < 14) {
          store_rows_bf16(Cs, (bf16_t*)(C + C_U) + (long)brow * 512 + (nt - 10) * 128, 512, [](float v, int) { return gelu_tanh(v); });
        } else if (nt < 18) {
          store_T_bf16(Cs, (bf16_t*)(C + C_GVT) + ((long)(brow >> 7) * 512 + (nt - 14) * 128) * 128, 128, [](float v) { return gelu_tanh(v); });
        } else if (nt == 18) {
          float* gates = (float*)(C + C_GATES);
          for (int id = tidx(); id < 128 * 24; id += 256) { int r = id / 24, c = id % 24; gates[(long)(brow + r) * 24 + c] = sigm(Cs[r * CS_LD + c]); }
        } else {
          const float* bm = P.b_merge + (nt - 19) * 128;
          store_rows_bf16(Cs, (bf16_t*)(ws + OFF_B) + (long)brow * 2048 + (nt - 19) * 128, 2048, [bm](float v, int c) { return sigm(v + bm[c]); });
        }
      });
    }
  }
}

__device__ void phase2(const Params& P, char* smem) {
  char* ws = P.ws; const int tid = tidx();
  for (int job = blockIdx.x; job < 32 + 128; job += gridDim.x) {
    if (job < 32) {
      const int kv = job >> 4, mt = job & 15, brow = mt * 128;
      RowCmp ar{(const bf16_t*)(ws + OFF_C + (kv ? C_VC : C_KC)), brow};
      RowLin br{(const bf16_t*)(ws + (kv ? OFF_WCV1 : OFF_WCK1)), 2048};
      const float* bias1 = (const float*)(ws + OFF_BIAS1) + kv * 128;
      const float* w2 = kv ? P.w_cv2 : P.w_ck2;
      gemm_tile(smem, ar, br, 32, 128, 64, [&](const float* Csc) {
        float* Cs = (float*)Csc;
        for (int it = 0; it < 64; ++it) { int id = it * 256 + tid; int r = id >> 7, n = id & 127; Cs[r * CS_LD + n] = gelu_tanh(Cs[r * CS_LD + n] + bias1[n]); }
        __syncthreads();
        const int r = tid >> 1, half = tid & 1;
        float acc[32];
#pragma unroll
        for (int i = 0; i < 32; ++i) acc[i] = 0.f;
        for (int n = 0; n < 128; ++n) {
          float h = Cs[r * CS_LD + n]; const float* wr = w2 + n * 64 + half * 32;
#pragma unroll
          for (int q = 0; q < 8; ++q) { f32x4 w = *(const f32x4*)(wr + q * 4); acc[q * 4] += h * w[0]; acc[q * 4 + 1] += h * w[1]; acc[q * 4 + 2] += h * w[2]; acc[q * 4 + 3] += h * w[3]; }
        }
        const int R = brow + r; const int b = R >> 10, rem = R & 1023, i = rem >> 1, g = rem & 1;
        if (i >= 511) {
#pragma unroll
          for (int q = 0; q < 32; ++q) acc[q] = 0.f;
        }
        if (kv == 0) {
          bf16_t* dst = (bf16_t*)(ws + OFF_KCMP) + (long)(b * 512 + i) * 128 + g * 64 + half * 32;
#pragma unroll
          for (int q = 0; q < 4; ++q) { float v[8];
#pragma unroll
            for (int e = 0; e < 8; ++e) v[e] = acc[q * 8 + e];
            *(u32x4*)(dst + q * 8) = pack8(v); }
        } else {
          bf16_t* dst = (bf16_t*)(ws + OFF_VCT) + ((long)(b * 128 + g * 64 + half * 32)) * 512 + i;
#pragma unroll
          for (int q = 0; q < 32; ++q) dst[(long)q * 512] = (bf16_t)f2bf(acc[q]);
        }
      });
    } else {
      const int bc = job - 32; bf16_t* base = (bf16_t*)(ws + OFF_C + C_GVT) + (long)bc * 512 * 128;
      float* ssum = (float*)smem; float* ssq = ssum + 128;
      float* psum = ssum + 256; float* psq = psum + 16 * 128;
      const int cs = tid >> 4, s8 = (tid & 15) * 8;
      float a[8], q[8];
#pragma unroll
      for (int i = 0; i < 8; ++i) { a[i] = 0.f; q[i] = 0.f; }
      for (int it = 0; it < 32; ++it) {
        u32x4 d = *(const u32x4*)(base + (long)(it * 16 + cs) * 128 + s8);
#pragma unroll
        for (int i = 0; i < 4; ++i) { float lo = bf2f(d[i] & 0xffffu), hi = bf2f(d[i] >> 16); a[2 * i] += lo; q[2 * i] += lo * lo; a[2 * i + 1] += hi; q[2 * i + 1] += hi * hi; }
      }
#pragma unroll
      for (int i = 0; i < 8; ++i) { psum[cs * 128 + s8 + i] = a[i]; psq[cs * 128 + s8 + i] = q[i]; }
      __syncthreads();
      if (tid < 128) {
        float su = 0.f, sq = 0.f;
        for (int c = 0; c < 16; ++c) { su += psum[c * 128 + tid]; sq += psq[c * 128 + tid]; }
        float mean_t = su * (1.f / 512.f); float var = sq * (1.f / 512.f) - mean_t * mean_t; if (var < 0.f) var = 0.f;
        ssum[tid] = mean_t; ssq[tid] = rsqrtf(var + 1e-6f);
      }
      __syncthreads();
      float mean[8], rs[8];
#pragma unroll
      for (int i = 0; i < 8; ++i) { mean[i] = ssum[s8 + i]; rs[i] = ssq[s8 + i]; }
      for (int it = 0; it < 32; ++it) {
        int ch = it * 16 + cs; float gg = P.ln_sgu[ch];
        u32x4 d = *(const u32x4*)(base + (long)ch * 128 + s8); float v[8];
#pragma unroll
        for (int i = 0; i < 4; ++i) { v[2 * i] = bf2f(d[i] & 0xffffu); v[2 * i + 1] = bf2f(d[i] >> 16); }
#pragma unroll
        for (int i = 0; i < 8; ++i) v[i] = (v[i] - mean[i]) * rs[i] * gg;
        *(u32x4*)(base + (long)ch * 128 + s8) = pack8(v);
      }
      __syncthreads();
    }
  }
  if (blockIdx.x >= 32) {
    for (int mtile = blockIdx.x - 32; mtile < 768 + 32; mtile += gridDim.x - 32) {
      if (mtile >= 768) {
        const int j = mtile - 768; const int mt = j >> 3, nt = j & 7; const int brow = mt * 128;
        RowLin ar{(const bf16_t*)(ws + OFF_MEMN) + (long)brow * 1024, 1024};
        RowLin br{(const bf16_t*)(ws + OFF_WMKV) + (long)nt * 128 * 1024, 1024};
        gemm_tile(smem, ar, br, 16, 64, 64, [&](const float* Cs) {
          if (nt < 4) store_rows_bf16(Cs, (bf16_t*)(ws + OFF_MK) + (long)brow * 512 + nt * 128, 512, [](float v, int) { return v; });
          else { int b = mt >> 1, n0 = (mt & 1) * 128; store_T_bf16(Cs, (bf16_t*)(ws + OFF_MVT) + ((long)b * 512 + (nt - 4) * 128) * 256 + n0, 256, [](float v) { return v; }); }
        });
        continue;
      }
      const int mt = mtile & 127, nt2 = 12 + (mtile >> 7), brow = mt * 128;
      RowLin ar{(const bf16_t*)(ws + OFF_A) + (long)brow * 1024, 1024};
      RowLin br{(const bf16_t*)(ws + OFF_W1) + (long)nt2 * 256 * 1024, 1024};
      gemm_tile2(smem, ar, br, 16, [&](const float* Cs, int p) {
        const int nt = nt2 * 2 + p; if (nt >= 35) return;
        const float* bm = P.b_merge + (nt - 19) * 128;
        store_rows_bf16(Cs, (bf16_t*)(ws + OFF_B) + (long)brow * 2048 + (nt - 19) * 128, 2048, [bm](float v, int c) { return sigm(v + bm[c]); });
      });
    }
  }
}

template <int MODE>
__device__ __forceinline__ void nsa_block(const bf16x8 (&qf)[4][2], f32x4 (&oacc)[4][4], float (&m)[4], float (&l)[4],
                                          const float (&sl2)[4], const float (&inv)[4], const bf16_t* kp, const bf16_t* vp, long vdt,
                                          int dist0, bool rowok, float (&asum)[2], float (&bsum)[2]) {
  constexpr int DSTEP = (MODE <= 1) ? 16 : 1;
  bf16x8 kf[2][2];
#pragma unroll
  for (int kt = 0; kt < 2; ++kt)
#pragma unroll
    for (int ks = 0; ks < 2; ++ks) kf[kt][ks] = *(const bf16x8*)(kp + kt * 16 * 128 + ks * 32);
  bf16x8 vf[4];
  if (MODE != 0) {
#pragma unroll
    for (int dt = 0; dt < 4; ++dt) {
      u32x2 lo = *(const u32x2*)(vp + dt * vdt); u32x2 hi = *(const u32x2*)(vp + dt * vdt + 16);
      u32x4 c; c[0] = lo[0]; c[1] = lo[1]; c[2] = hi[0]; c[3] = hi[1];
      vf[dt] = __builtin_bit_cast(bf16x8, c);
    }
  }
  const float fd0 = (float)dist0;
#pragma unroll
  for (int h = 0; h < 4; ++h) {
    f32x4 s[2];
#pragma unroll
    for (int kt = 0; kt < 2; ++kt) {
      s[kt] = __builtin_amdgcn_mfma_f32_16x16x32_bf16(kf[kt][0], qf[h][0], (f32x4){0.f, 0.f, 0.f, 0.f}, 0, 0, 0);
      s[kt] = __builtin_amdgcn_mfma_f32_16x16x32_bf16(kf[kt][1], qf[h][1], s[kt], 0, 0, 0);
    }
    float sc[8]; bool ok[8];
#pragma unroll
    for (int kt = 0; kt < 2; ++kt)
#pragma unroll
      for (int r = 0; r < 4; ++r) {
        const int e = kt * 16 + r; const int dist = dist0 - DSTEP * e;
        bool o = dist >= 0;
        if (MODE == 2) o = o && rowok;
        if (MODE == 3) o = o && (dist < 512);
        ok[kt * 4 + r] = o;
        sc[kt * 4 + r] = o ? s[kt][r] - sl2[h] * (fd0 - (float)(DSTEP * e)) : NEGF;
      }
    float p[8];
    if (MODE != 1) {
      float ml = NEGF;
#pragma unroll
      for (int i = 0; i < 8; ++i) ml = fmaxf(ml, sc[i]);
      ml = fmaxf(ml, __shfl_xor(ml, 16, 64)); ml = fmaxf(ml, __shfl_xor(ml, 32, 64));
      const float mn = fmaxf(m[h], ml); const float alpha = __builtin_amdgcn_exp2f(m[h] - mn); m[h] = mn;
      const float mref = fmaxf(mn, -1e29f);
      float ps = 0.f;
#pragma unroll
      for (int i = 0; i < 8; ++i) { p[i] = __builtin_amdgcn_exp2f(sc[i] - mref); ps += p[i]; }
      l[h] = l[h] * alpha + ps;
      if (MODE != 0) {
        if (__builtin_amdgcn_ballot_w64(alpha != 1.f) != 0ull) {
#pragma unroll
          for (int dt = 0; dt < 4; ++dt) oacc[h][dt] *= alpha;
        }
      }
    } else {
      const float mref1 = fmaxf(m[h], -1e29f);
#pragma unroll
      for (int i = 0; i < 8; ++i) p[i] = __builtin_amdgcn_exp2f(sc[i] - mref1) * l[h];
      asum[0] += (p[0] + p[1]) + (p[2] + p[3]); bsum[0] += p[3];
      asum[1] += (p[4] + p[5]) + (p[6] + p[7]); bsum[1] += p[7];
    }
    if (MODE != 0) {
      u32x4 pk; pk[0] = pack2(p[0], p[1]); pk[1] = pack2(p[2], p[3]); pk[2] = pack2(p[4], p[5]); pk[3] = pack2(p[6], p[7]);
      const bf16x8 pf = __builtin_bit_cast(bf16x8, pk);
#pragma unroll
      for (int dt = 0; dt < 4; ++dt) oacc[h][dt] = __builtin_amdgcn_mfma_f32_16x16x32_bf16(vf[dt], pf, oacc[h][dt], 0, 0, 0);
    }
    __builtin_amdgcn_sched_barrier(0);
  }
}

__device__ void nsa_tile(const Params& P, int wt, char* wl) {
  char* C = P.ws + OFF_C;
  const bf16_t* Q = (const bf16_t*)(C + C_Q);
  const bf16_t* KCMP = (const bf16_t*)(P.ws + OFF_KCMP); const bf16_t* VCT = (const bf16_t*)(P.ws + OFF_VCT);
  const bf16_t* KS = (const bf16_t*)(C + C_KS); const bf16_t* VST = (const bf16_t*)(C + C_VST);
  const bf16_t* KW = (const bf16_t*)(C + C_KW); const bf16_t* VWT = (const bf16_t*)(C + C_VWT);
  const float* GATES = (const float*)(C + C_GATES);
  bf16_t* O = (bf16_t*)(P.ws + OFF_D);
  const int lane = tidx() & 63, qi = lane & 15, quad = lane >> 4;
  wt = __builtin_amdgcn_readfirstlane(wt);
  const int jb = wt >> 2, wv4 = wt & 3;
  const int bg = jb & 3, b = bg >> 1, g = bg & 1;
  const int gq = jb >> 2;
  const int tq = (gq < 64 ? 127 - gq : gq - 64) * 4 + wv4;
  const int t0 = tq * 16;
  const int t = t0 + qi;
  const long row = (long)b * T_ + t;
  bf16x8 qf[4][2];
#pragma unroll
  for (int h = 0; h < 4; ++h)
#pragma unroll
    for (int ks = 0; ks < 2; ++ks) qf[h][ks] = *(const bf16x8*)(Q + row * 512 + (g * 4 + h) * 64 + ks * 32 + quad * 8);
  float sl2[4];
#pragma unroll
  for (int h = 0; h < 4; ++h) sl2[h] = __builtin_amdgcn_exp2f(-(float)(g * 4 + h + 1)) * LOG2E;
  f32x4 oacc[4][4]; float m[4], l[4], inv[4]; float asum[2], bsum[2];
  float* imp = (float*)wl; float* outl = (float*)wl;
  unsigned* sel = (unsigned*)(wl + 16384); unsigned* uni = sel + 64;
#pragma unroll
  for (int h = 0; h < 4; ++h) { m[h] = NEGF; l[h] = 0.f; inv[h] = 0.f; }
  asum[0] = asum[1] = bsum[0] = bsum[1] = 0.f;

  const int nI = t0 >> 4; const int nblk = (nI + 31) >> 5;
  for (int blk = nblk - 1; blk >= 0; --blk) {
    const int key0 = blk * 32;
    const bf16_t* kp = KCMP + (long)(b * 512 + key0 + qi) * 128 + g * 64 + quad * 8;
    nsa_block<0>(qf, oacc, m, l, sl2, inv, kp, nullptr, 0, t - 31 - 16 * (key0 + quad * 4), true, asum, bsum);
  }
#pragma unroll
  for (int h = 0; h < 4; ++h) { float lt = l[h]; lt += __shfl_xor(lt, 16, 64); lt += __shfl_xor(lt, 32, 64); l[h] = 1.f / fmaxf(lt, 1e-30f); }
  for (int i = lane; i < 16 * 132; i += 64) imp[i] = 0.f;
#pragma unroll
  for (int h = 0; h < 4; ++h)
#pragma unroll
    for (int dt = 0; dt < 4; ++dt) oacc[h][dt] = (f32x4){0.f, 0.f, 0.f, 0.f};
  for (int blk = 0; blk < nblk; ++blk) {
    const int key0 = blk * 32;
    const bf16_t* kp = KCMP + (long)(b * 512 + key0 + qi) * 128 + g * 64 + quad * 8;
    const bf16_t* vp = VCT + (long)(b * 128 + g * 64 + qi) * 512 + key0 + quad * 4;
    asum[0] = asum[1] = bsum[0] = bsum[1] = 0.f;
    nsa_block<1>(qf, oacc, m, l, sl2, inv, kp, vp, 16 * 512, t - 31 - 16 * (key0 + quad * 4), true, asum, bsum);
    const int J = (key0 >> 2) + quad;
    atomicAdd(&imp[qi * 132 + J], asum[0]); atomicAdd(&imp[qi * 132 + J + 1], bsum[0]);
    atomicAdd(&imp[qi * 132 + J + 4], asum[1]); atomicAdd(&imp[qi * 132 + J + 5], bsum[1]);
  }
  const int cur = t0 >> 6;
  if (lane < 16) {
    unsigned w0 = 0, w1 = 0, w2 = 0, w3 = 0;
    if (cur < 16) { w0 = (1u << (cur + 1)) - 1u; }
    else {
      w0 = 1u;
      { int j = cur; unsigned bit = 1u << (j & 31); int w = j >> 5; if (w == 0) w0 |= bit; else if (w == 1) w1 |= bit; else if (w == 2) w2 |= bit; else w3 |= bit; }
      { int j = cur - 1; unsigned bit = 1u << (j & 31); int w = j >> 5; if (w == 0) w0 |= bit; else if (w == 1) w1 |= bit; else if (w == 2) w2 |= bit; else w3 |= bit; }
    }
    sel[lane * 4 + 0] = w0; sel[lane * 4 + 1] = w1; sel[lane * 4 + 2] = w2; sel[lane * 4 + 3] = w3;
  }
  if (lane < 4) uni[lane] = 0u;
  if (cur >= 16) {
    for (int rnd = 0; rnd < 4; ++rnd) {
      const int qq = rnd * 4 + quad;
      unsigned key[8];
#pragma unroll
      for (int c = 0; c < 8; ++c) {
        const int j = qi + 16 * c;
        const bool v = (j <= cur) && (j != 0) && (j != cur) && (j != cur - 1);
        const unsigned bits = __float_as_uint(imp[qq * 132 + j]);
        key[c] = v ? ((bits & 0xFFFFFF00u) | (unsigned)(128 - j)) : 0u;
      }
      for (int it = 0; it < 13; ++it) {
        unsigned mx = key[0];
#pragma unroll
        for (int c = 1; c < 8; ++c) mx = key[c] > mx ? key[c] : mx;
#pragma unroll
        for (int o = 1; o < 16; o <<= 1) { unsigned ot = (unsigned)__shfl_xor((int)mx, o, 64); mx = ot > mx ? ot : mx; }
        if (mx != 0u) {
#pragma unroll
          for (int c = 0; c < 8; ++c) {
            if (key[c] == mx) { key[c] = 0u; const int j = qi + 16 * c; atomicOr(&sel[qq * 4 + (j >> 5)], 1u << (j & 31)); }
          }
        }
      }
    }
  }
  unsigned mym[4];
#pragma unroll
  for (int w = 0; w < 4; ++w) mym[w] = sel[qi * 4 + w];
  if (lane < 16) {
#pragma unroll
    for (int w = 0; w < 4; ++w) atomicOr(&uni[w], mym[w]);
  }
  const float* gp = GATES + row * 24 + g * 12;
#pragma unroll
  for (int h = 0; h < 4; ++h) {
    const float gt = gp[h * 3 + 0] * NSA_G0;
#pragma unroll
    for (int dt = 0; dt < 4; ++dt) *(f32x4*)(outl + ((h * 16 + qi) * 64 + (((dt * 4 + quad) ^ qi) << 2))) = oacc[h][dt] * gt;
  }
#pragma unroll
  for (int h = 0; h < 4; ++h) { m[h] = NEGF; l[h] = 0.f;
#pragma unroll
    for (int dt = 0; dt < 4; ++dt) oacc[h][dt] = (f32x4){0.f, 0.f, 0.f, 0.f}; }
#pragma unroll 1
  for (int w = 3; w >= 0; --w) {
    unsigned bits = __builtin_amdgcn_readfirstlane(uni[w]);
    const unsigned myw = sel[qi * 4 + w];
    while (bits) {
      const int jj = 31 - __builtin_clz(bits); bits &= ~(1u << jj);
      const int j = w * 32 + jj; const bool rowok = (myw >> jj) & 1u;
#pragma unroll 1
      for (int half = 1; half >= 0; --half) {
        const int key0 = j * 64 + half * 32;
        const bf16_t* kp = KS + (long)(b * T_ + key0 + qi) * 128 + g * 64 + quad * 8;
        const bf16_t* vp = VST + (long)(b * 128 + g * 64 + qi) * T_ + key0 + quad * 4;
        nsa_block<2>(qf, oacc, m, l, sl2, inv, kp, vp, 16L * T_, t - (key0 + quad * 4), rowok, asum, bsum);
      }
    }
  }
#pragma unroll
  for (int h = 0; h < 4; ++h) {
    float lt = l[h]; lt += __shfl_xor(lt, 16, 64); lt += __shfl_xor(lt, 32, 64);
    const float sc = NSA_G1 * gp[h * 3 + 1] / fmaxf(lt, 1e-30f);
#pragma unroll
    for (int dt = 0; dt < 4; ++dt) { f32x4* d = (f32x4*)(outl + ((h * 16 + qi) * 64 + (((dt * 4 + quad) ^ qi) << 2))); *d = *d + oacc[h][dt] * sc; }
  }
#pragma unroll
  for (int h = 0; h < 4; ++h) { m[h] = NEGF; l[h] = 0.f;
#pragma unroll
    for (int dt = 0; dt < 4; ++dt) oacc[h][dt] = (f32x4){0.f, 0.f, 0.f, 0.f}; }
  {
    const int kstart = t0 >= 512 ? ((t0 - 511) & ~31) : 0;
    for (int key0 = (t0 + 15) & ~31; key0 >= kstart; key0 -= 32) {
      const bf16_t* kp = KW + (long)(b * T_ + key0 + qi) * 128 + g * 64 + quad * 8;
      const bf16_t* vp = VWT + (long)(b * 128 + g * 64 + qi) * T_ + key0 + quad * 4;
      nsa_block<3>(qf, oacc, m, l, sl2, inv, kp, vp, 16L * T_, t - (key0 + quad * 4), true, asum, bsum);
    }
  }
#pragma unroll
  for (int h = 0; h < 4; ++h) {
    float lt = l[h]; lt += __shfl_xor(lt, 16, 64); lt += __shfl_xor(lt, 32, 64);
    const float sc = NSA_G2 * gp[h * 3 + 2] / fmaxf(lt, 1e-30f);
#pragma unroll
    for (int dt = 0; dt < 4; ++dt) { f32x4* d = (f32x4*)(outl + ((h * 16 + qi) * 64 + (((dt * 4 + quad) ^ qi) << 2))); *d = *d + oacc[h][dt] * sc; }
  }
#pragma unroll
  for (int it = 0; it < 8; ++it) {
    const int id = it * 64 + lane; const int h = id >> 7, rem = id & 127, q2 = rem >> 3, c8 = rem & 7;
    f32x4 a = *(const f32x4*)(outl + ((h * 16 + q2) * 64 + (((2 * c8) ^ q2) << 2)));
    f32x4 bb = *(const f32x4*)(outl + ((h * 16 + q2) * 64 + (((2 * c8 + 1) ^ q2) << 2)));
    float v[8] = {a[0], a[1], a[2], a[3], bb[0], bb[1], bb[2], bb[3]};
    *(u32x4*)(O + ((long)b * T_ + t0 + q2) * 512 + (g * 4 + h) * 64 + c8 * 8) = pack8(v);
  }
}

__device__ void xattn_tile(const Params& P, int wt) {
  const bf16_t* HQ = (const bf16_t*)(P.ws + OFF_D);
  const bf16_t* MK = (const bf16_t*)(P.ws + OFF_MK); const bf16_t* MVT = (const bf16_t*)(P.ws + OFF_MVT);
  bf16_t* OX = (bf16_t*)(P.ws + OFF_D) + (long)M_ * 512;
  const int lane = tidx() & 63, qi = lane & 15, quad = lane >> 4;
  wt = __builtin_amdgcn_readfirstlane(wt);
  const int h = wt & 3; const int row0 = (wt >> 2) * 32; const int b = row0 >> 13;
  bf16x8 qf[2][4];
#pragma unroll
  for (int nt = 0; nt < 2; ++nt)
#pragma unroll
    for (int ks = 0; ks < 4; ++ks) qf[nt][ks] = *(const bf16x8*)(HQ + (long)(row0 + nt * 16 + qi) * 512 + h * 128 + ks * 32 + quad * 8);
  f32x4 oacc[2][8]; float m[2], l[2];
#pragma unroll
  for (int nt = 0; nt < 2; ++nt) { m[nt] = NEGF; l[nt] = 0.f;
#pragma unroll
    for (int dt = 0; dt < 8; ++dt) oacc[nt][dt] = (f32x4){0.f, 0.f, 0.f, 0.f}; }
  for (int blk = 0; blk < 8; ++blk) {
    const int key0 = blk * 32;
    f32x4 s[2][2];
#pragma unroll
    for (int nt = 0; nt < 2; ++nt)
#pragma unroll
      for (int kt = 0; kt < 2; ++kt) s[nt][kt] = (f32x4){0.f, 0.f, 0.f, 0.f};
#pragma unroll
    for (int ks = 0; ks < 4; ++ks) {
#pragma unroll
      for (int kt = 0; kt < 2; ++kt) {
        bf16x8 kf = *(const bf16x8*)(MK + (long)(b * 256 + key0 + kt * 16 + qi) * 512 + h * 128 + ks * 32 + quad * 8);
#pragma unroll
        for (int nt = 0; nt < 2; ++nt) s[nt][kt] = __builtin_amdgcn_mfma_f32_16x16x32_bf16(kf, qf[nt][ks], s[nt][kt], 0, 0, 0);
      }
    }
    bf16x8 pf[2];
#pragma unroll
    for (int nt = 0; nt < 2; ++nt) {
      float ml = NEGF;
#pragma unroll
      for (int kt = 0; kt < 2; ++kt)
#pragma unroll
        for (int r = 0; r < 4; ++r) ml = fmaxf(ml, s[nt][kt][r]);
      ml = fmaxf(ml, __shfl_xor(ml, 16, 64)); ml = fmaxf(ml, __shfl_xor(ml, 32, 64));
      const float mn = fmaxf(m[nt], ml); const float alpha = __builtin_amdgcn_exp2f(m[nt] - mn); m[nt] = mn;
      float p[8]; float ps = 0.f;
#pragma unroll
      for (int kt = 0; kt < 2; ++kt)
#pragma unroll
        for (int r = 0; r < 4; ++r) { p[kt * 4 + r] = __builtin_amdgcn_exp2f(s[nt][kt][r] - mn); ps += p[kt * 4 + r]; }
      l[nt] = l[nt] * alpha + ps;
#pragma unroll
      for (int dt = 0; dt < 8; ++dt) oacc[nt][dt] *= alpha;
      u32x4 pk; pk[0] = pack2(p[0], p[1]); pk[1] = pack2(p[2], p[3]); pk[2] = pack2(p[4], p[5]); pk[3] = pack2(p[6], p[7]);
      pf[nt] = __builtin_bit_cast(bf16x8, pk);
    }
#pragma unroll
    for (int dt = 0; dt < 8; ++dt) {
      const bf16_t* vp = MVT + (long)(b * 512 + h * 128 + dt * 16 + qi) * 256 + key0 + quad * 4;
      u32x2 lo = *(const u32x2*)(vp); u32x2 hi = *(const u32x2*)(vp + 16);
      u32x4 c; c[0] = lo[0]; c[1] = lo[1]; c[2] = hi[0]; c[3] = hi[1];
      const bf16x8 vf = __builtin_bit_cast(bf16x8, c);
#pragma unroll
      for (int nt = 0; nt < 2; ++nt) oacc[nt][dt] = __builtin_amdgcn_mfma_f32_16x16x32_bf16(vf, pf[nt], oacc[nt][dt], 0, 0, 0);
    }
  }
#pragma unroll
  for (int nt = 0; nt < 2; ++nt) {
    float lt = l[nt]; lt += __shfl_xor(lt, 16, 64); lt += __shfl_xor(lt, 32, 64);
    const float iv = 1.f / lt;
#pragma unroll
    for (int dt = 0; dt < 8; ++dt) {
      f32x4 v = oacc[nt][dt] * iv; u32x2 pk; pk[0] = pack2(v[0], v[1]); pk[1] = pack2(v[2], v[3]);
      *(u32x2*)(OX + (long)(row0 + nt * 16 + qi) * 512 + h * 128 + dt * 16 + quad * 4) = pk;
    }
  }
}


#define XB_TMO      128
#define XB_XCNT(j)  (256  + 64 * (j))
#define XB_XSUB(j)  (1280 + 64 * (j))
#define XB_XGEN(j)  (2304 + 64 * (j))
#define XB_TOP      3328
#define XB_TOPGEN   3392
#define XCD_BAR_WORDS 3456
#define XB_SPIN_CAP (1u << 18)
#define LAS __attribute__((address_space(3)))
__device__ __forceinline__ unsigned xb_ld(unsigned* p) { return __hip_atomic_load(p, __ATOMIC_RELAXED, __HIP_MEMORY_SCOPE_AGENT); }
__device__ __forceinline__ unsigned xb_add(unsigned* p, unsigned v) { return __hip_atomic_fetch_add(p, v, __ATOMIC_RELAXED, __HIP_MEMORY_SCOPE_AGENT); }
__device__ __forceinline__ unsigned xb_xcc_id() { return (unsigned)__builtin_amdgcn_s_getreg((3 << 11) | 20) & 0xFu; }
#define XB_SPIN(cond, bar) do { unsigned _sp = 0; while (cond) { __builtin_amdgcn_s_sleep(1); \
    if ((++_sp & 255u) == 0u) { if (xb_ld(&(bar)[XB_TMO])) break; if (_sp > XB_SPIN_CAP) { atomicAdd(&(bar)[XB_TMO], 1u); break; } } } } while (0)
__device__ __forceinline__ void xcd_barrier_complete(unsigned* bar, unsigned x, unsigned& nloc, unsigned& nx) {
  const unsigned G = gridDim.x * gridDim.y * gridDim.z;
  unsigned sum, cnt, mine, sp = 0u;
  for (;;) {
    sum = 0u; cnt = 0u; mine = 0u;
#pragma unroll
    for (unsigned j = 0; j < 16; ++j) { const unsigned c = xb_ld(&bar[XB_XCNT(j)]); sum += c; cnt += (c > 0u) ? 1u : 0u; mine = (j == x) ? c : mine; }
    if (sum == G) break;
    __builtin_amdgcn_s_sleep(1);
    if ((++sp & 255u) == 0u) { if (xb_ld(&bar[XB_TMO])) break; if (sp > XB_SPIN_CAP) { atomicAdd(&bar[XB_TMO], 1u); break; } }
  }
  nloc = mine > 0u ? mine : 1u; nx = cnt > 0u ? cnt : 1u;
}
__device__ __forceinline__ void xcd_barrier(unsigned* bar, unsigned x, unsigned& st_nloc, unsigned& st_nx) {
  asm volatile("s_waitcnt vmcnt(0)" ::: "memory");
  __syncthreads();
  if (threadIdx.x == 0) {
    __builtin_amdgcn_s_waitcnt(0);
    unsigned nloc = st_nloc, nx = st_nx;
    if (nloc == 0u) { xcd_barrier_complete(bar, x, nloc, nx); st_nloc = nloc; st_nx = nx; }
    const unsigned old = xb_add(&bar[XB_XSUB(x)], 1u);
    const unsigned gen = old / nloc;
    if (old + 1u == (gen + 1u) * nloc) {
      __builtin_amdgcn_fence(__ATOMIC_RELEASE, "agent");
      asm volatile("s_waitcnt vmcnt(0)" ::: "memory");
      const unsigned og = xb_add(&bar[XB_TOP], 1u);
      const unsigned tg = og / nx;
      if (og + 1u == (tg + 1u) * nx) xb_add(&bar[XB_TOPGEN], 1u);
      else XB_SPIN(xb_ld(&bar[XB_TOPGEN]) == tg, bar);
      __builtin_amdgcn_fence(__ATOMIC_ACQUIRE, "agent");
      xb_add(&bar[XB_XGEN(x)], 1u);
      asm volatile("s_waitcnt vmcnt(0)" ::: "memory");
    } else {
      XB_SPIN(xb_ld(&bar[XB_XGEN(x)]) == gen, bar);
      __builtin_amdgcn_fence(__ATOMIC_ACQUIRE, "agent");
      asm volatile("s_waitcnt vmcnt(0)" ::: "memory");
    }
  }
  __syncthreads();
}

__device__ void run_phase(const Params& P, int ph, char* smem, bool ph_fused) {
  char* ws = P.ws; const int tid = tidx();
  switch (ph) {
    case 0: phase0(P, smem); break;
    case 1: phase1(P, smem); break;
    case 2: phase2(P, smem); break;
    case 3: {
      for (int job = blockIdx.x; job < 512; job += gridDim.x) { const int wv = tidx() >> 6; nsa_tile(P, job * 4 + wv, smem + wv * 16896); }
      __syncthreads();
      for (int job = blockIdx.x; job < 512; job += gridDim.x) {
        {
          const int tid = tidx();
          const int s = job; const int bc = s >> 2, g = s & 3;
          RowLin ar{(const bf16_t*)(ws + OFF_WM) + g * 16384, 128};
          RowLin br{(const bf16_t*)(ws + OFF_C + C_GVT) + ((long)bc * 512 + g * 128) * 128, 128};
          const float* bs = P.b_sp + g * 128;
          const bf16_t* U = (const bf16_t*)(ws + OFF_C + C_U) + (long)bc * 128 * 512 + g * 128;
          bf16_t* OS = (bf16_t*)(ws + OFF_D) + (long)M_ * 512 + (long)bc * 128 * 512 + g * 128;
          gemm_tile(smem, ar, br, 2, 64, 64, [&](const float* Cs) {
#pragma unroll 2
            for (int it = 0; it < 8; ++it) {
              int id = it * 256 + tid; int r = id >> 4, c = (id & 15) * 8; float v[8]; ld8(Cs, r, c, v);
              u32x4 d = *(const u32x4*)(U + (long)r * 512 + c); const float bb = bs[r];
#pragma unroll
              for (int i = 0; i < 4; ++i) { v[2 * i] = (v[2 * i] + bb) * bf2f(d[i] & 0xffffu); v[2 * i + 1] = (v[2 * i + 1] + bb) * bf2f(d[i] >> 16); }
              *(u32x4*)(OS + (long)r * 512 + c) = pack8(v);
            }
          });
        }
      }
    } break;
    case 4: {
      float* scr = (float*)(ws + OFF_C + C_SCR) + (long)blockIdx.x * 16384;
      const int xq = blockIdx.x & 7, lq = blockIdx.x >> 3, sq = gridDim.x >> 3;
      for (int t = lq; t < 16 * 8; t += sq) {
        const int mt = xq * 16 + (t & 15), nt = t >> 4, brow = mt * 128, bcol = nt * 128;
        const bf16_t* MG = (const bf16_t*)(ws + OFF_B) + (long)brow * 2048 + bcol;
        RowLin a1{(const bf16_t*)(ws + OFF_D) + (long)brow * 512, 512};
        RowLin b1{(const bf16_t*)(ws + OFF_WPA) + (long)bcol * 512, 512};
        gemm_tile(smem, a1, b1, 8, 64, 64, [&](const float* Cs) {
#pragma unroll 2
          for (int it = 0; it < 8; ++it) {
            int id = it * 256 + tid; int r = id >> 4, c = (id & 15) * 8; float v[8]; ld8(Cs, r, c, v);
            u32x4 d = *(const u32x4*)(MG + (long)r * 2048 + c);
#pragma unroll
            for (int i = 0; i < 4; ++i) { v[2 * i] *= bf2f(d[i] & 0xffffu); v[2 * i + 1] *= bf2f(d[i] >> 16); }
            *(f32x4*)(scr + id * 8) = (f32x4){v[0], v[1], v[2], v[3]}; *(f32x4*)(scr + id * 8 + 4) = (f32x4){v[4], v[5], v[6], v[7]};
          }
        });
        RowLin a2{(const bf16_t*)(ws + OFF_D) + (long)M_ * 512 + (long)brow * 512, 512};
        RowLin b2{(const bf16_t*)(ws + OFF_WPB) + (long)bcol * 512, 512};
        bf16_t* MX = (bf16_t*)(ws + OFF_C + C_MIXED) + (long)brow * 1024 + bcol;
        gemm_tile(smem, a2, b2, 8, 64, 64, [&](const float* Cs) {
#pragma unroll 2
          for (int it = 0; it < 8; ++it) {
            int id = it * 256 + tid; int r = id >> 4, c = (id & 15) * 8; float v[8]; ld8(Cs, r, c, v);
            u32x4 d = *(const u32x4*)(MG + (long)r * 2048 + 1024 + c);
            f32x4 p0 = *(const f32x4*)(scr + id * 8), p1 = *(const f32x4*)(scr + id * 8 + 4);
            float pv[8] = {p0[0], p0[1], p0[2], p0[3], p1[0], p1[1], p1[2], p1[3]};
#pragma unroll
            for (int i = 0; i < 4; ++i) { v[2 * i] = pv[2 * i] + v[2 * i] * bf2f(d[i] & 0xffffu); v[2 * i + 1] = pv[2 * i + 1] + v[2 * i + 1] * bf2f(d[i] >> 16); }
            *(u32x4*)(MX + (long)r * 1024 + c) = pack8(v);
          }
        });
      }
    } break;
    case 5: case 9: case 12: {
      const bf16_t* A; const bf16_t* W; const float* RES; float* DST; int K;
      if (ph == 5) { A = (const bf16_t*)(ws + OFF_C + C_MIXED); W = (const bf16_t*)(ws + OFF_WOUT); RES = P.x; DST = (float*)(ws + OFF_B); K = 1024; }
      else if (ph == 9) { A = (const bf16_t*)(ws + OFF_D) + (long)M_ * 512; W = (const bf16_t*)(ws + OFF_WMO); RES = (const float*)(ws + OFF_B); DST = (float*)(ws + OFF_C + C_H2); K = 512; }
      else { A = (const bf16_t*)(ws + OFF_B); W = (const bf16_t*)(ws + OFF_WDN); RES = (const float*)(ws + OFF_C + C_H2); DST = P.out; K = 2816; }
      const int xq = blockIdx.x & 7, lq = blockIdx.x >> 3, sq = gridDim.x >> 3;
      for (int t = lq; t < 16 * 4; t += sq) {
        const int mt = xq * 16 + (t & 15), nt2 = t >> 4, brow = mt * 128;
        RowLin ar{A + (long)brow * K, K}; RowLin br{W + (long)nt2 * 256 * K, K};
        gemm_tile2(smem, ar, br, K / 64, [&](const float* Cs, int p) {
          const int bcol = nt2 * 256 + p * 128;
          const float* rs = RES + (long)brow * 1024 + bcol; float* ds = DST + (long)brow * 1024 + bcol;
#pragma unroll 2
          for (int it = 0; it < 8; ++it) {
            int id = it * 256 + tid; int r = id >> 4, c = (id & 15) * 8;
            f32x4 a = *(const f32x4*)(Cs + r * CS_LD + c), bq = *(const f32x4*)(Cs + r * CS_LD + c + 4);
            f32x4 r0 = *(const f32x4*)(rs + (long)r * 1024 + c), r1 = *(const f32x4*)(rs + (long)r * 1024 + c + 4);
            const f32x4 h0 = a + r0, h1v = bq + r1;
            *(f32x4*)(ds + (long)r * 1024 + c) = h0; *(f32x4*)(ds + (long)r * 1024 + c + 4) = h1v;
            if (ph != 12) {
              const float* gn = (ph == 5 ? P.norm_mq : P.norm_ffn) + bcol + c;
              const f32x4 g0 = *(const f32x4*)gn, g1 = *(const f32x4*)(gn + 4);
              float v[8] = {h0[0] * g0[0], h0[1] * g0[1], h0[2] * g0[2], h0[3] * g0[3], h1v[0] * g1[0], h1v[1] * g1[1], h1v[2] * g1[2], h1v[3] * g1[3]};
              *(u32x4*)((bf16_t*)(ws + OFF_A) + (long)(brow + r) * 1024 + bcol + c) = pack8(v);
              float ss = (h0[0] * h0[0] + h0[1] * h0[1]) + (h0[2] * h0[2] + h0[3] * h0[3]) + (h1v[0] * h1v[0] + h1v[1] * h1v[1]) + (h1v[2] * h1v[2] + h1v[3] * h1v[3]);
              ss += __shfl_xor(ss, 1, 64); ss += __shfl_xor(ss, 2, 64); ss += __shfl_xor(ss, 4, 64); ss += __shfl_xor(ss, 8, 64);
              if ((tid & 15) == 0) ((float*)(ws + (ph == 5 ? OFF_SSQ1 : OFF_SSQ2)))[(long)(brow + r) * 8 + nt2 * 2 + p] = ss;
            }
          }
        });
      }
    } break;
    case 6: case 10: {
      const float* src = ph == 6 ? (const float*)(ws + OFF_B) : (const float*)(ws + OFF_C + C_H2);
      const float* g = ph == 6 ? P.norm_mq : P.norm_ffn;
      (void)src; (void)g;
    } break;
    case 7: {
      const int xq = blockIdx.x & 7, lq = blockIdx.x >> 3, sq = gridDim.x >> 3;
      for (int t = lq; t < 16 * 4; t += sq) {
        const int mt = xq * 16 + (t & 15), nt = t >> 4, brow = mt * 128;
        RowLin ar{(const bf16_t*)(ws + OFF_A) + (long)brow * 1024, 1024}; RowLin br{(const bf16_t*)(ws + OFF_WMQ) + (long)nt * 128 * 1024, 1024};
        gemm_tile(smem, ar, br, 16, 64, 64, [&](const float* Cs) {
          bf16_t* dq = (bf16_t*)(ws + OFF_D) + (long)brow * 512 + nt * 128; const float* sq1 = (const float*)(ws + OFF_SSQ1) + (long)brow * 8;
#pragma unroll 2
          for (int it = 0; it < 8; ++it) {
            int id = it * 256 + tid; int r = id >> 4, c = (id & 15) * 8; float v[8]; ld8(Cs, r, c, v);
            const f32x4 s0 = *(const f32x4*)(sq1 + r * 8), s1 = *(const f32x4*)(sq1 + r * 8 + 4);
            const float ssum = ((s0[0] + s0[1]) + (s0[2] + s0[3])) + ((s1[0] + s1[1]) + (s1[2] + s1[3]));
            const float rr = rsqrtf(ssum * (1.f / 1024.f) + 1e-6f) * (0.08838834764831845f * LOG2E);
#pragma unroll
            for (int i = 0; i < 8; ++i) v[i] *= rr;
            *(u32x4*)(dq + (long)r * 512 + c) = pack8(v);
          }
        });
        asm volatile("s_waitcnt vmcnt(0)" ::: "memory");
        __syncthreads();
        xattn_tile(P, ((brow >> 5) + (tid >> 6)) * 4 + nt);
      }
    } break;
    case 8: {
      if (ph_fused) break;
      for (int job = blockIdx.x; job < 512; job += gridDim.x) xattn_tile(P, job * 4 + (tid >> 6));
    } break;
    case 11: {
      const int xq = blockIdx.x & 7, lq = blockIdx.x >> 3, sq = gridDim.x >> 3;
      for (int t = lq; t < 16 * 22; t += sq) {
        const int mt = xq * 16 + (t & 15), nt2 = t >> 4, brow = mt * 128;
        RowLin ar{(const bf16_t*)(ws + OFF_A) + (long)brow * 1024, 1024}; RowLin br{(const bf16_t*)(ws + OFF_WGU) + (long)nt2 * 256 * 1024, 1024};
        gemm_tile2(smem, ar, br, 16, [&](const float* Cs, int p) {
          bf16_t* ACT = (bf16_t*)(ws + OFF_B) + (long)brow * 2816 + (nt2 * 2 + p) * 64;
#pragma unroll 2
          for (int it = 0; it < 4; ++it) {
            int id = it * 256 + tid; int r = id >> 3, c = (id & 7) * 8; float gt[8], up[8]; ld8(Cs, r, c, gt); ld8(Cs, r, c + 64, up);
            const float* sq2 = (const float*)(ws + OFF_SSQ2) + (long)(brow + r) * 8;
            const f32x4 s0 = *(const f32x4*)(sq2), s1 = *(const f32x4*)(sq2 + 4);
            const float ssum = ((s0[0] + s0[1]) + (s0[2] + s0[3])) + ((s1[0] + s1[1]) + (s1[2] + s1[3]));
            const float rr = rsqrtf(ssum * (1.f / 1024.f) + 1e-6f);
#pragma unroll
            for (int i = 0; i < 8; ++i) { const float gg = gt[i] * rr; gt[i] = gg * sigm(gg) * (up[i] * rr); }
            *(u32x4*)(ACT + (long)r * 2816 + c) = pack8(gt);
          }
        });
      }
    } break;
    case 13: {
      for (int job = blockIdx.x; job < 1024; job += gridDim.x) { int row = job * 16 + (tid >> 6) * 4; rownorm_rows<true, 4>(P.out + (long)row * 1024, P.norm_final, P.out + (long)row * 1024); }
    } break;
#ifdef PROBE_K
    case 14: {
      const bf16_t* s0 = (const bf16_t*)(ws + PROBE_SRC0); const bf16_t* s1 = (const bf16_t*)(ws + PROBE_SRC1);
      for (long i = (long)blockIdx.x * 256 + tid; i < (long)M_ * 512; i += (long)gridDim.x * 256) {
        long row = i >> 9; int c = (int)(i & 511);
        P.out[row * 1024 + c] = bf2f(s0[i]); P.out[row * 1024 + 512 + c] = bf2f(s1[i]);
      }
    } break;
    case 15: {
      const float* s0 = (const float*)(ws + PROBE_SRC0);
      for (long i = (long)blockIdx.x * 256 + tid; i < (long)M_ * 1024; i += (long)gridDim.x * 256) P.out[i] = s0[i];
    } break;
#endif
  }
}

__global__ void __launch_bounds__(256, 2) fwd_kernel(Params P, int ph_lo, int ph_hi) {
  __shared__ __attribute__((aligned(16))) char smem[81920];
  unsigned st_nloc = 0u, st_nx = 0u;
  const unsigned xcc = xb_xcc_id();
  if (ph_lo < ph_hi) {
    if (threadIdx.x == 0) (void)xb_add(&((unsigned*)(P.ws + OFF_BAR))[XB_XCNT(xcc)], 1u);
  }
  if (ph_hi < 0) cg::this_grid().sync();
  for (int ph = ph_lo; ph <= ph_hi; ++ph) {
    const uint64_t __attribute__((address_space(4)))* ka = (const uint64_t __attribute__((address_space(4)))*)__builtin_amdgcn_kernarg_segment_ptr();
    asm volatile("" : "+s"(ka));
    Params Pl; uint64_t* pd = (uint64_t*)&Pl;
#pragma unroll
    for (int i = 0; i < (int)(sizeof(Params) / 8); ++i) {
      const char __attribute__((address_space(1)))* gp = (const char __attribute__((address_space(1)))*)ka[i];
      pd[i] = (uint64_t)(const char*)gp;
    }
    if (ph == 6 || ph == 10 || ph == 8) continue;
    run_phase(Pl, ph, smem, true);
    if (ph < ph_hi) xcd_barrier((unsigned*)(Pl.ws + OFF_BAR), xcc, st_nloc, st_nx);
  }
}

extern "C" void kernel_launch(void* const* d_in, const int* in_sizes, int n_in, void* d_out, int out_size, void* d_ws, size_t ws_size,
                              hipStream_t stream) {
  static int grid_blocks = 0;
  if (!grid_blocks) {
    int dev = 0, cus = 0, per_cu = 0;
    hipGetDevice(&dev);
    hipDeviceGetAttribute(&cus, hipDeviceAttributeMultiprocessorCount, dev);
    hipOccupancyMaxActiveBlocksPerMultiprocessor(&per_cu, fwd_kernel, 256, 0);
    if (per_cu > 2) per_cu = 2;
    if (per_cu < 1) per_cu = 1;
    grid_blocks = cus * per_cu;
  }
  if (ws_size < (size_t)WS_NEED) fprintf(stderr, "workspace too small: %zu < %ld\n", ws_size, (long)WS_NEED);
  Params P{};
  const float** pp = (const float**)&P;
  for (int i = 0; i < 27; ++i) pp[i] = (const float*)d_in[i];
  P.out = (float*)d_out; P.ws = (char*)d_ws;
#if ONE_LAUNCH
  hipMemsetAsync((char*)d_ws + OFF_BAR, 0, XCD_BAR_WORDS * 4, stream);
#ifdef PROBE_K
  int lo = 0, hi = PROBE_DUMP;
#else
  int lo = 0, hi = 13;
#endif
  void* args[] = {&P, &lo, &hi};
  hipError_t e = hipLaunchCooperativeKernel((void*)fwd_kernel, dim3(grid_blocks), dim3(256), args, 0, stream);
  if (e != hipSuccess) fprintf(stderr, "cooperative launch failed: %s (grid %d)\n", hipGetErrorString(e), grid_blocks);
#else
  for (int ph = 0; ph <= 13; ++ph) fwd_kernel<<<grid_blocks, 256, 0, stream>>>(P, ph, ph);
#endif
}
```

```cpp
#include <hip/hip_runtime.h>
#include <hip/hip_cooperative_groups.h>
#include <stdint.h>
#include <stdio.h>
namespace cg = cooperative_groups;

#ifndef NSA_G0
#define NSA_G0 1.f
#define NSA_G1 1.f
#define NSA_G2 1.f
#endif
#ifndef ONE_LAUNCH
#define ONE_LAUNCH 1
#endif

typedef unsigned short bf16_t;
using bf16x8 = __attribute__((ext_vector_type(8))) short;
using f32x4 = __attribute__((ext_vector_type(4))) float;
using u32x4 = __attribute__((ext_vector_type(4))) unsigned;
using u32x2 = __attribute__((ext_vector_type(2))) unsigned;

#define T_ 8192
#define M_ 16384
#define NEGF (-1e30f)
#define LOG2E 1.4426950408889634f

constexpr long OFF_W1 = 0;
constexpr long OFF_WMKV = OFF_W1 + 4608L * 1024 * 2;
constexpr long OFF_WPA = OFF_WMKV + 2097152;
constexpr long OFF_WPB = OFF_WPA + 1048576;
constexpr long OFF_WOUT = OFF_WPB + 1048576;
constexpr long OFF_WMQ = OFF_WOUT + 2097152;
constexpr long OFF_WMO = OFF_WMQ + 1048576;
constexpr long OFF_WGU = OFF_WMO + 1048576;
constexpr long OFF_WDN = OFF_WGU + 11534336;
constexpr long OFF_WCK1 = OFF_WDN + 5767168;
constexpr long OFF_WCV1 = OFF_WCK1 + 524288;
constexpr long OFF_WM = OFF_WCV1 + 524288;
constexpr long OFF_BIAS1 = OFF_WM + 131072;
constexpr long OFF_MEMN = OFF_BIAS1 + 1024;
constexpr long OFF_MK = OFF_MEMN + 1048576;
constexpr long OFF_MVT = OFF_MK + 524288;
constexpr long OFF_KCMP = OFF_MVT + 524288;
constexpr long OFF_VCT = OFF_KCMP + 262144;
constexpr long OFF_A = OFF_VCT + 262144;
constexpr long OFF_B = OFF_A + 33554432;
constexpr long OFF_D = OFF_B + 67108864;
constexpr long OFF_C = OFF_D + 33554432;
constexpr long C_Q = 0, C_U = 16777216, C_GVT = 33554432, C_KC = 50331648, C_VC = 54525952, C_KS = 58720256,
               C_KW = 62914560, C_VST = 67108864, C_VWT = 71303168, C_GATES = 75497472;
constexpr long C_MIXED = 0, C_SCR = 33554432, C_H2 = 0;
constexpr long OFF_BAR = OFF_C + 77070336;
constexpr long OFF_SSQ1 = OFF_BAR + 16384;
constexpr long OFF_SSQ2 = OFF_SSQ1 + 524288;
constexpr long WS_NEED = OFF_SSQ2 + 524288;

struct Params {
  const float *x, *mem, *norm_mix, *w_in, *w_ck1, *w_ck2, *w_cv1, *w_cv2, *pe_k, *pe_v, *ln_sgu, *w_sp, *b_sp,
      *w_pa, *w_pb, *w_merge, *b_merge, *w_out, *norm_mq, *norm_mkv, *w_mq, *w_mkv, *w_mo, *norm_ffn, *w_gu, *w_dn, *norm_final;
  float* out;
  char* ws;
};

__device__ __forceinline__ int tidx() { int t = threadIdx.x; asm volatile("" : "+v"(t)); return t; }
__device__ __forceinline__ unsigned f2bf(float f) { unsigned u = __float_as_uint(f); u += 0x7fffu + ((u >> 16) & 1u); return u >> 16; }
__device__ __forceinline__ unsigned pack2(float a, float b) { unsigned r; asm("v_cvt_pk_bf16_f32 %0, %1, %2" : "=v"(r) : "v"(a), "v"(b)); return r; }
__device__ __forceinline__ float bf2f(unsigned h) { return __uint_as_float(h << 16); }
__device__ __forceinline__ float gelu_tanh(float x) { float u = 0.7978845608028654f * (x + 0.044715f * x * x * x); return x / (1.f + __expf(-2.f * u)); }
__device__ __forceinline__ float sigm(float x) { return 1.f / (1.f + __expf(-x)); }
__device__ __forceinline__ float wave_sum(float v) {
#pragma unroll
  for (int o = 32; o > 0; o >>= 1) v += __shfl_xor(v, o, 64);
  return v;
}
__device__ __forceinline__ u32x4 pack8(const float (&v)[8]) {
  u32x4 r; r[0] = pack2(v[0], v[1]); r[1] = pack2(v[2], v[3]); r[2] = pack2(v[4], v[5]); r[3] = pack2(v[6], v[7]); return r;
}

__device__ __forceinline__ int lds_byte(int r, int c) {
  int st = (r >> 4) * 2 + (c >> 5), rr = r & 15, cc = c & 31, ob = rr * 64 + cc * 2;
  return st * 1024 + (ob ^ (((ob >> 9) & 1) << 5));
}
__device__ __forceinline__ void stage_rc(int b, int& R, int& C) {
  int st = b >> 10, sb = b & 1023, swz = sb ^ (((sb >> 9) & 1) << 5);
  R = (st >> 1) * 16 + (swz >> 6); C = (st & 1) * 32 + ((swz & 63) >> 1);
}

#define CS_LD 132
__device__ __forceinline__ void ld8(const float* Cs, int r, int c, float (&v)[8]) {
  f32x4 a = *(const f32x4*)(Cs + r * CS_LD + c); f32x4 b = *(const f32x4*)(Cs + r * CS_LD + c + 4);
  v[0] = a[0]; v[1] = a[1]; v[2] = a[2]; v[3] = a[3]; v[4] = b[0]; v[5] = b[1]; v[6] = b[2]; v[7] = b[3];
}
__device__ __forceinline__ void ld8T(const float* Cs, int r8, int c, float (&v)[8]) {
#pragma unroll
  for (int i = 0; i < 8; ++i) v[i] = Cs[(r8 + i) * CS_LD + c];
}

struct RowLin {
  const bf16_t* base; long ld;
  __device__ __forceinline__ const bf16_t* operator()(int r) const { return base + (long)r * ld; }
};
struct RowCmp {
  const bf16_t* base; int brow;
  __device__ __forceinline__ const bf16_t* operator()(int r) const {
    int R = brow + r; int b = R >> 10, rem = R & 1023, i = rem >> 1, g = rem & 1; if (i > 510) i = 510;
    return base + ((long)(b * T_ + 16 * i) * 128 + g * 64);
  }
};

template <int AUX = 0, class ARow, class BRow, class Epi>
__device__ __forceinline__ void gemm_tile(char* smem, ARow arow, BRow brow, int nkt, int kstepA, int kstepB, Epi epi) {
  const int tid = tidx(), lane = tid & 63, wave = tid >> 6, wr = wave >> 1, wc = wave & 1, fr = lane & 15, fq = lane >> 4;
  const bf16_t* pa[4]; const bf16_t* pb[4];
#pragma unroll
  for (int i = 0; i < 4; ++i) { int b = tid * 16 + i * 4096; int R, C; stage_rc(b, R, C); pa[i] = arow(R) + C; pb[i] = brow(R) + C; }
  f32x4 acc[4][4];
#pragma unroll
  for (int m = 0; m < 4; ++m)
#pragma unroll
    for (int n = 0; n < 4; ++n) acc[m][n] = (f32x4){0.f, 0.f, 0.f, 0.f};
  {
#pragma unroll
    for (int i = 0; i < 4; ++i) {
      __builtin_amdgcn_global_load_lds((const unsigned*)(pa[i]), (unsigned*)(smem + tid * 16 + i * 4096), 16, 0, AUX);
      __builtin_amdgcn_global_load_lds((const unsigned*)(pb[i]), (unsigned*)(smem + 16384 + tid * 16 + i * 4096), 16, 0, AUX);
    }
  }
  for (int kt = 0; kt < nkt; ++kt) {
    asm volatile("s_waitcnt vmcnt(0)" ::: "memory");
    __syncthreads();
    if (kt + 1 < nkt) {
      char* la = smem + ((kt + 1) & 1) * 32768;
#pragma unroll
      for (int i = 0; i < 4; ++i) {
        __builtin_amdgcn_global_load_lds((const unsigned*)(pa[i] + (long)(kt + 1) * kstepA), (unsigned*)(la + tid * 16 + i * 4096), 16, 0, AUX);
        __builtin_amdgcn_global_load_lds((const unsigned*)(pb[i] + (long)(kt + 1) * kstepB), (unsigned*)(la + 16384 + tid * 16 + i * 4096), 16, 0, AUX);
      }
    }
    const char* la = smem + (kt & 1) * 32768; const char* lb = la + 16384;
#pragma unroll
    for (int ks = 0; ks < 2; ++ks) {
      bf16x8 a[4], b[4];
#pragma unroll
      for (int m = 0; m < 4; ++m) a[m] = *(const bf16x8*)(la + lds_byte(wr * 64 + m * 16 + fr, ks * 32 + fq * 8));
#pragma unroll
      for (int n = 0; n < 4; ++n) b[n] = *(const bf16x8*)(lb + lds_byte(wc * 64 + n * 16 + fr, ks * 32 + fq * 8));
#pragma unroll
      for (int m = 0; m < 4; ++m)
#pragma unroll
        for (int n = 0; n < 4; ++n) acc[m][n] = __builtin_amdgcn_mfma_f32_16x16x32_bf16(a[m], b[n], acc[m][n], 0, 0, 0);
    }
  }
  __syncthreads();
  float* Cs = (float*)smem;
#pragma unroll
  for (int m = 0; m < 4; ++m)
#pragma unroll
    for (int n = 0; n < 4; ++n)
#pragma unroll
      for (int r = 0; r < 4; ++r) Cs[(wr * 64 + m * 16 + fq * 4 + r) * CS_LD + wc * 64 + n * 16 + fr] = acc[m][n][r];
  __syncthreads();
  epi(Cs);
  __syncthreads();
}

template <class F>
__device__ __forceinline__ void store_rows_bf16(const float* Cs, bf16_t* dst, long ld, F f) {
#pragma unroll 2
  for (int it = 0; it < 8; ++it) {
    int id = it * 256 + tidx(); int r = id >> 4, c = (id & 15) * 8;
    float v[8]; ld8(Cs, r, c, v);
#pragma unroll
    for (int i = 0; i < 8; ++i) v[i] = f(v[i], c + i);
    *(u32x4*)(dst + (long)r * ld + c) = pack8(v);
  }
}
template <class F>
__device__ __forceinline__ void store_T_bf16(const float* Cs, bf16_t* dst, long cstride, F f) {
#pragma unroll 2
  for (int it = 0; it < 8; ++it) {
    int id = it * 256 + tidx(); int c = id >> 4, r8 = (id & 15) * 8;
    float v[8]; ld8T(Cs, r8, c, v);
#pragma unroll
    for (int i = 0; i < 8; ++i) v[i] = f(v[i]);
    *(u32x4*)(dst + (long)c * cstride + r8) = pack8(v);
  }
}


__device__ __forceinline__ int lds_byte32(int r, int c) { int rr = r & 15; return (r >> 4) * 1024 + rr * 64 + ((((c >> 3) ^ ((-(rr >> 2)) & 3)) & 3) << 4); }
__device__ __forceinline__ void stage_rc32(int b, int& R, int& C) { int st = b >> 10, sb = b & 1023, rr = sb >> 6, cp = (sb >> 4) & 3; R = st * 16 + rr; C = ((cp ^ ((-(rr >> 2)) & 3)) & 3) * 8; }
struct RowClamp {
  const bf16_t* base; long ld; int maxr;
  __device__ __forceinline__ const bf16_t* operator()(int r) const { return base + (long)(r < maxr ? r : maxr) * ld; }
};
__device__ __forceinline__ int lds_byte64(int r, int c) { int rr = r & 15; return (r >> 4) * 2048 + rr * 128 + ((((c >> 3) ^ (rr >> 1)) & 7) << 4); }
__device__ __forceinline__ void stage_rc64(int b, int& R, int& C) { int st = b >> 11, sb = b & 2047, rr = sb >> 7, cp = (sb >> 4) & 7; R = st * 16 + rr; C = ((cp ^ (rr >> 1)) & 7) * 8; }
template <class ARow, class BRow, class Epi>
__device__ __forceinline__ void gemm_tile2(char* smem, ARow arow, BRow brow, int nkt, Epi epi) {
  const int tid = tidx(), lane = tid & 63, wave = tid >> 6, wr = wave >> 1, wc = wave & 1, fr = lane & 15, fq = lane >> 4;
  int R0, C0; stage_rc64(tid * 16, R0, C0);
  const bf16_t* pa0 = arow(R0) + C0; const bf16_t* pb0 = brow(R0) + C0;
  const long sa32 = 32 * arow.ld, sb32 = 32 * brow.ld;
  f32x4 acc[4][8];
#pragma unroll
  for (int m = 0; m < 4; ++m)
#pragma unroll
    for (int n = 0; n < 8; ++n) acc[m][n] = (f32x4){0.f, 0.f, 0.f, 0.f};
  __syncthreads();
#pragma unroll
  for (int i = 0; i < 4; ++i) __builtin_amdgcn_global_load_lds((const unsigned*)(pa0 + i * sa32), (unsigned*)(smem + tid * 16 + i * 4096), 16, 0, 0);
#pragma unroll
  for (int i = 0; i < 8; ++i) __builtin_amdgcn_global_load_lds((const unsigned*)(pb0 + i * sb32), (unsigned*)(smem + 16384 + tid * 16 + i * 4096), 16, 0, 0);
  for (int kt = 0; kt < nkt; ++kt) {
    asm volatile("s_waitcnt vmcnt(0)" ::: "memory");
    __syncthreads();
    if (kt + 1 < nkt) {
      char* bn = smem + 16384 + ((kt + 1) & 1) * 32768;
#pragma unroll
      for (int i = 0; i < 8; ++i) __builtin_amdgcn_global_load_lds((const unsigned*)(pb0 + i * sb32 + (long)(kt + 1) * 64), (unsigned*)(bn + tid * 16 + i * 4096), 16, 0, 0);
    }
    {
      const char* pA = smem + lds_byte64(wr * 64 + fr, fq * 8);
      const char* pB = smem + 16384 + (kt & 1) * 32768 + lds_byte64(wc * 128 + fr, fq * 8);
      const int k1 = lds_byte64(fr, 32 + fq * 8) - lds_byte64(fr, fq * 8);
#pragma unroll
      for (int ks = 0; ks < 2; ++ks) {
        bf16x8 a[4], bb[8];
#pragma unroll
        for (int m = 0; m < 4; ++m) a[m] = *(const bf16x8*)(pA + m * 2048 + ks * k1);
#pragma unroll
        for (int n = 0; n < 8; ++n) bb[n] = *(const bf16x8*)(pB + n * 2048 + ks * k1);
#pragma unroll
        for (int m = 0; m < 4; ++m)
#pragma unroll
          for (int n = 0; n < 8; ++n) acc[m][n] = __builtin_amdgcn_mfma_f32_16x16x32_bf16(a[m], bb[n], acc[m][n], 0, 0, 0);
      }
    }
    __syncthreads();
    if (kt + 1 < nkt) {
#pragma unroll
      for (int i = 0; i < 4; ++i) __builtin_amdgcn_global_load_lds((const unsigned*)(pa0 + i * sa32 + (long)(kt + 1) * 64), (unsigned*)(smem + tid * 16 + i * 4096), 16, 0, 0);
    }
  }
  float* Cs = (float*)smem;
#pragma unroll
  for (int p = 0; p < 2; ++p) {
    __syncthreads();
    if (wc == p) {
#pragma unroll
      for (int m = 0; m < 4; ++m)
#pragma unroll
        for (int n = 0; n < 8; ++n)
#pragma unroll
          for (int r = 0; r < 4; ++r) Cs[(wr * 64 + m * 16 + fq * 4 + r) * CS_LD + n * 16 + fr] = acc[m][n][r];
    }
    __syncthreads();
    epi(Cs, p);
  }
  __syncthreads();
}

template <int MODE>
__device__ __forceinline__ void transpose_tile(const float* W, int Nsrc, bf16_t* Wt, int Kd, int k0, int n0, float* lds) {
  const int tid = tidx();
  {
    int tx = tid & 63, ty = tid >> 6; int np = n0 + tx; int sc;
    if (MODE == 0) sc = np < Nsrc ? np : -1;
    else { int x = np & 127, tl = np >> 7; sc = x < 64 ? tl * 64 + x : 2816 + tl * 64 + x - 64; }
    float v[32];
#pragma unroll
    for (int i = 0; i < 32; ++i) v[i] = sc >= 0 ? W[(long)(k0 + ty + 4 * i) * Nsrc + sc] : 0.f;
#pragma unroll
    for (int i = 0; i < 32; ++i) lds[(ty + 4 * i) * 65 + tx] = v[i];
  }
  __syncthreads();
  {
    int nrow = tid >> 2, kseg = (tid & 3) * 32;
#pragma unroll
    for (int q = 0; q < 4; ++q) {
      float v[8];
#pragma unroll
      for (int i = 0; i < 8; ++i) v[i] = lds[(kseg + q * 8 + i) * 65 + nrow];
      *(u32x4*)(Wt + (long)(n0 + nrow) * Kd + k0 + kseg + q * 8) = pack8(v);
    }
  }
  __syncthreads();
}

template <bool OUTF, int NR>
__device__ __forceinline__ void rownorm_rows(const float* src, const float* g, void* dst) {
  const int lane = tidx() & 63;
  f32x4 v[NR][4];
#pragma unroll
  for (int r = 0; r < NR; ++r)
#pragma unroll
    for (int i = 0; i < 4; ++i) v[r][i] = *(const f32x4*)(src + (long)r * 1024 + i * 256 + lane * 4);
  f32x4 gg[4];
#pragma unroll
  for (int i = 0; i < 4; ++i) gg[i] = *(const f32x4*)(g + i * 256 + lane * 4);
#pragma unroll
  for (int r = 0; r < NR; ++r) {
    float ss = 0.f;
#pragma unroll
    for (int i = 0; i < 4; ++i) ss += v[r][i][0] * v[r][i][0] + v[r][i][1] * v[r][i][1] + v[r][i][2] * v[r][i][2] + v[r][i][3] * v[r][i][3];
    ss = wave_sum(ss);
    const float rr = rsqrtf(ss * (1.f / 1024.f) + 1e-6f);
#pragma unroll
    for (int i = 0; i < 4; ++i) {
      float o0 = v[r][i][0] * rr * gg[i][0], o1 = v[r][i][1] * rr * gg[i][1], o2 = v[r][i][2] * rr * gg[i][2], o3 = v[r][i][3] * rr * gg[i][3];
      if (OUTF) { *(f32x4*)((float*)dst + (long)r * 1024 + i * 256 + lane * 4) = (f32x4){o0, o1, o2, o3}; }
      else { u32x2 p; p[0] = pack2(o0, o1); p[1] = pack2(o2, o3); *(u32x2*)((bf16_t*)dst + (long)r * 1024 + i * 256 + lane * 4) = p; }
    }
  }
}

__device__ void phase0(const Params& P, char* smem) {
  float* lds = (float*)smem;
  const int tid = tidx();
  const int NJ = 8 + 1024 + 32 + 32 + 2192;
  for (int job = blockIdx.x; job < NJ; job += gridDim.x) {
    int j = job;
    if (j < 8) {
      int n = j * 32 + (tid & 31), sl = tid >> 5; int kv = n >> 7, nn = n & 127;
      const float* pe = kv ? P.pe_v : P.pe_k; const float* w1 = kv ? P.w_cv1 : P.w_ck1;
      float s = 0.f;
      for (int k = sl * 256; k < sl * 256 + 256; ++k) s += pe[k] * w1[(long)k * 128 + nn];
      lds[sl * 32 + (tid & 31)] = s;
      __syncthreads();
      if (tid < 32) { float t = 0.f; for (int q = 0; q < 8; ++q) t += lds[q * 32 + tid]; ((float*)(P.ws + OFF_BIAS1))[j * 32 + tid] = t; }
      __syncthreads();
      continue;
    }
    j -= 8;
    if (j < 1024) { int row = j * 16 + (tid >> 6) * 4; rownorm_rows<false, 4>(P.x + (long)row * 1024, P.norm_mix, (bf16_t*)(P.ws + OFF_A) + (long)row * 1024); continue; }
    j -= 1024;
    if (j < 32) { int row = j * 16 + (tid >> 6) * 4; rownorm_rows<false, 4>(P.mem + (long)row * 1024, P.norm_mkv, (bf16_t*)(P.ws + OFF_MEMN) + (long)row * 1024); continue; }
    j -= 32;
    if (j < 32) {
      int e0 = j * 2048 + tid * 8; float v[8];
#pragma unroll
      for (int i = 0; i < 8; ++i) { int e = e0 + i; int t = (e >> 7) & 127, s = e & 127; v[i] = s <= t ? P.w_sp[e] : 0.f; }
      *(u32x4*)((bf16_t*)(P.ws + OFF_WM) + e0) = pack8(v);
      continue;
    }
    j -= 32;
#define TRJ(KT, NT, W, NSRC, WT, KD, MODE) \
    if (j < (KT) * (NT)) { transpose_tile<MODE>(W, NSRC, (bf16_t*)(P.ws + (WT)), KD, (j % (KT)) * 128, (j / (KT)) * 64, lds); continue; } \
    j -= (KT) * (NT);
    TRJ(8, 88, P.w_gu, 5632, OFF_WGU, 1024, 1)
    TRJ(22, 16, P.w_dn, 1024, OFF_WDN, 2816, 0)
    TRJ(8, 38, P.w_in, 2328, OFF_W1, 1024, 0)
    TRJ(8, 32, P.w_merge, 2048, OFF_W1 + 2432L * 1024 * 2, 1024, 0)
    TRJ(8, 16, P.w_mkv, 1024, OFF_WMKV, 1024, 0)
    TRJ(8, 16, P.w_out, 1024, OFF_WOUT, 1024, 0)
    TRJ(4, 16, P.w_pa, 1024, OFF_WPA, 512, 0)
    TRJ(4, 16, P.w_pb, 1024, OFF_WPB, 512, 0)
    TRJ(8, 8, P.w_mq, 512, OFF_WMQ, 1024, 0)
    TRJ(4, 16, P.w_mo, 1024, OFF_WMO, 512, 0)
    TRJ(16, 2, P.w_ck1, 128, OFF_WCK1, 2048, 0)
    TRJ(16, 2, P.w_cv1, 128, OFF_WCV1, 2048, 0)
#undef TRJ
  }
}

__device__ void phase1(const Params& P, char* smem) {
  char* ws = P.ws;
  const int NG1 = 128 * 18;
  const int xq = blockIdx.x & 7, lq = blockIdx.x >> 3, sq = gridDim.x >> 3;
  for (int t = lq; t < 16 * 12; t += sq) {
    {
      const int mt = xq * 16 + (t & 15), nt2 = t >> 4; const int brow = mt * 128;
      RowLin ar{(const bf16_t*)(ws + OFF_A) + (long)brow * 1024, 1024};
      RowLin br{(const bf16_t*)(ws + OFF_W1) + (long)nt2 * 256 * 1024, 1024};
      gemm_tile2(smem, ar, br, 16, [&](const float* Cs, int p) {
        const int nt = nt2 * 2 + p; if (nt >= 35) return;
        char* C = ws + OFF_C;
        if (nt < 4) {
          store_rows_bf16(Cs, (bf16_t*)(C + C_Q) + (long)brow * 512 + nt * 128, 512, [](float v, int) { return v * (0.125f * LOG2E); });
        } else if (nt == 4 || nt == 5 || nt == 6 || nt == 8) {
          long off = nt == 4 ? C_KC : nt == 5 ? C_VC : nt == 6 ? C_KS : C_KW;
          store_rows_bf16(Cs, (bf16_t*)(C + off) + (long)brow * 128, 128, [](float v, int) { return v; });
        } else if (nt == 7 || nt == 9) {
          long off = nt == 7 ? C_VST : C_VWT; int b = brow >> 13, tl = brow & 8191;
          store_T_bf16(Cs, (bf16_t*)(C + off) + (long)b * 128 * T_ + tl, T_, [](float v) { return v; });
        } else if (nt < 14) {
          store_rows_bf16(Cs, (bf16_t*)(C + C_U) + (long)brow * 512 + (nt - 10) * 128, 512, [](float v, int) { return gelu_tanh(v); });
        } else if (nt < 18) {
          store_T_bf16(Cs, (bf16_t*)(C + C_GVT) + ((long)(brow >> 7) * 512 + (nt - 14) * 128) * 128, 128, [](float v) { return gelu_tanh(v); });
        } else if (nt == 18) {
          float* gates = (float*)(C + C_GATES);
          for (int id = tidx(); id < 128 * 24; id += 256) { int r = id / 24, c = id % 24; gates[(long)(brow + r) * 24 + c] = sigm(Cs[r * CS_LD + c]); }
        } else {
          const float* bm = P.b_merge + (nt - 19) * 128;
          store_rows_bf16(Cs, (bf16_t*)(ws + OFF_B) + (long)brow * 2048 + (nt - 19) * 128, 2048, [bm](float v, int c) { return sigm(v + bm[c]); });
        }
      });
    }
  }
}

__device__ void phase2(const Params& P, char* smem) {
  char* ws = P.ws; const int tid = tidx();
  for (int job = blockIdx.x; job < 32 + 128; job += gridDim.x) {
    if (job < 32) {
      const int kv = job >> 4, mt = job & 15, brow = mt * 128;
      RowCmp ar{(const bf16_t*)(ws + OFF_C + (kv ? C_VC : C_KC)), brow};
      RowLin br{(const bf16_t*)(ws + (kv ? OFF_WCV1 : OFF_WCK1)), 2048};
      const float* bias1 = (const float*)(ws + OFF_BIAS1) + kv * 128;
      const float* w2 = kv ? P.w_cv2 : P.w_ck2;
      gemm_tile(smem, ar, br, 32, 128, 64, [&](const float* Csc) {
        float* Cs = (float*)Csc;
        for (int it = 0; it < 64; ++it) { int id = it * 256 + tid; int r = id >> 7, n = id & 127; Cs[r * CS_LD + n] = gelu_tanh(Cs[r * CS_LD + n] + bias1[n]); }
        __syncthreads();
        const int r = tid >> 1, half = tid & 1;
        float acc[32];
#pragma unroll
        for (int i = 0; i < 32; ++i) acc[i] = 0.f;
        for (int n = 0; n < 128; ++n) {
          float h = Cs[r * CS_LD + n]; const float* wr = w2 + n * 64 + half * 32;
#pragma unroll
          for (int q = 0; q < 8; ++q) { f32x4 w = *(const f32x4*)(wr + q * 4); acc[q * 4] += h * w[0]; acc[q * 4 + 1] += h * w[1]; acc[q * 4 + 2] += h * w[2]; acc[q * 4 + 3] += h * w[3]; }
        }
        const int R = brow + r; const int b = R >> 10, rem = R & 1023, i = rem >> 1, g = rem & 1;
        if (i >= 511) {
#pragma unroll
          for (int q = 0; q < 32; ++q) acc[q] = 0.f;
        }
        if (kv == 0) {
          bf16_t* dst = (bf16_t*)(ws + OFF_KCMP) + (long)(b * 512 + i) * 128 + g * 64 + half * 32;
#pragma unroll
          for (int q = 0; q < 4; ++q) { float v[8];
#pragma unroll
            for (int e = 0; e < 8; ++e) v[e] = acc[q * 8 + e];
            *(u32x4*)(dst + q * 8) = pack8(v); }
        } else {
          bf16_t* dst = (bf16_t*)(ws + OFF_VCT) + ((long)(b * 128 + g * 64 + half * 32)) * 512 + i;
#pragma unroll
          for (int q = 0; q < 32; ++q) dst[(long)q * 512] = (bf16_t)f2bf(acc[q]);
        }
      });
    } else {
      const int bc = job - 32; bf16_t* base = (bf16_t*)(ws + OFF_C + C_GVT) + (long)bc * 512 * 128;
      float* ssum = (float*)smem; float* ssq = ssum + 128;
      float* psum = ssum + 256; float* psq = psum + 16 * 128;
      const int cs = tid >> 4, s8 = (tid & 15) * 8;
      float a[8], q[8];
#pragma unroll
      for (int i = 0; i < 8; ++i) { a[i] = 0.f; q[i] = 0.f; }
      for (int it = 0; it < 32; ++it) {
        u32x4 d = *(const u32x4*)(base + (long)(it * 16 + cs) * 128 + s8);
#pragma unroll
        for (int i = 0; i < 4; ++i) { float lo = bf2f(d[i] & 0xffffu), hi = bf2f(d[i] >> 16); a[2 * i] += lo; q[2 * i] += lo * lo; a[2 * i + 1] += hi; q[2 * i + 1] += hi * hi; }
      }
#pragma unroll
      for (int i = 0; i < 8; ++i) { psum[cs * 128 + s8 + i] = a[i]; psq[cs * 128 + s8 + i] = q[i]; }
      __syncthreads();
      if (tid < 128) {
        float su = 0.f, sq = 0.f;
        for (int c = 0; c < 16; ++c) { su += psum[c * 128 + tid]; sq += psq[c * 128 + tid]; }
        float mean_t = su * (1.f / 512.f); float var = sq * (1.f / 512.f) - mean_t * mean_t; if (var < 0.f) var = 0.f;
        ssum[tid] = mean_t; ssq[tid] = rsqrtf(var + 1e-6f);
      }
      __syncthreads();
      float mean[8], rs[8];
#pragma unroll
      for (int i = 0; i < 8; ++i) { mean[i] = ssum[s8 + i]; rs[i] = ssq[s8 + i]; }
      for (int it = 0; it < 32; ++it) {
        int ch = it * 16 + cs; float gg = P.ln_sgu[ch];
        u32x4 d = *(const u32x4*)(base + (long)ch * 128 + s8); float v[8];
#pragma unroll
        for (int i = 0; i < 4; ++i) { v[2 * i] = bf2f(d[i] & 0xffffu); v[2 * i + 1] = bf2f(d[i] >> 16); }
#pragma unroll
        for (int i = 0; i < 8; ++i) v[i] = (v[i] - mean[i]) * rs[i] * gg;
        *(u32x4*)(base + (long)ch * 128 + s8) = pack8(v);
      }
      __syncthreads();
    }
  }
  if (blockIdx.x >= 32) {
    for (int mtile = blockIdx.x - 32; mtile < 768 + 32; mtile += gridDim.x - 32) {
      if (mtile >= 768) {
        const int j = mtile - 768; const int mt = j >> 3, nt = j & 7; const int brow = mt * 128;
        RowLin ar{(const bf16_t*)(ws + OFF_MEMN) + (long)brow * 1024, 1024};
        RowLin br{(const bf16_t*)(ws + OFF_WMKV) + (long)nt * 128 * 1024, 1024};
        gemm_tile(smem, ar, br, 16, 64, 64, [&](const float* Cs) {
          if (nt < 4) store_rows_bf16(Cs, (bf16_t*)(ws + OFF_MK) + (long)brow * 512 + nt * 128, 512, [](float v, int) { return v; });
          else { int b = mt >> 1, n0 = (mt & 1) * 128; store_T_bf16(Cs, (bf16_t*)(ws + OFF_MVT) + ((long)b * 512 + (nt - 4) * 128) * 256 + n0, 256, [](float v) { return v; }); }
        });
        continue;
      }
      const int mt = mtile & 127, nt2 = 12 + (mtile >> 7), brow = mt * 128;
      RowLin ar{(const bf16_t*)(ws + OFF_A) + (long)brow * 1024, 1024};
      RowLin br{(const bf16_t*)(ws + OFF_W1) + (long)nt2 * 256 * 1024, 1024};
      gemm_tile2(smem, ar, br, 16, [&](const float* Cs, int p) {
        const int nt = nt2 * 2 + p; if (nt >= 35) return;
        const float* bm = P.b_merge + (nt - 19) * 128;
        store_rows_bf16(Cs, (bf16_t*)(ws + OFF_B) + (long)brow * 2048 + (nt - 19) * 128, 2048, [bm](float v, int c) { return sigm(v + bm[c]); });
      });
    }
  }
}

template <int MODE>
__device__ __forceinline__ void nsa_block(const bf16x8 (&qf)[4][2], f32x4 (&oacc)[4][4], float (&m)[4], float (&l)[4],
                                          const float (&sl2)[4], const float (&inv)[4], const bf16_t* kp, const bf16_t* vp, long vdt,
                                          int dist0, bool rowok, float (&asum)[2], float (&bsum)[2]) {
  constexpr int DSTEP = (MODE <= 1) ? 16 : 1;
  bf16x8 kf[2][2];
#pragma unroll
  for (int kt = 0; kt < 2; ++kt)
#pragma unroll
    for (int ks = 0; ks < 2; ++ks) kf[kt][ks] = *(const bf16x8*)(kp + kt * 16 * 128 + ks * 32);
  bf16x8 vf[4];
  if (MODE != 0) {
#pragma unroll
    for (int dt = 0; dt < 4; ++dt) {
      u32x2 lo = *(const u32x2*)(vp + dt * vdt); u32x2 hi = *(const u32x2*)(vp + dt * vdt + 16);
      u32x4 c; c[0] = lo[0]; c[1] = lo[1]; c[2] = hi[0]; c[3] = hi[1];
      vf[dt] = __builtin_bit_cast(bf16x8, c);
    }
  }
  const float fd0 = (float)dist0;
#pragma unroll
  for (int h = 0; h < 4; ++h) {
    f32x4 s[2];
#pragma unroll
    for (int kt = 0; kt < 2; ++kt) {
      s[kt] = __builtin_amdgcn_mfma_f32_16x16x32_bf16(kf[kt][0], qf[h][0], (f32x4){0.f, 0.f, 0.f, 0.f}, 0, 0, 0);
      s[kt] = __builtin_amdgcn_mfma_f32_16x16x32_bf16(kf[kt][1], qf[h][1], s[kt], 0, 0, 0);
    }
    float sc[8]; bool ok[8];
#pragma unroll
    for (int kt = 0; kt < 2; ++kt)
#pragma unroll
      for (int r = 0; r < 4; ++r) {
        const int e = kt * 16 + r; const int dist = dist0 - DSTEP * e;
        bool o = dist >= 0;
        if (MODE == 2) o = o && rowok;
        if (MODE == 3) o = o && (dist < 512);
        ok[kt * 4 + r] = o;
        sc[kt * 4 + r] = o ? s[kt][r] - sl2[h] * (fd0 - (float)(DSTEP * e)) : NEGF;
      }
    float p[8];
    if (MODE != 1) {
      float ml = NEGF;
#pragma unroll
      for (int i = 0; i < 8; ++i) ml = fmaxf(ml, sc[i]);
      ml = fmaxf(ml, __shfl_xor(ml, 16, 64)); ml = fmaxf(ml, __shfl_xor(ml, 32, 64));
      const float mn = fmaxf(m[h], ml); const float alpha = __builtin_amdgcn_exp2f(m[h] - mn); m[h] = mn;
      const float mref = fmaxf(mn, -1e29f);
      float ps = 0.f;
#pragma unroll
      for (int i = 0; i < 8; ++i) { p[i] = __builtin_amdgcn_exp2f(sc[i] - mref); ps += p[i]; }
      l[h] = l[h] * alpha + ps;
      if (MODE != 0) {
        if (__builtin_amdgcn_ballot_w64(alpha != 1.f) != 0ull) {
#pragma unroll
          for (int dt = 0; dt < 4; ++dt) oacc[h][dt] *= alpha;
        }
      }
    } else {
      const float mref1 = fmaxf(m[h], -1e29f);
#pragma unroll
      for (int i = 0; i < 8; ++i) p[i] = __builtin_amdgcn_exp2f(sc[i] - mref1) * l[h];
      asum[0] += (p[0] + p[1]) + (p[2] + p[3]); bsum[0] += p[3];
      asum[1] += (p[4] + p[5]) + (p[6] + p[7]); bsum[1] += p[7];
    }
    if (MODE != 0) {
      u32x4 pk; pk[0] = pack2(p[0], p[1]); pk[1] = pack2(p[2], p[3]); pk[2] = pack2(p[4], p[5]); pk[3] = pack2(p[6], p[7]);
      const bf16x8 pf = __builtin_bit_cast(bf16x8, pk);
#pragma unroll
      for (int dt = 0; dt < 4; ++dt) oacc[h][dt] = __builtin_amdgcn_mfma_f32_16x16x32_bf16(vf[dt], pf, oacc[h][dt], 0, 0, 0);
    }
    __builtin_amdgcn_sched_barrier(0);
  }
}

__device__ void nsa_tile(const Params& P, int wt, char* wl) {
  char* C = P.ws + OFF_C;
  const bf16_t* Q = (const bf16_t*)(C + C_Q);
  const bf16_t* KCMP = (const bf16_t*)(P.ws + OFF_KCMP); const bf16_t* VCT = (const bf16_t*)(P.ws + OFF_VCT);
  const bf16_t* KS = (const bf16_t*)(C + C_KS); const bf16_t* VST = (const bf16_t*)(C + C_VST);
  const bf16_t* KW = (const bf16_t*)(C + C_KW); const bf16_t* VWT = (const bf16_t*)(C + C_VWT);
  const float* GATES = (const float*)(C + C_GATES);
  bf16_t* O = (bf16_t*)(P.ws + OFF_D);
  const int lane = tidx() & 63, qi = lane & 15, quad = lane >> 4;
  wt = __builtin_amdgcn_readfirstlane(wt);
  const int jb = wt >> 2, wv4 = wt & 3;
  const int bg = jb & 3, b = bg >> 1, g = bg & 1;
  const int gq = jb >> 2;
  const int tq = (gq < 64 ? 127 - gq : gq - 64) * 4 + wv4;
  const int t0 = tq * 16;
  const int t = t0 + qi;
  const long row = (long)b * T_ + t;
  bf16x8 qf[4][2];
#pragma unroll
  for (int h = 0; h < 4; ++h)
#pragma unroll
    for (int ks = 0; ks < 2; ++ks) qf[h][ks] = *(const bf16x8*)(Q + row * 512 + (g * 4 + h) * 64 + ks * 32 + quad * 8);
  float sl2[4];
#pragma unroll
  for (int h = 0; h < 4; ++h) sl2[h] = __builtin_amdgcn_exp2f(-(float)(g * 4 + h + 1)) * LOG2E;
  f32x4 oacc[4][4]; float m[4], l[4], inv[4]; float asum[2], bsum[2];
  float* imp = (float*)wl; float* outl = (float*)wl;
  unsigned* sel = (unsigned*)(wl + 16384); unsigned* uni = sel + 64;
#pragma unroll
  for (int h = 0; h < 4; ++h) { m[h] = NEGF; l[h] = 0.f; inv[h] = 0.f; }
  asum[0] = asum[1] = bsum[0] = bsum[1] = 0.f;

  const int nI = t0 >> 4; const int nblk = (nI + 31) >> 5;
  for (int blk = nblk - 1; blk >= 0; --blk) {
    const int key0 = blk * 32;
    const bf16_t* kp = KCMP + (long)(b * 512 + key0 + qi) * 128 + g * 64 + quad * 8;
    nsa_block<0>(qf, oacc, m, l, sl2, inv, kp, nullptr, 0, t - 31 - 16 * (key0 + quad * 4), true, asum, bsum);
  }
#pragma unroll
  for (int h = 0; h < 4; ++h) { float lt = l[h]; lt += __shfl_xor(lt, 16, 64); lt += __shfl_xor(lt, 32, 64); l[h] = 1.f / fmaxf(lt, 1e-30f); }
  for (int i = lane; i < 16 * 132; i += 64) imp[i] = 0.f;
#pragma unroll
  for (int h = 0; h < 4; ++h)
#pragma unroll
    for (int dt = 0; dt < 4; ++dt) oacc[h][dt] = (f32x4){0.f, 0.f, 0.f, 0.f};
  for (int blk = 0; blk < nblk; ++blk) {
    const int key0 = blk * 32;
    const bf16_t* kp = KCMP + (long)(b * 512 + key0 + qi) * 128 + g * 64 + quad * 8;
    const bf16_t* vp = VCT + (long)(b * 128 + g * 64 + qi) * 512 + key0 + quad * 4;
    asum[0] = asum[1] = bsum[0] = bsum[1] = 0.f;
    nsa_block<1>(qf, oacc, m, l, sl2, inv, kp, vp, 16 * 512, t - 31 - 16 * (key0 + quad * 4), true, asum, bsum);
    const int J = (key0 >> 2) + quad;
    atomicAdd(&imp[qi * 132 + J], asum[0]); atomicAdd(&imp[qi * 132 + J + 1], bsum[0]);
    atomicAdd(&imp[qi * 132 + J + 4], asum[1]); atomicAdd(&imp[qi * 132 + J + 5], bsum[1]);
  }
  const int cur = t0 >> 6;
  if (lane < 16) {
    unsigned w0 = 0, w1 = 0, w2 = 0, w3 = 0;
    if (cur < 16) { w0 = (1u << (cur + 1)) - 1u; }
    else {
      w0 = 1u;
      { int j = cur; unsigned bit = 1u << (j & 31); int w = j >> 5; if (w == 0) w0 |= bit; else if (w == 1) w1 |= bit; else if (w == 2) w2 |= bit; else w3 |= bit; }
      { int j = cur - 1; unsigned bit = 1u << (j & 31); int w = j >> 5; if (w == 0) w0 |= bit; else if (w == 1) w1 |= bit; else if (w == 2) w2 |= bit; else w3 |= bit; }
    }
    sel[lane * 4 + 0] = w0; sel[lane * 4 + 1] = w1; sel[lane * 4 + 2] = w2; sel[lane * 4 + 3] = w3;
  }
  if (lane < 4) uni[lane] = 0u;
  if (cur >= 16) {
    for (int rnd = 0; rnd < 4; ++rnd) {
      const int qq = rnd * 4 + quad;
      unsigned key[8];
#pragma unroll
      for (int c = 0; c < 8; ++c) {
        const int j = qi + 16 * c;
        const bool v = (j <= cur) && (j != 0) && (j != cur) && (j != cur - 1);
        const unsigned bits = __float_as_uint(imp[qq * 132 + j]);
        key[c] = v ? ((bits & 0xFFFFFF00u) | (unsigned)(128 - j)) : 0u;
      }
      for (int it = 0; it < 13; ++it) {
        unsigned mx = key[0];
#pragma unroll
        for (int c = 1; c < 8; ++c) mx = key[c] > mx ? key[c] : mx;
#pragma unroll
        for (int o = 1; o < 16; o <<= 1) { unsigned ot = (unsigned)__shfl_xor((int)mx, o, 64); mx = ot > mx ? ot : mx; }
        if (mx != 0u) {
#pragma unroll
          for (int c = 0; c < 8; ++c) {
            if (key[c] == mx) { key[c] = 0u; const int j = qi + 16 * c; atomicOr(&sel[qq * 4 + (j >> 5)], 1u << (j & 31)); }
          }
        }
      }
    }
  }
  unsigned mym[4];
#pragma unroll
  for (int w = 0; w < 4; ++w) mym[w] = sel[qi * 4 + w];
  if (lane < 16) {
#pragma unroll
    for (int w = 0; w < 4; ++w) atomicOr(&uni[w], mym[w]);
  }
  const float* gp = GATES + row * 24 + g * 12;
#pragma unroll
  for (int h = 0; h < 4; ++h) {
    const float gt = gp[h * 3 + 0] * NSA_G0;
#pragma unroll
    for (int dt = 0; dt < 4; ++dt) *(f32x4*)(outl + ((h * 16 + qi) * 64 + (((dt * 4 + quad) ^ qi) << 2))) = oacc[h][dt] * gt;
  }
#pragma unroll
  for (int h = 0; h < 4; ++h) { m[h] = NEGF; l[h] = 0.f;
#pragma unroll
    for (int dt = 0; dt < 4; ++dt) oacc[h][dt] = (f32x4){0.f, 0.f, 0.f, 0.f}; }
#pragma unroll 1
  for (int w = 3; w >= 0; --w) {
    unsigned bits = __builtin_amdgcn_readfirstlane(uni[w]);
    const unsigned myw = sel[qi * 4 + w];
    while (bits) {
      const int jj = 31 - __builtin_clz(bits); bits &= ~(1u << jj);
      const int j = w * 32 + jj; const bool rowok = (myw >> jj) & 1u;
#pragma unroll 1
      for (int half = 1; half >= 0; --half) {
        const int key0 = j * 64 + half * 32;
        const bf16_t* kp = KS + (long)(b * T_ + key0 + qi) * 128 + g * 64 + quad * 8;
        const bf16_t* vp = VST + (long)(b * 128 + g * 64 + qi) * T_ + key0 + quad * 4;
        nsa_block<2>(qf, oacc, m, l, sl2, inv, kp, vp, 16L * T_, t - (key0 + quad * 4), rowok, asum, bsum);
      }
    }
  }
#pragma unroll
  for (int h = 0; h < 4; ++h) {
    float lt = l[h]; lt += __shfl_xor(lt, 16, 64); lt += __shfl_xor(lt, 32, 64);
    const float sc = NSA_G1 * gp[h * 3 + 1] / fmaxf(lt, 1e-30f);
#pragma unroll
    for (int dt = 0; dt < 4; ++dt) { f32x4* d = (f32x4*)(outl + ((h * 16 + qi) * 64 + (((dt * 4 + quad) ^ qi) << 2))); *d = *d + oacc[h][dt] * sc; }
  }
#pragma unroll
  for (int h = 0; h < 4; ++h) { m[h] = NEGF; l[h] = 0.f;
#pragma unroll
    for (int dt = 0; dt < 4; ++dt) oacc[h][dt] = (f32x4){0.f, 0.f, 0.f, 0.f}; }
  {
    const int kstart = t0 >= 512 ? ((t0 - 511) & ~31) : 0;
    for (int key0 = (t0 + 15) & ~31; key0 >= kstart; key0 -= 32) {
      const bf16_t* kp = KW + (long)(b * T_ + key0 + qi) * 128 + g * 64 + quad * 8;
      const bf16_t* vp = VWT + (long)(b * 128 + g * 64 + qi) * T_ + key0 + quad * 4;
      nsa_block<3>(qf, oacc, m, l, sl2, inv, kp, vp, 16L * T_, t - (key0 + quad * 4), true, asum, bsum);
    }
  }
#pragma unroll
  for (int h = 0; h < 4; ++h) {
    float lt = l[h]; lt += __shfl_xor(lt, 16, 64); lt += __shfl_xor(lt, 32, 64);
    const float sc = NSA_G2 * gp[h * 3 + 2] / fmaxf(lt, 1e-30f);
#pragma unroll
    for (int dt = 0; dt < 4; ++dt) { f32x4* d = (f32x4*)(outl + ((h * 16 + qi) * 64 + (((dt * 4 + quad) ^ qi) << 2))); *d = *d + oacc[h][dt] * sc; }
  }
#pragma unroll
  for (int it = 0; it < 8; ++it) {
    const int id = it * 64 + lane; const int h = id >> 7, rem = id & 127, q2 = rem >> 3, c8 = rem & 7;
    f32x4 a = *(const f32x4*)(outl + ((h * 16 + q2) * 64 + (((2 * c8) ^ q2) << 2)));
    f32x4 bb = *(const f32x4*)(outl + ((h * 16 + q2) * 64 + (((2 * c8 + 1) ^ q2) << 2)));
    float v[8] = {a[0], a[1], a[2], a[3], bb[0], bb[1], bb[2], bb[3]};
    *(u32x4*)(O + ((long)b * T_ + t0 + q2) * 512 + (g * 4 + h) * 64 + c8 * 8) = pack8(v);
  }
}

__device__ void xattn_tile(const Params& P, int wt) {
  const bf16_t* HQ = (const bf16_t*)(P.ws + OFF_D);
  const bf16_t* MK = (const bf16_t*)(P.ws + OFF_MK); const bf16_t* MVT = (const bf16_t*)(P.ws + OFF_MVT);
  bf16_t* OX = (bf16_t*)(P.ws + OFF_D) + (long)M_ * 512;
  const int lane = tidx() & 63, qi = lane & 15, quad = lane >> 4;
  wt = __builtin_amdgcn_readfirstlane(wt);
  const int h = wt & 3; const int row0 = (wt >> 2) * 32; const int b = row0 >> 13;
  bf16x8 qf[2][4];
#pragma unroll
  for (int nt = 0; nt < 2; ++nt)
#pragma unroll
    for (int ks = 0; ks < 4; ++ks) qf[nt][ks] = *(const bf16x8*)(HQ + (long)(row0 + nt * 16 + qi) * 512 + h * 128 + ks * 32 + quad * 8);
  f32x4 oacc[2][8]; float m[2], l[2];
#pragma unroll
  for (int nt = 0; nt < 2; ++nt) { m[nt] = NEGF; l[nt] = 0.f;
#pragma unroll
    for (int dt = 0; dt < 8; ++dt) oacc[nt][dt] = (f32x4){0.f, 0.f, 0.f, 0.f}; }
  for (int blk = 0; blk < 8; ++blk) {
    const int key0 = blk * 32;
    f32x4 s[2][2];
#pragma unroll
    for (int nt = 0; nt < 2; ++nt)
#pragma unroll
      for (int kt = 0; kt < 2; ++kt) s[nt][kt] = (f32x4){0.f, 0.f, 0.f, 0.f};
#pragma unroll
    for (int ks = 0; ks < 4; ++ks) {
#pragma unroll
      for (int kt = 0; kt < 2; ++kt) {
        bf16x8 kf = *(const bf16x8*)(MK + (long)(b * 256 + key0 + kt * 16 + qi) * 512 + h * 128 + ks * 32 + quad * 8);
#pragma unroll
        for (int nt = 0; nt < 2; ++nt) s[nt][kt] = __builtin_amdgcn_mfma_f32_16x16x32_bf16(kf, qf[nt][ks], s[nt][kt], 0, 0, 0);
      }
    }
    bf16x8 pf[2];
#pragma unroll
    for (int nt = 0; nt < 2; ++nt) {
      float ml = NEGF;
#pragma unroll
      for (int kt = 0; kt < 2; ++kt)
#pragma unroll
        for (int r = 0; r < 4; ++r) ml = fmaxf(ml, s[nt][kt][r]);
      ml = fmaxf(ml, __shfl_xor(ml, 16, 64)); ml = fmaxf(ml, __shfl_xor(ml, 32, 64));
      const float mn = fmaxf(m[nt], ml); const float alpha = __builtin_amdgcn_exp2f(m[nt] - mn); m[nt] = mn;
      float p[8]; float ps = 0.f;
#pragma unroll
      for (int kt = 0; kt < 2; ++kt)
#pragma unroll
        for (int r = 0; r < 4; ++r) { p[kt * 4 + r] = __builtin_amdgcn_exp2f(s[nt][kt][r] - mn); ps += p[kt * 4 + r]; }
      l[nt] = l[nt] * alpha + ps;
#pragma unroll
      for (int dt = 0; dt < 8; ++dt) oacc[nt][dt] *= alpha;
      u32x4 pk; pk[0] = pack2(p[0], p[1]); pk[1] = pack2(p[2], p[3]); pk[2] = pack2(p[4], p[5]); pk[3] = pack2(p[6], p[7]);
      pf[nt] = __builtin_bit_cast(bf16x8, pk);
    }
#pragma unroll
    for (int dt = 0; dt < 8; ++dt) {
      const bf16_t* vp = MVT + (long)(b * 512 + h * 128 + dt * 16 + qi) * 256 + key0 + quad * 4;
      u32x2 lo = *(const u32x2*)(vp); u32x2 hi = *(const u32x2*)(vp + 16);
      u32x4 c; c[0] = lo[0]; c[1] = lo[1]; c[2] = hi[0]; c[3] = hi[1];
      const bf16x8 vf = __builtin_bit_cast(bf16x8, c);
#pragma unroll
      for (int nt = 0; nt < 2; ++nt) oacc[nt][dt] = __builtin_amdgcn_mfma_f32_16x16x32_bf16(vf, pf[nt], oacc[nt][dt], 0, 0, 0);
    }
  }
#pragma unroll
  for (int nt = 0; nt < 2; ++nt) {
    float lt = l[nt]; lt += __shfl_xor(lt, 16, 64); lt += __shfl_xor(lt, 32, 64);
    const float iv = 1.f / lt;
#pragma unroll
    for (int dt = 0; dt < 8; ++dt) {
      f32x4 v = oacc[nt][dt] * iv; u32x2 pk; pk[0] = pack2(v[0], v[1]); pk[1] = pack2(v[2], v[3]);
      *(u32x2*)(OX + (long)(row0 + nt * 16 + qi) * 512 + h * 128 + dt * 16 + quad * 4) = pk;
    }
  }
}


#define XB_TMO      128
#define XB_XCNT(j)  (256  + 64 * (j))
#define XB_XSUB(j)  (1280 + 64 * (j))
#define XB_XGEN(j)  (2304 + 64 * (j))
#define XB_TOP      3328
#define XB_TOPGEN   3392
#define XCD_BAR_WORDS 3456
#define XB_SPIN_CAP (1u << 18)
#define LAS __attribute__((address_space(3)))
__device__ __forceinline__ unsigned xb_ld(unsigned* p) { return __hip_atomic_load(p, __ATOMIC_RELAXED, __HIP_MEMORY_SCOPE_AGENT); }
__device__ __forceinline__ unsigned xb_add(unsigned* p, unsigned v) { return __hip_atomic_fetch_add(p, v, __ATOMIC_RELAXED, __HIP_MEMORY_SCOPE_AGENT); }
__device__ __forceinline__ unsigned xb_xcc_id() { return (unsigned)__builtin_amdgcn_s_getreg((3 << 11) | 20) & 0xFu; }
#define XB_SPIN(cond, bar) do { unsigned _sp = 0; while (cond) { __builtin_amdgcn_s_sleep(1); \
    if ((++_sp & 255u) == 0u) { if (xb_ld(&(bar)[XB_TMO])) break; if (_sp > XB_SPIN_CAP) { atomicAdd(&(bar)[XB_TMO], 1u); break; } } } } while (0)
__device__ __forceinline__ void xcd_barrier_complete(unsigned* bar, unsigned x, unsigned& nloc, unsigned& nx) {
  const unsigned G = gridDim.x * gridDim.y * gridDim.z;
  unsigned sum, cnt, mine, sp = 0u;
  for (;;) {
    sum = 0u; cnt = 0u; mine = 0u;
#pragma unroll
    for (unsigned j = 0; j < 16; ++j) { const unsigned c = xb_ld(&bar[XB_XCNT(j)]); sum += c; cnt += (c > 0u) ? 1u : 0u; mine = (j == x) ? c : mine; }
    if (sum == G) break;
    __builtin_amdgcn_s_sleep(1);
    if ((++sp & 255u) == 0u) { if (xb_ld(&bar[XB_TMO])) break; if (sp > XB_SPIN_CAP) { atomicAdd(&bar[XB_TMO], 1u); break; } }
  }
  nloc = mine > 0u ? mine : 1u; nx = cnt > 0u ? cnt : 1u;
}
__device__ __forceinline__ void xcd_barrier(unsigned* bar, unsigned x, unsigned& st_nloc, unsigned& st_nx) {
  asm volatile("s_waitcnt vmcnt(0)" ::: "memory");
  __syncthreads();
  if (threadIdx.x == 0) {
    __builtin_amdgcn_s_waitcnt(0);
    unsigned nloc = st_nloc, nx = st_nx;
    if (nloc == 0u) { xcd_barrier_complete(bar, x, nloc, nx); st_nloc = nloc; st_nx = nx; }
    const unsigned old = xb_add(&bar[XB_XSUB(x)], 1u);
    const unsigned gen = old / nloc;
    if (old + 1u == (gen + 1u) * nloc) {
      __builtin_amdgcn_fence(__ATOMIC_RELEASE, "agent");
      asm volatile("s_waitcnt vmcnt(0)" ::: "memory");
      const unsigned og = xb_add(&bar[XB_TOP], 1u);
      const unsigned tg = og / nx;
      if (og + 1u == (tg + 1u) * nx) xb_add(&bar[XB_TOPGEN], 1u);
      else XB_SPIN(xb_ld(&bar[XB_TOPGEN]) == tg, bar);
      __builtin_amdgcn_fence(__ATOMIC_ACQUIRE, "agent");
      xb_add(&bar[XB_XGEN(x)], 1u);
      asm volatile("s_waitcnt vmcnt(0)" ::: "memory");
    } else {
      XB_SPIN(xb_ld(&bar[XB_XGEN(x)]) == gen, bar);
      __builtin_amdgcn_fence(__ATOMIC_ACQUIRE, "agent");
      asm volatile("s_waitcnt vmcnt(0)" ::: "memory");
    }
  }
  __syncthreads();
}

__device__ void run_phase(const Params& P, int ph, char* smem, bool ph_fused) {
  char* ws = P.ws; const int tid = tidx();
  switch (ph) {
    case 0: phase0(P, smem); break;
    case 1: phase1(P, smem); break;
    case 2: phase2(P, smem); break;
    case 3: {
      for (int job = blockIdx.x; job < 512; job += gridDim.x) { const int wv = tidx() >> 6; nsa_tile(P, job * 4 + wv, smem + wv * 16896); }
      __syncthreads();
      for (int job = blockIdx.x; job < 512; job += gridDim.x) {
        {
          const int tid = tidx();
          const int s = job; const int bc = s >> 2, g = s & 3;
          RowLin ar{(const bf16_t*)(ws + OFF_WM) + g * 16384, 128};
          RowLin br{(const bf16_t*)(ws + OFF_C + C_GVT) + ((long)bc * 512 + g * 128) * 128, 128};
          const float* bs = P.b_sp + g * 128;
          const bf16_t* U = (const bf16_t*)(ws + OFF_C + C_U) + (long)bc * 128 * 512 + g * 128;
          bf16_t* OS = (bf16_t*)(ws + OFF_D) + (long)M_ * 512 + (long)bc * 128 * 512 + g * 128;
          gemm_tile(smem, ar, br, 2, 64, 64, [&](const float* Cs) {
#pragma unroll 2
            for (int it = 0; it < 8; ++it) {
              int id = it * 256 + tid; int r = id >> 4, c = (id & 15) * 8; float v[8]; ld8(Cs, r, c, v);
              u32x4 d = *(const u32x4*)(U + (long)r * 512 + c); const float bb = bs[r];
#pragma unroll
              for (int i = 0; i < 4; ++i) { v[2 * i] = (v[2 * i] + bb) * bf2f(d[i] & 0xffffu); v[2 * i + 1] = (v[2 * i + 1] + bb) * bf2f(d[i] >> 16); }
              *(u32x4*)(OS + (long)r * 512 + c) = pack8(v);
            }
          });
        }
      }
    } break;
    case 4: {
      float* scr = (float*)(ws + OFF_C + C_SCR) + (long)blockIdx.x * 16384;
      const int xq = blockIdx.x & 7, lq = blockIdx.x >> 3, sq = gridDim.x >> 3;
      for (int t = lq; t < 16 * 8; t += sq) {
        const int mt = xq * 16 + (t & 15), nt = t >> 4, brow = mt * 128, bcol = nt * 128;
        const bf16_t* MG = (const bf16_t*)(ws + OFF_B) + (long)brow * 2048 + bcol;
        RowLin a1{(const bf16_t*)(ws + OFF_D) + (long)brow * 512, 512};
        RowLin b1{(const bf16_t*)(ws + OFF_WPA) + (long)bcol * 512, 512};
        gemm_tile(smem, a1, b1, 8, 64, 64, [&](const float* Cs) {
#pragma unroll 2
          for (int it = 0; it < 8; ++it) {
            int id = it * 256 + tid; int r = id >> 4, c = (id & 15) * 8; float v[8]; ld8(Cs, r, c, v);
            u32x4 d = *(const u32x4*)(MG + (long)r * 2048 + c);
#pragma unroll
            for (int i = 0; i < 4; ++i) { v[2 * i] *= bf2f(d[i] & 0xffffu); v[2 * i + 1] *= bf2f(d[i] >> 16); }
            *(f32x4*)(scr + id * 8) = (f32x4){v[0], v[1], v[2], v[3]}; *(f32x4*)(scr + id * 8 + 4) = (f32x4){v[4], v[5], v[6], v[7]};
          }
        });
        RowLin a2{(const bf16_t*)(ws + OFF_D) + (long)M_ * 512 + (long)brow * 512, 512};
        RowLin b2{(const bf16_t*)(ws + OFF_WPB) + (long)bcol * 512, 512};
        bf16_t* MX = (bf16_t*)(ws + OFF_C + C_MIXED) + (long)brow * 1024 + bcol;
        gemm_tile(smem, a2, b2, 8, 64, 64, [&](const float* Cs) {
#pragma unroll 2
          for (int it = 0; it < 8; ++it) {
            int id = it * 256 + tid; int r = id >> 4, c = (id & 15) * 8; float v[8]; ld8(Cs, r, c, v);
            u32x4 d = *(const u32x4*)(MG + (long)r * 2048 + 1024 + c);
            f32x4 p0 = *(const f32x4*)(scr + id * 8), p1 = *(const f32x4*)(scr + id * 8 + 4);
            float pv[8] = {p0[0], p0[1], p0[2], p0[3], p1[0], p1[1], p1[2], p1[3]};
#pragma unroll
            for (int i = 0; i < 4; ++i) { v[2 * i] = pv[2 * i] + v[2 * i] * bf2f(d[i] & 0xffffu); v[2 * i + 1] = pv[2 * i + 1] + v[2 * i + 1] * bf2f(d[i] >> 16); }
            *(u32x4*)(MX + (long)r * 1024 + c) = pack8(v);
          }
        });
      }
    } break;
    case 5: case 9: case 12: {
      const bf16_t* A; const bf16_t* W; const float* RES; float* DST; int K;
      if (ph == 5) { A = (const bf16_t*)(ws + OFF_C + C_MIXED); W = (const bf16_t*)(ws + OFF_WOUT); RES = P.x; DST = (float*)(ws + OFF_B); K = 1024; }
      else if (ph == 9) { A = (const bf16_t*)(ws + OFF_D) + (long)M_ * 512; W = (const bf16_t*)(ws + OFF_WMO); RES = (const float*)(ws + OFF_B); DST = (float*)(ws + OFF_C + C_H2); K = 512; }
      else { A = (const bf16_t*)(ws + OFF_B); W = (const bf16_t*)(ws + OFF_WDN); RES = (const float*)(ws + OFF_C + C_H2); DST = P.out; K = 2816; }
      const int xq = blockIdx.x & 7, lq = blockIdx.x >> 3, sq = gridDim.x >> 3;
      for (int t = lq; t < 16 * 4; t += sq) {
        const int mt = xq * 16 + (t & 15), nt2 = t >> 4, brow = mt * 128;
        RowLin ar{A + (long)brow * K, K}; RowLin br{W + (long)nt2 * 256 * K, K};
        gemm_tile2(smem, ar, br, K / 64, [&](const float* Cs, int p) {
          const int bcol = nt2 * 256 + p * 128;
          const float* rs = RES + (long)brow * 1024 + bcol; float* ds = DST + (long)brow * 1024 + bcol;
#pragma unroll 2
          for (int it = 0; it < 8; ++it) {
            int id = it * 256 + tid; int r = id >> 4, c = (id & 15) * 8;
            f32x4 a = *(const f32x4*)(Cs + r * CS_LD + c), bq = *(const f32x4*)(Cs + r * CS_LD + c + 4);
            f32x4 r0 = *(const f32x4*)(rs + (long)r * 1024 + c), r1 = *(const f32x4*)(rs + (long)r * 1024 + c + 4);
            const f32x4 h0 = a + r0, h1v = bq + r1;
            *(f32x4*)(ds + (long)r * 1024 + c) = h0; *(f32x4*)(ds + (long)r * 1024 + c + 4) = h1v;
            if (ph != 12) {
              const float* gn = (ph == 5 ? P.norm_mq : P.norm_ffn) + bcol + c;
              const f32x4 g0 = *(const f32x4*)gn, g1 = *(const f32x4*)(gn + 4);
              float v[8] = {h0[0] * g0[0], h0[1] * g0[1], h0[2] * g0[2], h0[3] * g0[3], h1v[0] * g1[0], h1v[1] * g1[1], h1v[2] * g1[2], h1v[3] * g1[3]};
              *(u32x4*)((bf16_t*)(ws + OFF_A) + (long)(brow + r) * 1024 + bcol + c) = pack8(v);
              float ss = (h0[0] * h0[0] + h0[1] * h0[1]) + (h0[2] * h0[2] + h0[3] * h0[3]) + (h1v[0] * h1v[0] + h1v[1] * h1v[1]) + (h1v[2] * h1v[2] + h1v[3] * h1v[3]);
              ss += __shfl_xor(ss, 1, 64); ss += __shfl_xor(ss, 2, 64); ss += __shfl_xor(ss, 4, 64); ss += __shfl_xor(ss, 8, 64);
              if ((tid & 15) == 0) ((float*)(ws + (ph == 5 ? OFF_SSQ1 : OFF_SSQ2)))[(long)(brow + r) * 8 + nt2 * 2 + p] = ss;
            }
          }
        });
      }
    } break;
    case 6: case 10: {
      const float* src = ph == 6 ? (const float*)(ws + OFF_B) : (const float*)(ws + OFF_C + C_H2);
      const float* g = ph == 6 ? P.norm_mq : P.norm_ffn;
      (void)src; (void)g;
    } break;
    case 7: {
      const int xq = blockIdx.x & 7, lq = blockIdx.x >> 3, sq = gridDim.x >> 3;
      for (int t = lq; t < 16 * 4; t += sq) {
        const int mt = xq * 16 + (t & 15), nt = t >> 4, brow = mt * 128;
        RowLin ar{(const bf16_t*)(ws + OFF_A) + (long)brow * 1024, 1024}; RowLin br{(const bf16_t*)(ws + OFF_WMQ) + (long)nt * 128 * 1024, 1024};
        gemm_tile(smem, ar, br, 16, 64, 64, [&](const float* Cs) {
          bf16_t* dq = (bf16_t*)(ws + OFF_D) + (long)brow * 512 + nt * 128; const float* sq1 = (const float*)(ws + OFF_SSQ1) + (long)brow * 8;
#pragma unroll 2
          for (int it = 0; it < 8; ++it) {
            int id = it * 256 + tid; int r = id >> 4, c = (id & 15) * 8; float v[8]; ld8(Cs, r, c, v);
            const f32x4 s0 = *(const f32x4*)(sq1 + r * 8), s1 = *(const f32x4*)(sq1 + r * 8 + 4);
            const float ssum = ((s0[0] + s0[1]) + (s0[2] + s0[3])) + ((s1[0] + s1[1]) + (s1[2] + s1[3]));
            const float rr = rsqrtf(ssum * (1.f / 1024.f) + 1e-6f) * (0.08838834764831845f * LOG2E);
#pragma unroll
            for (int i = 0; i < 8; ++i) v[i] *= rr;
            *(u32x4*)(dq + (long)r * 512 + c) = pack8(v);
          }
        });
        asm volatile("s_waitcnt vmcnt(0)" ::: "memory");
        __syncthreads();
        xattn_tile(P, ((brow >> 5) + (tid >> 6)) * 4 + nt);
      }
    } break;
    case 8: {
      if (ph_fused) break;
      for (int job = blockIdx.x; job < 512; job += gridDim.x) xattn_tile(P, job * 4 + (tid >> 6));
    } break;
    case 11: {
      const int xq = blockIdx.x & 7, lq = blockIdx.x >> 3, sq = gridDim.x >> 3;
      for (int t = lq; t < 16 * 22; t += sq) {
        const int mt = xq * 16 + (t & 15), nt2 = t >> 4, brow = mt * 128;
        RowLin ar{(const bf16_t*)(ws + OFF_A) + (long)brow * 1024, 1024}; RowLin br{(const bf16_t*)(ws + OFF_WGU) + (long)nt2 * 256 * 1024, 1024};
        gemm_tile2(smem, ar, br, 16, [&](const float* Cs, int p) {
          bf16_t* ACT = (bf16_t*)(ws + OFF_B) + (long)brow * 2816 + (nt2 * 2 + p) * 64;
#pragma unroll 2
          for (int it = 0; it < 4; ++it) {
            int id = it * 256 + tid; int r = id >> 3, c = (id & 7) * 8; float gt[8], up[8]; ld8(Cs, r, c, gt); ld8(Cs, r, c + 64, up);
            const float* sq2 = (const float*)(ws + OFF_SSQ2) + (long)(brow + r) * 8;
            const f32x4 s0 = *(const f32x4*)(sq2), s1 = *(const f32x4*)(sq2 + 4);
            const float ssum = ((s0[0] + s0[1]) + (s0[2] + s0[3])) + ((s1[0] + s1[1]) + (s1[2] + s1[3]));
            const float rr = rsqrtf(ssum * (1.f / 1024.f) + 1e-6f);
#pragma unroll
            for (int i = 0; i < 8; ++i) { const float gg = gt[i] * rr; gt[i] = gg * sigm(gg) * (up[i] * rr); }
            __builtin_nontemporal_store(pack8(gt), (u32x4*)(ACT + (long)r * 2816 + c));
          }
        });
      }
    } break;
    case 13: {
      for (int job = blockIdx.x; job < 1024; job += gridDim.x) { int row = job * 16 + (tid >> 6) * 4; rownorm_rows<true, 4>(P.out + (long)row * 1024, P.norm_final, P.out + (long)row * 1024); }
    } break;
#ifdef PROBE_K
    case 14: {
      const bf16_t* s0 = (const bf16_t*)(ws + PROBE_SRC0); const bf16_t* s1 = (const bf16_t*)(ws + PROBE_SRC1);
      for (long i = (long)blockIdx.x * 256 + tid; i < (long)M_ * 512; i += (long)gridDim.x * 256) {
        long row = i >> 9; int c = (int)(i & 511);
        P.out[row * 1024 + c] = bf2f(s0[i]); P.out[row * 1024 + 512 + c] = bf2f(s1[i]);
      }
    } break;
    case 15: {
      const float* s0 = (const float*)(ws + PROBE_SRC0);
      for (long i = (long)blockIdx.x * 256 + tid; i < (long)M_ * 1024; i += (long)gridDim.x * 256) P.out[i] = s0[i];
    } break;
#endif
  }
}

__global__ void __launch_bounds__(256, 2) fwd_kernel(Params P, int ph_lo, int ph_hi) {
  __shared__ __attribute__((aligned(16))) char smem[81920];
  unsigned st_nloc = 0u, st_nx = 0u;
  const unsigned xcc = xb_xcc_id();
  if (ph_lo < ph_hi) {
    if (threadIdx.x == 0) (void)xb_add(&((unsigned*)(P.ws + OFF_BAR))[XB_XCNT(xcc)], 1u);
  }
  if (ph_hi < 0) cg::this_grid().sync();
  for (int ph = ph_lo; ph <= ph_hi; ++ph) {
    const uint64_t __attribute__((address_space(4)))* ka = (const uint64_t __attribute__((address_space(4)))*)__builtin_amdgcn_kernarg_segment_ptr();
    asm volatile("" : "+s"(ka));
    Params Pl; uint64_t* pd = (uint64_t*)&Pl;
#pragma unroll
    for (int i = 0; i < (int)(sizeof(Params) / 8); ++i) {
      const char __attribute__((address_space(1)))* gp = (const char __attribute__((address_space(1)))*)ka[i];
      pd[i] = (uint64_t)(const char*)gp;
    }
    if (ph == 6 || ph == 10 || ph == 8) continue;
    run_phase(Pl, ph, smem, true);
    if (ph < ph_hi) xcd_barrier((unsigned*)(Pl.ws + OFF_BAR), xcc, st_nloc, st_nx);
  }
}

extern "C" void kernel_launch(void* const* d_in, const int* in_sizes, int n_in, void* d_out, int out_size, void* d_ws, size_t ws_size,
                              hipStream_t stream) {
  static int grid_blocks = 0;
  if (!grid_blocks) {
    int dev = 0, cus = 0, per_cu = 0;
    hipGetDevice(&dev);
    hipDeviceGetAttribute(&cus, hipDeviceAttributeMultiprocessorCount, dev);
    hipOccupancyMaxActiveBlocksPerMultiprocessor(&per_cu, fwd_kernel, 256, 0);
    if (per_cu > 2) per_cu = 2;
    if (per_cu < 1) per_cu = 1;
    grid_blocks = cus * per_cu;
  }
  if (ws_size < (size_t)WS_NEED) fprintf(stderr, "workspace too small: %zu < %ld\n", ws_size, (long)WS_NEED);
  Params P{};
  const float** pp = (const float**)&P;
  for (int i = 0; i < 27; ++i) pp[i] = (const float*)d_in[i];
  P.out = (float*)d_out; P.ws = (char*)d_ws;
#if ONE_LAUNCH
  hipMemsetAsync((char*)d_ws + OFF_BAR, 0, XCD_BAR_WORDS * 4, stream);
#ifdef PROBE_K
  int lo = 0, hi = PROBE_DUMP;
#else
  int lo = 0, hi = 13;
#endif
  void* args[] = {&P, &lo, &hi};
  hipError_t e = hipLaunchCooperativeKernel((void*)fwd_kernel, dim3(grid_blocks), dim3(256), args, 0, stream);
  if (e != hipSuccess) fprintf(stderr, "cooperative launch failed: %s (grid %d)\n", hipGetErrorString(e), grid_blocks);
#else
  for (int ph = 0; ph <= 13; ++ph) fwd_kernel<<<grid_blocks, 256, 0, stream>>>(P, ph, ph);
#endif
}
```

```cpp
#include <hip/hip_runtime.h>
#include <hip/hip_cooperative_groups.h>
#include <stdint.h>
#include <stdio.h>
namespace cg = cooperative_groups;

#ifndef NSA_G0
#define NSA_G0 1.f
#define NSA_G1 1.f
#define NSA_G2 1.f
#endif
#ifndef ONE_LAUNCH
#define ONE_LAUNCH 1
#endif

typedef unsigned short bf16_t;
using bf16x8 = __attribute__((ext_vector_type(8))) short;
using f32x4 = __attribute__((ext_vector_type(4))) float;
using u32x4 = __attribute__((ext_vector_type(4))) unsigned;
using u32x2 = __attribute__((ext_vector_type(2))) unsigned;

#define T_ 8192
#define M_ 16384
#define NEGF (-1e30f)
#define LOG2E 1.4426950408889634f

constexpr long OFF_W1 = 0;
constexpr long OFF_WMKV = OFF_W1 + 4608L * 1024 * 2;
constexpr long OFF_WPA = OFF_WMKV + 2097152;
constexpr long OFF_WPB = OFF_WPA + 1048576;
constexpr long OFF_WOUT = OFF_WPB + 1048576;
constexpr long OFF_WMQ = OFF_WOUT + 2097152;
constexpr long OFF_WMO = OFF_WMQ + 1048576;
constexpr long OFF_WGU = OFF_WMO + 1048576;
constexpr long OFF_WDN = OFF_WGU + 11534336;
constexpr long OFF_WCK1 = OFF_WDN + 5767168;
constexpr long OFF_WCV1 = OFF_WCK1 + 524288;
constexpr long OFF_WM = OFF_WCV1 + 524288;
constexpr long OFF_BIAS1 = OFF_WM + 131072;
constexpr long OFF_MEMN = OFF_BIAS1 + 1024;
constexpr long OFF_MK = OFF_MEMN + 1048576;
constexpr long OFF_MVT = OFF_MK + 524288;
constexpr long OFF_KCMP = OFF_MVT + 524288;
constexpr long OFF_VCT = OFF_KCMP + 262144;
constexpr long OFF_A = OFF_VCT + 262144;
constexpr long OFF_B = OFF_A + 33554432;
constexpr long OFF_D = OFF_B + 67108864;
constexpr long OFF_C = OFF_D + 33554432;
constexpr long C_Q = 0, C_U = 16777216, C_GVT = 33554432, C_KC = 50331648, C_VC = 54525952, C_KS = 58720256,
               C_KW = 62914560, C_VST = 67108864, C_VWT = 71303168, C_GATES = 75497472;
constexpr long C_MIXED = 0, C_SCR = 33554432, C_H2 = 0;
constexpr long OFF_BAR = OFF_C + 77070336;
constexpr long OFF_SSQ1 = OFF_BAR + 16384;
constexpr long OFF_SSQ2 = OFF_SSQ1 + 524288;
constexpr long WS_NEED = OFF_SSQ2 + 524288;

struct Params {
  const float *x, *mem, *norm_mix, *w_in, *w_ck1, *w_ck2, *w_cv1, *w_cv2, *pe_k, *pe_v, *ln_sgu, *w_sp, *b_sp,
      *w_pa, *w_pb, *w_merge, *b_merge, *w_out, *norm_mq, *norm_mkv, *w_mq, *w_mkv, *w_mo, *norm_ffn, *w_gu, *w_dn, *norm_final;
  float* out;
  char* ws;
};

__device__ __forceinline__ int tidx() { int t = threadIdx.x; asm volatile("" : "+v"(t)); return t; }
__device__ __forceinline__ unsigned f2bf(float f) { unsigned u = __float_as_uint(f); u += 0x7fffu + ((u >> 16) & 1u); return u >> 16; }
__device__ __forceinline__ unsigned pack2(float a, float b) { unsigned r; asm("v_cvt_pk_bf16_f32 %0, %1, %2" : "=v"(r) : "v"(a), "v"(b)); return r; }
__device__ __forceinline__ float bf2f(unsigned h) { return __uint_as_float(h << 16); }
__device__ __forceinline__ float gelu_tanh(float x) { float u = 0.7978845608028654f * (x + 0.044715f * x * x * x); return x / (1.f + __expf(-2.f * u)); }
__device__ __forceinline__ float sigm(float x) { return 1.f / (1.f + __expf(-x)); }
__device__ __forceinline__ float wave_sum(float v) {
#pragma unroll
  for (int o = 32; o > 0; o >>= 1) v += __shfl_xor(v, o, 64);
  return v;
}
__device__ __forceinline__ u32x4 pack8(const float (&v)[8]) {
  u32x4 r; r[0] = pack2(v[0], v[1]); r[1] = pack2(v[2], v[3]); r[2] = pack2(v[4], v[5]); r[3] = pack2(v[6], v[7]); return r;
}

__device__ __forceinline__ int lds_byte(int r, int c) {
  int st = (r >> 4) * 2 + (c >> 5), rr = r & 15, cc = c & 31, ob = rr * 64 + cc * 2;
  return st * 1024 + (ob ^ (((ob >> 9) & 1) << 5));
}
__device__ __forceinline__ void stage_rc(int b, int& R, int& C) {
  int st = b >> 10, sb = b & 1023, swz = sb ^ (((sb >> 9) & 1) << 5);
  R = (st >> 1) * 16 + (swz >> 6); C = (st & 1) * 32 + ((swz & 63) >> 1);
}

#define CS_LD 132
__device__ __forceinline__ void ld8(const float* Cs, int r, int c, float (&v)[8]) {
  f32x4 a = *(const f32x4*)(Cs + r * CS_LD + c); f32x4 b = *(const f32x4*)(Cs + r * CS_LD + c + 4);
  v[0] = a[0]; v[1] = a[1]; v[2] = a[2]; v[3] = a[3]; v[4] = b[0]; v[5] = b[1]; v[6] = b[2]; v[7] = b[3];
}
__device__ __forceinline__ void ld8T(const float* Cs, int r8, int c, float (&v)[8]) {
#pragma unroll
  for (int i = 0; i < 8; ++i) v[i] = Cs[(r8 + i) * CS_LD + c];
}

struct RowLin {
  const bf16_t* base; long ld;
  __device__ __forceinline__ const bf16_t* operator()(int r) const { return base + (long)r * ld; }
};
struct RowCmp {
  const bf16_t* base; int brow;
  __device__ __forceinline__ const bf16_t* operator()(int r) const {
    int R = brow + r; int b = R >> 10, rem = R & 1023, i = rem >> 1, g = rem & 1; if (i > 510) i = 510;
    return base + ((long)(b * T_ + 16 * i) * 128 + g * 64);
  }
};

template <int AUX = 0, class ARow, class BRow, class Epi>
__device__ __forceinline__ void gemm_tile(char* smem, ARow arow, BRow brow, int nkt, int kstepA, int kstepB, Epi epi) {
  const int tid = tidx(), lane = tid & 63, wave = tid >> 6, wr = wave >> 1, wc = wave & 1, fr = lane & 15, fq = lane >> 4;
  const bf16_t* pa[4]; const bf16_t* pb[4];
#pragma unroll
  for (int i = 0; i < 4; ++i) { int b = tid * 16 + i * 4096; int R, C; stage_rc(b, R, C); pa[i] = arow(R) + C; pb[i] = brow(R) + C; }
  f32x4 acc[4][4];
#pragma unroll
  for (int m = 0; m < 4; ++m)
#pragma unroll
    for (int n = 0; n < 4; ++n) acc[m][n] = (f32x4){0.f, 0.f, 0.f, 0.f};
  {
#pragma unroll
    for (int i = 0; i < 4; ++i) {
      __builtin_amdgcn_global_load_lds((const unsigned*)(pa[i]), (unsigned*)(smem + tid * 16 + i * 4096), 16, 0, AUX);
      __builtin_amdgcn_global_load_lds((const unsigned*)(pb[i]), (unsigned*)(smem + 16384 + tid * 16 + i * 4096), 16, 0, AUX);
    }
  }
  for (int kt = 0; kt < nkt; ++kt) {
    asm volatile("s_waitcnt vmcnt(0)" ::: "memory");
    __syncthreads();
    if (kt + 1 < nkt) {
      char* la = smem + ((kt + 1) & 1) * 32768;
#pragma unroll
      for (int i = 0; i < 4; ++i) {
        __builtin_amdgcn_global_load_lds((const unsigned*)(pa[i] + (long)(kt + 1) * kstepA), (unsigned*)(la + tid * 16 + i * 4096), 16, 0, AUX);
        __builtin_amdgcn_global_load_lds((const unsigned*)(pb[i] + (long)(kt + 1) * kstepB), (unsigned*)(la + 16384 + tid * 16 + i * 4096), 16, 0, AUX);
      }
    }
    const char* la = smem + (kt & 1) * 32768; const char* lb = la + 16384;
#pragma unroll
    for (int ks = 0; ks < 2; ++ks) {
      bf16x8 a[4], b[4];
#pragma unroll
      for (int m = 0; m < 4; ++m) a[m] = *(const bf16x8*)(la + lds_byte(wr * 64 + m * 16 + fr, ks * 32 + fq * 8));
#pragma unroll
      for (int n = 0; n < 4; ++n) b[n] = *(const bf16x8*)(lb + lds_byte(wc * 64 + n * 16 + fr, ks * 32 + fq * 8));
#pragma unroll
      for (int m = 0; m < 4; ++m)
#pragma unroll
        for (int n = 0; n < 4; ++n) acc[m][n] = __builtin_amdgcn_mfma_f32_16x16x32_bf16(a[m], b[n], acc[m][n], 0, 0, 0);
    }
  }
  __syncthreads();
  float* Cs = (float*)smem;
#pragma unroll
  for (int m = 0; m < 4; ++m)
#pragma unroll
    for (int n = 0; n < 4; ++n)
#pragma unroll
      for (int r = 0; r < 4; ++r) Cs[(wr * 64 + m * 16 + fq * 4 + r) * CS_LD + wc * 64 + n * 16 + fr] = acc[m][n][r];
  __syncthreads();
  epi(Cs);
  __syncthreads();
}

template <class F>
__device__ __forceinline__ void store_rows_bf16(const float* Cs, bf16_t* dst, long ld, F f) {
#pragma unroll 2
  for (int it = 0; it < 8; ++it) {
    int id = it * 256 + tidx(); int r = id >> 4, c = (id & 15) * 8;
    float v[8]; ld8(Cs, r, c, v);
#pragma unroll
    for (int i = 0; i < 8; ++i) v[i] = f(v[i], c + i);
    *(u32x4*)(dst + (long)r * ld + c) = pack8(v);
  }
}
template <class F>
__device__ __forceinline__ void store_T_bf16(const float* Cs, bf16_t* dst, long cstride, F f) {
#pragma unroll 2
  for (int it = 0; it < 8; ++it) {
    int id = it * 256 + tidx(); int c = id >> 4, r8 = (id & 15) * 8;
    float v[8]; ld8T(Cs, r8, c, v);
#pragma unroll
    for (int i = 0; i < 8; ++i) v[i] = f(v[i]);
    *(u32x4*)(dst + (long)c * cstride + r8) = pack8(v);
  }
}


__device__ __forceinline__ int lds_byte32(int r, int c) { int rr = r & 15; return (r >> 4) * 1024 + rr * 64 + ((((c >> 3) ^ ((-(rr >> 2)) & 3)) & 3) << 4); }
__device__ __forceinline__ void stage_rc32(int b, int& R, int& C) { int st = b >> 10, sb = b & 1023, rr = sb >> 6, cp = (sb >> 4) & 3; R = st * 16 + rr; C = ((cp ^ ((-(rr >> 2)) & 3)) & 3) * 8; }
struct RowClamp {
  const bf16_t* base; long ld; int maxr;
  __device__ __forceinline__ const bf16_t* operator()(int r) const { return base + (long)(r < maxr ? r : maxr) * ld; }
};
__device__ __forceinline__ int lds_byte64(int r, int c) { int rr = r & 15; return (r >> 4) * 2048 + rr * 128 + ((((c >> 3) ^ (rr >> 1)) & 7) << 4); }
__device__ __forceinline__ void stage_rc64(int b, int& R, int& C) { int st = b >> 11, sb = b & 2047, rr = sb >> 7, cp = (sb >> 4) & 7; R = st * 16 + rr; C = ((cp ^ (rr >> 1)) & 7) * 8; }
template <class ARow, class BRow, class Epi>
__device__ __forceinline__ void gemm_tile2(char* smem, ARow arow, BRow brow, int nkt, Epi epi) {
  const int tid = tidx(), lane = tid & 63, wave = tid >> 6, wr = wave >> 1, wc = wave & 1, fr = lane & 15, fq = lane >> 4;
  int R0, C0; stage_rc64(tid * 16, R0, C0);
  const bf16_t* pa0 = arow(R0) + C0; const bf16_t* pb0 = brow(R0) + C0;
  const long sa32 = 32 * arow.ld, sb32 = 32 * brow.ld;
  f32x4 acc[4][8];
#pragma unroll
  for (int m = 0; m < 4; ++m)
#pragma unroll
    for (int n = 0; n < 8; ++n) acc[m][n] = (f32x4){0.f, 0.f, 0.f, 0.f};
  __syncthreads();
#pragma unroll
  for (int i = 0; i < 4; ++i) __builtin_amdgcn_global_load_lds((const unsigned*)(pa0 + i * sa32), (unsigned*)(smem + tid * 16 + i * 4096), 16, 0, 0);
#pragma unroll
  for (int i = 0; i < 8; ++i) __builtin_amdgcn_global_load_lds((const unsigned*)(pb0 + i * sb32), (unsigned*)(smem + 16384 + tid * 16 + i * 4096), 16, 0, 0);
  for (int kt = 0; kt < nkt; ++kt) {
    asm volatile("s_waitcnt vmcnt(0)" ::: "memory");
    __syncthreads();
    if (kt + 1 < nkt) {
      char* bn = smem + 16384 + ((kt + 1) & 1) * 32768;
#pragma unroll
      for (int i = 0; i < 8; ++i) __builtin_amdgcn_global_load_lds((const unsigned*)(pb0 + i * sb32 + (long)(kt + 1) * 64), (unsigned*)(bn + tid * 16 + i * 4096), 16, 0, 0);
    }
    {
      const char* pA = smem + lds_byte64(wr * 64 + fr, fq * 8);
      const char* pB = smem + 16384 + (kt & 1) * 32768 + lds_byte64(wc * 128 + fr, fq * 8);
      const int k1 = lds_byte64(fr, 32 + fq * 8) - lds_byte64(fr, fq * 8);
#pragma unroll
      for (int ks = 0; ks < 2; ++ks) {
        bf16x8 a[4], bb[8];
#pragma unroll
        for (int m = 0; m < 4; ++m) a[m] = *(const bf16x8*)(pA + m * 2048 + ks * k1);
#pragma unroll
        for (int n = 0; n < 8; ++n) bb[n] = *(const bf16x8*)(pB + n * 2048 + ks * k1);
#pragma unroll
        for (int m = 0; m < 4; ++m)
#pragma unroll
          for (int n = 0; n < 8; ++n) acc[m][n] = __builtin_amdgcn_mfma_f32_16x16x32_bf16(a[m], bb[n], acc[m][n], 0, 0, 0);
      }
    }
    __syncthreads();
    if (kt + 1 < nkt) {
#pragma unroll
      for (int i = 0; i < 4; ++i) __builtin_amdgcn_global_load_lds((const unsigned*)(pa0 + i * sa32 + (long)(kt + 1) * 64), (unsigned*)(smem + tid * 16 + i * 4096), 16, 0, 0);
    }
  }
  float* Cs = (float*)smem;
#pragma unroll
  for (int p = 0; p < 2; ++p) {
    __syncthreads();
    if (wc == p) {
#pragma unroll
      for (int m = 0; m < 4; ++m)
#pragma unroll
        for (int n = 0; n < 8; ++n)
#pragma unroll
          for (int r = 0; r < 4; ++r) Cs[(wr * 64 + m * 16 + fq * 4 + r) * CS_LD + n * 16 + fr] = acc[m][n][r];
    }
    __syncthreads();
    epi(Cs, p);
  }
  __syncthreads();
}

template <int MODE>
__device__ __forceinline__ void transpose_tile(const float* W, int Nsrc, bf16_t* Wt, int Kd, int k0, int n0, float* lds) {
  const int tid = tidx();
  {
    int tx = tid & 63, ty = tid >> 6; int np = n0 + tx; int sc;
    if (MODE == 0) sc = np < Nsrc ? np : -1;
    else { int x = np & 127, tl = np >> 7; sc = x < 64 ? tl * 64 + x : 2816 + tl * 64 + x - 64; }
    float v[32];
#pragma unroll
    for (int i = 0; i < 32; ++i) v[i] = sc >= 0 ? W[(long)(k0 + ty + 4 * i) * Nsrc + sc] : 0.f;
#pragma unroll
    for (int i = 0; i < 32; ++i) lds[(ty + 4 * i) * 65 + tx] = v[i];
  }
  __syncthreads();
  {
    int nrow = tid >> 2, kseg = (tid & 3) * 32;
#pragma unroll
    for (int q = 0; q < 4; ++q) {
      float v[8];
#pragma unroll
      for (int i = 0; i < 8; ++i) v[i] = lds[(kseg + q * 8 + i) * 65 + nrow];
      *(u32x4*)(Wt + (long)(n0 + nrow) * Kd + k0 + kseg + q * 8) = pack8(v);
    }
  }
  __syncthreads();
}

template <bool OUTF, int NR>
__device__ __forceinline__ void rownorm_rows(const float* src, const float* g, void* dst) {
  const int lane = tidx() & 63;
  f32x4 v[NR][4];
#pragma unroll
  for (int r = 0; r < NR; ++r)
#pragma unroll
    for (int i = 0; i < 4; ++i) v[r][i] = *(const f32x4*)(src + (long)r * 1024 + i * 256 + lane * 4);
  f32x4 gg[4];
#pragma unroll
  for (int i = 0; i < 4; ++i) gg[i] = *(const f32x4*)(g + i * 256 + lane * 4);
#pragma unroll
  for (int r = 0; r < NR; ++r) {
    float ss = 0.f;
#pragma unroll
    for (int i = 0; i < 4; ++i) ss += v[r][i][0] * v[r][i][0] + v[r][i][1] * v[r][i][1] + v[r][i][2] * v[r][i][2] + v[r][i][3] * v[r][i][3];
    ss = wave_sum(ss);
    const float rr = rsqrtf(ss * (1.f / 1024.f) + 1e-6f);
#pragma unroll
    for (int i = 0; i < 4; ++i) {
      float o0 = v[r][i][0] * rr * gg[i][0], o1 = v[r][i][1] * rr * gg[i][1], o2 = v[r][i][2] * rr * gg[i][2], o3 = v[r][i][3] * rr * gg[i][3];
      if (OUTF) { *(f32x4*)((float*)dst + (long)r * 1024 + i * 256 + lane * 4) = (f32x4){o0, o1, o2, o3}; }
      else { u32x2 p; p[0] = pack2(o0, o1); p[1] = pack2(o2, o3); *(u32x2*)((bf16_t*)dst + (long)r * 1024 + i * 256 + lane * 4) = p; }
    }
  }
}

__device__ void phase0(const Params& P, char* smem) {
  float* lds = (float*)smem;
  const int tid = tidx();
  const int NJ = 8 + 1024 + 32 + 32 + 2192;
  for (int job = blockIdx.x; job < NJ; job += gridDim.x) {
    int j = job;
    if (j < 8) {
      int n = j * 32 + (tid & 31), sl = tid >> 5; int kv = n >> 7, nn = n & 127;
      const float* pe = kv ? P.pe_v : P.pe_k; const float* w1 = kv ? P.w_cv1 : P.w_ck1;
      float s = 0.f;
      for (int k = sl * 256; k < sl * 256 + 256; ++k) s += pe[k] * w1[(long)k * 128 + nn];
      lds[sl * 32 + (tid & 31)] = s;
      __syncthreads();
      if (tid < 32) { float t = 0.f; for (int q = 0; q < 8; ++q) t += lds[q * 32 + tid]; ((float*)(P.ws + OFF_BIAS1))[j * 32 + tid] = t; }
      __syncthreads();
      continue;
    }
    j -= 8;
    if (j < 1024) { int row = j * 16 + (tid >> 6) * 4; rownorm_rows<false, 4>(P.x + (long)row * 1024, P.norm_mix, (bf16_t*)(P.ws + OFF_A) + (long)row * 1024); continue; }
    j -= 1024;
    if (j < 32) { int row = j * 16 + (tid >> 6) * 4; rownorm_rows<false, 4>(P.mem + (long)row * 1024, P.norm_mkv, (bf16_t*)(P.ws + OFF_MEMN) + (long)row * 1024); continue; }
    j -= 32;
    if (j < 32) {
      int e0 = j * 2048 + tid * 8; float v[8];
#pragma unroll
      for (int i = 0; i < 8; ++i) { int e = e0 + i; int t = (e >> 7) & 127, s = e & 127; v[i] = s <= t ? P.w_sp[e] : 0.f; }
      *(u32x4*)((bf16_t*)(P.ws + OFF_WM) + e0) = pack8(v);
      continue;
    }
    j -= 32;
#define TRJ(KT, NT, W, NSRC, WT, KD, MODE) \
    if (j < (KT) * (NT)) { transpose_tile<MODE>(W, NSRC, (bf16_t*)(P.ws + (WT)), KD, (j % (KT)) * 128, (j / (KT)) * 64, lds); continue; } \
    j -= (KT) * (NT);
    TRJ(8, 88, P.w_gu, 5632, OFF_WGU, 1024, 1)
    TRJ(22, 16, P.w_dn, 1024, OFF_WDN, 2816, 0)
    TRJ(8, 38, P.w_in, 2328, OFF_W1, 1024, 0)
    TRJ(8, 32, P.w_merge, 2048, OFF_W1 + 2432L * 1024 * 2, 1024, 0)
    TRJ(8, 16, P.w_mkv, 1024, OFF_WMKV, 1024, 0)
    TRJ(8, 16, P.w_out, 1024, OFF_WOUT, 1024, 0)
    TRJ(4, 16, P.w_pa, 1024, OFF_WPA, 512, 0)
    TRJ(4, 16, P.w_pb, 1024, OFF_WPB, 512, 0)
    TRJ(8, 8, P.w_mq, 512, OFF_WMQ, 1024, 0)
    TRJ(4, 16, P.w_mo, 1024, OFF_WMO, 512, 0)
    TRJ(16, 2, P.w_ck1, 128, OFF_WCK1, 2048, 0)
    TRJ(16, 2, P.w_cv1, 128, OFF_WCV1, 2048, 0)
#undef TRJ
  }
}

__device__ void phase1(const Params& P, char* smem) {
  char* ws = P.ws;
  const int NG1 = 128 * 18;
  const int xq = blockIdx.x & 7, lq = blockIdx.x >> 3, sq = gridDim.x >> 3;
  for (int t = lq; t < 16 * 12; t += sq) {
    {
      const int mt = xq * 16 + (t & 15), nt2 = t >> 4; const int brow = mt * 128;
      RowLin ar{(const bf16_t*)(ws + OFF_A) + (long)brow * 1024, 1024};
      RowLin br{(const bf16_t*)(ws + OFF_W1) + (long)nt2 * 256 * 1024, 1024};
      gemm_tile2(smem, ar, br, 16, [&](const float* Cs, int p) {
        const int nt = nt2 * 2 + p; if (nt >= 35) return;
        char* C = ws + OFF_C;
        if (nt < 4) {
          store_rows_bf16(Cs, (bf16_t*)(C + C_Q) + (long)brow * 512 + nt * 128, 512, [](float v, int) { return v * (0.125f * LOG2E); });
        } else if (nt == 4 || nt == 5 || nt == 6 || nt == 8) {
          long off = nt == 4 ? C_KC : nt == 5 ? C_VC : nt == 6 ? C_KS : C_KW;
          store_rows_bf16(Cs, (bf16_t*)(C + off) + (long)brow * 128, 128, [](float v, int) { return v; });
        } else if (nt == 7 || nt == 9) {
          long off = nt == 7 ? C_VST : C_VWT; int b = brow >> 13, tl = brow & 8191;
          store_T_bf16(Cs, (bf16_t*)(C + off) + (long)b * 128 * T_ + tl, T_, [](float v) { return v; });
        } else if (nt < 14) {
          store_rows_bf16(Cs, (bf16_t*)(C + C_U) + (long)brow * 512 + (nt - 10) * 128, 512, [](float v, int) { return gelu_tanh(v); });
        } else if (nt < 18) {
          store_T_bf16(Cs, (bf16_t*)(C + C_GVT) + ((long)(brow >> 7) * 512 + (nt - 14) * 128) * 128, 128, [](float v) { return gelu_tanh(v); });
        } else if (nt == 18) {
          float* gates = (float*)(C + C_GATES);
          for (int id = tidx(); id < 128 * 24; id += 256) { int r = id / 24, c = id % 24; gates[(long)(brow + r) * 24 + c] = sigm(Cs[r * CS_LD + c]); }
        } else {
          const float* bm = P.b_merge + (nt - 19) * 128;
          store_rows_bf16(Cs, (bf16_t*)(ws + OFF_B) + (long)brow * 2048 + (nt - 19) * 128, 2048, [bm](float v, int c) { return sigm(v + bm[c]); });
        }
      });
    }
  }
}

__device__ void phase2(const Params& P, char* smem) {
  char* ws = P.ws; const int tid = tidx();
  for (int job = blockIdx.x; job < 32 + 128; job += gridDim.x) {
    if (job < 32) {
      const int kv = job >> 4, mt = job & 15, brow = mt * 128;
      RowCmp ar{(const bf16_t*)(ws + OFF_C + (kv ? C_VC : C_KC)), brow};
      RowLin br{(const bf16_t*)(ws + (kv ? OFF_WCV1 : OFF_WCK1)), 2048};
      const float* bias1 = (const float*)(ws + OFF_BIAS1) + kv * 128;
      const float* w2 = kv ? P.w_cv2 : P.w_ck2;
      gemm_tile(smem, ar, br, 32, 128, 64, [&](const float* Csc) {
        float* Cs = (float*)Csc;
        for (int it = 0; it < 64; ++it) { int id = it * 256 + tid; int r = id >> 7, n = id & 127; Cs[r * CS_LD + n] = gelu_tanh(Cs[r * CS_LD + n] + bias1[n]); }
        __syncthreads();
        const int r = tid >> 1, half = tid & 1;
        float acc[32];
#pragma unroll
        for (int i = 0; i < 32; ++i) acc[i] = 0.f;
        for (int n = 0; n < 128; ++n) {
          float h = Cs[r * CS_LD + n]; const float* wr = w2 + n * 64 + half * 32;
#pragma unroll
          for (int q = 0; q < 8; ++q) { f32x4 w = *(const f32x4*)(wr + q * 4); acc[q * 4] += h * w[0]; acc[q * 4 + 1] += h * w[1]; acc[q * 4 + 2] += h * w[2]; acc[q * 4 + 3] += h * w[3]; }
        }
        const int R = brow + r; const int b = R >> 10, rem = R & 1023, i = rem >> 1, g = rem & 1;
        if (i >= 511) {
#pragma unroll
          for (int q = 0; q < 32; ++q) acc[q] = 0.f;
        }
        if (kv == 0) {
          bf16_t* dst = (bf16_t*)(ws + OFF_KCMP) + (long)(b * 512 + i) * 128 + g * 64 + half * 32;
#pragma unroll
          for (int q = 0; q < 4; ++q) { float v[8];
#pragma unroll
            for (int e = 0; e < 8; ++e) v[e] = acc[q * 8 + e];
            *(u32x4*)(dst + q * 8) = pack8(v); }
        } else {
          bf16_t* dst = (bf16_t*)(ws + OFF_VCT) + ((long)(b * 128 + g * 64 + half * 32)) * 512 + i;
#pragma unroll
          for (int q = 0; q < 32; ++q) dst[(long)q * 512] = (bf16_t)f2bf(acc[q]);
        }
      });
    } else {
      const int bc = job - 32; bf16_t* base = (bf16_t*)(ws + OFF_C + C_GVT) + (long)bc * 512 * 128;
      float* ssum = (float*)smem; float* ssq = ssum + 128;
      float* psum = ssum + 256; float* psq = psum + 16 * 128;
      const int cs = tid >> 4, s8 = (tid & 15) * 8;
      float a[8], q[8];
#pragma unroll
      for (int i = 0; i < 8; ++i) { a[i] = 0.f; q[i] = 0.f; }
      for (int it = 0; it < 32; ++it) {
        u32x4 d = *(const u32x4*)(base + (long)(it * 16 + cs) * 128 + s8);
#pragma unroll
        for (int i = 0; i < 4; ++i) { float lo = bf2f(d[i] & 0xffffu), hi = bf2f(d[i] >> 16); a[2 * i] += lo; q[2 * i] += lo * lo; a[2 * i + 1] += hi; q[2 * i + 1] += hi * hi; }
      }
#pragma unroll
      for (int i = 0; i < 8; ++i) { psum[cs * 128 + s8 + i] = a[i]; psq[cs * 128 + s8 + i] = q[i]; }
      __syncthreads();
      if (tid < 128) {
        float su = 0.f, sq = 0.f;
        for (int c = 0; c < 16; ++c) { su += psum[c * 128 + tid]; sq += psq[c * 128 + tid]; }
        float mean_t = su * (1.f / 512.f); float var = sq * (1.f / 512.f) - mean_t * mean_t; if (var < 0.f) var = 0.f;
        ssum[tid] = mean_t; ssq[tid] = rsqrtf(var + 1e-6f);
      }
      __syncthreads();
      float mean[8], rs[8];
#pragma unroll
      for (int i = 0; i < 8; ++i) { mean[i] = ssum[s8 + i]; rs[i] = ssq[s8 + i]; }
      for (int it = 0; it < 32; ++it) {
        int ch = it * 16 + cs; float gg = P.ln_sgu[ch];
        u32x4 d = *(const u32x4*)(base + (long)ch * 128 + s8); float v[8];
#pragma unroll
        for (int i = 0; i < 4; ++i) { v[2 * i] = bf2f(d[i] & 0xffffu); v[2 * i + 1] = bf2f(d[i] >> 16); }
#pragma unroll
        for (int i = 0; i < 8; ++i) v[i] = (v[i] - mean[i]) * rs[i] * gg;
        *(u32x4*)(base + (long)ch * 128 + s8) = pack8(v);
      }
      __syncthreads();
    }
  }
  if (blockIdx.x >= 32) {
    for (int mtile = blockIdx.x - 32; mtile < 768 + 32; mtile += gridDim.x - 32) {
      if (mtile >= 768) {
        const int j = mtile - 768; const int mt = j >> 3, nt = j & 7; const int brow = mt * 128;
        RowLin ar{(const bf16_t*)(ws + OFF_MEMN) + (long)brow * 1024, 1024};
        RowLin br{(const bf16_t*)(ws + OFF_WMKV) + (long)nt * 128 * 1024, 1024};
        gemm_tile(smem, ar, br, 16, 64, 64, [&](const float* Cs) {
          if (nt < 4) store_rows_bf16(Cs, (bf16_t*)(ws + OFF_MK) + (long)brow * 512 + nt * 128, 512, [](float v, int) { return v; });
          else { int b = mt >> 1, n0 = (mt & 1) * 128; store_T_bf16(Cs, (bf16_t*)(ws + OFF_MVT) + ((long)b * 512 + (nt - 4) * 128) * 256 + n0, 256, [](float v) { return v; }); }
        });
        continue;
      }
      const int mt = mtile & 127, nt2 = 12 + (mtile >> 7), brow = mt * 128;
      RowLin ar{(const bf16_t*)(ws + OFF_A) + (long)brow * 1024, 1024};
      RowLin br{(const bf16_t*)(ws + OFF_W1) + (long)nt2 * 256 * 1024, 1024};
      gemm_tile2(smem, ar, br, 16, [&](const float* Cs, int p) {
        const int nt = nt2 * 2 + p; if (nt >= 35) return;
        const float* bm = P.b_merge + (nt - 19) * 128;
        store_rows_bf16(Cs, (bf16_t*)(ws + OFF_B) + (long)brow * 2048 + (nt - 19) * 128, 2048, [bm](float v, int c) { return sigm(v + bm[c]); });
      });
    }
  }
}

template <int MODE>
__device__ __forceinline__ void nsa_block(const bf16x8 (&qf)[4][2], f32x4 (&oacc)[4][4], float (&m)[4], float (&l)[4],
                                          const float (&sl2)[4], const float (&inv)[4], const bf16_t* kp, const bf16_t* vp, long vdt,
                                          int dist0, bool rowok, float (&asum)[2], float (&bsum)[2]) {
  constexpr int DSTEP = (MODE <= 1) ? 16 : 1;
  bf16x8 kf[2][2];
#pragma unroll
  for (int kt = 0; kt < 2; ++kt)
#pragma unroll
    for (int ks = 0; ks < 2; ++ks) kf[kt][ks] = *(const bf16x8*)(kp + kt * 16 * 128 + ks * 32);
  bf16x8 vf[4];
  if (MODE != 0) {
#pragma unroll
    for (int dt = 0; dt < 4; ++dt) {
      u32x2 lo = *(const u32x2*)(vp + dt * vdt); u32x2 hi = *(const u32x2*)(vp + dt * vdt + 16);
      u32x4 c; c[0] = lo[0]; c[1] = lo[1]; c[2] = hi[0]; c[3] = hi[1];
      vf[dt] = __builtin_bit_cast(bf16x8, c);
    }
  }
  const float fd0 = (float)dist0;
#pragma unroll
  for (int h = 0; h < 4; ++h) {
    f32x4 s[2];
#pragma unroll
    for (int kt = 0; kt < 2; ++kt) {
      s[kt] = __builtin_amdgcn_mfma_f32_16x16x32_bf16(kf[kt][0], qf[h][0], (f32x4){0.f, 0.f, 0.f, 0.f}, 0, 0, 0);
      s[kt] = __builtin_amdgcn_mfma_f32_16x16x32_bf16(kf[kt][1], qf[h][1], s[kt], 0, 0, 0);
    }
    float sc[8]; bool ok[8];
#pragma unroll
    for (int kt = 0; kt < 2; ++kt)
#pragma unroll
      for (int r = 0; r < 4; ++r) {
        const int e = kt * 16 + r; const int dist = dist0 - DSTEP * e;
        bool o = dist >= 0;
        if (MODE == 2) o = o && rowok;
        if (MODE == 3) o = o && (dist < 512);
        ok[kt * 4 + r] = o;
        sc[kt * 4 + r] = o ? s[kt][r] - sl2[h] * (fd0 - (float)(DSTEP * e)) : NEGF;
      }
    float p[8];
    if (MODE != 1) {
      float ml = NEGF;
#pragma unroll
      for (int i = 0; i < 8; ++i) ml = fmaxf(ml, sc[i]);
      ml = fmaxf(ml, __shfl_xor(ml, 16, 64)); ml = fmaxf(ml, __shfl_xor(ml, 32, 64));
      const float mn = fmaxf(m[h], ml); const float alpha = __builtin_amdgcn_exp2f(m[h] - mn); m[h] = mn;
      const float mref = fmaxf(mn, -1e29f);
      float ps = 0.f;
#pragma unroll
      for (int i = 0; i < 8; ++i) { p[i] = __builtin_amdgcn_exp2f(sc[i] - mref); ps += p[i]; }
      l[h] = l[h] * alpha + ps;
      if (MODE != 0) {
        if (__builtin_amdgcn_ballot_w64(alpha != 1.f) != 0ull) {
#pragma unroll
          for (int dt = 0; dt < 4; ++dt) oacc[h][dt] *= alpha;
        }
      }
    } else {
      const float mref1 = fmaxf(m[h], -1e29f);
#pragma unroll
      for (int i = 0; i < 8; ++i) p[i] = __builtin_amdgcn_exp2f(sc[i] - mref1) * l[h];
      asum[0] += (p[0] + p[1]) + (p[2] + p[3]); bsum[0] += p[3];
      asum[1] += (p[4] + p[5]) + (p[6] + p[7]); bsum[1] += p[7];
    }
    if (MODE != 0) {
      u32x4 pk; pk[0] = pack2(p[0], p[1]); pk[1] = pack2(p[2], p[3]); pk[2] = pack2(p[4], p[5]); pk[3] = pack2(p[6], p[7]);
      const bf16x8 pf = __builtin_bit_cast(bf16x8, pk);
#pragma unroll
      for (int dt = 0; dt < 4; ++dt) oacc[h][dt] = __builtin_amdgcn_mfma_f32_16x16x32_bf16(vf[dt], pf, oacc[h][dt], 0, 0, 0);
    }
    __builtin_amdgcn_sched_barrier(0);
  }
}

__device__ void nsa_tile(const Params& P, int wt, char* wl) {
  char* C = P.ws + OFF_C;
  const bf16_t* Q = (const bf16_t*)(C + C_Q);
  const bf16_t* KCMP = (const bf16_t*)(P.ws + OFF_KCMP); const bf16_t* VCT = (const bf16_t*)(P.ws + OFF_VCT);
  const bf16_t* KS = (const bf16_t*)(C + C_KS); const bf16_t* VST = (const bf16_t*)(C + C_VST);
  const bf16_t* KW = (const bf16_t*)(C + C_KW); const bf16_t* VWT = (const bf16_t*)(C + C_VWT);
  const float* GATES = (const float*)(C + C_GATES);
  bf16_t* O = (bf16_t*)(P.ws + OFF_D);
  const int lane = tidx() & 63, qi = lane & 15, quad = lane >> 4;
  wt = __builtin_amdgcn_readfirstlane(wt);
  const int jb = wt >> 2, wv4 = wt & 3;
  const int bg = jb & 3, b = bg >> 1, g = bg & 1;
  const int gq = jb >> 2;
  const int tq = (gq < 64 ? 127 - gq : gq - 64) * 4 + wv4;
  const int t0 = tq * 16;
  const int t = t0 + qi;
  const long row = (long)b * T_ + t;
  bf16x8 qf[4][2];
#pragma unroll
  for (int h = 0; h < 4; ++h)
#pragma unroll
    for (int ks = 0; ks < 2; ++ks) qf[h][ks] = *(const bf16x8*)(Q + row * 512 + (g * 4 + h) * 64 + ks * 32 + quad * 8);
  float sl2[4];
#pragma unroll
  for (int h = 0; h < 4; ++h) sl2[h] = __builtin_amdgcn_exp2f(-(float)(g * 4 + h + 1)) * LOG2E;
  f32x4 oacc[4][4]; float m[4], l[4], inv[4]; float asum[2], bsum[2];
  float* imp = (float*)wl; float* outl = (float*)wl;
  unsigned* sel = (unsigned*)(wl + 16384); unsigned* uni = sel + 64;
#pragma unroll
  for (int h = 0; h < 4; ++h) { m[h] = NEGF; l[h] = 0.f; inv[h] = 0.f; }
  asum[0] = asum[1] = bsum[0] = bsum[1] = 0.f;

  const int nI = t0 >> 4; const int nblk = (nI + 31) >> 5;
  for (int blk = nblk - 1; blk >= 0; --blk) {
    const int key0 = blk * 32;
    const bf16_t* kp = KCMP + (long)(b * 512 + key0 + qi) * 128 + g * 64 + quad * 8;
    nsa_block<0>(qf, oacc, m, l, sl2, inv, kp, nullptr, 0, t - 31 - 16 * (key0 + quad * 4), true, asum, bsum);
  }
#pragma unroll
  for (int h = 0; h < 4; ++h) { float lt = l[h]; lt += __shfl_xor(lt, 16, 64); lt += __shfl_xor(lt, 32, 64); l[h] = 1.f / fmaxf(lt, 1e-30f); }
  for (int i = lane; i < 16 * 132; i += 64) imp[i] = 0.f;
#pragma unroll
  for (int h = 0; h < 4; ++h)
#pragma unroll
    for (int dt = 0; dt < 4; ++dt) oacc[h][dt] = (f32x4){0.f, 0.f, 0.f, 0.f};
  for (int blk = 0; blk < nblk; ++blk) {
    const int key0 = blk * 32;
    const bf16_t* kp = KCMP + (long)(b * 512 + key0 + qi) * 128 + g * 64 + quad * 8;
    const bf16_t* vp = VCT + (long)(b * 128 + g * 64 + qi) * 512 + key0 + quad * 4;
    asum[0] = asum[1] = bsum[0] = bsum[1] = 0.f;
    nsa_block<1>(qf, oacc, m, l, sl2, inv, kp, vp, 16 * 512, t - 31 - 16 * (key0 + quad * 4), true, asum, bsum);
    const int J = (key0 >> 2) + quad;
    atomicAdd(&imp[qi * 132 + J], asum[0]); atomicAdd(&imp[qi * 132 + J + 1], bsum[0]);
    atomicAdd(&imp[qi * 132 + J + 4], asum[1]); atomicAdd(&imp[qi * 132 + J + 5], bsum[1]);
  }
  const int cur = t0 >> 6;
  if (lane < 16) {
    unsigned w0 = 0, w1 = 0, w2 = 0, w3 = 0;
    if (cur < 16) { w0 = (1u << (cur + 1)) - 1u; }
    else {
      w0 = 1u;
      { int j = cur; unsigned bit = 1u << (j & 31); int w = j >> 5; if (w == 0) w0 |= bit; else if (w == 1) w1 |= bit; else if (w == 2) w2 |= bit; else w3 |= bit; }
      { int j = cur - 1; unsigned bit = 1u << (j & 31); int w = j >> 5; if (w == 0) w0 |= bit; else if (w == 1) w1 |= bit; else if (w == 2) w2 |= bit; else w3 |= bit; }
    }
    sel[lane * 4 + 0] = w0; sel[lane * 4 + 1] = w1; sel[lane * 4 + 2] = w2; sel[lane * 4 + 3] = w3;
  }
  if (lane < 4) uni[lane] = 0u;
  if (cur >= 16) {
    for (int rnd = 0; rnd < 4; ++rnd) {
      const int qq = rnd * 4 + quad;
      unsigned key[8];
#pragma unroll
      for (int c = 0; c < 8; ++c) {
        const int j = qi + 16 * c;
        const bool v = (j <= cur) && (j != 0) && (j != cur) && (j != cur - 1);
        const unsigned bits = __float_as_uint(imp[qq * 132 + j]);
        key[c] = v ? ((bits & 0xFFFFFF00u) | (unsigned)(128 - j)) : 0u;
      }
      for (int it = 0; it < 13; ++it) {
        unsigned mx = key[0];
#pragma unroll
        for (int c = 1; c < 8; ++c) mx = key[c] > mx ? key[c] : mx;
#pragma unroll
        for (int o = 1; o < 16; o <<= 1) { unsigned ot = (unsigned)__shfl_xor((int)mx, o, 64); mx = ot > mx ? ot : mx; }
        if (mx != 0u) {
#pragma unroll
          for (int c = 0; c < 8; ++c) {
            if (key[c] == mx) { key[c] = 0u; const int j = qi + 16 * c; atomicOr(&sel[qq * 4 + (j >> 5)], 1u << (j & 31)); }
          }
        }
      }
    }
  }
  unsigned mym[4];
#pragma unroll
  for (int w = 0; w < 4; ++w) mym[w] = sel[qi * 4 + w];
  if (lane < 16) {
#pragma unroll
    for (int w = 0; w < 4; ++w) atomicOr(&uni[w], mym[w]);
  }
  const float* gp = GATES + row * 24 + g * 12;
#pragma unroll
  for (int h = 0; h < 4; ++h) {
    const float gt = gp[h * 3 + 0] * NSA_G0;
#pragma unroll
    for (int dt = 0; dt < 4; ++dt) *(f32x4*)(outl + ((h * 16 + qi) * 64 + (((dt * 4 + quad) ^ qi) << 2))) = oacc[h][dt] * gt;
  }
#pragma unroll
  for (int h = 0; h < 4; ++h) { m[h] = NEGF; l[h] = 0.f;
#pragma unroll
    for (int dt = 0; dt < 4; ++dt) oacc[h][dt] = (f32x4){0.f, 0.f, 0.f, 0.f}; }
#pragma unroll 1
  for (int w = 3; w >= 0; --w) {
    unsigned bits = __builtin_amdgcn_readfirstlane(uni[w]);
    const unsigned myw = sel[qi * 4 + w];
    while (bits) {
      const int jj = 31 - __builtin_clz(bits); bits &= ~(1u << jj);
      const int j = w * 32 + jj; const bool rowok = (myw >> jj) & 1u;
#pragma unroll 1
      for (int half = 1; half >= 0; --half) {
        const int key0 = j * 64 + half * 32;
        const bf16_t* kp = KS + (long)(b * T_ + key0 + qi) * 128 + g * 64 + quad * 8;
        const bf16_t* vp = VST + (long)(b * 128 + g * 64 + qi) * T_ + key0 + quad * 4;
        nsa_block<2>(qf, oacc, m, l, sl2, inv, kp, vp, 16L * T_, t - (key0 + quad * 4), rowok, asum, bsum);
      }
    }
  }
#pragma unroll
  for (int h = 0; h < 4; ++h) {
    float lt = l[h]; lt += __shfl_xor(lt, 16, 64); lt += __shfl_xor(lt, 32, 64);
    const float sc = NSA_G1 * gp[h * 3 + 1] / fmaxf(lt, 1e-30f);
#pragma unroll
    for (int dt = 0; dt < 4; ++dt) { f32x4* d = (f32x4*)(outl + ((h * 16 + qi) * 64 + (((dt * 4 + quad) ^ qi) << 2))); *d = *d + oacc[h][dt] * sc; }
  }
#pragma unroll
  for (int h = 0; h < 4; ++h) { m[h] = NEGF; l[h] = 0.f;
#pragma unroll
    for (int dt = 0; dt < 4; ++dt) oacc[h][dt] = (f32x4){0.f, 0.f, 0.f, 0.f}; }
  {
    const int kstart = t0 >= 512 ? ((t0 - 511) & ~31) : 0;
    for (int key0 = (t0 + 15) & ~31; key0 >= kstart; key0 -= 32) {
      const bf16_t* kp = KW + (long)(b * T_ + key0 + qi) * 128 + g * 64 + quad * 8;
      const bf16_t* vp = VWT + (long)(b * 128 + g * 64 + qi) * T_ + key0 + quad * 4;
      nsa_block<3>(qf, oacc, m, l, sl2, inv, kp, vp, 16L * T_, t - (key0 + quad * 4), true, asum, bsum);
    }
  }
#pragma unroll
  for (int h = 0; h < 4; ++h) {
    float lt = l[h]; lt += __shfl_xor(lt, 16, 64); lt += __shfl_xor(lt, 32, 64);
    const float sc = NSA_G2 * gp[h * 3 + 2] / fmaxf(lt, 1e-30f);
#pragma unroll
    for (int dt = 0; dt < 4; ++dt) { f32x4* d = (f32x4*)(outl + ((h * 16 + qi) * 64 + (((dt * 4 + quad) ^ qi) << 2))); *d = *d + oacc[h][dt] * sc; }
  }
#pragma unroll
  for (int it = 0; it < 8; ++it) {
    const int id = it * 64 + lane; const int h = id >> 7, rem = id & 127, q2 = rem >> 3, c8 = rem & 7;
    f32x4 a = *(const f32x4*)(outl + ((h * 16 + q2) * 64 + (((2 * c8) ^ q2) << 2)));
    f32x4 bb = *(const f32x4*)(outl + ((h * 16 + q2) * 64 + (((2 * c8 + 1) ^ q2) << 2)));
    float v[8] = {a[0], a[1], a[2], a[3], bb[0], bb[1], bb[2], bb[3]};
    *(u32x4*)(O + ((long)b * T_ + t0 + q2) * 512 + (g * 4 + h) * 64 + c8 * 8) = pack8(v);
  }
}

__device__ void xattn_tile(const Params& P, int wt) {
  const bf16_t* HQ = (const bf16_t*)(P.ws + OFF_D);
  const bf16_t* MK = (const bf16_t*)(P.ws + OFF_MK); const bf16_t* MVT = (const bf16_t*)(P.ws + OFF_MVT);
  bf16_t* OX = (bf16_t*)(P.ws + OFF_D) + (long)M_ * 512;
  const int lane = tidx() & 63, qi = lane & 15, quad = lane >> 4;
  wt = __builtin_amdgcn_readfirstlane(wt);
  const int h = wt & 3; const int row0 = (wt >> 2) * 32; const int b = row0 >> 13;
  bf16x8 qf[2][4];
#pragma unroll
  for (int nt = 0; nt < 2; ++nt)
#pragma unroll
    for (int ks = 0; ks < 4; ++ks) qf[nt][ks] = *(const bf16x8*)(HQ + (long)(row0 + nt * 16 + qi) * 512 + h * 128 + ks * 32 + quad * 8);
  f32x4 oacc[2][8]; float m[2], l[2];
#pragma unroll
  for (int nt = 0; nt < 2; ++nt) { m[nt] = NEGF; l[nt] = 0.f;
#pragma unroll
    for (int dt = 0; dt < 8; ++dt) oacc[nt][dt] = (f32x4){0.f, 0.f, 0.f, 0.f}; }
  for (int blk = 0; blk < 8; ++blk) {
    const int key0 = blk * 32;
    f32x4 s[2][2];
#pragma unroll
    for (int nt = 0; nt < 2; ++nt)
#pragma unroll
      for (int kt = 0; kt < 2; ++kt) s[nt][kt] = (f32x4){0.f, 0.f, 0.f, 0.f};
#pragma unroll
    for (int ks = 0; ks < 4; ++ks) {
#pragma unroll
      for (int kt = 0; kt < 2; ++kt) {
        bf16x8 kf = *(const bf16x8*)(MK + (long)(b * 256 + key0 + kt * 16 + qi) * 512 + h * 128 + ks * 32 + quad * 8);
#pragma unroll
        for (int nt = 0; nt < 2; ++nt) s[nt][kt] = __builtin_amdgcn_mfma_f32_16x16x32_bf16(kf, qf[nt][ks], s[nt][kt], 0, 0, 0);
      }
    }
    bf16x8 pf[2];
#pragma unroll
    for (int nt = 0; nt < 2; ++nt) {
      float ml = NEGF;
#pragma unroll
      for (int kt = 0; kt < 2; ++kt)
#pragma unroll
        for (int r = 0; r < 4; ++r) ml = fmaxf(ml, s[nt][kt][r]);
      ml = fmaxf(ml, __shfl_xor(ml, 16, 64)); ml = fmaxf(ml, __shfl_xor(ml, 32, 64));
      const float mn = fmaxf(m[nt], ml); const float alpha = __builtin_amdgcn_exp2f(m[nt] - mn); m[nt] = mn;
      float p[8]; float ps = 0.f;
#pragma unroll
      for (int kt = 0; kt < 2; ++kt)
#pragma unroll
        for (int r = 0; r < 4; ++r) { p[kt * 4 + r] = __builtin_amdgcn_exp2f(s[nt][kt][r] - mn); ps += p[kt * 4 + r]; }
      l[nt] = l[nt] * alpha + ps;
#pragma unroll
      for (int dt = 0; dt < 8; ++dt) oacc[nt][dt] *= alpha;
      u32x4 pk; pk[0] = pack2(p[0], p[1]); pk[1] = pack2(p[2], p[3]); pk[2] = pack2(p[4], p[5]); pk[3] = pack2(p[6], p[7]);
      pf[nt] = __builtin_bit_cast(bf16x8, pk);
    }
#pragma unroll
    for (int dt = 0; dt < 8; ++dt) {
      const bf16_t* vp = MVT + (long)(b * 512 + h * 128 + dt * 16 + qi) * 256 + key0 + quad * 4;
      u32x2 lo = *(const u32x2*)(vp); u32x2 hi = *(const u32x2*)(vp + 16);
      u32x4 c; c[0] = lo[0]; c[1] = lo[1]; c[2] = hi[0]; c[3] = hi[1];
      const bf16x8 vf = __builtin_bit_cast(bf16x8, c);
#pragma unroll
      for (int nt = 0; nt < 2; ++nt) oacc[nt][dt] = __builtin_amdgcn_mfma_f32_16x16x32_bf16(vf, pf[nt], oacc[nt][dt], 0, 0, 0);
    }
  }
#pragma unroll
  for (int nt = 0; nt < 2; ++nt) {
    float lt = l[nt]; lt += __shfl_xor(lt, 16, 64); lt += __shfl_xor(lt, 32, 64);
    const float iv = 1.f / lt;
#pragma unroll
    for (int dt = 0; dt < 8; ++dt) {
      f32x4 v = oacc[nt][dt] * iv; u32x2 pk; pk[0] = pack2(v[0], v[1]); pk[1] = pack2(v[2], v[3]);
      *(u32x2*)(OX + (long)(row0 + nt * 16 + qi) * 512 + h * 128 + dt * 16 + quad * 4) = pk;
    }
  }
}


#define XB_TMO      128
#define XB_XCNT(j)  (256  + 64 * (j))
#define XB_XSUB(j)  (1280 + 64 * (j))
#define XB_XGEN(j)  (2304 + 64 * (j))
#define XB_TOP      3328
#define XB_TOPGEN   3392
#define XCD_BAR_WORDS 3456
#define XB_SPIN_CAP (1u << 18)
#define LAS __attribute__((address_space(3)))
__device__ __forceinline__ unsigned xb_ld(unsigned* p) { return __hip_atomic_load(p, __ATOMIC_RELAXED, __HIP_MEMORY_SCOPE_AGENT); }
__device__ __forceinline__ unsigned xb_add(unsigned* p, unsigned v) { return __hip_atomic_fetch_add(p, v, __ATOMIC_RELAXED, __HIP_MEMORY_SCOPE_AGENT); }
__device__ __forceinline__ unsigned xb_xcc_id() { return (unsigned)__builtin_amdgcn_s_getreg((3 << 11) | 20) & 0xFu; }
#define XB_SPIN(cond, bar) do { unsigned _sp = 0; while (cond) { __builtin_amdgcn_s_sleep(1); \
    if ((++_sp & 255u) == 0u) { if (xb_ld(&(bar)[XB_TMO])) break; if (_sp > XB_SPIN_CAP) { atomicAdd(&(bar)[XB_TMO], 1u); break; } } } } while (0)
__device__ __forceinline__ void xcd_barrier_complete(unsigned* bar, unsigned x, unsigned& nloc, unsigned& nx) {
  const unsigned G = gridDim.x * gridDim.y * gridDim.z;
  unsigned sum, cnt, mine, sp = 0u;
  for (;;) {
    sum = 0u; cnt = 0u; mine = 0u;
#pragma unroll
    for (unsigned j = 0; j < 16; ++j) { const unsigned c = xb_ld(&bar[XB_XCNT(j)]); sum += c; cnt += (c > 0u) ? 1u : 0u; mine = (j == x) ? c : mine; }
    if (sum == G) break;
    __builtin_amdgcn_s_sleep(1);
    if ((++sp & 255u) == 0u) { if (xb_ld(&bar[XB_TMO])) break; if (sp > XB_SPIN_CAP) { atomicAdd(&bar[XB_TMO], 1u); break; } }
  }
  nloc = mine > 0u ? mine : 1u; nx = cnt > 0u ? cnt : 1u;
}
__device__ __forceinline__ void xcd_barrier(unsigned* bar, unsigned x, unsigned& st_nloc, unsigned& st_nx) {
  asm volatile("s_waitcnt vmcnt(0)" ::: "memory");
  __syncthreads();
  if (threadIdx.x == 0) {
    __builtin_amdgcn_s_waitcnt(0);
    unsigned nloc = st_nloc, nx = st_nx;
    if (nloc == 0u) { xcd_barrier_complete(bar, x, nloc, nx); st_nloc = nloc; st_nx = nx; }
    const unsigned old = xb_add(&bar[XB_XSUB(x)], 1u);
    const unsigned gen = old / nloc;
    if (old + 1u == (gen + 1u) * nloc) {
      __builtin_amdgcn_fence(__ATOMIC_RELEASE, "agent");
      asm volatile("s_waitcnt vmcnt(0)" ::: "memory");
      const unsigned og = xb_add(&bar[XB_TOP], 1u);
      const unsigned tg = og / nx;
      if (og + 1u == (tg + 1u) * nx) xb_add(&bar[XB_TOPGEN], 1u);
      else XB_SPIN(xb_ld(&bar[XB_TOPGEN]) == tg, bar);
      __builtin_amdgcn_fence(__ATOMIC_ACQUIRE, "agent");
      xb_add(&bar[XB_XGEN(x)], 1u);
      asm volatile("s_waitcnt vmcnt(0)" ::: "memory");
    } else {
      XB_SPIN(xb_ld(&bar[XB_XGEN(x)]) == gen, bar);
      __builtin_amdgcn_fence(__ATOMIC_ACQUIRE, "agent");
      asm volatile("s_waitcnt vmcnt(0)" ::: "memory");
    }
  }
  __syncthreads();
}

__device__ void run_phase(const Params& P, int ph, char* smem, bool ph_fused) {
  char* ws = P.ws; const int tid = tidx();
  switch (ph) {
    case 0: phase0(P, smem); break;
    case 1: phase1(P, smem); break;
    case 2: phase2(P, smem); break;
    case 3: {
      for (int job = blockIdx.x; job < 512; job += gridDim.x) { const int wv = tidx() >> 6; nsa_tile(P, job * 4 + wv, smem + wv * 16896); }
      __syncthreads();
      for (int job = blockIdx.x; job < 512; job += gridDim.x) {
        {
          const int tid = tidx();
          const int s = job; const int bc = s >> 2, g = s & 3;
          RowLin ar{(const bf16_t*)(ws + OFF_WM) + g * 16384, 128};
          RowLin br{(const bf16_t*)(ws + OFF_C + C_GVT) + ((long)bc * 512 + g * 128) * 128, 128};
          const float* bs = P.b_sp + g * 128;
          const bf16_t* U = (const bf16_t*)(ws + OFF_C + C_U) + (long)bc * 128 * 512 + g * 128;
          bf16_t* OS = (bf16_t*)(ws + OFF_D) + (long)M_ * 512 + (long)bc * 128 * 512 + g * 128;
          gemm_tile(smem, ar, br, 2, 64, 64, [&](const float* Cs) {
#pragma unroll 2
            for (int it = 0; it < 8; ++it) {
              int id = it * 256 + tid; int r = id >> 4, c = (id & 15) * 8; float v[8]; ld8(Cs, r, c, v);
              u32x4 d = *(const u32x4*)(U + (long)r * 512 + c); const float bb = bs[r];
#pragma unroll
              for (int i = 0; i < 4; ++i) { v[2 * i] = (v[2 * i] + bb) * bf2f(d[i] & 0xffffu); v[2 * i + 1] = (v[2 * i + 1] + bb) * bf2f(d[i] >> 16); }
              *(u32x4*)(OS + (long)r * 512 + c) = pack8(v);
            }
          });
        }
      }
    } break;
    case 4: {
      float* scr = (float*)(ws + OFF_C + C_SCR) + (long)blockIdx.x * 16384;
      const int xq = blockIdx.x & 7, lq = blockIdx.x >> 3, sq = gridDim.x >> 3;
      for (int t = lq; t < 16 * 8; t += sq) {
        const int mt = xq * 16 + (t & 15), nt = t >> 4, brow = mt * 128, bcol = nt * 128;
        const bf16_t* MG = (const bf16_t*)(ws + OFF_B) + (long)brow * 2048 + bcol;
        RowLin a1{(const bf16_t*)(ws + OFF_D) + (long)brow * 512, 512};
        RowLin b1{(const bf16_t*)(ws + OFF_WPA) + (long)bcol * 512, 512};
        gemm_tile(smem, a1, b1, 8, 64, 64, [&](const float* Cs) {
#pragma unroll 2
          for (int it = 0; it < 8; ++it) {
            int id = it * 256 + tid; int r = id >> 4, c = (id & 15) * 8; float v[8]; ld8(Cs, r, c, v);
            u32x4 d = *(const u32x4*)(MG + (long)r * 2048 + c);
#pragma unroll
            for (int i = 0; i < 4; ++i) { v[2 * i] *= bf2f(d[i] & 0xffffu); v[2 * i + 1] *= bf2f(d[i] >> 16); }
            *(f32x4*)(scr + id * 8) = (f32x4){v[0], v[1], v[2], v[3]}; *(f32x4*)(scr + id * 8 + 4) = (f32x4){v[4], v[5], v[6], v[7]};
          }
        });
        RowLin a2{(const bf16_t*)(ws + OFF_D) + (long)M_ * 512 + (long)brow * 512, 512};
        RowLin b2{(const bf16_t*)(ws + OFF_WPB) + (long)bcol * 512, 512};
        bf16_t* MX = (bf16_t*)(ws + OFF_C + C_MIXED) + (long)brow * 1024 + bcol;
        gemm_tile(smem, a2, b2, 8, 64, 64, [&](const float* Cs) {
#pragma unroll 2
          for (int it = 0; it < 8; ++it) {
            int id = it * 256 + tid; int r = id >> 4, c = (id & 15) * 8; float v[8]; ld8(Cs, r, c, v);
            u32x4 d = *(const u32x4*)(MG + (long)r * 2048 + 1024 + c);
            f32x4 p0 = *(const f32x4*)(scr + id * 8), p1 = *(const f32x4*)(scr + id * 8 + 4);
            float pv[8] = {p0[0], p0[1], p0[2], p0[3], p1[0], p1[1], p1[2], p1[3]};
#pragma unroll
            for (int i = 0; i < 4; ++i) { v[2 * i] = pv[2 * i] + v[2 * i] * bf2f(d[i] & 0xffffu); v[2 * i + 1] = pv[2 * i + 1] + v[2 * i + 1] * bf2f(d[i] >> 16); }
            *(u32x4*)(MX + (long)r * 1024 + c) = pack8(v);
          }
        });
      }
    } break;
    case 5: case 9: case 12: {
      const bf16_t* A; const bf16_t* W; const float* RES; float* DST; int K;
      if (ph == 5) { A = (const bf16_t*)(ws + OFF_C + C_MIXED); W = (const bf16_t*)(ws + OFF_WOUT); RES = P.x; DST = (float*)(ws + OFF_B); K = 1024; }
      else if (ph == 9) { A = (const bf16_t*)(ws + OFF_D) + (long)M_ * 512; W = (const bf16_t*)(ws + OFF_WMO); RES = (const float*)(ws + OFF_B); DST = (float*)(ws + OFF_C + C_H2); K = 512; }
      else { A = (const bf16_t*)(ws + OFF_B); W = (const bf16_t*)(ws + OFF_WDN); RES = (const float*)(ws + OFF_C + C_H2); DST = P.out; K = 2816; }
      const int xq = blockIdx.x & 7, lq = blockIdx.x >> 3, sq = gridDim.x >> 3;
      for (int t = lq; t < 16 * 4; t += sq) {
        const int mt = xq * 16 + (t & 15), nt2 = t >> 4, brow = mt * 128;
        RowLin ar{A + (long)brow * K, K}; RowLin br{W + (long)nt2 * 256 * K, K};
        gemm_tile2(smem, ar, br, K / 64, [&](const float* Cs, int p) {
          const int bcol = nt2 * 256 + p * 128;
          const float* rs = RES + (long)brow * 1024 + bcol; float* ds = DST + (long)brow * 1024 + bcol;
#pragma unroll 2
          for (int it = 0; it < 8; ++it) {
            int id = it * 256 + tid; int r = id >> 4, c = (id & 15) * 8;
            f32x4 a = *(const f32x4*)(Cs + r * CS_LD + c), bq = *(const f32x4*)(Cs + r * CS_LD + c + 4);
            f32x4 r0 = __builtin_nontemporal_load((const f32x4*)(rs + (long)r * 1024 + c)), r1 = __builtin_nontemporal_load((const f32x4*)(rs + (long)r * 1024 + c + 4));
            const f32x4 h0 = a + r0, h1v = bq + r1;
            *(f32x4*)(ds + (long)r * 1024 + c) = h0; *(f32x4*)(ds + (long)r * 1024 + c + 4) = h1v;
            if (ph != 12) {
              const float* gn = (ph == 5 ? P.norm_mq : P.norm_ffn) + bcol + c;
              const f32x4 g0 = *(const f32x4*)gn, g1 = *(const f32x4*)(gn + 4);
              float v[8] = {h0[0] * g0[0], h0[1] * g0[1], h0[2] * g0[2], h0[3] * g0[3], h1v[0] * g1[0], h1v[1] * g1[1], h1v[2] * g1[2], h1v[3] * g1[3]};
              *(u32x4*)((bf16_t*)(ws + OFF_A) + (long)(brow + r) * 1024 + bcol + c) = pack8(v);
              float ss = (h0[0] * h0[0] + h0[1] * h0[1]) + (h0[2] * h0[2] + h0[3] * h0[3]) + (h1v[0] * h1v[0] + h1v[1] * h1v[1]) + (h1v[2] * h1v[2] + h1v[3] * h1v[3]);
              ss += __shfl_xor(ss, 1, 64); ss += __shfl_xor(ss, 2, 64); ss += __shfl_xor(ss, 4, 64); ss += __shfl_xor(ss, 8, 64);
              if ((tid & 15) == 0) ((float*)(ws + (ph == 5 ? OFF_SSQ1 : OFF_SSQ2)))[(long)(brow + r) * 8 + nt2 * 2 + p] = ss;
            }
          }
        });
      }
    } break;
    case 6: case 10: {
      const float* src = ph == 6 ? (const float*)(ws + OFF_B) : (const float*)(ws + OFF_C + C_H2);
      const float* g = ph == 6 ? P.norm_mq : P.norm_ffn;
      (void)src; (void)g;
    } break;
    case 7: {
      const int xq = blockIdx.x & 7, lq = blockIdx.x >> 3, sq = gridDim.x >> 3;
      for (int t = lq; t < 16 * 4; t += sq) {
        const int mt = xq * 16 + (t & 15), nt = t >> 4, brow = mt * 128;
        RowLin ar{(const bf16_t*)(ws + OFF_A) + (long)brow * 1024, 1024}; RowLin br{(const bf16_t*)(ws + OFF_WMQ) + (long)nt * 128 * 1024, 1024};
        gemm_tile(smem, ar, br, 16, 64, 64, [&](const float* Cs) {
          bf16_t* dq = (bf16_t*)(ws + OFF_D) + (long)brow * 512 + nt * 128; const float* sq1 = (const float*)(ws + OFF_SSQ1) + (long)brow * 8;
#pragma unroll 2
          for (int it = 0; it < 8; ++it) {
            int id = it * 256 + tid; int r = id >> 4, c = (id & 15) * 8; float v[8]; ld8(Cs, r, c, v);
            const f32x4 s0 = *(const f32x4*)(sq1 + r * 8), s1 = *(const f32x4*)(sq1 + r * 8 + 4);
            const float ssum = ((s0[0] + s0[1]) + (s0[2] + s0[3])) + ((s1[0] + s1[1]) + (s1[2] + s1[3]));
            const float rr = rsqrtf(ssum * (1.f / 1024.f) + 1e-6f) * (0.08838834764831845f * LOG2E);
#pragma unroll
            for (int i = 0; i < 8; ++i) v[i] *= rr;
            *(u32x4*)(dq + (long)r * 512 + c) = pack8(v);
          }
        });
        asm volatile("s_waitcnt vmcnt(0)" ::: "memory");
        __syncthreads();
        xattn_tile(P, ((brow >> 5) + (tid >> 6)) * 4 + nt);
      }
    } break;
    case 8: {
      if (ph_fused) break;
      for (int job = blockIdx.x; job < 512; job += gridDim.x) xattn_tile(P, job * 4 + (tid >> 6));
    } break;
    case 11: {
      const int xq = blockIdx.x & 7, lq = blockIdx.x >> 3, sq = gridDim.x >> 3;
      for (int t = lq; t < 16 * 22; t += sq) {
        const int mt = xq * 16 + (t & 15), nt2 = t >> 4, brow = mt * 128;
        RowLin ar{(const bf16_t*)(ws + OFF_A) + (long)brow * 1024, 1024}; RowLin br{(const bf16_t*)(ws + OFF_WGU) + (long)nt2 * 256 * 1024, 1024};
        gemm_tile2(smem, ar, br, 16, [&](const float* Cs, int p) {
          bf16_t* ACT = (bf16_t*)(ws + OFF_B) + (long)brow * 2816 + (nt2 * 2 + p) * 64;
#pragma unroll 2
          for (int it = 0; it < 4; ++it) {
            int id = it * 256 + tid; int r = id >> 3, c = (id & 7) * 8; float gt[8], up[8]; ld8(Cs, r, c, gt); ld8(Cs, r, c + 64, up);
            const float* sq2 = (const float*)(ws + OFF_SSQ2) + (long)(brow + r) * 8;
            const f32x4 s0 = *(const f32x4*)(sq2), s1 = *(const f32x4*)(sq2 + 4);
            const float ssum = ((s0[0] + s0[1]) + (s0[2] + s0[3])) + ((s1[0] + s1[1]) + (s1[2] + s1[3]));
            const float rr = rsqrtf(ssum * (1.f / 1024.f) + 1e-6f);
#pragma unroll
            for (int i = 0; i < 8; ++i) { const float gg = gt[i] * rr; gt[i] = gg * sigm(gg) * (up[i] * rr); }
            __builtin_nontemporal_store(pack8(gt), (u32x4*)(ACT + (long)r * 2816 + c));
          }
        });
      }
    } break;
    case 13: {
      for (int job = blockIdx.x; job < 1024; job += gridDim.x) { int row = job * 16 + (tid >> 6) * 4; rownorm_rows<true, 4>(P.out + (long)row * 1024, P.norm_final, P.out + (long)row * 1024); }
    } break;
#ifdef PROBE_K
    case 14: {
      const bf16_t* s0 = (const bf16_t*)(ws + PROBE_SRC0); const bf16_t* s1 = (const bf16_t*)(ws + PROBE_SRC1);
      for (long i = (long)blockIdx.x * 256 + tid; i < (long)M_ * 512; i += (long)gridDim.x * 256) {
        long row = i >> 9; int c = (int)(i & 511);
        P.out[row * 1024 + c] = bf2f(s0[i]); P.out[row * 1024 + 512 + c] = bf2f(s1[i]);
      }
    } break;
    case 15: {
      const float* s0 = (const float*)(ws + PROBE_SRC0);
      for (long i = (long)blockIdx.x * 256 + tid; i < (long)M_ * 1024; i += (long)gridDim.x * 256) P.out[i] = s0[i];
    } break;
#endif
  }
}

__global__ void __launch_bounds__(256, 2) fwd_kernel(Params P, int ph_lo, int ph_hi) {
  __shared__ __attribute__((aligned(16))) char smem[81920];
  unsigned st_nloc = 0u, st_nx = 0u;
  const unsigned xcc = xb_xcc_id();
  if (ph_lo < ph_hi) {
    if (threadIdx.x == 0) (void)xb_add(&((unsigned*)(P.ws + OFF_BAR))[XB_XCNT(xcc)], 1u);
  }
  if (ph_hi < 0) cg::this_grid().sync();
  for (int ph = ph_lo; ph <= ph_hi; ++ph) {
    const uint64_t __attribute__((address_space(4)))* ka = (const uint64_t __attribute__((address_space(4)))*)__builtin_amdgcn_kernarg_segment_ptr();
    asm volatile("" : "+s"(ka));
    Params Pl; uint64_t* pd = (uint64_t*)&Pl;
#pragma unroll
    for (int i = 0; i < (int)(sizeof(Params) / 8); ++i) {
      const char __attribute__((address_space(1)))* gp = (const char __attribute__((address_space(1)))*)ka[i];
      pd[i] = (uint64_t)(const char*)gp;
    }
    if (ph == 6 || ph == 10 || ph == 8) continue;
    run_phase(Pl, ph, smem, true);
    if (ph < ph_hi) xcd_barrier((unsigned*)(Pl.ws + OFF_BAR), xcc, st_nloc, st_nx);
  }
}

extern "C" void kernel_launch(void* const* d_in, const int* in_sizes, int n_in, void* d_out, int out_size, void* d_ws, size_t ws_size,
                              hipStream_t stream) {
  static int grid_blocks = 0;
  if (!grid_blocks) {
    int dev = 0, cus = 0, per_cu = 0;
    hipGetDevice(&dev);
    hipDeviceGetAttribute(&cus, hipDeviceAttributeMultiprocessorCount, dev);
    hipOccupancyMaxActiveBlocksPerMultiprocessor(&per_cu, fwd_kernel, 256, 0);
    if (per_cu > 2) per_cu = 2;
    if (per_cu < 1) per_cu = 1;
    grid_blocks = cus * per_cu;
  }
  if (ws_size < (size_t)WS_NEED) fprintf(stderr, "workspace too small: %zu < %ld\n", ws_size, (long)WS_NEED);
  Params P{};
  const float** pp = (const float**)&P;
  for (int i = 0; i < 27; ++i) pp[i] = (const float*)d_in[i];
  P.out = (float*)d_out; P.ws = (char*)d_ws;
#if ONE_LAUNCH
  hipMemsetAsync((char*)d_ws + OFF_BAR, 0, XCD_BAR_WORDS * 4, stream);
#ifdef PROBE_K
  int lo = 0, hi = PROBE_DUMP;
#else
  int lo = 0, hi = 13;
#endif
  void* args[] = {&P, &lo, &hi};
  hipError_t e = hipLaunchCooperativeKernel((void*)fwd_kernel, dim3(grid_blocks), dim3(256), args, 0, stream);
  if (e != hipSuccess) fprintf(stderr, "cooperative launch failed: %s (grid %d)\n", hipGetErrorString(e), grid_blocks);
#else
  for (int ph = 0; ph <= 13; ++ph) fwd_kernel<<<grid_blocks, 256, 0, stream>>>(P, ph, ph);
#endif
}
```

```cpp
#include <hip/hip_runtime.h>
#include <hip/hip_cooperative_groups.h>
#include <stdint.h>
#include <stdio.h>
namespace cg = cooperative_groups;

#ifndef NSA_G0
#define NSA_G0 1.f
#define NSA_G1 1.f
#define NSA_G2 1.f
#endif
#ifndef ONE_LAUNCH
#define ONE_LAUNCH 1
#endif

typedef unsigned short bf16_t;
using bf16x8 = __attribute__((ext_vector_type(8))) short;
using f32x4 = __attribute__((ext_vector_type(4))) float;
using u32x4 = __attribute__((ext_vector_type(4))) unsigned;
using u32x2 = __attribute__((ext_vector_type(2))) unsigned;

#define T_ 8192
#define M_ 16384
#define NEGF (-1e30f)
#define LOG2E 1.4426950408889634f

constexpr long OFF_W1 = 0;
constexpr long OFF_WMKV = OFF_W1 + 4608L * 1024 * 2;
constexpr long OFF_WPA = OFF_WMKV + 2097152;
constexpr long OFF_WPB = OFF_WPA + 1048576;
constexpr long OFF_WOUT = OFF_WPB + 1048576;
constexpr long OFF_WMQ = OFF_WOUT + 2097152;
constexpr long OFF_WMO = OFF_WMQ + 1048576;
constexpr long OFF_WGU = OFF_WMO + 1048576;
constexpr long OFF_WDN = OFF_WGU + 11534336;
constexpr long OFF_WCK1 = OFF_WDN + 5767168;
constexpr long OFF_WCV1 = OFF_WCK1 + 524288;
constexpr long OFF_WM = OFF_WCV1 + 524288;
constexpr long OFF_BIAS1 = OFF_WM + 131072;
constexpr long OFF_MEMN = OFF_BIAS1 + 1024;
constexpr long OFF_MK = OFF_MEMN + 1048576;
constexpr long OFF_MVT = OFF_MK + 524288;
constexpr long OFF_KCMP = OFF_MVT + 524288;
constexpr long OFF_VCT = OFF_KCMP + 262144;
constexpr long OFF_A = OFF_VCT + 262144;
constexpr long OFF_B = OFF_A + 33554432;
constexpr long OFF_D = OFF_B + 67108864;
constexpr long OFF_C = OFF_D + 33554432;
constexpr long C_Q = 0, C_U = 16777216, C_GVT = 33554432, C_KC = 50331648, C_VC = 54525952, C_KS = 58720256,
               C_KW = 62914560, C_VST = 67108864, C_VWT = 71303168, C_GATES = 75497472;
constexpr long C_MIXED = 0, C_SCR = 33554432, C_H2 = 0;
constexpr long OFF_BAR = OFF_C + 77070336;
constexpr long OFF_SSQ1 = OFF_BAR + 16384;
constexpr long OFF_SSQ2 = OFF_SSQ1 + 524288;
constexpr long WS_NEED = OFF_SSQ2 + 524288;

struct Params {
  const float *x, *mem, *norm_mix, *w_in, *w_ck1, *w_ck2, *w_cv1, *w_cv2, *pe_k, *pe_v, *ln_sgu, *w_sp, *b_sp,
      *w_pa, *w_pb, *w_merge, *b_merge, *w_out, *norm_mq, *norm_mkv, *w_mq, *w_mkv, *w_mo, *norm_ffn, *w_gu, *w_dn, *norm_final;
  float* out;
  char* ws;
};

__device__ __forceinline__ int tidx() { int t = threadIdx.x; asm volatile("" : "+v"(t)); return t; }
__device__ __forceinline__ unsigned f2bf(float f) { unsigned u = __float_as_uint(f); u += 0x7fffu + ((u >> 16) & 1u); return u >> 16; }
__device__ __forceinline__ unsigned pack2(float a, float b) { unsigned r; asm("v_cvt_pk_bf16_f32 %0, %1, %2" : "=v"(r) : "v"(a), "v"(b)); return r; }
__device__ __forceinline__ float bf2f(unsigned h) { return __uint_as_float(h << 16); }
__device__ __forceinline__ float gelu_tanh(float x) { float u = 0.7978845608028654f * (x + 0.044715f * x * x * x); return x / (1.f + __expf(-2.f * u)); }
__device__ __forceinline__ float sigm(float x) { return 1.f / (1.f + __expf(-x)); }
__device__ __forceinline__ float wave_sum(float v) {
#pragma unroll
  for (int o = 32; o > 0; o >>= 1) v += __shfl_xor(v, o, 64);
  return v;
}
__device__ __forceinline__ u32x4 pack8(const float (&v)[8]) {
  u32x4 r; r[0] = pack2(v[0], v[1]); r[1] = pack2(v[2], v[3]); r[2] = pack2(v[4], v[5]); r[3] = pack2(v[6], v[7]); return r;
}

__device__ __forceinline__ int lds_byte(int r, int c) {
  int st = (r >> 4) * 2 + (c >> 5), rr = r & 15, cc = c & 31, ob = rr * 64 + cc * 2;
  return st * 1024 + (ob ^ (((ob >> 9) & 1) << 5));
}
__device__ __forceinline__ void stage_rc(int b, int& R, int& C) {
  int st = b >> 10, sb = b & 1023, swz = sb ^ (((sb >> 9) & 1) << 5);
  R = (st >> 1) * 16 + (swz >> 6); C = (st & 1) * 32 + ((swz & 63) >> 1);
}

#define CS_LD 132
__device__ __forceinline__ void ld8(const float* Cs, int r, int c, float (&v)[8]) {
  f32x4 a = *(const f32x4*)(Cs + r * CS_LD + c); f32x4 b = *(const f32x4*)(Cs + r * CS_LD + c + 4);
  v[0] = a[0]; v[1] = a[1]; v[2] = a[2]; v[3] = a[3]; v[4] = b[0]; v[5] = b[1]; v[6] = b[2]; v[7] = b[3];
}
__device__ __forceinline__ void ld8T(const float* Cs, int r8, int c, float (&v)[8]) {
#pragma unroll
  for (int i = 0; i < 8; ++i) v[i] = Cs[(r8 + i) * CS_LD + c];
}

struct RowLin {
  const bf16_t* base; long ld;
  __device__ __forceinline__ const bf16_t* operator()(int r) const { return base + (long)r * ld; }
};
struct RowCmp {
  const bf16_t* base; int brow;
  __device__ __forceinline__ const bf16_t* operator()(int r) const {
    int R = brow + r; int b = R >> 10, rem = R & 1023, i = rem >> 1, g = rem & 1; if (i > 510) i = 510;
    return base + ((long)(b * T_ + 16 * i) * 128 + g * 64);
  }
};

template <int AUX = 0, class ARow, class BRow, class Epi>
__device__ __forceinline__ void gemm_tile(char* smem, ARow arow, BRow brow, int nkt, int kstepA, int kstepB, Epi epi) {
  const int tid = tidx(), lane = tid & 63, wave = tid >> 6, wr = wave >> 1, wc = wave & 1, fr = lane & 15, fq = lane >> 4;
  const bf16_t* pa[4]; const bf16_t* pb[4];
#pragma unroll
  for (int i = 0; i < 4; ++i) { int b = tid * 16 + i * 4096; int R, C; stage_rc(b, R, C); pa[i] = arow(R) + C; pb[i] = brow(R) + C; }
  f32x4 acc[4][4];
#pragma unroll
  for (int m = 0; m < 4; ++m)
#pragma unroll
    for (int n = 0; n < 4; ++n) acc[m][n] = (f32x4){0.f, 0.f, 0.f, 0.f};
  {
#pragma unroll
    for (int i = 0; i < 4; ++i) {
      __builtin_amdgcn_global_load_lds((const unsigned*)(pa[i]), (unsigned*)(smem + tid * 16 + i * 4096), 16, 0, AUX);
      __builtin_amdgcn_global_load_lds((const unsigned*)(pb[i]), (unsigned*)(smem + 16384 + tid * 16 + i * 4096), 16, 0, AUX);
    }
  }
  for (int kt = 0; kt < nkt; ++kt) {
    asm volatile("s_waitcnt vmcnt(0)" ::: "memory");
    __syncthreads();
    if (kt + 1 < nkt) {
      char* la = smem + ((kt + 1) & 1) * 32768;
#pragma unroll
      for (int i = 0; i < 4; ++i) {
        __builtin_amdgcn_global_load_lds((const unsigned*)(pa[i] + (long)(kt + 1) * kstepA), (unsigned*)(la + tid * 16 + i * 4096), 16, 0, AUX);
        __builtin_amdgcn_global_load_lds((const unsigned*)(pb[i] + (long)(kt + 1) * kstepB), (unsigned*)(la + 16384 + tid * 16 + i * 4096), 16, 0, AUX);
      }
    }
    const char* la = smem + (kt & 1) * 32768; const char* lb = la + 16384;
#pragma unroll
    for (int ks = 0; ks < 2; ++ks) {
      bf16x8 a[4], b[4];
#pragma unroll
      for (int m = 0; m < 4; ++m) a[m] = *(const bf16x8*)(la + lds_byte(wr * 64 + m * 16 + fr, ks * 32 + fq * 8));
#pragma unroll
      for (int n = 0; n < 4; ++n) b[n] = *(const bf16x8*)(lb + lds_byte(wc * 64 + n * 16 + fr, ks * 32 + fq * 8));
#pragma unroll
      for (int m = 0; m < 4; ++m)
#pragma unroll
        for (int n = 0; n < 4; ++n) acc[m][n] = __builtin_amdgcn_mfma_f32_16x16x32_bf16(a[m], b[n], acc[m][n], 0, 0, 0);
    }
  }
  __syncthreads();
  float* Cs = (float*)smem;
#pragma unroll
  for (int m = 0; m < 4; ++m)
#pragma unroll
    for (int n = 0; n < 4; ++n)
#pragma unroll
      for (int r = 0; r < 4; ++r) Cs[(wr * 64 + m * 16 + fq * 4 + r) * CS_LD + wc * 64 + n * 16 + fr] = acc[m][n][r];
  __syncthreads();
  epi(Cs);
  __syncthreads();
}

template <class F>
__device__ __forceinline__ void store_rows_bf16(const float* Cs, bf16_t* dst, long ld, F f) {
#pragma unroll 2
  for (int it = 0; it < 8; ++it) {
    int id = it * 256 + tidx(); int r = id >> 4, c = (id & 15) * 8;
    float v[8]; ld8(Cs, r, c, v);
#pragma unroll
    for (int i = 0; i < 8; ++i) v[i] = f(v[i], c + i);
    *(u32x4*)(dst + (long)r * ld + c) = pack8(v);
  }
}
template <class F>
__device__ __forceinline__ void store_T_bf16(const float* Cs, bf16_t* dst, long cstride, F f) {
#pragma unroll 2
  for (int it = 0; it < 8; ++it) {
    int id = it * 256 + tidx(); int c = id >> 4, r8 = (id & 15) * 8;
    float v[8]; ld8T(Cs, r8, c, v);
#pragma unroll
    for (int i = 0; i < 8; ++i) v[i] = f(v[i]);
    *(u32x4*)(dst + (long)c * cstride + r8) = pack8(v);
  }
}


__device__ __forceinline__ int lds_byte32(int r, int c) { int rr = r & 15; return (r >> 4) * 1024 + rr * 64 + ((((c >> 3) ^ ((-(rr >> 2)) & 3)) & 3) << 4); }
__device__ __forceinline__ void stage_rc32(int b, int& R, int& C) { int st = b >> 10, sb = b & 1023, rr = sb >> 6, cp = (sb >> 4) & 3; R = st * 16 + rr; C = ((cp ^ ((-(rr >> 2)) & 3)) & 3) * 8; }
struct RowClamp {
  const bf16_t* base; long ld; int maxr;
  __device__ __forceinline__ const bf16_t* operator()(int r) const { return base + (long)(r < maxr ? r : maxr) * ld; }
};
__device__ __forceinline__ int lds_byte64(int r, int c) { int rr = r & 15; return (r >> 4) * 2048 + rr * 128 + ((((c >> 3) ^ (rr >> 1)) & 7) << 4); }
__device__ __forceinline__ void stage_rc64(int b, int& R, int& C) { int st = b >> 11, sb = b & 2047, rr = sb >> 7, cp = (sb >> 4) & 7; R = st * 16 + rr; C = ((cp ^ (rr >> 1)) & 7) * 8; }
template <class ARow, class BRow, class Epi>
__device__ __forceinline__ void gemm_tile2(char* smem, ARow arow, BRow brow, int nkt, Epi epi) {
  const int tid = tidx(), lane = tid & 63, wave = tid >> 6, wr = wave >> 1, wc = wave & 1, fr = lane & 15, fq = lane >> 4;
  int R0, C0; stage_rc64(tid * 16, R0, C0);
  const bf16_t* pa0 = arow(R0) + C0; const bf16_t* pb0 = brow(R0) + C0;
  const long sa32 = 32 * arow.ld, sb32 = 32 * brow.ld;
  f32x4 acc[4][8];
#pragma unroll
  for (int m = 0; m < 4; ++m)
#pragma unroll
    for (int n = 0; n < 8; ++n) acc[m][n] = (f32x4){0.f, 0.f, 0.f, 0.f};
  __syncthreads();
#pragma unroll
  for (int i = 0; i < 4; ++i) __builtin_amdgcn_global_load_lds((const unsigned*)(pa0 + i * sa32), (unsigned*)(smem + tid * 16 + i * 4096), 16, 0, 0);
#pragma unroll
  for (int i = 0; i < 8; ++i) __builtin_amdgcn_global_load_lds((const unsigned*)(pb0 + i * sb32), (unsigned*)(smem + 16384 + tid * 16 + i * 4096), 16, 0, 0);
  for (int kt = 0; kt < nkt; ++kt) {
    asm volatile("s_waitcnt vmcnt(0)" ::: "memory");
    __syncthreads();
    if (kt + 1 < nkt) {
      char* bn = smem + 16384 + ((kt + 1) & 1) * 32768;
#pragma unroll
      for (int i = 0; i < 8; ++i) __builtin_amdgcn_global_load_lds((const unsigned*)(pb0 + i * sb32 + (long)(kt + 1) * 64), (unsigned*)(bn + tid * 16 + i * 4096), 16, 0, 0);
    }
    {
      const char* pA = smem + lds_byte64(wr * 64 + fr, fq * 8);
      const char* pB = smem + 16384 + (kt & 1) * 32768 + lds_byte64(wc * 128 + fr, fq * 8);
      const int k1 = lds_byte64(fr, 32 + fq * 8) - lds_byte64(fr, fq * 8);
#pragma unroll
      for (int ks = 0; ks < 2; ++ks) {
        bf16x8 a[4], bb[8];
#pragma unroll
        for (int m = 0; m < 4; ++m) a[m] = *(const bf16x8*)(pA + m * 2048 + ks * k1);
#pragma unroll
        for (int n = 0; n < 8; ++n) bb[n] = *(const bf16x8*)(pB + n * 2048 + ks * k1);
#pragma unroll
        for (int m = 0; m < 4; ++m)
#pragma unroll
          for (int n = 0; n < 8; ++n) acc[m][n] = __builtin_amdgcn_mfma_f32_16x16x32_bf16(a[m], bb[n], acc[m][n], 0, 0, 0);
      }
    }
    __syncthreads();
    if (kt + 1 < nkt) {
#pragma unroll
      for (int i = 0; i < 4; ++i) __builtin_amdgcn_global_load_lds((const unsigned*)(pa0 + i * sa32 + (long)(kt + 1) * 64), (unsigned*)(smem + tid * 16 + i * 4096), 16, 0, 0);
    }
  }
  float* Cs = (float*)smem;
#pragma unroll
  for (int p = 0; p < 2; ++p) {
    __syncthreads();
    if (wc == p) {
#pragma unroll
      for (int m = 0; m < 4; ++m)
#pragma unroll
        for (int n = 0; n < 8; ++n)
#pragma unroll
          for (int r = 0; r < 4; ++r) Cs[(wr * 64 + m * 16 + fq * 4 + r) * CS_LD + n * 16 + fr] = acc[m][n][r];
    }
    __syncthreads();
    epi(Cs, p);
  }
  __syncthreads();
}

template <int MODE>
__device__ __forceinline__ void transpose_tile(const float* W, int Nsrc, bf16_t* Wt, int Kd, int k0, int n0, float* lds) {
  const int tid = tidx();
  {
    int tx = tid & 63, ty = tid >> 6; int np = n0 + tx; int sc;
    if (MODE == 0) sc = np < Nsrc ? np : -1;
    else { int x = np & 127, tl = np >> 7; sc = x < 64 ? tl * 64 + x : 2816 + tl * 64 + x - 64; }
    float v[32];
#pragma unroll
    for (int i = 0; i < 32; ++i) v[i] = sc >= 0 ? W[(long)(k0 + ty + 4 * i) * Nsrc + sc] : 0.f;
#pragma unroll
    for (int i = 0; i < 32; ++i) lds[(ty + 4 * i) * 65 + tx] = v[i];
  }
  __syncthreads();
  {
    int nrow = tid >> 2, kseg = (tid & 3) * 32;
#pragma unroll
    for (int q = 0; q < 4; ++q) {
      float v[8];
#pragma unroll
      for (int i = 0; i < 8; ++i) v[i] = lds[(kseg + q * 8 + i) * 65 + nrow];
      *(u32x4*)(Wt + (long)(n0 + nrow) * Kd + k0 + kseg + q * 8) = pack8(v);
    }
  }
  __syncthreads();
}

template <bool OUTF, int NR>
__device__ __forceinline__ void rownorm_rows(const float* src, const float* g, void* dst) {
  const int lane = tidx() & 63;
  f32x4 v[NR][4];
#pragma unroll
  for (int r = 0; r < NR; ++r)
#pragma unroll
    for (int i = 0; i < 4; ++i) v[r][i] = *(const f32x4*)(src + (long)r * 1024 + i * 256 + lane * 4);
  f32x4 gg[4];
#pragma unroll
  for (int i = 0; i < 4; ++i) gg[i] = *(const f32x4*)(g + i * 256 + lane * 4);
#pragma unroll
  for (int r = 0; r < NR; ++r) {
    float ss = 0.f;
#pragma unroll
    for (int i = 0; i < 4; ++i) ss += v[r][i][0] * v[r][i][0] + v[r][i][1] * v[r][i][1] + v[r][i][2] * v[r][i][2] + v[r][i][3] * v[r][i][3];
    ss = wave_sum(ss);
    const float rr = rsqrtf(ss * (1.f / 1024.f) + 1e-6f);
#pragma unroll
    for (int i = 0; i < 4; ++i) {
      float o0 = v[r][i][0] * rr * gg[i][0], o1 = v[r][i][1] * rr * gg[i][1], o2 = v[r][i][2] * rr * gg[i][2], o3 = v[r][i][3] * rr * gg[i][3];
      if (OUTF) { __builtin_nontemporal_store((f32x4){o0, o1, o2, o3}, (f32x4*)((float*)dst + (long)r * 1024 + i * 256 + lane * 4)); }
      else { u32x2 p; p[0] = pack2(o0, o1); p[1] = pack2(o2, o3); *(u32x2*)((bf16_t*)dst + (long)r * 1024 + i * 256 + lane * 4) = p; }
    }
  }
}

__device__ void phase0(const Params& P, char* smem) {
  float* lds = (float*)smem;
  const int tid = tidx();
  const int NJ = 8 + 1024 + 32 + 32 + 2192;
  for (int job = blockIdx.x; job < NJ; job += gridDim.x) {
    int j = job;
    if (j < 8) {
      int n = j * 32 + (tid & 31), sl = tid >> 5; int kv = n >> 7, nn = n & 127;
      const float* pe = kv ? P.pe_v : P.pe_k; const float* w1 = kv ? P.w_cv1 : P.w_ck1;
      float s = 0.f;
      for (int k = sl * 256; k < sl * 256 + 256; ++k) s += pe[k] * w1[(long)k * 128 + nn];
      lds[sl * 32 + (tid & 31)] = s;
      __syncthreads();
      if (tid < 32) { float t = 0.f; for (int q = 0; q < 8; ++q) t += lds[q * 32 + tid]; ((float*)(P.ws + OFF_BIAS1))[j * 32 + tid] = t; }
      __syncthreads();
      continue;
    }
    j -= 8;
    if (j < 1024) { int row = j * 16 + (tid >> 6) * 4; rownorm_rows<false, 4>(P.x + (long)row * 1024, P.norm_mix, (bf16_t*)(P.ws + OFF_A) + (long)row * 1024); continue; }
    j -= 1024;
    if (j < 32) { int row = j * 16 + (tid >> 6) * 4; rownorm_rows<false, 4>(P.mem + (long)row * 1024, P.norm_mkv, (bf16_t*)(P.ws + OFF_MEMN) + (long)row * 1024); continue; }
    j -= 32;
    if (j < 32) {
      int e0 = j * 2048 + tid * 8; float v[8];
#pragma unroll
      for (int i = 0; i < 8; ++i) { int e = e0 + i; int t = (e >> 7) & 127, s = e & 127; v[i] = s <= t ? P.w_sp[e] : 0.f; }
      *(u32x4*)((bf16_t*)(P.ws + OFF_WM) + e0) = pack8(v);
      continue;
    }
    j -= 32;
#define TRJ(KT, NT, W, NSRC, WT, KD, MODE) \
    if (j < (KT) * (NT)) { transpose_tile<MODE>(W, NSRC, (bf16_t*)(P.ws + (WT)), KD, (j % (KT)) * 128, (j / (KT)) * 64, lds); continue; } \
    j -= (KT) * (NT);
    TRJ(8, 88, P.w_gu, 5632, OFF_WGU, 1024, 1)
    TRJ(22, 16, P.w_dn, 1024, OFF_WDN, 2816, 0)
    TRJ(8, 38, P.w_in, 2328, OFF_W1, 1024, 0)
    TRJ(8, 32, P.w_merge, 2048, OFF_W1 + 2432L * 1024 * 2, 1024, 0)
    TRJ(8, 16, P.w_mkv, 1024, OFF_WMKV, 1024, 0)
    TRJ(8, 16, P.w_out, 1024, OFF_WOUT, 1024, 0)
    TRJ(4, 16, P.w_pa, 1024, OFF_WPA, 512, 0)
    TRJ(4, 16, P.w_pb, 1024, OFF_WPB, 512, 0)
    TRJ(8, 8, P.w_mq, 512, OFF_WMQ, 1024, 0)
    TRJ(4, 16, P.w_mo, 1024, OFF_WMO, 512, 0)
    TRJ(16, 2, P.w_ck1, 128, OFF_WCK1, 2048, 0)
    TRJ(16, 2, P.w_cv1, 128, OFF_WCV1, 2048, 0)
#undef TRJ
  }
}

__device__ void phase1(const Params& P, char* smem) {
  char* ws = P.ws;
  const int NG1 = 128 * 18;
  const int xq = blockIdx.x & 7, lq = blockIdx.x >> 3, sq = gridDim.x >> 3;
  for (int t = lq; t < 16 * 12; t += sq) {
    {
      const int mt = xq * 16 + (t & 15), nt2 = t >> 4; const int brow = mt * 128;
      RowLin ar{(const bf16_t*)(ws + OFF_A) + (long)brow * 1024, 1024};
      RowLin br{(const bf16_t*)(ws + OFF_W1) + (long)nt2 * 256 * 1024, 1024};
      gemm_tile2(smem, ar, br, 16, [&](const float* Cs, int p) {
        const int nt = nt2 * 2 + p; if (nt >= 35) return;
        char* C = ws + OFF_C;
        if (nt < 4) {
          store_rows_bf16(Cs, (bf16_t*)(C + C_Q) + (long)brow * 512 + nt * 128, 512, [](float v, int) { return v * (0.125f * LOG2E); });
        } else if (nt == 4 || nt == 5 || nt == 6 || nt == 8) {
          long off = nt == 4 ? C_KC : nt == 5 ? C_VC : nt == 6 ? C_KS : C_KW;
          store_rows_bf16(Cs, (bf16_t*)(C + off) + (long)brow * 128, 128, [](float v, int) { return v; });
        } else if (nt == 7 || nt == 9) {
          long off = nt == 7 ? C_VST : C_VWT; int b = brow >> 13, tl = brow & 8191;
          store_T_bf16(Cs, (bf16_t*)(C + off) + (long)b * 128 * T_ + tl, T_, [](float v) { return v; });
        } else if (nt < 14) {
          store_rows_bf16(Cs, (bf16_t*)(C + C_U) + (long)brow * 512 + (nt - 10) * 128, 512, [](float v, int) { return gelu_tanh(v); });
        } else if (nt < 18) {
          store_T_bf16(Cs, (bf16_t*)(C + C_GVT) + ((long)(brow >> 7) * 512 + (nt - 14) * 128) * 128, 128, [](float v) { return gelu_tanh(v); });
        } else if (nt == 18) {
          float* gates = (float*)(C + C_GATES);
          for (int id = tidx(); id < 128 * 24; id += 256) { int r = id / 24, c = id % 24; gates[(long)(brow + r) * 24 + c] = sigm(Cs[r * CS_LD + c]); }
        } else {
          const float* bm = P.b_merge + (nt - 19) * 128;
          store_rows_bf16(Cs, (bf16_t*)(ws + OFF_B) + (long)brow * 2048 + (nt - 19) * 128, 2048, [bm](float v, int c) { return sigm(v + bm[c]); });
        }
      });
    }
  }
}

__device__ void phase2(const Params& P, char* smem) {
  char* ws = P.ws; const int tid = tidx();
  for (int job = blockIdx.x; job < 32 + 128; job += gridDim.x) {
    if (job < 32) {
      const int kv = job >> 4, mt = job & 15, brow = mt * 128;
      RowCmp ar{(const bf16_t*)(ws + OFF_C + (kv ? C_VC : C_KC)), brow};
      RowLin br{(const bf16_t*)(ws + (kv ? OFF_WCV1 : OFF_WCK1)), 2048};
      const float* bias1 = (const float*)(ws + OFF_BIAS1) + kv * 128;
      const float* w2 = kv ? P.w_cv2 : P.w_ck2;
      gemm_tile(smem, ar, br, 32, 128, 64, [&](const float* Csc) {
        float* Cs = (float*)Csc;
        for (int it = 0; it < 64; ++it) { int id = it * 256 + tid; int r = id >> 7, n = id & 127; Cs[r * CS_LD + n] = gelu_tanh(Cs[r * CS_LD + n] + bias1[n]); }
        __syncthreads();
        const int r = tid >> 1, half = tid & 1;
        float acc[32];
#pragma unroll
        for (int i = 0; i < 32; ++i) acc[i] = 0.f;
        for (int n = 0; n < 128; ++n) {
          float h = Cs[r * CS_LD + n]; const float* wr = w2 + n * 64 + half * 32;
#pragma unroll
          for (int q = 0; q < 8; ++q) { f32x4 w = *(const f32x4*)(wr + q * 4); acc[q * 4] += h * w[0]; acc[q * 4 + 1] += h * w[1]; acc[q * 4 + 2] += h * w[2]; acc[q * 4 + 3] += h * w[3]; }
        }
        const int R = brow + r; const int b = R >> 10, rem = R & 1023, i = rem >> 1, g = rem & 1;
        if (i >= 511) {
#pragma unroll
          for (int q = 0; q < 32; ++q) acc[q] = 0.f;
        }
        if (kv == 0) {
          bf16_t* dst = (bf16_t*)(ws + OFF_KCMP) + (long)(b * 512 + i) * 128 + g * 64 + half * 32;
#pragma unroll
          for (int q = 0; q < 4; ++q) { float v[8];
#pragma unroll
            for (int e = 0; e < 8; ++e) v[e] = acc[q * 8 + e];
            *(u32x4*)(dst + q * 8) = pack8(v); }
        } else {
          bf16_t* dst = (bf16_t*)(ws + OFF_VCT) + ((long)(b * 128 + g * 64 + half * 32)) * 512 + i;
#pragma unroll
          for (int q = 0; q < 32; ++q) dst[(long)q * 512] = (bf16_t)f2bf(acc[q]);
        }
      });
    } else {
      const int bc = job - 32; bf16_t* base = (bf16_t*)(ws + OFF_C + C_GVT) + (long)bc * 512 * 128;
      float* ssum = (float*)smem; float* ssq = ssum + 128;
      float* psum = ssum + 256; float* psq = psum + 16 * 128;
      const int cs = tid >> 4, s8 = (tid & 15) * 8;
      float a[8], q[8];
#pragma unroll
      for (int i = 0; i < 8; ++i) { a[i] = 0.f; q[i] = 0.f; }
      for (int it = 0; it < 32; ++it) {
        u32x4 d = *(const u32x4*)(base + (long)(it * 16 + cs) * 128 + s8);
#pragma unroll
        for (int i = 0; i < 4; ++i) { float lo = bf2f(d[i] & 0xffffu), hi = bf2f(d[i] >> 16); a[2 * i] += lo; q[2 * i] += lo * lo; a[2 * i + 1] += hi; q[2 * i + 1] += hi * hi; }
      }
#pragma unroll
      for (int i = 0; i < 8; ++i) { psum[cs * 128 + s8 + i] = a[i]; psq[cs * 128 + s8 + i] = q[i]; }
      __syncthreads();
      if (tid < 128) {
        float su = 0.f, sq = 0.f;
        for (int c = 0; c < 16; ++c) { su += psum[c * 128 + tid]; sq += psq[c * 128 + tid]; }
        float mean_t = su * (1.f / 512.f); float var = sq * (1.f / 512.f) - mean_t * mean_t; if (var < 0.f) var = 0.f;
        ssum[tid] = mean_t; ssq[tid] = rsqrtf(var + 1e-6f);
      }
      __syncthreads();
      float mean[8], rs[8];
#pragma unroll
      for (int i = 0; i < 8; ++i) { mean[i] = ssum[s8 + i]; rs[i] = ssq[s8 + i]; }
      for (int it = 0; it < 32; ++it) {
        int ch = it * 16 + cs; float gg = P.ln_sgu[ch];
        u32x4 d = *(const u32x4*)(base + (long)ch * 128 + s8); float v[8];
#pragma unroll
        for (int i = 0; i < 4; ++i) { v[2 * i] = bf2f(d[i] & 0xffffu); v[2 * i + 1] = bf2f(d[i] >> 16); }
#pragma unroll
        for (int i = 0; i < 8; ++i) v[i] = (v[i] - mean[i]) * rs[i] * gg;
        *(u32x4*)(base + (long)ch * 128 + s8) = pack8(v);
      }
      __syncthreads();
    }
  }
  if (blockIdx.x >= 32) {
    for (int mtile = blockIdx.x - 32; mtile < 768 + 32; mtile += gridDim.x - 32) {
      if (mtile >= 768) {
        const int j = mtile - 768; const int mt = j >> 3, nt = j & 7; const int brow = mt * 128;
        RowLin ar{(const bf16_t*)(ws + OFF_MEMN) + (long)brow * 1024, 1024};
        RowLin br{(const bf16_t*)(ws + OFF_WMKV) + (long)nt * 128 * 1024, 1024};
        gemm_tile(smem, ar, br, 16, 64, 64, [&](const float* Cs) {
          if (nt < 4) store_rows_bf16(Cs, (bf16_t*)(ws + OFF_MK) + (long)brow * 512 + nt * 128, 512, [](float v, int) { return v; });
          else { int b = mt >> 1, n0 = (mt & 1) * 128; store_T_bf16(Cs, (bf16_t*)(ws + OFF_MVT) + ((long)b * 512 + (nt - 4) * 128) * 256 + n0, 256, [](float v) { return v; }); }
        });
        continue;
      }
      const int mt = mtile & 127, nt2 = 12 + (mtile >> 7), brow = mt * 128;
      RowLin ar{(const bf16_t*)(ws + OFF_A) + (long)brow * 1024, 1024};
      RowLin br{(const bf16_t*)(ws + OFF_W1) + (long)nt2 * 256 * 1024, 1024};
      gemm_tile2(smem, ar, br, 16, [&](const float* Cs, int p) {
        const int nt = nt2 * 2 + p; if (nt >= 35) return;
        const float* bm = P.b_merge + (nt - 19) * 128;
        store_rows_bf16(Cs, (bf16_t*)(ws + OFF_B) + (long)brow * 2048 + (nt - 19) * 128, 2048, [bm](float v, int c) { return sigm(v + bm[c]); });
      });
    }
  }
}

template <int MODE>
__device__ __forceinline__ void nsa_block(const bf16x8 (&qf)[4][2], f32x4 (&oacc)[4][4], float (&m)[4], float (&l)[4],
                                          const float (&sl2)[4], const float (&inv)[4], const bf16_t* kp, const bf16_t* vp, long vdt,
                                          int dist0, bool rowok, float (&asum)[2], float (&bsum)[2]) {
  constexpr int DSTEP = (MODE <= 1) ? 16 : 1;
  bf16x8 kf[2][2];
#pragma unroll
  for (int kt = 0; kt < 2; ++kt)
#pragma unroll
    for (int ks = 0; ks < 2; ++ks) kf[kt][ks] = *(const bf16x8*)(kp + kt * 16 * 128 + ks * 32);
  bf16x8 vf[4];
  if (MODE != 0) {
#pragma unroll
    for (int dt = 0; dt < 4; ++dt) {
      u32x2 lo = *(const u32x2*)(vp + dt * vdt); u32x2 hi = *(const u32x2*)(vp + dt * vdt + 16);
      u32x4 c; c[0] = lo[0]; c[1] = lo[1]; c[2] = hi[0]; c[3] = hi[1];
      vf[dt] = __builtin_bit_cast(bf16x8, c);
    }
  }
  const float fd0 = (float)dist0;
#pragma unroll
  for (int h = 0; h < 4; ++h) {
    f32x4 s[2];
#pragma unroll
    for (int kt = 0; kt < 2; ++kt) {
      s[kt] = __builtin_amdgcn_mfma_f32_16x16x32_bf16(kf[kt][0], qf[h][0], (f32x4){0.f, 0.f, 0.f, 0.f}, 0, 0, 0);
      s[kt] = __builtin_amdgcn_mfma_f32_16x16x32_bf16(kf[kt][1], qf[h][1], s[kt], 0, 0, 0);
    }
    float sc[8]; bool ok[8];
#pragma unroll
    for (int kt = 0; kt < 2; ++kt)
#pragma unroll
      for (int r = 0; r < 4; ++r) {
        const int e = kt * 16 + r; const int dist = dist0 - DSTEP * e;
        bool o = dist >= 0;
        if (MODE == 2) o = o && rowok;
        if (MODE == 3) o = o && (dist < 512);
        ok[kt * 4 + r] = o;
        sc[kt * 4 + r] = o ? s[kt][r] - sl2[h] * (fd0 - (float)(DSTEP * e)) : NEGF;
      }
    float p[8];
    if (MODE != 1) {
      float ml = NEGF;
#pragma unroll
      for (int i = 0; i < 8; ++i) ml = fmaxf(ml, sc[i]);
      ml = fmaxf(ml, __shfl_xor(ml, 16, 64)); ml = fmaxf(ml, __shfl_xor(ml, 32, 64));
      const float mn = fmaxf(m[h], ml); const float alpha = __builtin_amdgcn_exp2f(m[h] - mn); m[h] = mn;
      const float mref = fmaxf(mn, -1e29f);
      float ps = 0.f;
#pragma unroll
      for (int i = 0; i < 8; ++i) { p[i] = __builtin_amdgcn_exp2f(sc[i] - mref); ps += p[i]; }
      l[h] = l[h] * alpha + ps;
      if (MODE != 0) {
        if (__builtin_amdgcn_ballot_w64(alpha != 1.f) != 0ull) {
#pragma unroll
          for (int dt = 0; dt < 4; ++dt) oacc[h][dt] *= alpha;
        }
      }
    } else {
      const float mref1 = fmaxf(m[h], -1e29f);
#pragma unroll
      for (int i = 0; i < 8; ++i) p[i] = __builtin_amdgcn_exp2f(sc[i] - mref1) * l[h];
      asum[0] += (p[0] + p[1]) + (p[2] + p[3]); bsum[0] += p[3];
      asum[1] += (p[4] + p[5]) + (p[6] + p[7]); bsum[1] += p[7];
    }
    if (MODE != 0) {
      u32x4 pk; pk[0] = pack2(p[0], p[1]); pk[1] = pack2(p[2], p[3]); pk[2] = pack2(p[4], p[5]); pk[3] = pack2(p[6], p[7]);
      const bf16x8 pf = __builtin_bit_cast(bf16x8, pk);
#pragma unroll
      for (int dt = 0; dt < 4; ++dt) oacc[h][dt] = __builtin_amdgcn_mfma_f32_16x16x32_bf16(vf[dt], pf, oacc[h][dt], 0, 0, 0);
    }
    __builtin_amdgcn_sched_barrier(0);
  }
}

__device__ void nsa_tile(const Params& P, int wt, char* wl) {
  char* C = P.ws + OFF_C;
  const bf16_t* Q = (const bf16_t*)(C + C_Q);
  const bf16_t* KCMP = (const bf16_t*)(P.ws + OFF_KCMP); const bf16_t* VCT = (const bf16_t*)(P.ws + OFF_VCT);
  const bf16_t* KS = (const bf16_t*)(C + C_KS); const bf16_t* VST = (const bf16_t*)(C + C_VST);
  const bf16_t* KW = (const bf16_t*)(C + C_KW); const bf16_t* VWT = (const bf16_t*)(C + C_VWT);
  const float* GATES = (const float*)(C + C_GATES);
  bf16_t* O = (bf16_t*)(P.ws + OFF_D);
  const int lane = tidx() & 63, qi = lane & 15, quad = lane >> 4;
  wt = __builtin_amdgcn_readfirstlane(wt);
  const int jb = wt >> 2, wv4 = wt & 3;
  const int bg = jb & 3, b = bg >> 1, g = bg & 1;
  const int gq = jb >> 2;
  const int tq = (gq < 64 ? 127 - gq : gq - 64) * 4 + wv4;
  const int t0 = tq * 16;
  const int t = t0 + qi;
  const long row = (long)b * T_ + t;
  bf16x8 qf[4][2];
#pragma unroll
  for (int h = 0; h < 4; ++h)
#pragma unroll
    for (int ks = 0; ks < 2; ++ks) qf[h][ks] = *(const bf16x8*)(Q + row * 512 + (g * 4 + h) * 64 + ks * 32 + quad * 8);
  float sl2[4];
#pragma unroll
  for (int h = 0; h < 4; ++h) sl2[h] = __builtin_amdgcn_exp2f(-(float)(g * 4 + h + 1)) * LOG2E;
  f32x4 oacc[4][4]; float m[4], l[4], inv[4]; float asum[2], bsum[2];
  float* imp = (float*)wl; float* outl = (float*)wl;
  unsigned* sel = (unsigned*)(wl + 16384); unsigned* uni = sel + 64;
#pragma unroll
  for (int h = 0; h < 4; ++h) { m[h] = NEGF; l[h] = 0.f; inv[h] = 0.f; }
  asum[0] = asum[1] = bsum[0] = bsum[1] = 0.f;

  const int nI = t0 >> 4; const int nblk = (nI + 31) >> 5;
  for (int blk = nblk - 1; blk >= 0; --blk) {
    const int key0 = blk * 32;
    const bf16_t* kp = KCMP + (long)(b * 512 + key0 + qi) * 128 + g * 64 + quad * 8;
    nsa_block<0>(qf, oacc, m, l, sl2, inv, kp, nullptr, 0, t - 31 - 16 * (key0 + quad * 4), true, asum, bsum);
  }
#pragma unroll
  for (int h = 0; h < 4; ++h) { float lt = l[h]; lt += __shfl_xor(lt, 16, 64); lt += __shfl_xor(lt, 32, 64); l[h] = 1.f / fmaxf(lt, 1e-30f); }
  for (int i = lane; i < 16 * 132; i += 64) imp[i] = 0.f;
#pragma unroll
  for (int h = 0; h < 4; ++h)
#pragma unroll
    for (int dt = 0; dt < 4; ++dt) oacc[h][dt] = (f32x4){0.f, 0.f, 0.f, 0.f};
  for (int blk = 0; blk < nblk; ++blk) {
    const int key0 = blk * 32;
    const bf16_t* kp = KCMP + (long)(b * 512 + key0 + qi) * 128 + g * 64 + quad * 8;
    const bf16_t* vp = VCT + (long)(b * 128 + g * 64 + qi) * 512 + key0 + quad * 4;
    asum[0] = asum[1] = bsum[0] = bsum[1] = 0.f;
    nsa_block<1>(qf, oacc, m, l, sl2, inv, kp, vp, 16 * 512, t - 31 - 16 * (key0 + quad * 4), true, asum, bsum);
    const int J = (key0 >> 2) + quad;
    atomicAdd(&imp[qi * 132 + J], asum[0]); atomicAdd(&imp[qi * 132 + J + 1], bsum[0]);
    atomicAdd(&imp[qi * 132 + J + 4], asum[1]); atomicAdd(&imp[qi * 132 + J + 5], bsum[1]);
  }
  const int cur = t0 >> 6;
  if (lane < 16) {
    unsigned w0 = 0, w1 = 0, w2 = 0, w3 = 0;
    if (cur < 16) { w0 = (1u << (cur + 1)) - 1u; }
    else {
      w0 = 1u;
      { int j = cur; unsigned bit = 1u << (j & 31); int w = j >> 5; if (w == 0) w0 |= bit; else if (w == 1) w1 |= bit; else if (w == 2) w2 |= bit; else w3 |= bit; }
      { int j = cur - 1; unsigned bit = 1u << (j & 31); int w = j >> 5; if (w == 0) w0 |= bit; else if (w == 1) w1 |= bit; else if (w == 2) w2 |= bit; else w3 |= bit; }
    }
    sel[lane * 4 + 0] = w0; sel[lane * 4 + 1] = w1; sel[lane * 4 + 2] = w2; sel[lane * 4 + 3] = w3;
  }
  if (lane < 4) uni[lane] = 0u;
  if (cur >= 16) {
    for (int rnd = 0; rnd < 4; ++rnd) {
      const int qq = rnd * 4 + quad;
      unsigned key[8];
#pragma unroll
      for (int c = 0; c < 8; ++c) {
        const int j = qi + 16 * c;
        const bool v = (j <= cur) && (j != 0) && (j != cur) && (j != cur - 1);
        const unsigned bits = __float_as_uint(imp[qq * 132 + j]);
        key[c] = v ? ((bits & 0xFFFFFF00u) | (unsigned)(128 - j)) : 0u;
      }
      for (int it = 0; it < 13; ++it) {
        unsigned mx = key[0];
#pragma unroll
        for (int c = 1; c < 8; ++c) mx = key[c] > mx ? key[c] : mx;
#pragma unroll
        for (int o = 1; o < 16; o <<= 1) { unsigned ot = (unsigned)__shfl_xor((int)mx, o, 64); mx = ot > mx ? ot : mx; }
        if (mx != 0u) {
#pragma unroll
          for (int c = 0; c < 8; ++c) {
            if (key[c] == mx) { key[c] = 0u; const int j = qi + 16 * c; atomicOr(&sel[qq * 4 + (j >> 5)], 1u << (j & 31)); }
          }
        }
      }
    }
  }
  unsigned mym[4];
#pragma unroll
  for (int w = 0; w < 4; ++w) mym[w] = sel[qi * 4 + w];
  if (lane < 16) {
#pragma unroll
    for (int w = 0; w < 4; ++w) atomicOr(&uni[w], mym[w]);
  }
  const float* gp = GATES + row * 24 + g * 12;
#pragma unroll
  for (int h = 0; h < 4; ++h) {
    const float gt = gp[h * 3 + 0] * NSA_G0;
#pragma unroll
    for (int dt = 0; dt < 4; ++dt) *(f32x4*)(outl + ((h * 16 + qi) * 64 + (((dt * 4 + quad) ^ qi) << 2))) = oacc[h][dt] * gt;
  }
#pragma unroll
  for (int h = 0; h < 4; ++h) { m[h] = NEGF; l[h] = 0.f;
#pragma unroll
    for (int dt = 0; dt < 4; ++dt) oacc[h][dt] = (f32x4){0.f, 0.f, 0.f, 0.f}; }
#pragma unroll 1
  for (int w = 3; w >= 0; --w) {
    unsigned bits = __builtin_amdgcn_readfirstlane(uni[w]);
    const unsigned myw = sel[qi * 4 + w];
    while (bits) {
      const int jj = 31 - __builtin_clz(bits); bits &= ~(1u << jj);
      const int j = w * 32 + jj; const bool rowok = (myw >> jj) & 1u;
#pragma unroll 1
      for (int half = 1; half >= 0; --half) {
        const int key0 = j * 64 + half * 32;
        const bf16_t* kp = KS + (long)(b * T_ + key0 + qi) * 128 + g * 64 + quad * 8;
        const bf16_t* vp = VST + (long)(b * 128 + g * 64 + qi) * T_ + key0 + quad * 4;
        nsa_block<2>(qf, oacc, m, l, sl2, inv, kp, vp, 16L * T_, t - (key0 + quad * 4), rowok, asum, bsum);
      }
    }
  }
#pragma unroll
  for (int h = 0; h < 4; ++h) {
    float lt = l[h]; lt += __shfl_xor(lt, 16, 64); lt += __shfl_xor(lt, 32, 64);
    const float sc = NSA_G1 * gp[h * 3 + 1] / fmaxf(lt, 1e-30f);
#pragma unroll
    for (int dt = 0; dt < 4; ++dt) { f32x4* d = (f32x4*)(outl + ((h * 16 + qi) * 64 + (((dt * 4 + quad) ^ qi) << 2))); *d = *d + oacc[h][dt] * sc; }
  }
#pragma unroll
  for (int h = 0; h < 4; ++h) { m[h] = NEGF; l[h] = 0.f;
#pragma unroll
    for (int dt = 0; dt < 4; ++dt) oacc[h][dt] = (f32x4){0.f, 0.f, 0.f, 0.f}; }
  {
    const int kstart = t0 >= 512 ? ((t0 - 511) & ~31) : 0;
    for (int key0 = (t0 + 15) & ~31; key0 >= kstart; key0 -= 32) {
      const bf16_t* kp = KW + (long)(b * T_ + key0 + qi) * 128 + g * 64 + quad * 8;
      const bf16_t* vp = VWT + (long)(b * 128 + g * 64 + qi) * T_ + key0 + quad * 4;
      nsa_block<3>(qf, oacc, m, l, sl2, inv, kp, vp, 16L * T_, t - (key0 + quad * 4), true, asum, bsum);
    }
  }
#pragma unroll
  for (int h = 0; h < 4; ++h) {
    float lt = l[h]; lt += __shfl_xor(lt, 16, 64); lt += __shfl_xor(lt, 32, 64);
    const float sc = NSA_G2 * gp[h * 3 + 2] / fmaxf(lt, 1e-30f);
#pragma unroll
    for (int dt = 0; dt < 4; ++dt) { f32x4* d = (f32x4*)(outl + ((h * 16 + qi) * 64 + (((dt * 4 + quad) ^ qi) << 2))); *d = *d + oacc[h][dt] * sc; }
  }
#pragma unroll
  for (int it = 0; it < 8; ++it) {
    const int id = it * 64 + lane; const int h = id >> 7, rem = id & 127, q2 = rem >> 3, c8 = rem & 7;
    f32x4 a = *(const f32x4*)(outl + ((h * 16 + q2) * 64 + (((2 * c8) ^ q2) << 2)));
    f32x4 bb = *(const f32x4*)(outl + ((h * 16 + q2) * 64 + (((2 * c8 + 1) ^ q2) << 2)));
    float v[8] = {a[0], a[1], a[2], a[3], bb[0], bb[1], bb[2], bb[3]};
    *(u32x4*)(O + ((long)b * T_ + t0 + q2) * 512 + (g * 4 + h) * 64 + c8 * 8) = pack8(v);
  }
}

__device__ void xattn_tile(const Params& P, int wt) {
  const bf16_t* HQ = (const bf16_t*)(P.ws + OFF_D);
  const bf16_t* MK = (const bf16_t*)(P.ws + OFF_MK); const bf16_t* MVT = (const bf16_t*)(P.ws + OFF_MVT);
  bf16_t* OX = (bf16_t*)(P.ws + OFF_D) + (long)M_ * 512;
  const int lane = tidx() & 63, qi = lane & 15, quad = lane >> 4;
  wt = __builtin_amdgcn_readfirstlane(wt);
  const int h = wt & 3; const int row0 = (wt >> 2) * 32; const int b = row0 >> 13;
  bf16x8 qf[2][4];
#pragma unroll
  for (int nt = 0; nt < 2; ++nt)
#pragma unroll
    for (int ks = 0; ks < 4; ++ks) qf[nt][ks] = *(const bf16x8*)(HQ + (long)(row0 + nt * 16 + qi) * 512 + h * 128 + ks * 32 + quad * 8);
  f32x4 oacc[2][8]; float m[2], l[2];
#pragma unroll
  for (int nt = 0; nt < 2; ++nt) { m[nt] = NEGF; l[nt] = 0.f;
#pragma unroll
    for (int dt = 0; dt < 8; ++dt) oacc[nt][dt] = (f32x4){0.f, 0.f, 0.f, 0.f}; }
  for (int blk = 0; blk < 8; ++blk) {
    const int key0 = blk * 32;
    f32x4 s[2][2];
#pragma unroll
    for (int nt = 0; nt < 2; ++nt)
#pragma unroll
      for (int kt = 0; kt < 2; ++kt) s[nt][kt] = (f32x4){0.f, 0.f, 0.f, 0.f};
#pragma unroll
    for (int ks = 0; ks < 4; ++ks) {
#pragma unroll
      for (int kt = 0; kt < 2; ++kt) {
        bf16x8 kf = *(const bf16x8*)(MK + (long)(b * 256 + key0 + kt * 16 + qi) * 512 + h * 128 + ks * 32 + quad * 8);
#pragma unroll
        for (int nt = 0; nt < 2; ++nt) s[nt][kt] = __builtin_amdgcn_mfma_f32_16x16x32_bf16(kf, qf[nt][ks], s[nt][kt], 0, 0, 0);
      }
    }
    bf16x8 pf[2];
#pragma unroll
    for (int nt = 0; nt < 2; ++nt) {
      float ml = NEGF;
#pragma unroll
      for (int kt = 0; kt < 2; ++kt)
#pragma unroll
        for (int r = 0; r < 4; ++r) ml = fmaxf(ml, s[nt][kt][r]);
      ml = fmaxf(ml, __shfl_xor(ml, 16, 64)); ml = fmaxf(ml, __shfl_xor(ml, 32, 64));
      const float mn = fmaxf(m[nt], ml); const float alpha = __builtin_amdgcn_exp2f(m[nt] - mn); m[nt] = mn;
      float p[8]; float ps = 0.f;
#pragma unroll
      for (int kt = 0; kt < 2; ++kt)
#pragma unroll
        for (int r = 0; r < 4; ++r) { p[kt * 4 + r] = __builtin_amdgcn_exp2f(s[nt][kt][r] - mn); ps += p[kt * 4 + r]; }
      l[nt] = l[nt] * alpha + ps;
#pragma unroll
      for (int dt = 0; dt < 8; ++dt) oacc[nt][dt] *= alpha;
      u32x4 pk; pk[0] = pack2(p[0], p[1]); pk[1] = pack2(p[2], p[3]); pk[2] = pack2(p[4], p[5]); pk[3] = pack2(p[6], p[7]);
      pf[nt] = __builtin_bit_cast(bf16x8, pk);
    }
#pragma unroll
    for (int dt = 0; dt < 8; ++dt) {
      const bf16_t* vp = MVT + (long)(b * 512 + h * 128 + dt * 16 + qi) * 256 + key0 + quad * 4;
      u32x2 lo = *(const u32x2*)(vp); u32x2 hi = *(const u32x2*)(vp + 16);
      u32x4 c; c[0] = lo[0]; c[1] = lo[1]; c[2] = hi[0]; c[3] = hi[1];
      const bf16x8 vf = __builtin_bit_cast(bf16x8, c);
#pragma unroll
      for (int nt = 0; nt < 2; ++nt) oacc[nt][dt] = __builtin_amdgcn_mfma_f32_16x16x32_bf16(vf, pf[nt], oacc[nt][dt], 0, 0, 0);
    }
  }
#pragma unroll
  for (int nt = 0; nt < 2; ++nt) {
    float lt = l[nt]; lt += __shfl_xor(lt, 16, 64); lt += __shfl_xor(lt, 32, 64);
    const float iv = 1.f / lt;
#pragma unroll
    for (int dt = 0; dt < 8; ++dt) {
      f32x4 v = oacc[nt][dt] * iv; u32x2 pk; pk[0] = pack2(v[0], v[1]); pk[1] = pack2(v[2], v[3]);
      *(u32x2*)(OX + (long)(row0 + nt * 16 + qi) * 512 + h * 128 + dt * 16 + quad * 4) = pk;
    }
  }
}


#define XB_TMO      128
#define XB_XCNT(j)  (256  + 64 * (j))
#define XB_XSUB(j)  (1280 + 64 * (j))
#define XB_XGEN(j)  (2304 + 64 * (j))
#define XB_TOP      3328
#define XB_TOPGEN   3392
#define XCD_BAR_WORDS 3456
#define XB_SPIN_CAP (1u << 18)
#define LAS __attribute__((address_space(3)))
__device__ __forceinline__ unsigned xb_ld(unsigned* p) { return __hip_atomic_load(p, __ATOMIC_RELAXED, __HIP_MEMORY_SCOPE_AGENT); }
__device__ __forceinline__ unsigned xb_add(unsigned* p, unsigned v) { return __hip_atomic_fetch_add(p, v, __ATOMIC_RELAXED, __HIP_MEMORY_SCOPE_AGENT); }
__device__ __forceinline__ unsigned xb_xcc_id() { return (unsigned)__builtin_amdgcn_s_getreg((3 << 11) | 20) & 0xFu; }
#define XB_SPIN(cond, bar) do { unsigned _sp = 0; while (cond) { __builtin_amdgcn_s_sleep(1); \
    if ((++_sp & 255u) == 0u) { if (xb_ld(&(bar)[XB_TMO])) break; if (_sp > XB_SPIN_CAP) { atomicAdd(&(bar)[XB_TMO], 1u); break; } } } } while (0)
__device__ __forceinline__ void xcd_barrier_complete(unsigned* bar, unsigned x, unsigned& nloc, unsigned& nx) {
  const unsigned G = gridDim.x * gridDim.y * gridDim.z;
  unsigned sum, cnt, mine, sp = 0u;
  for (;;) {
    sum = 0u; cnt = 0u; mine = 0u;
#pragma unroll
    for (unsigned j = 0; j < 16; ++j) { const unsigned c = xb_ld(&bar[XB_XCNT(j)]); sum += c; cnt += (c > 0u) ? 1u : 0u; mine = (j == x) ? c : mine; }
    if (sum == G) break;
    __builtin_amdgcn_s_sleep(1);
    if ((++sp & 255u) == 0u) { if (xb_ld(&bar[XB_TMO])) break; if (sp > XB_SPIN_CAP) { atomicAdd(&bar[XB_TMO], 1u); break; } }
  }
  nloc = mine > 0u ? mine : 1u; nx = cnt > 0u ? cnt : 1u;
}
__device__ __forceinline__ void xcd_barrier(unsigned* bar, unsigned x, unsigned& st_nloc, unsigned& st_nx) {
  asm volatile("s_waitcnt vmcnt(0)" ::: "memory");
  __syncthreads();
  if (threadIdx.x == 0) {
    __builtin_amdgcn_s_waitcnt(0);
    unsigned nloc = st_nloc, nx = st_nx;
    if (nloc == 0u) { xcd_barrier_complete(bar, x, nloc, nx); st_nloc = nloc; st_nx = nx; }
    const unsigned old = xb_add(&bar[XB_XSUB(x)], 1u);
    const unsigned gen = old / nloc;
    if (old + 1u == (gen + 1u) * nloc) {
      __builtin_amdgcn_fence(__ATOMIC_RELEASE, "agent");
      asm volatile("s_waitcnt vmcnt(0)" ::: "memory");
      const unsigned og = xb_add(&bar[XB_TOP], 1u);
      const unsigned tg = og / nx;
      if (og + 1u == (tg + 1u) * nx) xb_add(&bar[XB_TOPGEN], 1u);
      else XB_SPIN(xb_ld(&bar[XB_TOPGEN]) == tg, bar);
      __builtin_amdgcn_fence(__ATOMIC_ACQUIRE, "agent");
      xb_add(&bar[XB_XGEN(x)], 1u);
      asm volatile("s_waitcnt vmcnt(0)" ::: "memory");
    } else {
      XB_SPIN(xb_ld(&bar[XB_XGEN(x)]) == gen, bar);
      __builtin_amdgcn_fence(__ATOMIC_ACQUIRE, "agent");
      asm volatile("s_waitcnt vmcnt(0)" ::: "memory");
    }
  }
  __syncthreads();
}

__device__ void run_phase(const Params& P, int ph, char* smem, bool ph_fused) {
  char* ws = P.ws; const int tid = tidx();
  switch (ph) {
    case 0: phase0(P, smem); break;
    case 1: phase1(P, smem); break;
    case 2: phase2(P, smem); break;
    case 3: {
      for (int job = blockIdx.x; job < 512; job += gridDim.x) { const int wv = tidx() >> 6; nsa_tile(P, job * 4 + wv, smem + wv * 16896); }
      __syncthreads();
      for (int job = blockIdx.x; job < 512; job += gridDim.x) {
        {
          const int tid = tidx();
          const int s = job; const int bc = s >> 2, g = s & 3;
          RowLin ar{(const bf16_t*)(ws + OFF_WM) + g * 16384, 128};
          RowLin br{(const bf16_t*)(ws + OFF_C + C_GVT) + ((long)bc * 512 + g * 128) * 128, 128};
          const float* bs = P.b_sp + g * 128;
          const bf16_t* U = (const bf16_t*)(ws + OFF_C + C_U) + (long)bc * 128 * 512 + g * 128;
          bf16_t* OS = (bf16_t*)(ws + OFF_D) + (long)M_ * 512 + (long)bc * 128 * 512 + g * 128;
          gemm_tile(smem, ar, br, 2, 64, 64, [&](const float* Cs) {
#pragma unroll 2
            for (int it = 0; it < 8; ++it) {
              int id = it * 256 + tid; int r = id >> 4, c = (id & 15) * 8; float v[8]; ld8(Cs, r, c, v);
              u32x4 d = *(const u32x4*)(U + (long)r * 512 + c); const float bb = bs[r];
#pragma unroll
              for (int i = 0; i < 4; ++i) { v[2 * i] = (v[2 * i] + bb) * bf2f(d[i] & 0xffffu); v[2 * i + 1] = (v[2 * i + 1] + bb) * bf2f(d[i] >> 16); }
              *(u32x4*)(OS + (long)r * 512 + c) = pack8(v);
            }
          });
        }
      }
    } break;
    case 4: {
      float* scr = (float*)(ws + OFF_C + C_SCR) + (long)blockIdx.x * 16384;
      const int xq = blockIdx.x & 7, lq = blockIdx.x >> 3, sq = gridDim.x >> 3;
      for (int t = lq; t < 16 * 8; t += sq) {
        const int mt = xq * 16 + (t & 15), nt = t >> 4, brow = mt * 128, bcol = nt * 128;
        const bf16_t* MG = (const bf16_t*)(ws + OFF_B) + (long)brow * 2048 + bcol;
        RowLin a1{(const bf16_t*)(ws + OFF_D) + (long)brow * 512, 512};
        RowLin b1{(const bf16_t*)(ws + OFF_WPA) + (long)bcol * 512, 512};
        gemm_tile(smem, a1, b1, 8, 64, 64, [&](const float* Cs) {
#pragma unroll 2
          for (int it = 0; it < 8; ++it) {
            int id = it * 256 + tid; int r = id >> 4, c = (id & 15) * 8; float v[8]; ld8(Cs, r, c, v);
            u32x4 d = *(const u32x4*)(MG + (long)r * 2048 + c);
#pragma unroll
            for (int i = 0; i < 4; ++i) { v[2 * i] *= bf2f(d[i] & 0xffffu); v[2 * i + 1] *= bf2f(d[i] >> 16); }
            *(f32x4*)(scr + id * 8) = (f32x4){v[0], v[1], v[2], v[3]}; *(f32x4*)(scr + id * 8 + 4) = (f32x4){v[4], v[5], v[6], v[7]};
          }
        });
        RowLin a2{(const bf16_t*)(ws + OFF_D) + (long)M_ * 512 + (long)brow * 512, 512};
        RowLin b2{(const bf16_t*)(ws + OFF_WPB) + (long)bcol * 512, 512};
        bf16_t* MX = (bf16_t*)(ws + OFF_C + C_MIXED) + (long)brow * 1024 + bcol;
        gemm_tile(smem, a2, b2, 8, 64, 64, [&](const float* Cs) {
#pragma unroll 2
          for (int it = 0; it < 8; ++it) {
            int id = it * 256 + tid; int r = id >> 4, c = (id & 15) * 8; float v[8]; ld8(Cs, r, c, v);
            u32x4 d = *(const u32x4*)(MG + (long)r * 2048 + 1024 + c);
            f32x4 p0 = *(const f32x4*)(scr + id * 8), p1 = *(const f32x4*)(scr + id * 8 + 4);
            float pv[8] = {p0[0], p0[1], p0[2], p0[3], p1[0], p1[1], p1[2], p1[3]};
#pragma unroll
            for (int i = 0; i < 4; ++i) { v[2 * i] = pv[2 * i] + v[2 * i] * bf2f(d[i] & 0xffffu); v[2 * i + 1] = pv[2 * i + 1] + v[2 * i + 1] * bf2f(d[i] >> 16); }
            *(u32x4*)(MX + (long)r * 1024 + c) = pack8(v);
          }
        });
      }
    } break;
    case 5: case 9: case 12: {
      const bf16_t* A; const bf16_t* W; const float* RES; float* DST; int K;
      if (ph == 5) { A = (const bf16_t*)(ws + OFF_C + C_MIXED); W = (const bf16_t*)(ws + OFF_WOUT); RES = P.x; DST = (float*)(ws + OFF_B); K = 1024; }
      else if (ph == 9) { A = (const bf16_t*)(ws + OFF_D) + (long)M_ * 512; W = (const bf16_t*)(ws + OFF_WMO); RES = (const float*)(ws + OFF_B); DST = (float*)(ws + OFF_C + C_H2); K = 512; }
      else { A = (const bf16_t*)(ws + OFF_B); W = (const bf16_t*)(ws + OFF_WDN); RES = (const float*)(ws + OFF_C + C_H2); DST = P.out; K = 2816; }
      const int xq = blockIdx.x & 7, lq = blockIdx.x >> 3, sq = gridDim.x >> 3;
      for (int t = lq; t < 16 * 4; t += sq) {
        const int mt = xq * 16 + (t & 15), nt2 = t >> 4, brow = mt * 128;
        RowLin ar{A + (long)brow * K, K}; RowLin br{W + (long)nt2 * 256 * K, K};
        gemm_tile2(smem, ar, br, K / 64, [&](const float* Cs, int p) {
          const int bcol = nt2 * 256 + p * 128;
          const float* rs = RES + (long)brow * 1024 + bcol; float* ds = DST + (long)brow * 1024 + bcol;
#pragma unroll 2
          for (int it = 0; it < 8; ++it) {
            int id = it * 256 + tid; int r = id >> 4, c = (id & 15) * 8;
            f32x4 a = *(const f32x4*)(Cs + r * CS_LD + c), bq = *(const f32x4*)(Cs + r * CS_LD + c + 4);
            f32x4 r0 = __builtin_nontemporal_load((const f32x4*)(rs + (long)r * 1024 + c)), r1 = __builtin_nontemporal_load((const f32x4*)(rs + (long)r * 1024 + c + 4));
            const f32x4 h0 = a + r0, h1v = bq + r1;
            *(f32x4*)(ds + (long)r * 1024 + c) = h0; *(f32x4*)(ds + (long)r * 1024 + c + 4) = h1v;
            if (ph != 12) {
              const float* gn = (ph == 5 ? P.norm_mq : P.norm_ffn) + bcol + c;
              const f32x4 g0 = *(const f32x4*)gn, g1 = *(const f32x4*)(gn + 4);
              float v[8] = {h0[0] * g0[0], h0[1] * g0[1], h0[2] * g0[2], h0[3] * g0[3], h1v[0] * g1[0], h1v[1] * g1[1], h1v[2] * g1[2], h1v[3] * g1[3]};
              *(u32x4*)((bf16_t*)(ws + OFF_A) + (long)(brow + r) * 1024 + bcol + c) = pack8(v);
              float ss = (h0[0] * h0[0] + h0[1] * h0[1]) + (h0[2] * h0[2] + h0[3] * h0[3]) + (h1v[0] * h1v[0] + h1v[1] * h1v[1]) + (h1v[2] * h1v[2] + h1v[3] * h1v[3]);
              ss += __shfl_xor(ss, 1, 64); ss += __shfl_xor(ss, 2, 64); ss += __shfl_xor(ss, 4, 64); ss += __shfl_xor(ss, 8, 64);
              if ((tid & 15) == 0) ((float*)(ws + (ph == 5 ? OFF_SSQ1 : OFF_SSQ2)))[(long)(brow + r) * 8 + nt2 * 2 + p] = ss;
            }
          }
        });
      }
    } break;
    case 6: case 10: {
      const float* src = ph == 6 ? (const float*)(ws + OFF_B) : (const float*)(ws + OFF_C + C_H2);
      const float* g = ph == 6 ? P.norm_mq : P.norm_ffn;
      (void)src; (void)g;
    } break;
    case 7: {
      const int xq = blockIdx.x & 7, lq = blockIdx.x >> 3, sq = gridDim.x >> 3;
      for (int t = lq; t < 16 * 4; t += sq) {
        const int mt = xq * 16 + (t & 15), nt = t >> 4, brow = mt * 128;
        RowLin ar{(const bf16_t*)(ws + OFF_A) + (long)brow * 1024, 1024}; RowLin br{(const bf16_t*)(ws + OFF_WMQ) + (long)nt * 128 * 1024, 1024};
        gemm_tile(smem, ar, br, 16, 64, 64, [&](const float* Cs) {
          bf16_t* dq = (bf16_t*)(ws + OFF_D) + (long)brow * 512 + nt * 128; const float* sq1 = (const float*)(ws + OFF_SSQ1) + (long)brow * 8;
#pragma unroll 2
          for (int it = 0; it < 8; ++it) {
            int id = it * 256 + tid; int r = id >> 4, c = (id & 15) * 8; float v[8]; ld8(Cs, r, c, v);
            const f32x4 s0 = *(const f32x4*)(sq1 + r * 8), s1 = *(const f32x4*)(sq1 + r * 8 + 4);
            const float ssum = ((s0[0] + s0[1]) + (s0[2] + s0[3])) + ((s1[0] + s1[1]) + (s1[2] + s1[3]));
            const float rr = rsqrtf(ssum * (1.f / 1024.f) + 1e-6f) * (0.08838834764831845f * LOG2E);
#pragma unroll
            for (int i = 0; i < 8; ++i) v[i] *= rr;
            *(u32x4*)(dq + (long)r * 512 + c) = pack8(v);
          }
        });
        asm volatile("s_waitcnt vmcnt(0)" ::: "memory");
        __syncthreads();
        xattn_tile(P, ((brow >> 5) + (tid >> 6)) * 4 + nt);
      }
    } break;
    case 8: {
      if (ph_fused) break;
      for (int job = blockIdx.x; job < 512; job += gridDim.x) xattn_tile(P, job * 4 + (tid >> 6));
    } break;
    case 11: {
      const int xq = blockIdx.x & 7, lq = blockIdx.x >> 3, sq = gridDim.x >> 3;
      for (int t = lq; t < 16 * 22; t += sq) {
        const int mt = xq * 16 + (t & 15), nt2 = t >> 4, brow = mt * 128;
        RowLin ar{(const bf16_t*)(ws + OFF_A) + (long)brow * 1024, 1024}; RowLin br{(const bf16_t*)(ws + OFF_WGU) + (long)nt2 * 256 * 1024, 1024};
        gemm_tile2(smem, ar, br, 16, [&](const float* Cs, int p) {
          bf16_t* ACT = (bf16_t*)(ws + OFF_B) + (long)brow * 2816 + (nt2 * 2 + p) * 64;
#pragma unroll 2
          for (int it = 0; it < 4; ++it) {
            int id = it * 256 + tid; int r = id >> 3, c = (id & 7) * 8; float gt[8], up[8]; ld8(Cs, r, c, gt); ld8(Cs, r, c + 64, up);
            const float* sq2 = (const float*)(ws + OFF_SSQ2) + (long)(brow + r) * 8;
            const f32x4 s0 = *(const f32x4*)(sq2), s1 = *(const f32x4*)(sq2 + 4);
            const float ssum = ((s0[0] + s0[1]) + (s0[2] + s0[3])) + ((s1[0] + s1[1]) + (s1[2] + s1[3]));
            const float rr = rsqrtf(ssum * (1.f / 1024.f) + 1e-6f);
#pragma unroll
            for (int i = 0; i < 8; ++i) { const float gg = gt[i] * rr; gt[i] = gg * sigm(gg) * (up[i] * rr); }
            __builtin_nontemporal_store(pack8(gt), (u32x4*)(ACT + (long)r * 2816 + c));
          }
        });
      }
    } break;
    case 13: {
      for (int job = blockIdx.x; job < 1024; job += gridDim.x) { int row = job * 16 + (tid >> 6) * 4; rownorm_rows<true, 4>(P.out + (long)row * 1024, P.norm_final, P.out + (long)row * 1024); }
    } break;
#ifdef PROBE_K
    case 14: {
      const bf16_t* s0 = (const bf16_t*)(ws + PROBE_SRC0); const bf16_t* s1 = (const bf16_t*)(ws + PROBE_SRC1);
      for (long i = (long)blockIdx.x * 256 + tid; i < (long)M_ * 512; i += (long)gridDim.x * 256) {
        long row = i >> 9; int c = (int)(i & 511);
        P.out[row * 1024 + c] = bf2f(s0[i]); P.out[row * 1024 + 512 + c] = bf2f(s1[i]);
      }
    } break;
    case 15: {
      const float* s0 = (const float*)(ws + PROBE_SRC0);
      for (long i = (long)blockIdx.x * 256 + tid; i < (long)M_ * 1024; i += (long)gridDim.x * 256) P.out[i] = s0[i];
    } break;
#endif
  }
}

__global__ void __launch_bounds__(256, 2) fwd_kernel(Params P, int ph_lo, int ph_hi) {
  __shared__ __attribute__((aligned(16))) char smem[81920];
  unsigned st_nloc = 0u, st_nx = 0u;
  const unsigned xcc = xb_xcc_id();
  if (ph_lo < ph_hi) {
    if (threadIdx.x == 0) (void)xb_add(&((unsigned*)(P.ws + OFF_BAR))[XB_XCNT(xcc)], 1u);
  }
  if (ph_hi < 0) cg::this_grid().sync();
  for (int ph = ph_lo; ph <= ph_hi; ++ph) {
    const uint64_t __attribute__((address_space(4)))* ka = (const uint64_t __attribute__((address_space(4)))*)__builtin_amdgcn_kernarg_segment_ptr();
    asm volatile("" : "+s"(ka));
    Params Pl; uint64_t* pd = (uint64_t*)&Pl;
#pragma unroll
    for (int i = 0; i < (int)(sizeof(Params) / 8); ++i) {
      const char __attribute__((address_space(1)))* gp = (const char __attribute__((address_space(1)))*)ka[i];
      pd[i] = (uint64_t)(const char*)gp;
    }
    if (ph == 6 || ph == 10 || ph == 8) continue;
    run_phase(Pl, ph, smem, true);
    if (ph < ph_hi) xcd_barrier((unsigned*)(Pl.ws + OFF_BAR), xcc, st_nloc, st_nx);
  }
}

extern "C" void kernel_launch(void* const* d_in, const int* in_sizes, int n_in, void* d_out, int out_size, void* d_ws, size_t ws_size,
                              hipStream_t stream) {
  static int grid_blocks = 0;
  if (!grid_blocks) {
    int dev = 0, cus = 0, per_cu = 0;
    hipGetDevice(&dev);
    hipDeviceGetAttribute(&cus, hipDeviceAttributeMultiprocessorCount, dev);
    hipOccupancyMaxActiveBlocksPerMultiprocessor(&per_cu, fwd_kernel, 256, 0);
    if (per_cu > 2) per_cu = 2;
    if (per_cu < 1) per_cu = 1;
    grid_blocks = cus * per_cu;
  }
  if (ws_size < (size_t)WS_NEED) fprintf(stderr, "workspace too small: %zu < %ld\n", ws_size, (long)WS_NEED);
  Params P{};
  const float** pp = (const float**)&P;
  for (int i = 0; i < 27; ++i) pp[i] = (const float*)d_in[i];
  P.out = (float*)d_out; P.ws = (char*)d_ws;
#if ONE_LAUNCH
  hipMemsetAsync((char*)d_ws + OFF_BAR, 0, XCD_BAR_WORDS * 4, stream);
#ifdef PROBE_K
  int lo = 0, hi = PROBE_DUMP;
#else
  int lo = 0, hi = 13;
#endif
  void* args[] = {&P, &lo, &hi};
  hipError_t e = hipLaunchCooperativeKernel((void*)fwd_kernel, dim3(grid_blocks), dim3(256), args, 0, stream);
  if (e != hipSuccess) fprintf(stderr, "cooperative launch failed: %s (grid %d)\n", hipGetErrorString(e), grid_blocks);
#else
  for (int ph = 0; ph <= 13; ++ph) fwd_kernel<<<grid_blocks, 256, 0, stream>>>(P, ph, ph);
#endif
}
```

```cpp
#include <hip/hip_runtime.h>
#include <hip/hip_cooperative_groups.h>
#include <stdint.h>
#include <stdio.h>
namespace cg = cooperative_groups;

#ifndef NSA_G0
#define NSA_G0 1.f
#define NSA_G1 1.f
#define NSA_G2 1.f
#endif
#ifndef ONE_LAUNCH
#define ONE_LAUNCH 1
#endif

typedef unsigned short bf16_t;
using bf16x8 = __attribute__((ext_vector_type(8))) short;
using f32x4 = __attribute__((ext_vector_type(4))) float;
using u32x4 = __attribute__((ext_vector_type(4))) unsigned;
using u32x2 = __attribute__((ext_vector_type(2))) unsigned;

#define T_ 8192
#define M_ 16384
#define NEGF (-1e30f)
#define LOG2E 1.4426950408889634f

constexpr long OFF_W1 = 0;
constexpr long OFF_WMKV = OFF_W1 + 4608L * 1024 * 2;
constexpr long OFF_WPA = OFF_WMKV + 2097152;
constexpr long OFF_WPB = OFF_WPA + 1048576;
constexpr long OFF_WOUT = OFF_WPB + 1048576;
constexpr long OFF_WMQ = OFF_WOUT + 2097152;
constexpr long OFF_WMO = OFF_WMQ + 1048576;
constexpr long OFF_WGU = OFF_WMO + 1048576;
constexpr long OFF_WDN = OFF_WGU + 11534336;
constexpr long OFF_WCK1 = OFF_WDN + 5767168;
constexpr long OFF_WCV1 = OFF_WCK1 + 524288;
constexpr long OFF_WM = OFF_WCV1 + 524288;
constexpr long OFF_BIAS1 = OFF_WM + 131072;
constexpr long OFF_MEMN = OFF_BIAS1 + 1024;
constexpr long OFF_MK = OFF_MEMN + 1048576;
constexpr long OFF_MVT = OFF_MK + 524288;
constexpr long OFF_KCMP = OFF_MVT + 524288;
constexpr long OFF_VCT = OFF_KCMP + 262144;
constexpr long OFF_A = OFF_VCT + 262144;
constexpr long OFF_B = OFF_A + 33554432;
constexpr long OFF_D = OFF_B + 67108864;
constexpr long OFF_C = OFF_D + 33554432;
constexpr long C_Q = 0, C_U = 16777216, C_GVT = 33554432, C_KC = 50331648, C_VC = 54525952, C_KS = 58720256,
               C_KW = 62914560, C_VST = 67108864, C_VWT = 71303168, C_GATES = 75497472;
constexpr long C_MIXED = 0, C_SCR = 33554432, C_H2 = 0;
constexpr long OFF_BAR = OFF_C + 77070336;
constexpr long OFF_SSQ1 = OFF_BAR + 16384;
constexpr long OFF_SSQ2 = OFF_SSQ1 + 524288;
constexpr long WS_NEED = OFF_SSQ2 + 524288;

struct Params {
  const float *x, *mem, *norm_mix, *w_in, *w_ck1, *w_ck2, *w_cv1, *w_cv2, *pe_k, *pe_v, *ln_sgu, *w_sp, *b_sp,
      *w_pa, *w_pb, *w_merge, *b_merge, *w_out, *norm_mq, *norm_mkv, *w_mq, *w_mkv, *w_mo, *norm_ffn, *w_gu, *w_dn, *norm_final;
  float* out;
  char* ws;
};

__device__ __forceinline__ int tidx() { int t = threadIdx.x; asm volatile("" : "+v"(t)); return t; }
__device__ __forceinline__ unsigned f2bf(float f) { unsigned u = __float_as_uint(f); u += 0x7fffu + ((u >> 16) & 1u); return u >> 16; }
__device__ __forceinline__ unsigned pack2(float a, float b) { unsigned r; asm("v_cvt_pk_bf16_f32 %0, %1, %2" : "=v"(r) : "v"(a), "v"(b)); return r; }
__device__ __forceinline__ float bf2f(unsigned h) { return __uint_as_float(h << 16); }
__device__ __forceinline__ float gelu_tanh(float x) { float u = 0.7978845608028654f * (x + 0.044715f * x * x * x); return x / (1.f + __expf(-2.f * u)); }
__device__ __forceinline__ float sigm(float x) { return 1.f / (1.f + __expf(-x)); }
__device__ __forceinline__ float wave_sum(float v) {
#pragma unroll
  for (int o = 32; o > 0; o >>= 1) v += __shfl_xor(v, o, 64);
  return v;
}
__device__ __forceinline__ u32x4 pack8(const float (&v)[8]) {
  u32x4 r; r[0] = pack2(v[0], v[1]); r[1] = pack2(v[2], v[3]); r[2] = pack2(v[4], v[5]); r[3] = pack2(v[6], v[7]); return r;
}

__device__ __forceinline__ int lds_byte(int r, int c) {
  int st = (r >> 4) * 2 + (c >> 5), rr = r & 15, cc = c & 31, ob = rr * 64 + cc * 2;
  return st * 1024 + (ob ^ (((ob >> 9) & 1) << 5));
}
__device__ __forceinline__ void stage_rc(int b, int& R, int& C) {
  int st = b >> 10, sb = b & 1023, swz = sb ^ (((sb >> 9) & 1) << 5);
  R = (st >> 1) * 16 + (swz >> 6); C = (st & 1) * 32 + ((swz & 63) >> 1);
}

#define CS_LD 132
__device__ __forceinline__ void ld8(const float* Cs, int r, int c, float (&v)[8]) {
  f32x4 a = *(const f32x4*)(Cs + r * CS_LD + c); f32x4 b = *(const f32x4*)(Cs + r * CS_LD + c + 4);
  v[0] = a[0]; v[1] = a[1]; v[2] = a[2]; v[3] = a[3]; v[4] = b[0]; v[5] = b[1]; v[6] = b[2]; v[7] = b[3];
}
__device__ __forceinline__ void ld8T(const float* Cs, int r8, int c, float (&v)[8]) {
#pragma unroll
  for (int i = 0; i < 8; ++i) v[i] = Cs[(r8 + i) * CS_LD + c];
}

struct RowLin {
  const bf16_t* base; long ld;
  __device__ __forceinline__ const bf16_t* operator()(int r) const { return base + (long)r * ld; }
};
struct RowCmp {
  const bf16_t* base; int brow;
  __device__ __forceinline__ const bf16_t* operator()(int r) const {
    int R = brow + r; int b = R >> 10, rem = R & 1023, i = rem >> 1, g = rem & 1; if (i > 510) i = 510;
    return base + ((long)(b * T_ + 16 * i) * 128 + g * 64);
  }
};

template <int AUX = 0, class ARow, class BRow, class Epi>
__device__ __forceinline__ void gemm_tile(char* smem, ARow arow, BRow brow, int nkt, int kstepA, int kstepB, Epi epi) {
  const int tid = tidx(), lane = tid & 63, wave = tid >> 6, wr = wave >> 1, wc = wave & 1, fr = lane & 15, fq = lane >> 4;
  const bf16_t* pa[4]; const bf16_t* pb[4];
#pragma unroll
  for (int i = 0; i < 4; ++i) { int b = tid * 16 + i * 4096; int R, C; stage_rc(b, R, C); pa[i] = arow(R) + C; pb[i] = brow(R) + C; }
  f32x4 acc[4][4];
#pragma unroll
  for (int m = 0; m < 4; ++m)
#pragma unroll
    for (int n = 0; n < 4; ++n) acc[m][n] = (f32x4){0.f, 0.f, 0.f, 0.f};
  {
#pragma unroll
    for (int i = 0; i < 4; ++i) {
      __builtin_amdgcn_global_load_lds((const unsigned*)(pa[i]), (unsigned*)(smem + tid * 16 + i * 4096), 16, 0, AUX);
      __builtin_amdgcn_global_load_lds((const unsigned*)(pb[i]), (unsigned*)(smem + 16384 + tid * 16 + i * 4096), 16, 0, AUX);
    }
  }
  for (int kt = 0; kt < nkt; ++kt) {
    asm volatile("s_waitcnt vmcnt(0)" ::: "memory");
    __syncthreads();
    if (kt + 1 < nkt) {
      char* la = smem + ((kt + 1) & 1) * 32768;
#pragma unroll
      for (int i = 0; i < 4; ++i) {
        __builtin_amdgcn_global_load_lds((const unsigned*)(pa[i] + (long)(kt + 1) * kstepA), (unsigned*)(la + tid * 16 + i * 4096), 16, 0, AUX);
        __builtin_amdgcn_global_load_lds((const unsigned*)(pb[i] + (long)(kt + 1) * kstepB), (unsigned*)(la + 16384 + tid * 16 + i * 4096), 16, 0, AUX);
      }
    }
    const char* la = smem + (kt & 1) * 32768; const char* lb = la + 16384;
#pragma unroll
    for (int ks = 0; ks < 2; ++ks) {
      bf16x8 a[4], b[4];
#pragma unroll
      for (int m = 0; m < 4; ++m) a[m] = *(const bf16x8*)(la + lds_byte(wr * 64 + m * 16 + fr, ks * 32 + fq * 8));
#pragma unroll
      for (int n = 0; n < 4; ++n) b[n] = *(const bf16x8*)(lb + lds_byte(wc * 64 + n * 16 + fr, ks * 32 + fq * 8));
#pragma unroll
      for (int m = 0; m < 4; ++m)
#pragma unroll
        for (int n = 0; n < 4; ++n) acc[m][n] = __builtin_amdgcn_mfma_f32_16x16x32_bf16(a[m], b[n], acc[m][n], 0, 0, 0);
    }
  }
  __syncthreads();
  float* Cs = (float*)smem;
#pragma unroll
  for (int m = 0; m < 4; ++m)
#pragma unroll
    for (int n = 0; n < 4; ++n)
#pragma unroll
      for (int r = 0; r < 4; ++r) Cs[(wr * 64 + m * 16 + fq * 4 + r) * CS_LD + wc * 64 + n * 16 + fr] = acc[m][n][r];
  __syncthreads();
  epi(Cs);
  __syncthreads();
}

template <class F>
__device__ __forceinline__ void store_rows_bf16(const float* Cs, bf16_t* dst, long ld, F f) {
#pragma unroll 2
  for (int it = 0; it < 8; ++it) {
    int id = it * 256 + tidx(); int r = id >> 4, c = (id & 15) * 8;
    float v[8]; ld8(Cs, r, c, v);
#pragma unroll
    for (int i = 0; i < 8; ++i) v[i] = f(v[i], c + i);
    *(u32x4*)(dst + (long)r * ld + c) = pack8(v);
  }
}
template <class F>
__device__ __forceinline__ void store_T_bf16(const float* Cs, bf16_t* dst, long cstride, F f) {
#pragma unroll 2
  for (int it = 0; it < 8; ++it) {
    int id = it * 256 + tidx(); int c = id >> 4, r8 = (id & 15) * 8;
    float v[8]; ld8T(Cs, r8, c, v);
#pragma unroll
    for (int i = 0; i < 8; ++i) v[i] = f(v[i]);
    *(u32x4*)(dst + (long)c * cstride + r8) = pack8(v);
  }
}


__device__ __forceinline__ int lds_byte32(int r, int c) { int rr = r & 15; return (r >> 4) * 1024 + rr * 64 + ((((c >> 3) ^ ((-(rr >> 2)) & 3)) & 3) << 4); }
__device__ __forceinline__ void stage_rc32(int b, int& R, int& C) { int st = b >> 10, sb = b & 1023, rr = sb >> 6, cp = (sb >> 4) & 3; R = st * 16 + rr; C = ((cp ^ ((-(rr >> 2)) & 3)) & 3) * 8; }
struct RowClamp {
  const bf16_t* base; long ld; int maxr;
  __device__ __forceinline__ const bf16_t* operator()(int r) const { return base + (long)(r < maxr ? r : maxr) * ld; }
};
__device__ __forceinline__ int lds_byte64(int r, int c) { int rr = r & 15; return (r >> 4) * 2048 + rr * 128 + ((((c >> 3) ^ (rr >> 1)) & 7) << 4); }
__device__ __forceinline__ void stage_rc64(int b, int& R, int& C) { int st = b >> 11, sb = b & 2047, rr = sb >> 7, cp = (sb >> 4) & 7; R = st * 16 + rr; C = ((cp ^ (rr >> 1)) & 7) * 8; }
template <class ARow, class BRow, class Epi>
__device__ __forceinline__ void gemm_tile2(char* smem, ARow arow, BRow brow, int nkt, Epi epi) {
  const int tid = tidx(), lane = tid & 63, wave = tid >> 6, wr = wave >> 1, wc = wave & 1, fr = lane & 15, fq = lane >> 4;
  int R0, C0; stage_rc64(tid * 16, R0, C0);
  const bf16_t* pa0 = arow(R0) + C0; const bf16_t* pb0 = brow(R0) + C0;
  const long sa32 = 32 * arow.ld, sb32 = 32 * brow.ld;
  f32x4 acc[4][8];
#pragma unroll
  for (int m = 0; m < 4; ++m)
#pragma unroll
    for (int n = 0; n < 8; ++n) acc[m][n] = (f32x4){0.f, 0.f, 0.f, 0.f};
  __syncthreads();
#pragma unroll
  for (int i = 0; i < 4; ++i) __builtin_amdgcn_global_load_lds((const unsigned*)(pa0 + i * sa32), (unsigned*)(smem + tid * 16 + i * 4096), 16, 0, 0);
#pragma unroll
  for (int i = 0; i < 8; ++i) __builtin_amdgcn_global_load_lds((const unsigned*)(pb0 + i * sb32), (unsigned*)(smem + 16384 + tid * 16 + i * 4096), 16, 0, 0);
  for (int kt = 0; kt < nkt; ++kt) {
    asm volatile("s_waitcnt vmcnt(0)" ::: "memory");
    __syncthreads();
    if (kt + 1 < nkt) {
      char* bn = smem + 16384 + ((kt + 1) & 1) * 32768;
#pragma unroll
      for (int i = 0; i < 8; ++i) __builtin_amdgcn_global_load_lds((const unsigned*)(pb0 + i * sb32 + (long)(kt + 1) * 64), (unsigned*)(bn + tid * 16 + i * 4096), 16, 0, 0);
    }
    {
      const char* pA = smem + lds_byte64(wr * 64 + fr, fq * 8);
      const char* pB = smem + 16384 + (kt & 1) * 32768 + lds_byte64(wc * 128 + fr, fq * 8);
      const int k1 = lds_byte64(fr, 32 + fq * 8) - lds_byte64(fr, fq * 8);
#pragma unroll
      for (int ks = 0; ks < 2; ++ks) {
        bf16x8 a[4], bb[8];
#pragma unroll
        for (int m = 0; m < 4; ++m) a[m] = *(const bf16x8*)(pA + m * 2048 + ks * k1);
#pragma unroll
        for (int n = 0; n < 8; ++n) bb[n] = *(const bf16x8*)(pB + n * 2048 + ks * k1);
#pragma unroll
        for (int m = 0; m < 4; ++m)
#pragma unroll
          for (int n = 0; n < 8; ++n) acc[m][n] = __builtin_amdgcn_mfma_f32_16x16x32_bf16(a[m], bb[n], acc[m][n], 0, 0, 0);
      }
    }
    __syncthreads();
    if (kt + 1 < nkt) {
#pragma unroll
      for (int i = 0; i < 4; ++i) __builtin_amdgcn_global_load_lds((const unsigned*)(pa0 + i * sa32 + (long)(kt + 1) * 64), (unsigned*)(smem + tid * 16 + i * 4096), 16, 0, 0);
    }
  }
  float* Cs = (float*)smem;
#pragma unroll
  for (int p = 0; p < 2; ++p) {
    __syncthreads();
    if (wc == p) {
#pragma unroll
      for (int m = 0; m < 4; ++m)
#pragma unroll
        for (int n = 0; n < 8; ++n)
#pragma unroll
          for (int r = 0; r < 4; ++r) Cs[(wr * 64 + m * 16 + fq * 4 + r) * CS_LD + n * 16 + fr] = acc[m][n][r];
    }
    __syncthreads();
    epi(Cs, p);
  }
  __syncthreads();
}

template <int MODE>
__device__ __forceinline__ void transpose_tile(const float* W, int Nsrc, bf16_t* Wt, int Kd, int k0, int n0, float* lds) {
  const int tid = tidx();
  {
    int tx = tid & 63, ty = tid >> 6; int np = n0 + tx; int sc;
    if (MODE == 0) sc = np < Nsrc ? np : -1;
    else { int x = np & 127, tl = np >> 7; sc = x < 64 ? tl * 64 + x : 2816 + tl * 64 + x - 64; }
    float v[32];
#pragma unroll
    for (int i = 0; i < 32; ++i) v[i] = sc >= 0 ? W[(long)(k0 + ty + 4 * i) * Nsrc + sc] : 0.f;
#pragma unroll
    for (int i = 0; i < 32; ++i) lds[(ty + 4 * i) * 65 + tx] = v[i];
  }
  __syncthreads();
  {
    int nrow = tid >> 2, kseg = (tid & 3) * 32;
#pragma unroll
    for (int q = 0; q < 4; ++q) {
      float v[8];
#pragma unroll
      for (int i = 0; i < 8; ++i) v[i] = lds[(kseg + q * 8 + i) * 65 + nrow];
      *(u32x4*)(Wt + (long)(n0 + nrow) * Kd + k0 + kseg + q * 8) = pack8(v);
    }
  }
  __syncthreads();
}

template <bool OUTF, int NR>
__device__ __forceinline__ void rownorm_rows(const float* src, const float* g, void* dst) {
  const int lane = tidx() & 63;
  f32x4 v[NR][4];
#pragma unroll
  for (int r = 0; r < NR; ++r)
#pragma unroll
    for (int i = 0; i < 4; ++i) v[r][i] = *(const f32x4*)(src + (long)r * 1024 + i * 256 + lane * 4);
  f32x4 gg[4];
#pragma unroll
  for (int i = 0; i < 4; ++i) gg[i] = *(const f32x4*)(g + i * 256 + lane * 4);
#pragma unroll
  for (int r = 0; r < NR; ++r) {
    float ss = 0.f;
#pragma unroll
    for (int i = 0; i < 4; ++i) ss += v[r][i][0] * v[r][i][0] + v[r][i][1] * v[r][i][1] + v[r][i][2] * v[r][i][2] + v[r][i][3] * v[r][i][3];
    ss = wave_sum(ss);
    const float rr = rsqrtf(ss * (1.f / 1024.f) + 1e-6f);
#pragma unroll
    for (int i = 0; i < 4; ++i) {
      float o0 = v[r][i][0] * rr * gg[i][0], o1 = v[r][i][1] * rr * gg[i][1], o2 = v[r][i][2] * rr * gg[i][2], o3 = v[r][i][3] * rr * gg[i][3];
      if (OUTF) { __builtin_nontemporal_store((f32x4){o0, o1, o2, o3}, (f32x4*)((float*)dst + (long)r * 1024 + i * 256 + lane * 4)); }
      else { u32x2 p; p[0] = pack2(o0, o1); p[1] = pack2(o2, o3); *(u32x2*)((bf16_t*)dst + (long)r * 1024 + i * 256 + lane * 4) = p; }
    }
  }
}

__device__ void phase0(const Params& P, char* smem) {
  float* lds = (float*)smem;
  const int tid = tidx();
  const int NJ = 8 + 1024 + 32 + 32 + 2192;
  for (int job = blockIdx.x; job < NJ; job += gridDim.x) {
    int j = job;
    if (j < 8) {
      int n = j * 32 + (tid & 31), sl = tid >> 5; int kv = n >> 7, nn = n & 127;
      const float* pe = kv ? P.pe_v : P.pe_k; const float* w1 = kv ? P.w_cv1 : P.w_ck1;
      float s = 0.f;
      for (int k = sl * 256; k < sl * 256 + 256; ++k) s += pe[k] * w1[(long)k * 128 + nn];
      lds[sl * 32 + (tid & 31)] = s;
      __syncthreads();
      if (tid < 32) { float t = 0.f; for (int q = 0; q < 8; ++q) t += lds[q * 32 + tid]; ((float*)(P.ws + OFF_BIAS1))[j * 32 + tid] = t; }
      __syncthreads();
      continue;
    }
    j -= 8;
    if (j < 1024) { int row = j * 16 + (tid >> 6) * 4; rownorm_rows<false, 4>(P.x + (long)row * 1024, P.norm_mix, (bf16_t*)(P.ws + OFF_A) + (long)row * 1024); continue; }
    j -= 1024;
    if (j < 32) { int row = j * 16 + (tid >> 6) * 4; rownorm_rows<false, 4>(P.mem + (long)row * 1024, P.norm_mkv, (bf16_t*)(P.ws + OFF_MEMN) + (long)row * 1024); continue; }
    j -= 32;
    if (j < 32) {
      int e0 = j * 2048 + tid * 8; float v[8];
#pragma unroll
      for (int i = 0; i < 8; ++i) { int e = e0 + i; int t = (e >> 7) & 127, s = e & 127; v[i] = s <= t ? P.w_sp[e] : 0.f; }
      *(u32x4*)((bf16_t*)(P.ws + OFF_WM) + e0) = pack8(v);
      continue;
    }
    j -= 32;
#define TRJ(KT, NT, W, NSRC, WT, KD, MODE) \
    if (j < (KT) * (NT)) { transpose_tile<MODE>(W, NSRC, (bf16_t*)(P.ws + (WT)), KD, (j % (KT)) * 128, (j / (KT)) * 64, lds); continue; } \
    j -= (KT) * (NT);
    TRJ(8, 88, P.w_gu, 5632, OFF_WGU, 1024, 1)
    TRJ(22, 16, P.w_dn, 1024, OFF_WDN, 2816, 0)
    TRJ(8, 38, P.w_in, 2328, OFF_W1, 1024, 0)
    TRJ(8, 32, P.w_merge, 2048, OFF_W1 + 2432L * 1024 * 2, 1024, 0)
    TRJ(8, 16, P.w_mkv, 1024, OFF_WMKV, 1024, 0)
    TRJ(8, 16, P.w_out, 1024, OFF_WOUT, 1024, 0)
    TRJ(4, 16, P.w_pa, 1024, OFF_WPA, 512, 0)
    TRJ(4, 16, P.w_pb, 1024, OFF_WPB, 512, 0)
    TRJ(8, 8, P.w_mq, 512, OFF_WMQ, 1024, 0)
    TRJ(4, 16, P.w_mo, 1024, OFF_WMO, 512, 0)
    TRJ(16, 2, P.w_ck1, 128, OFF_WCK1, 2048, 0)
    TRJ(16, 2, P.w_cv1, 128, OFF_WCV1, 2048, 0)
#undef TRJ
  }
}

__device__ void phase1(const Params& P, char* smem) {
  char* ws = P.ws;
  const int NG1 = 128 * 18;
  const int xq = blockIdx.x & 7, lq = blockIdx.x >> 3, sq = gridDim.x >> 3;
  for (int t = lq; t < 16 * 12; t += sq) {
    {
      const int mt = xq * 16 + (t & 15), nt2 = t >> 4; const int brow = mt * 128;
      RowLin ar{(const bf16_t*)(ws + OFF_A) + (long)brow * 1024, 1024};
      RowLin br{(const bf16_t*)(ws + OFF_W1) + (long)nt2 * 256 * 1024, 1024};
      gemm_tile2(smem, ar, br, 16, [&](const float* Cs, int p) {
        const int nt = nt2 * 2 + p; if (nt >= 35) return;
        char* C = ws + OFF_C;
        if (nt < 4) {
          store_rows_bf16(Cs, (bf16_t*)(C + C_Q) + (long)brow * 512 + nt * 128, 512, [](float v, int) { return v * (0.125f * LOG2E); });
        } else if (nt == 4 || nt == 5 || nt == 6 || nt == 8) {
          long off = nt == 4 ? C_KC : nt == 5 ? C_VC : nt == 6 ? C_KS : C_KW;
          store_rows_bf16(Cs, (bf16_t*)(C + off) + (long)brow * 128, 128, [](float v, int) { return v; });
        } else if (nt == 7 || nt == 9) {
          long off = nt == 7 ? C_VST : C_VWT; int b = brow >> 13, tl = brow & 8191;
          store_T_bf16(Cs, (bf16_t*)(C + off) + (long)b * 128 * T_ + tl, T_, [](float v) { return v; });
        } else if (nt < 14) {
          store_rows_bf16(Cs, (bf16_t*)(C + C_U) + (long)brow * 512 + (nt - 10) * 128, 512, [](float v, int) { return gelu_tanh(v); });
        } else if (nt < 18) {
          store_T_bf16(Cs, (bf16_t*)(C + C_GVT) + ((long)(brow >> 7) * 512 + (nt - 14) * 128) * 128, 128, [](float v) { return gelu_tanh(v); });
        } else if (nt == 18) {
          float* gates = (float*)(C + C_GATES);
          for (int id = tidx(); id < 128 * 24; id += 256) { int r = id / 24, c = id % 24; gates[(long)(brow + r) * 24 + c] = sigm(Cs[r * CS_LD + c]); }
        } else {
          const float* bm = P.b_merge + (nt - 19) * 128;
          store_rows_bf16(Cs, (bf16_t*)(ws + OFF_B) + (long)brow * 2048 + (nt - 19) * 128, 2048, [bm](float v, int c) { return sigm(v + bm[c]); });
        }
      });
    }
  }
}

__device__ void phase2(const Params& P, char* smem) {
  char* ws = P.ws; const int tid = tidx();
  for (int job = blockIdx.x; job < 32 + 128; job += gridDim.x) {
    if (job < 32) {
      const int kv = job >> 4, mt = job & 15, brow = mt * 128;
      RowCmp ar{(const bf16_t*)(ws + OFF_C + (kv ? C_VC : C_KC)), brow};
      RowLin br{(const bf16_t*)(ws + (kv ? OFF_WCV1 : OFF_WCK1)), 2048};
      const float* bias1 = (const float*)(ws + OFF_BIAS1) + kv * 128;
      const float* w2 = kv ? P.w_cv2 : P.w_ck2;
      gemm_tile(smem, ar, br, 32, 128, 64, [&](const float* Csc) {
        float* Cs = (float*)Csc;
        for (int it = 0; it < 64; ++it) { int id = it * 256 + tid; int r = id >> 7, n = id & 127; Cs[r * CS_LD + n] = gelu_tanh(Cs[r * CS_LD + n] + bias1[n]); }
        __syncthreads();
        const int r = tid >> 1, half = tid & 1;
        float acc[32];
#pragma unroll
        for (int i = 0; i < 32; ++i) acc[i] = 0.f;
        for (int n = 0; n < 128; ++n) {
          float h = Cs[r * CS_LD + n]; const float* wr = w2 + n * 64 + half * 32;
#pragma unroll
          for (int q = 0; q < 8; ++q) { f32x4 w = *(const f32x4*)(wr + q * 4); acc[q * 4] += h * w[0]; acc[q * 4 + 1] += h * w[1]; acc[q * 4 + 2] += h * w[2]; acc[q * 4 + 3] += h * w[3]; }
        }
        const int R = brow + r; const int b = R >> 10, rem = R & 1023, i = rem >> 1, g = rem & 1;
        if (i >= 511) {
#pragma unroll
          for (int q = 0; q < 32; ++q) acc[q] = 0.f;
        }
        if (kv == 0) {
          bf16_t* dst = (bf16_t*)(ws + OFF_KCMP) + (long)(b * 512 + i) * 128 + g * 64 + half * 32;
#pragma unroll
          for (int q = 0; q < 4; ++q) { float v[8];
#pragma unroll
            for (int e = 0; e < 8; ++e) v[e] = acc[q * 8 + e];
            *(u32x4*)(dst + q * 8) = pack8(v); }
        } else {
          bf16_t* dst = (bf16_t*)(ws + OFF_VCT) + ((long)(b * 128 + g * 64 + half * 32)) * 512 + i;
#pragma unroll
          for (int q = 0; q < 32; ++q) dst[(long)q * 512] = (bf16_t)f2bf(acc[q]);
        }
      });
    } else {
      const int bc = job - 32; bf16_t* base = (bf16_t*)(ws + OFF_C + C_GVT) + (long)bc * 512 * 128;
      float* ssum = (float*)smem; float* ssq = ssum + 128;
      float* psum = ssum + 256; float* psq = psum + 16 * 128;
      const int cs = tid >> 4, s8 = (tid & 15) * 8;
      float a[8], q[8];
#pragma unroll
      for (int i = 0; i < 8; ++i) { a[i] = 0.f; q[i] = 0.f; }
      for (int it = 0; it < 32; ++it) {
        u32x4 d = *(const u32x4*)(base + (long)(it * 16 + cs) * 128 + s8);
#pragma unroll
        for (int i = 0; i < 4; ++i) { float lo = bf2f(d[i] & 0xffffu), hi = bf2f(d[i] >> 16); a[2 * i] += lo; q[2 * i] += lo * lo; a[2 * i + 1] += hi; q[2 * i + 1] += hi * hi; }
      }
#pragma unroll
      for (int i = 0; i < 8; ++i) { psum[cs * 128 + s8 + i] = a[i]; psq[cs * 128 + s8 + i] = q[i]; }
      __syncthreads();
      if (tid < 128) {
        float su = 0.f, sq = 0.f;
        for (int c = 0; c < 16; ++c) { su += psum[c * 128 + tid]; sq += psq[c * 128 + tid]; }
        float mean_t = su * (1.f / 512.f); float var = sq * (1.f / 512.f) - mean_t * mean_t; if (var < 0.f) var = 0.f;
        ssum[tid] = mean_t; ssq[tid] = rsqrtf(var + 1e-6f);
      }
      __syncthreads();
      float mean[8], rs[8];
#pragma unroll
      for (int i = 0; i < 8; ++i) { mean[i] = ssum[s8 + i]; rs[i] = ssq[s8 + i]; }
      for (int it = 0; it < 32; ++it) {
        int ch = it * 16 + cs; float gg = P.ln_sgu[ch];
        u32x4 d = *(const u32x4*)(base + (long)ch * 128 + s8); float v[8];
#pragma unroll
        for (int i = 0; i < 4; ++i) { v[2 * i] = bf2f(d[i] & 0xffffu); v[2 * i + 1] = bf2f(d[i] >> 16); }
#pragma unroll
        for (int i = 0; i < 8; ++i) v[i] = (v[i] - mean[i]) * rs[i] * gg;
        *(u32x4*)(base + (long)ch * 128 + s8) = pack8(v);
      }
      __syncthreads();
    }
  }
  if (blockIdx.x >= 32) {
    for (int mtile = blockIdx.x - 32; mtile < 768 + 32; mtile += gridDim.x - 32) {
      if (mtile >= 768) {
        const int j = mtile - 768; const int mt = j >> 3, nt = j & 7; const int brow = mt * 128;
        RowLin ar{(const bf16_t*)(ws + OFF_MEMN) + (long)brow * 1024, 1024};
        RowLin br{(const bf16_t*)(ws + OFF_WMKV) + (long)nt * 128 * 1024, 1024};
        gemm_tile(smem, ar, br, 16, 64, 64, [&](const float* Cs) {
          if (nt < 4) store_rows_bf16(Cs, (bf16_t*)(ws + OFF_MK) + (long)brow * 512 + nt * 128, 512, [](float v, int) { return v; });
          else { int b = mt >> 1, n0 = (mt & 1) * 128; store_T_bf16(Cs, (bf16_t*)(ws + OFF_MVT) + ((long)b * 512 + (nt - 4) * 128) * 256 + n0, 256, [](float v) { return v; }); }
        });
        continue;
      }
      const int mt = mtile & 127, nt2 = 12 + (mtile >> 7), brow = mt * 128;
      RowLin ar{(const bf16_t*)(ws + OFF_A) + (long)brow * 1024, 1024};
      RowLin br{(const bf16_t*)(ws + OFF_W1) + (long)nt2 * 256 * 1024, 1024};
      gemm_tile2(smem, ar, br, 16, [&](const float* Cs, int p) {
        const int nt = nt2 * 2 + p; if (nt >= 35) return;
        const float* bm = P.b_merge + (nt - 19) * 128;
        store_rows_bf16(Cs, (bf16_t*)(ws + OFF_B) + (long)brow * 2048 + (nt - 19) * 128, 2048, [bm](float v, int c) { return sigm(v + bm[c]); });
      });
    }
  }
}

template <int MODE>
__device__ __forceinline__ void nsa_block(const bf16x8 (&qf)[4][2], f32x4 (&oacc)[4][4], float (&m)[4], float (&l)[4],
                                          const float (&sl2)[4], const float (&inv)[4], const bf16_t* kp, const bf16_t* vp, long vdt,
                                          int dist0, bool rowok, float (&asum)[2], float (&bsum)[2]) {
  constexpr int DSTEP = (MODE <= 1) ? 16 : 1;
  bf16x8 kf[2][2];
#pragma unroll
  for (int kt = 0; kt < 2; ++kt)
#pragma unroll
    for (int ks = 0; ks < 2; ++ks) kf[kt][ks] = *(const bf16x8*)(kp + kt * 16 * 128 + ks * 32);
  bf16x8 vf[4];
  if (MODE != 0) {
#pragma unroll
    for (int dt = 0; dt < 4; ++dt) {
      u32x2 lo = *(const u32x2*)(vp + dt * vdt); u32x2 hi = *(const u32x2*)(vp + dt * vdt + 16);
      u32x4 c; c[0] = lo[0]; c[1] = lo[1]; c[2] = hi[0]; c[3] = hi[1];
      vf[dt] = __builtin_bit_cast(bf16x8, c);
    }
  }
  const float fd0 = (float)dist0;
#pragma unroll
  for (int h = 0; h < 4; ++h) {
    f32x4 s[2];
#pragma unroll
    for (int kt = 0; kt < 2; ++kt) {
      s[kt] = __builtin_amdgcn_mfma_f32_16x16x32_bf16(kf[kt][0], qf[h][0], (f32x4){0.f, 0.f, 0.f, 0.f}, 0, 0, 0);
      s[kt] = __builtin_amdgcn_mfma_f32_16x16x32_bf16(kf[kt][1], qf[h][1], s[kt], 0, 0, 0);
    }
    float sc[8]; bool ok[8];
#pragma unroll
    for (int kt = 0; kt < 2; ++kt)
#pragma unroll
      for (int r = 0; r < 4; ++r) {
        const int e = kt * 16 + r; const int dist = dist0 - DSTEP * e;
        bool o = dist >= 0;
        if (MODE == 2) o = o && rowok;
        if (MODE == 3) o = o && (dist < 512);
        ok[kt * 4 + r] = o;
        sc[kt * 4 + r] = o ? s[kt][r] - sl2[h] * (fd0 - (float)(DSTEP * e)) : NEGF;
      }
    float p[8];
    if (MODE != 1) {
      float ml = NEGF;
#pragma unroll
      for (int i = 0; i < 8; ++i) ml = fmaxf(ml, sc[i]);
      ml = fmaxf(ml, __shfl_xor(ml, 16, 64)); ml = fmaxf(ml, __shfl_xor(ml, 32, 64));
      const float mn = fmaxf(m[h], ml); const float alpha = __builtin_amdgcn_exp2f(m[h] - mn); m[h] = mn;
      const float mref = fmaxf(mn, -1e29f);
      float ps = 0.f;
#pragma unroll
      for (int i = 0; i < 8; ++i) { p[i] = __builtin_amdgcn_exp2f(sc[i] - mref); ps += p[i]; }
      l[h] = l[h] * alpha + ps;
      if (MODE != 0) {
        if (__builtin_amdgcn_ballot_w64(alpha != 1.f) != 0ull) {
#pragma unroll
          for (int dt = 0; dt < 4; ++dt) oacc[h][dt] *= alpha;
        }
      }
    } else {
      const float mref1 = fmaxf(m[h], -1e29f);
#pragma unroll
      for (int i = 0; i < 8; ++i) p[i] = __builtin_amdgcn_exp2f(sc[i] - mref1) * l[h];
      asum[0] += (p[0] + p[1]) + (p[2] + p[3]); bsum[0] += p[3];
      asum[1] += (p[4] + p[5]) + (p[6] + p[7]); bsum[1] += p[7];
    }
    if (MODE != 0) {
      u32x4 pk; pk[0] = pack2(p[0], p[1]); pk[1] = pack2(p[2], p[3]); pk[2] = pack2(p[4], p[5]); pk[3] = pack2(p[6], p[7]);
      const bf16x8 pf = __builtin_bit_cast(bf16x8, pk);
#pragma unroll
      for (int dt = 0; dt < 4; ++dt) oacc[h][dt] = __builtin_amdgcn_mfma_f32_16x16x32_bf16(vf[dt], pf, oacc[h][dt], 0, 0, 0);
    }
    __builtin_amdgcn_sched_barrier(0);
  }
}

__device__ void nsa_tile(const Params& P, int wt, char* wl) {
  char* C = P.ws + OFF_C;
  const bf16_t* Q = (const bf16_t*)(C + C_Q);
  const bf16_t* KCMP = (const bf16_t*)(P.ws + OFF_KCMP); const bf16_t* VCT = (const bf16_t*)(P.ws + OFF_VCT);
  const bf16_t* KS = (const bf16_t*)(C + C_KS); const bf16_t* VST = (const bf16_t*)(C + C_VST);
  const bf16_t* KW = (const bf16_t*)(C + C_KW); const bf16_t* VWT = (const bf16_t*)(C + C_VWT);
  const float* GATES = (const float*)(C + C_GATES);
  bf16_t* O = (bf16_t*)(P.ws + OFF_D);
  const int lane = tidx() & 63, qi = lane & 15, quad = lane >> 4;
  wt = __builtin_amdgcn_readfirstlane(wt);
  const int jb = wt >> 2, wv4 = wt & 3;
  const int bg = jb & 3, b = bg >> 1, g = bg & 1;
  const int gq = jb >> 2;
  const int tq = (gq < 64 ? 127 - gq : gq - 64) * 4 + wv4;
  const int t0 = tq * 16;
  const int t = t0 + qi;
  const long row = (long)b * T_ + t;
  bf16x8 qf[4][2];
#pragma unroll
  for (int h = 0; h < 4; ++h)
#pragma unroll
    for (int ks = 0; ks < 2; ++ks) qf[h][ks] = __builtin_nontemporal_load((const bf16x8*)(Q + row * 512 + (g * 4 + h) * 64 + ks * 32 + quad * 8));
  float sl2[4];
#pragma unroll
  for (int h = 0; h < 4; ++h) sl2[h] = __builtin_amdgcn_exp2f(-(float)(g * 4 + h + 1)) * LOG2E;
  f32x4 oacc[4][4]; float m[4], l[4], inv[4]; float asum[2], bsum[2];
  float* imp = (float*)wl; float* outl = (float*)wl;
  unsigned* sel = (unsigned*)(wl + 16384); unsigned* uni = sel + 64;
#pragma unroll
  for (int h = 0; h < 4; ++h) { m[h] = NEGF; l[h] = 0.f; inv[h] = 0.f; }
  asum[0] = asum[1] = bsum[0] = bsum[1] = 0.f;

  const int nI = t0 >> 4; const int nblk = (nI + 31) >> 5;
  for (int blk = nblk - 1; blk >= 0; --blk) {
    const int key0 = blk * 32;
    const bf16_t* kp = KCMP + (long)(b * 512 + key0 + qi) * 128 + g * 64 + quad * 8;
    nsa_block<0>(qf, oacc, m, l, sl2, inv, kp, nullptr, 0, t - 31 - 16 * (key0 + quad * 4), true, asum, bsum);
  }
#pragma unroll
  for (int h = 0; h < 4; ++h) { float lt = l[h]; lt += __shfl_xor(lt, 16, 64); lt += __shfl_xor(lt, 32, 64); l[h] = 1.f / fmaxf(lt, 1e-30f); }
  for (int i = lane; i < 16 * 132; i += 64) imp[i] = 0.f;
#pragma unroll
  for (int h = 0; h < 4; ++h)
#pragma unroll
    for (int dt = 0; dt < 4; ++dt) oacc[h][dt] = (f32x4){0.f, 0.f, 0.f, 0.f};
  for (int blk = 0; blk < nblk; ++blk) {
    const int key0 = blk * 32;
    const bf16_t* kp = KCMP + (long)(b * 512 + key0 + qi) * 128 + g * 64 + quad * 8;
    const bf16_t* vp = VCT + (long)(b * 128 + g * 64 + qi) * 512 + key0 + quad * 4;
    asum[0] = asum[1] = bsum[0] = bsum[1] = 0.f;
    nsa_block<1>(qf, oacc, m, l, sl2, inv, kp, vp, 16 * 512, t - 31 - 16 * (key0 + quad * 4), true, asum, bsum);
    const int J = (key0 >> 2) + quad;
    atomicAdd(&imp[qi * 132 + J], asum[0]); atomicAdd(&imp[qi * 132 + J + 1], bsum[0]);
    atomicAdd(&imp[qi * 132 + J + 4], asum[1]); atomicAdd(&imp[qi * 132 + J + 5], bsum[1]);
  }
  const int cur = t0 >> 6;
  if (lane < 16) {
    unsigned w0 = 0, w1 = 0, w2 = 0, w3 = 0;
    if (cur < 16) { w0 = (1u << (cur + 1)) - 1u; }
    else {
      w0 = 1u;
      { int j = cur; unsigned bit = 1u << (j & 31); int w = j >> 5; if (w == 0) w0 |= bit; else if (w == 1) w1 |= bit; else if (w == 2) w2 |= bit; else w3 |= bit; }
      { int j = cur - 1; unsigned bit = 1u << (j & 31); int w = j >> 5; if (w == 0) w0 |= bit; else if (w == 1) w1 |= bit; else if (w == 2) w2 |= bit; else w3 |= bit; }
    }
    sel[lane * 4 + 0] = w0; sel[lane * 4 + 1] = w1; sel[lane * 4 + 2] = w2; sel[lane * 4 + 3] = w3;
  }
  if (lane < 4) uni[lane] = 0u;
  if (cur >= 16) {
    for (int rnd = 0; rnd < 4; ++rnd) {
      const int qq = rnd * 4 + quad;
      unsigned key[8];
#pragma unroll
      for (int c = 0; c < 8; ++c) {
        const int j = qi + 16 * c;
        const bool v = (j <= cur) && (j != 0) && (j != cur) && (j != cur - 1);
        const unsigned bits = __float_as_uint(imp[qq * 132 + j]);
        key[c] = v ? ((bits & 0xFFFFFF00u) | (unsigned)(128 - j)) : 0u;
      }
      for (int it = 0; it < 13; ++it) {
        unsigned mx = key[0];
#pragma unroll
        for (int c = 1; c < 8; ++c) mx = key[c] > mx ? key[c] : mx;
#pragma unroll
        for (int o = 1; o < 16; o <<= 1) { unsigned ot = (unsigned)__shfl_xor((int)mx, o, 64); mx = ot > mx ? ot : mx; }
        if (mx != 0u) {
#pragma unroll
          for (int c = 0; c < 8; ++c) {
            if (key[c] == mx) { key[c] = 0u; const int j = qi + 16 * c; atomicOr(&sel[qq * 4 + (j >> 5)], 1u << (j & 31)); }
          }
        }
      }
    }
  }
  unsigned mym[4];
#pragma unroll
  for (int w = 0; w < 4; ++w) mym[w] = sel[qi * 4 + w];
  if (lane < 16) {
#pragma unroll
    for (int w = 0; w < 4; ++w) atomicOr(&uni[w], mym[w]);
  }
  const float* gp = GATES + row * 24 + g * 12;
#pragma unroll
  for (int h = 0; h < 4; ++h) {
    const float gt = gp[h * 3 + 0] * NSA_G0;
#pragma unroll
    for (int dt = 0; dt < 4; ++dt) *(f32x4*)(outl + ((h * 16 + qi) * 64 + (((dt * 4 + quad) ^ qi) << 2))) = oacc[h][dt] * gt;
  }
#pragma unroll
  for (int h = 0; h < 4; ++h) { m[h] = NEGF; l[h] = 0.f;
#pragma unroll
    for (int dt = 0; dt < 4; ++dt) oacc[h][dt] = (f32x4){0.f, 0.f, 0.f, 0.f}; }
#pragma unroll 1
  for (int w = 3; w >= 0; --w) {
    unsigned bits = __builtin_amdgcn_readfirstlane(uni[w]);
    const unsigned myw = sel[qi * 4 + w];
    while (bits) {
      const int jj = 31 - __builtin_clz(bits); bits &= ~(1u << jj);
      const int j = w * 32 + jj; const bool rowok = (myw >> jj) & 1u;
#pragma unroll 1
      for (int half = 1; half >= 0; --half) {
        const int key0 = j * 64 + half * 32;
        const bf16_t* kp = KS + (long)(b * T_ + key0 + qi) * 128 + g * 64 + quad * 8;
        const bf16_t* vp = VST + (long)(b * 128 + g * 64 + qi) * T_ + key0 + quad * 4;
        nsa_block<2>(qf, oacc, m, l, sl2, inv, kp, vp, 16L * T_, t - (key0 + quad * 4), rowok, asum, bsum);
      }
    }
  }
#pragma unroll
  for (int h = 0; h < 4; ++h) {
    float lt = l[h]; lt += __shfl_xor(lt, 16, 64); lt += __shfl_xor(lt, 32, 64);
    const float sc = NSA_G1 * gp[h * 3 + 1] / fmaxf(lt, 1e-30f);
#pragma unroll
    for (int dt = 0; dt < 4; ++dt) { f32x4* d = (f32x4*)(outl + ((h * 16 + qi) * 64 + (((dt * 4 + quad) ^ qi) << 2))); *d = *d + oacc[h][dt] * sc; }
  }
#pragma unroll
  for (int h = 0; h < 4; ++h) { m[h] = NEGF; l[h] = 0.f;
#pragma unroll
    for (int dt = 0; dt < 4; ++dt) oacc[h][dt] = (f32x4){0.f, 0.f, 0.f, 0.f}; }
  {
    const int kstart = t0 >= 512 ? ((t0 - 511) & ~31) : 0;
    for (int key0 = (t0 + 15) & ~31; key0 >= kstart; key0 -= 32) {
      const bf16_t* kp = KW + (long)(b * T_ + key0 + qi) * 128 + g * 64 + quad * 8;
      const bf16_t* vp = VWT + (long)(b * 128 + g * 64 + qi) * T_ + key0 + quad * 4;
      nsa_block<3>(qf, oacc, m, l, sl2, inv, kp, vp, 16L * T_, t - (key0 + quad * 4), true, asum, bsum);
    }
  }
#pragma unroll
  for (int h = 0; h < 4; ++h) {
    float lt = l[h]; lt += __shfl_xor(lt, 16, 64); lt += __shfl_xor(lt, 32, 64);
    const float sc = NSA_G2 * gp[h * 3 + 2] / fmaxf(lt, 1e-30f);
#pragma unroll
    for (int dt = 0; dt < 4; ++dt) { f32x4* d = (f32x4*)(outl + ((h * 16 + qi) * 64 + (((dt * 4 + quad) ^ qi) << 2))); *d = *d + oacc[h][dt] * sc; }
  }
#pragma unroll
  for (int it = 0; it < 8; ++it) {
    const int id = it * 64 + lane; const int h = id >> 7, rem = id & 127, q2 = rem >> 3, c8 = rem & 7;
    f32x4 a = *(const f32x4*)(outl + ((h * 16 + q2) * 64 + (((2 * c8) ^ q2) << 2)));
    f32x4 bb = *(const f32x4*)(outl + ((h * 16 + q2) * 64 + (((2 * c8 + 1) ^ q2) << 2)));
    float v[8] = {a[0], a[1], a[2], a[3], bb[0], bb[1], bb[2], bb[3]};
    *(u32x4*)(O + ((long)b * T_ + t0 + q2) * 512 + (g * 4 + h) * 64 + c8 * 8) = pack8(v);
  }
}

__device__ void xattn_tile(const Params& P, int wt) {
  const bf16_t* HQ = (const bf16_t*)(P.ws + OFF_D);
  const bf16_t* MK = (const bf16_t*)(P.ws + OFF_MK); const bf16_t* MVT = (const bf16_t*)(P.ws + OFF_MVT);
  bf16_t* OX = (bf16_t*)(P.ws + OFF_D) + (long)M_ * 512;
  const int lane = tidx() & 63, qi = lane & 15, quad = lane >> 4;
  wt = __builtin_amdgcn_readfirstlane(wt);
  const int h = wt & 3; const int row0 = (wt >> 2) * 32; const int b = row0 >> 13;
  bf16x8 qf[2][4];
#pragma unroll
  for (int nt = 0; nt < 2; ++nt)
#pragma unroll
    for (int ks = 0; ks < 4; ++ks) qf[nt][ks] = *(const bf16x8*)(HQ + (long)(row0 + nt * 16 + qi) * 512 + h * 128 + ks * 32 + quad * 8);
  f32x4 oacc[2][8]; float m[2], l[2];
#pragma unroll
  for (int nt = 0; nt < 2; ++nt) { m[nt] = NEGF; l[nt] = 0.f;
#pragma unroll
    for (int dt = 0; dt < 8; ++dt) oacc[nt][dt] = (f32x4){0.f, 0.f, 0.f, 0.f}; }
  for (int blk = 0; blk < 8; ++blk) {
    const int key0 = blk * 32;
    f32x4 s[2][2];
#pragma unroll
    for (int nt = 0; nt < 2; ++nt)
#pragma unroll
      for (int kt = 0; kt < 2; ++kt) s[nt][kt] = (f32x4){0.f, 0.f, 0.f, 0.f};
#pragma unroll
    for (int ks = 0; ks < 4; ++ks) {
#pragma unroll
      for (int kt = 0; kt < 2; ++kt) {
        bf16x8 kf = *(const bf16x8*)(MK + (long)(b * 256 + key0 + kt * 16 + qi) * 512 + h * 128 + ks * 32 + quad * 8);
#pragma unroll
        for (int nt = 0; nt < 2; ++nt) s[nt][kt] = __builtin_amdgcn_mfma_f32_16x16x32_bf16(kf, qf[nt][ks], s[nt][kt], 0, 0, 0);
      }
    }
    bf16x8 pf[2];
#pragma unroll
    for (int nt = 0; nt < 2; ++nt) {
      float ml = NEGF;
#pragma unroll
      for (int kt = 0; kt < 2; ++kt)
#pragma unroll
        for (int r = 0; r < 4; ++r) ml = fmaxf(ml, s[nt][kt][r]);
      ml = fmaxf(ml, __shfl_xor(ml, 16, 64)); ml = fmaxf(ml, __shfl_xor(ml, 32, 64));
      const float mn = fmaxf(m[nt], ml); const float alpha = __builtin_amdgcn_exp2f(m[nt] - mn); m[nt] = mn;
      float p[8]; float ps = 0.f;
#pragma unroll
      for (int kt = 0; kt < 2; ++kt)
#pragma unroll
        for (int r = 0; r < 4; ++r) { p[kt * 4 + r] = __builtin_amdgcn_exp2f(s[nt][kt][r] - mn); ps += p[kt * 4 + r]; }
      l[nt] = l[nt] * alpha + ps;
#pragma unroll
      for (int dt = 0; dt < 8; ++dt) oacc[nt][dt] *= alpha;
      u32x4 pk; pk[0] = pack2(p[0], p[1]); pk[1] = pack2(p[2], p[3]); pk[2] = pack2(p[4], p[5]); pk[3] = pack2(p[6], p[7]);
      pf[nt] = __builtin_bit_cast(bf16x8, pk);
    }
#pragma unroll
    for (int dt = 0; dt < 8; ++dt) {
      const bf16_t* vp = MVT + (long)(b * 512 + h * 128 + dt * 16 + qi) * 256 + key0 + quad * 4;
      u32x2 lo = *(const u32x2*)(vp); u32x2 hi = *(const u32x2*)(vp + 16);
      u32x4 c; c[0] = lo[0]; c[1] = lo[1]; c[2] = hi[0]; c[3] = hi[1];
      const bf16x8 vf = __builtin_bit_cast(bf16x8, c);
#pragma unroll
      for (int nt = 0; nt < 2; ++nt) oacc[nt][dt] = __builtin_amdgcn_mfma_f32_16x16x32_bf16(vf, pf[nt], oacc[nt][dt], 0, 0, 0);
    }
  }
#pragma unroll
  for (int nt = 0; nt < 2; ++nt) {
    float lt = l[nt]; lt += __shfl_xor(lt, 16, 64); lt += __shfl_xor(lt, 32, 64);
    const float iv = 1.f / lt;
#pragma unroll
    for (int dt = 0; dt < 8; ++dt) {
      f32x4 v = oacc[nt][dt] * iv; u32x2 pk; pk[0] = pack2(v[0], v[1]); pk[1] = pack2(v[2], v[3]);
      *(u32x2*)(OX + (long)(row0 + nt * 16 + qi) * 512 + h * 128 + dt * 16 + quad * 4) = pk;
    }
  }
}


#define XB_TMO      128
#define XB_XCNT(j)  (256  + 64 * (j))
#define XB_XSUB(j)  (1280 + 64 * (j))
#define XB_XGEN(j)  (2304 + 64 * (j))
#define XB_TOP      3328
#define XB_TOPGEN   3392
#define XCD_BAR_WORDS 3456
#define XB_SPIN_CAP (1u << 18)
#define LAS __attribute__((address_space(3)))
__device__ __forceinline__ unsigned xb_ld(unsigned* p) { return __hip_atomic_load(p, __ATOMIC_RELAXED, __HIP_MEMORY_SCOPE_AGENT); }
__device__ __forceinline__ unsigned xb_add(unsigned* p, unsigned v) { return __hip_atomic_fetch_add(p, v, __ATOMIC_RELAXED, __HIP_MEMORY_SCOPE_AGENT); }
__device__ __forceinline__ unsigned xb_xcc_id() { return (unsigned)__builtin_amdgcn_s_getreg((3 << 11) | 20) & 0xFu; }
#define XB_SPIN(cond, bar) do { unsigned _sp = 0; while (cond) { __builtin_amdgcn_s_sleep(1); \
    if ((++_sp & 255u) == 0u) { if (xb_ld(&(bar)[XB_TMO])) break; if (_sp > XB_SPIN_CAP) { atomicAdd(&(bar)[XB_TMO], 1u); break; } } } } while (0)
__device__ __forceinline__ void xcd_barrier_complete(unsigned* bar, unsigned x, unsigned& nloc, unsigned& nx) {
  const unsigned G = gridDim.x * gridDim.y * gridDim.z;
  unsigned sum, cnt, mine, sp = 0u;
  for (;;) {
    sum = 0u; cnt = 0u; mine = 0u;
#pragma unroll
    for (unsigned j = 0; j < 16; ++j) { const unsigned c = xb_ld(&bar[XB_XCNT(j)]); sum += c; cnt += (c > 0u) ? 1u : 0u; mine = (j == x) ? c : mine; }
    if (sum == G) break;
    __builtin_amdgcn_s_sleep(1);
    if ((++sp & 255u) == 0u) { if (xb_ld(&bar[XB_TMO])) break; if (sp > XB_SPIN_CAP) { atomicAdd(&bar[XB_TMO], 1u); break; } }
  }
  nloc = mine > 0u ? mine : 1u; nx = cnt > 0u ? cnt : 1u;
}
__device__ __forceinline__ void xcd_barrier(unsigned* bar, unsigned x, unsigned& st_nloc, unsigned& st_nx) {
  asm volatile("s_waitcnt vmcnt(0)" ::: "memory");
  __syncthreads();
  if (threadIdx.x == 0) {
    __builtin_amdgcn_s_waitcnt(0);
    unsigned nloc = st_nloc, nx = st_nx;
    if (nloc == 0u) { xcd_barrier_complete(bar, x, nloc, nx); st_nloc = nloc; st_nx = nx; }
    const unsigned old = xb_add(&bar[XB_XSUB(x)], 1u);
    const unsigned gen = old / nloc;
    if (old + 1u == (gen + 1u) * nloc) {
      __builtin_amdgcn_fence(__ATOMIC_RELEASE, "agent");
      asm volatile("s_waitcnt vmcnt(0)" ::: "memory");
      const unsigned og = xb_add(&bar[XB_TOP], 1u);
      const unsigned tg = og / nx;
      if (og + 1u == (tg + 1u) * nx) xb_add(&bar[XB_TOPGEN], 1u);
      else XB_SPIN(xb_ld(&bar[XB_TOPGEN]) == tg, bar);
      __builtin_amdgcn_fence(__ATOMIC_ACQUIRE, "agent");
      xb_add(&bar[XB_XGEN(x)], 1u);
      asm volatile("s_waitcnt vmcnt(0)" ::: "memory");
    } else {
      XB_SPIN(xb_ld(&bar[XB_XGEN(x)]) == gen, bar);
      __builtin_amdgcn_fence(__ATOMIC_ACQUIRE, "agent");
      asm volatile("s_waitcnt vmcnt(0)" ::: "memory");
    }
  }
  __syncthreads();
}

__device__ void run_phase(const Params& P, int ph, char* smem, bool ph_fused) {
  char* ws = P.ws; const int tid = tidx();
  switch (ph) {
    case 0: phase0(P, smem); break;
    case 1: phase1(P, smem); break;
    case 2: phase2(P, smem); break;
    case 3: {
      for (int job = blockIdx.x; job < 512; job += gridDim.x) { const int wv = tidx() >> 6; nsa_tile(P, job * 4 + wv, smem + wv * 16896); }
      __syncthreads();
      for (int job = blockIdx.x; job < 512; job += gridDim.x) {
        {
          const int tid = tidx();
          const int s = job; const int bc = s >> 2, g = s & 3;
          RowLin ar{(const bf16_t*)(ws + OFF_WM) + g * 16384, 128};
          RowLin br{(const bf16_t*)(ws + OFF_C + C_GVT) + ((long)bc * 512 + g * 128) * 128, 128};
          const float* bs = P.b_sp + g * 128;
          const bf16_t* U = (const bf16_t*)(ws + OFF_C + C_U) + (long)bc * 128 * 512 + g * 128;
          bf16_t* OS = (bf16_t*)(ws + OFF_D) + (long)M_ * 512 + (long)bc * 128 * 512 + g * 128;
          gemm_tile(smem, ar, br, 2, 64, 64, [&](const float* Cs) {
#pragma unroll 2
            for (int it = 0; it < 8; ++it) {
              int id = it * 256 + tid; int r = id >> 4, c = (id & 15) * 8; float v[8]; ld8(Cs, r, c, v);
              u32x4 d = *(const u32x4*)(U + (long)r * 512 + c); const float bb = bs[r];
#pragma unroll
              for (int i = 0; i < 4; ++i) { v[2 * i] = (v[2 * i] + bb) * bf2f(d[i] & 0xffffu); v[2 * i + 1] = (v[2 * i + 1] + bb) * bf2f(d[i] >> 16); }
              *(u32x4*)(OS + (long)r * 512 + c) = pack8(v);
            }
          });
        }
      }
    } break;
    case 4: {
      float* scr = (float*)(ws + OFF_C + C_SCR) + (long)blockIdx.x * 16384;
      const int xq = blockIdx.x & 7, lq = blockIdx.x >> 3, sq = gridDim.x >> 3;
      for (int t = lq; t < 16 * 8; t += sq) {
        const int mt = xq * 16 + (t & 15), nt = t >> 4, brow = mt * 128, bcol = nt * 128;
        const bf16_t* MG = (const bf16_t*)(ws + OFF_B) + (long)brow * 2048 + bcol;
        RowLin a1{(const bf16_t*)(ws + OFF_D) + (long)brow * 512, 512};
        RowLin b1{(const bf16_t*)(ws + OFF_WPA) + (long)bcol * 512, 512};
        gemm_tile(smem, a1, b1, 8, 64, 64, [&](const float* Cs) {
#pragma unroll 2
          for (int it = 0; it < 8; ++it) {
            int id = it * 256 + tid; int r = id >> 4, c = (id & 15) * 8; float v[8]; ld8(Cs, r, c, v);
            u32x4 d = *(const u32x4*)(MG + (long)r * 2048 + c);
#pragma unroll
            for (int i = 0; i < 4; ++i) { v[2 * i] *= bf2f(d[i] & 0xffffu); v[2 * i + 1] *= bf2f(d[i] >> 16); }
            *(f32x4*)(scr + id * 8) = (f32x4){v[0], v[1], v[2], v[3]}; *(f32x4*)(scr + id * 8 + 4) = (f32x4){v[4], v[5], v[6], v[7]};
          }
        });
        RowLin a2{(const bf16_t*)(ws + OFF_D) + (long)M_ * 512 + (long)brow * 512, 512};
        RowLin b2{(const bf16_t*)(ws + OFF_WPB) + (long)bcol * 512, 512};
        bf16_t* MX = (bf16_t*)(ws + OFF_C + C_MIXED) + (long)brow * 1024 + bcol;
        gemm_tile(smem, a2, b2, 8, 64, 64, [&](const float* Cs) {
#pragma unroll 2
          for (int it = 0; it < 8; ++it) {
            int id = it * 256 + tid; int r = id >> 4, c = (id & 15) * 8; float v[8]; ld8(Cs, r, c, v);
            u32x4 d = *(const u32x4*)(MG + (long)r * 2048 + 1024 + c);
            f32x4 p0 = *(const f32x4*)(scr + id * 8), p1 = *(const f32x4*)(scr + id * 8 + 4);
            float pv[8] = {p0[0], p0[1], p0[2], p0[3], p1[0], p1[1], p1[2], p1[3]};
#pragma unroll
            for (int i = 0; i < 4; ++i) { v[2 * i] = pv[2 * i] + v[2 * i] * bf2f(d[i] & 0xffffu); v[2 * i + 1] = pv[2 * i + 1] + v[2 * i + 1] * bf2f(d[i] >> 16); }
            *(u32x4*)(MX + (long)r * 1024 + c) = pack8(v);
          }
        });
      }
    } break;
    case 5: case 9: case 12: {
      const bf16_t* A; const bf16_t* W; const float* RES; float* DST; int K;
      if (ph == 5) { A = (const bf16_t*)(ws + OFF_C + C_MIXED); W = (const bf16_t*)(ws + OFF_WOUT); RES = P.x; DST = (float*)(ws + OFF_B); K = 1024; }
      else if (ph == 9) { A = (const bf16_t*)(ws + OFF_D) + (long)M_ * 512; W = (const bf16_t*)(ws + OFF_WMO); RES = (const float*)(ws + OFF_B); DST = (float*)(ws + OFF_C + C_H2); K = 512; }
      else { A = (const bf16_t*)(ws + OFF_B); W = (const bf16_t*)(ws + OFF_WDN); RES = (const float*)(ws + OFF_C + C_H2); DST = P.out; K = 2816; }
      const int xq = blockIdx.x & 7, lq = blockIdx.x >> 3, sq = gridDim.x >> 3;
      for (int t = lq; t < 16 * 4; t += sq) {
        const int mt = xq * 16 + (t & 15), nt2 = t >> 4, brow = mt * 128;
        RowLin ar{A + (long)brow * K, K}; RowLin br{W + (long)nt2 * 256 * K, K};
        gemm_tile2(smem, ar, br, K / 64, [&](const float* Cs, int p) {
          const int bcol = nt2 * 256 + p * 128;
          const float* rs = RES + (long)brow * 1024 + bcol; float* ds = DST + (long)brow * 1024 + bcol;
#pragma unroll 2
          for (int it = 0; it < 8; ++it) {
            int id = it * 256 + tid; int r = id >> 4, c = (id & 15) * 8;
            f32x4 a = *(const f32x4*)(Cs + r * CS_LD + c), bq = *(const f32x4*)(Cs + r * CS_LD + c + 4);
            f32x4 r0 = __builtin_nontemporal_load((const f32x4*)(rs + (long)r * 1024 + c)), r1 = __builtin_nontemporal_load((const f32x4*)(rs + (long)r * 1024 + c + 4));
            const f32x4 h0 = a + r0, h1v = bq + r1;
            *(f32x4*)(ds + (long)r * 1024 + c) = h0; *(f32x4*)(ds + (long)r * 1024 + c + 4) = h1v;
            if (ph != 12) {
              const float* gn = (ph == 5 ? P.norm_mq : P.norm_ffn) + bcol + c;
              const f32x4 g0 = *(const f32x4*)gn, g1 = *(const f32x4*)(gn + 4);
              float v[8] = {h0[0] * g0[0], h0[1] * g0[1], h0[2] * g0[2], h0[3] * g0[3], h1v[0] * g1[0], h1v[1] * g1[1], h1v[2] * g1[2], h1v[3] * g1[3]};
              *(u32x4*)((bf16_t*)(ws + OFF_A) + (long)(brow + r) * 1024 + bcol + c) = pack8(v);
              float ss = (h0[0] * h0[0] + h0[1] * h0[1]) + (h0[2] * h0[2] + h0[3] * h0[3]) + (h1v[0] * h1v[0] + h1v[1] * h1v[1]) + (h1v[2] * h1v[2] + h1v[3] * h1v[3]);
              ss += __shfl_xor(ss, 1, 64); ss += __shfl_xor(ss, 2, 64); ss += __shfl_xor(ss, 4, 64); ss += __shfl_xor(ss, 8, 64);
              if ((tid & 15) == 0) ((float*)(ws + (ph == 5 ? OFF_SSQ1 : OFF_SSQ2)))[(long)(brow + r) * 8 + nt2 * 2 + p] = ss;
            }
          }
        });
      }
    } break;
    case 6: case 10: {
      const float* src = ph == 6 ? (const float*)(ws + OFF_B) : (const float*)(ws + OFF_C + C_H2);
      const float* g = ph == 6 ? P.norm_mq : P.norm_ffn;
      (void)src; (void)g;
    } break;
    case 7: {
      const int xq = blockIdx.x & 7, lq = blockIdx.x >> 3, sq = gridDim.x >> 3;
      for (int t = lq; t < 16 * 4; t += sq) {
        const int mt = xq * 16 + (t & 15), nt = t >> 4, brow = mt * 128;
        RowLin ar{(const bf16_t*)(ws + OFF_A) + (long)brow * 1024, 1024}; RowLin br{(const bf16_t*)(ws + OFF_WMQ) + (long)nt * 128 * 1024, 1024};
        gemm_tile(smem, ar, br, 16, 64, 64, [&](const float* Cs) {
          bf16_t* dq = (bf16_t*)(ws + OFF_D) + (long)brow * 512 + nt * 128; const float* sq1 = (const float*)(ws + OFF_SSQ1) + (long)brow * 8;
#pragma unroll 2
          for (int it = 0; it < 8; ++it) {
            int id = it * 256 + tid; int r = id >> 4, c = (id & 15) * 8; float v[8]; ld8(Cs, r, c, v);
            const f32x4 s0 = *(const f32x4*)(sq1 + r * 8), s1 = *(const f32x4*)(sq1 + r * 8 + 4);
            const float ssum = ((s0[0] + s0[1]) + (s0[2] + s0[3])) + ((s1[0] + s1[1]) + (s1[2] + s1[3]));
            const float rr = rsqrtf(ssum * (1.f / 1024.f) + 1e-6f) * (0.08838834764831845f * LOG2E);
#pragma unroll
            for (int i = 0; i < 8; ++i) v[i] *= rr;
            *(u32x4*)(dq + (long)r * 512 + c) = pack8(v);
          }
        });
        asm volatile("s_waitcnt vmcnt(0)" ::: "memory");
        __syncthreads();
        xattn_tile(P, ((brow >> 5) + (tid >> 6)) * 4 + nt);
      }
    } break;
    case 8: {
      if (ph_fused) break;
      for (int job = blockIdx.x; job < 512; job += gridDim.x) xattn_tile(P, job * 4 + (tid >> 6));
    } break;
    case 11: {
      const int xq = blockIdx.x & 7, lq = blockIdx.x >> 3, sq = gridDim.x >> 3;
      for (int t = lq; t < 16 * 22; t += sq) {
        const int mt = xq * 16 + (t & 15), nt2 = t >> 4, brow = mt * 128;
        RowLin ar{(const bf16_t*)(ws + OFF_A) + (long)brow * 1024, 1024}; RowLin br{(const bf16_t*)(ws + OFF_WGU) + (long)nt2 * 256 * 1024, 1024};
        gemm_tile2(smem, ar, br, 16, [&](const float* Cs, int p) {
          bf16_t* ACT = (bf16_t*)(ws + OFF_B) + (long)brow * 2816 + (nt2 * 2 + p) * 64;
#pragma unroll 2
          for (int it = 0; it < 4; ++it) {
            int id = it * 256 + tid; int r = id >> 3, c = (id & 7) * 8; float gt[8], up[8]; ld8(Cs, r, c, gt); ld8(Cs, r, c + 64, up);
            const float* sq2 = (const float*)(ws + OFF_SSQ2) + (long)(brow + r) * 8;
            const f32x4 s0 = *(const f32x4*)(sq2), s1 = *(const f32x4*)(sq2 + 4);
            const float ssum = ((s0[0] + s0[1]) + (s0[2] + s0[3])) + ((s1[0] + s1[1]) + (s1[2] + s1[3]));
            const float rr = rsqrtf(ssum * (1.f / 1024.f) + 1e-6f);
#pragma unroll
            for (int i = 0; i < 8; ++i) { const float gg = gt[i] * rr; gt[i] = gg * sigm(gg) * (up[i] * rr); }
            __builtin_nontemporal_store(pack8(gt), (u32x4*)(ACT + (long)r * 2816 + c));
          }
        });
      }
    } break;
    case 13: {
      for (int job = blockIdx.x; job < 1024; job += gridDim.x) { int row = job * 16 + (tid >> 6) * 4; rownorm_rows<true, 4>(P.out + (long)row * 1024, P.norm_final, P.out + (long)row * 1024); }
    } break;
#ifdef PROBE_K
    case 14: {
      const bf16_t* s0 = (const bf16_t*)(ws + PROBE_SRC0); const bf16_t* s1 = (const bf16_t*)(ws + PROBE_SRC1);
      for (long i = (long)blockIdx.x * 256 + tid; i < (long)M_ * 512; i += (long)gridDim.x * 256) {
        long row = i >> 9; int c = (int)(i & 511);
        P.out[row * 1024 + c] = bf2f(s0[i]); P.out[row * 1024 + 512 + c] = bf2f(s1[i]);
      }
    } break;
    case 15: {
      const float* s0 = (const float*)(ws + PROBE_SRC0);
      for (long i = (long)blockIdx.x * 256 + tid; i < (long)M_ * 1024; i += (long)gridDim.x * 256) P.out[i] = s0[i];
    } break;
#endif
  }
}

__global__ void __launch_bounds__(256, 2) fwd_kernel(Params P, int ph_lo, int ph_hi) {
  __shared__ __attribute__((aligned(16))) char smem[81920];
  unsigned st_nloc = 0u, st_nx = 0u;
  const unsigned xcc = xb_xcc_id();
  if (ph_lo < ph_hi) {
    if (threadIdx.x == 0) (void)xb_add(&((unsigned*)(P.ws + OFF_BAR))[XB_XCNT(xcc)], 1u);
  }
  if (ph_hi < 0) cg::this_grid().sync();
  for (int ph = ph_lo; ph <= ph_hi; ++ph) {
    const uint64_t __attribute__((address_space(4)))* ka = (const uint64_t __attribute__((address_space(4)))*)__builtin_amdgcn_kernarg_segment_ptr();
    asm volatile("" : "+s"(ka));
    Params Pl; uint64_t* pd = (uint64_t*)&Pl;
#pragma unroll
    for (int i = 0; i < (int)(sizeof(Params) / 8); ++i) {
      const char __attribute__((address_space(1)))* gp = (const char __attribute__((address_space(1)))*)ka[i];
      pd[i] = (uint64_t)(const char*)gp;
    }
    if (ph == 6 || ph == 10 || ph == 8) continue;
    run_phase(Pl, ph, smem, true);
    if (ph < ph_hi) xcd_barrier((unsigned*)(Pl.ws + OFF_BAR), xcc, st_nloc, st_nx);
  }
}

extern "C" void kernel_launch(void* const* d_in, const int* in_sizes, int n_in, void* d_out, int out_size, void* d_ws, size_t ws_size,
                              hipStream_t stream) {
  static int grid_blocks = 0;
  if (!grid_blocks) {
    int dev = 0, cus = 0, per_cu = 0;
    hipGetDevice(&dev);
    hipDeviceGetAttribute(&cus, hipDeviceAttributeMultiprocessorCount, dev);
    hipOccupancyMaxActiveBlocksPerMultiprocessor(&per_cu, fwd_kernel, 256, 0);
    if (per_cu > 2) per_cu = 2;
    if (per_cu < 1) per_cu = 1;
    grid_blocks = cus * per_cu;
  }
  if (ws_size < (size_t)WS_NEED) fprintf(stderr, "workspace too small: %zu < %ld\n", ws_size, (long)WS_NEED);
  Params P{};
  const float** pp = (const float**)&P;
  for (int i = 0; i < 27; ++i) pp[i] = (const float*)d_in[i];
  P.out = (float*)d_out; P.ws = (char*)d_ws;
#if ONE_LAUNCH
  hipMemsetAsync((char*)d_ws + OFF_BAR, 0, XCD_BAR_WORDS * 4, stream);
#ifdef PROBE_K
  int lo = 0, hi = PROBE_DUMP;
#else
  int lo = 0, hi = 13;
#endif
  void* args[] = {&P, &lo, &hi};
  hipError_t e = hipLaunchCooperativeKernel((void*)fwd_kernel, dim3(grid_blocks), dim3(256), args, 0, stream);
  if (e != hipSuccess) fprintf(stderr, "cooperative launch failed: %s (grid %d)\n", hipGetErrorString(e), grid_blocks);
#else
  for (int ph = 0; ph <= 13; ++ph) fwd_kernel<<<grid_blocks, 256, 0, stream>>>(P, ph, ph);
#endif
}
```
